# Optimizing an MI355X kernel written in HIP

```python
import math
import jax, jax.numpy as jnp
from jax import lax
import numpy as np

D_MODEL = 1024
BATCH = 16
SEQ = 2048
DEPTH = 2
DEC_BATCH = 8
DEC_SEQ = 2048
PAST_LEN = 128

HY_WIDTH = D_MODEL // 2
HY_ORDER = 2
FILT_EMB = 33
FILT_BANDS = (FILT_EMB - 1) // 2
FILT_HIDDEN = 64
DECAY_TARGET = 1e-2
FAST_DECAY_PCT = 0.3
SLOW_DECAY_PCT = 1.5
N_DIR = 2
HEAD_DIM = 64
N_Q_HEADS = (D_MODEL // 2) // HEAD_DIM
N_KV_HEADS = 2
GQA_GROUP = N_Q_HEADS // N_KV_HEADS
WINDOW = 128
BLOCK = 128
ROPE_THETA = 10000.0
ATTN_WIDTH = N_Q_HEADS * HEAD_DIM
KV_WIDTH = N_KV_HEADS * HEAD_DIM
HY_COLS = (HY_ORDER + 1) * HY_WIDTH
IN_COLS = HY_COLS + ATTN_WIDTH + 2 * KV_WIDTH + 2 * D_MODEL
SPLITS = (HY_COLS, HY_COLS + ATTN_WIDTH, HY_COLS + ATTN_WIDTH + KV_WIDTH,
          HY_COLS + ATTN_WIDTH + 2 * KV_WIDTH, HY_COLS + ATTN_WIDTH + 2 * KV_WIDTH + D_MODEL)
PEER_HEADS = 8
N_KEYS = 128
N_EXPERTS = N_KEYS * N_KEYS
PEER_TOPK = 16
PEER_QDIM = 256
PEER_HALF = PEER_QDIM // 2
PEER_CHUNK = 128
EPS = 1e-6

kernel_name = "hybrid_hyena_swa_peer_encoder"


def rmsnorm(x, gain):
    x32 = x.astype(jnp.float32)
    y = x32 * lax.rsqrt(jnp.mean(x32 * x32, axis=-1, keepdims=True) + EPS)
    return y.astype(x.dtype) * gain


def rope(x):
    L = x.shape[1]
    inv = ROPE_THETA ** (-jnp.arange(0, HEAD_DIM, 2, dtype=jnp.float32) / HEAD_DIM)
    ang = jnp.arange(L, dtype=jnp.float32)[:, None] * inv[None, :]
    cos = jnp.cos(ang)[None, :, None, :]
    sin = jnp.sin(ang)[None, :, None, :]
    x32 = x.astype(jnp.float32)
    x1, x2 = x32[..., :HEAD_DIM // 2], x32[..., HEAD_DIM // 2:]
    return jnp.concatenate([x1 * cos - x2 * sin, x2 * cos + x1 * sin], axis=-1).astype(x.dtype)


def implicit_filters(L, w1, b1, freq, w2, b2, w3):
    f32 = jnp.float32
    t = jnp.linspace(0.0, 1.0, L, dtype=f32)[:, None]
    w = 2.0 * math.pi * jnp.arange(L, dtype=f32)[:, None] / L
    bands = jnp.linspace(1e-4, FILT_BANDS - 1, FILT_BANDS, dtype=f32)[None, :]
    z = jnp.concatenate([t, jnp.cos(bands * w), -jnp.sin(bands * w)], axis=-1)
    fr = freq.astype(f32)
    a = jnp.sin(fr * (z @ w1.astype(f32) + b1.astype(f32)))
    a = jnp.sin(fr * (a @ w2.astype(f32) + b2.astype(f32)))
    hf = (a @ w3.astype(f32)).reshape(L, HY_ORDER, N_DIR, HY_WIDTH)
    max_decay = math.log(DECAY_TARGET) / FAST_DECAY_PCT
    min_decay = math.log(DECAY_TARGET) / SLOW_DECAY_PCT
    deltas = jnp.linspace(min_decay, max_decay, HY_WIDTH, dtype=f32)
    hf = hf * jnp.exp(-t * jnp.abs(deltas))[:, None, None, :]
    h_full = jnp.concatenate([hf[:, :, 0], jnp.zeros((1, HY_ORDER, HY_WIDTH), f32), hf[:0:-1, :, 1]], axis=0)
    return jnp.fft.rfft(h_full, axis=0)


def fftconv(u, Hf, bias):
    L = u.shape[1]
    u32 = u.astype(jnp.float32)
    U = jnp.fft.rfft(u32, n=2 * L, axis=1)
    y = jnp.fft.irfft(U * Hf[None], n=2 * L, axis=1)[:, :L]
    return (y + u32 * bias.astype(jnp.float32)).astype(u.dtype)


def window_attention(q, k, v, sink):
    B, L = q.shape[0], q.shape[1]
    nb = L // BLOCK
    qb = q.reshape(B, nb, BLOCK, N_KV_HEADS, GQA_GROUP, HEAD_DIM)
    pad = ((0, 0), (BLOCK, BLOCK), (0, 0), (0, 0))
    kp = jnp.pad(k, pad).reshape(B, nb + 2, BLOCK, N_KV_HEADS, HEAD_DIM)
    vp = jnp.pad(v, pad).reshape(B, nb + 2, BLOCK, N_KV_HEADS, HEAD_DIM)
    kb = jnp.concatenate([kp[:, :-2], kp[:, 1:-1], kp[:, 2:]], axis=2)
    vb = jnp.concatenate([vp[:, :-2], vp[:, 1:-1], vp[:, 2:]], axis=2)
    s = jnp.einsum('bnqkgd,bnjkd->bnkgqj', qb, kb).astype(jnp.float32) * (HEAD_DIM ** -0.5)
    blk = jnp.arange(nb)[:, None, None] * BLOCK
    qpos = blk + jnp.arange(BLOCK)[None, :, None]
    kpos = blk - BLOCK + jnp.arange(3 * BLOCK)[None, None, :]
    valid = (jnp.abs(kpos - qpos) <= WINDOW) & (kpos >= 0) & (kpos < L)
    s = jnp.where(valid[None, :, None, None], s, -jnp.inf)
    sk = sink.astype(jnp.float32).reshape(N_KV_HEADS, GQA_GROUP)[None, None, :, :, None, None]
    m = jnp.maximum(jnp.max(s, axis=-1, keepdims=True), sk)
    p = jnp.exp(s - m)
    p = p / (jnp.sum(p, axis=-1, keepdims=True) + jnp.exp(sk - m))
    o = jnp.einsum('bnkgqj,bnjkd->bnqkgd', p.astype(v.dtype), vb)
    return o.reshape(B, L, ATTN_WIDTH)


def token_mixer(h, w_in, conv_w, conv_b, f_w1, f_b1, f_freq, f_w2, f_b2, f_w3, f_bias,
                q_gain, k_gain, sink, w_pa, w_pb, w_out):
    B, L, _ = h.shape
    z = h @ w_in
    hy, q, k, v, ga, gb = jnp.split(z, SPLITS, axis=-1)
    hp = jnp.pad(hy, ((0, 0), (1, 1), (0, 0)))
    hy = hp[:, :-2] * conv_w[0] + hp[:, 1:-1] * conv_w[1] + hp[:, 2:] * conv_w[2] + conv_b
    v0, x1, x2 = jnp.split(hy, HY_ORDER + 1, axis=-1)
    Hf = implicit_filters(L, f_w1, f_b1, f_freq, f_w2, f_b2, f_w3)
    zz = x1 * fftconv(v0, Hf[:, 0], f_bias[0])
    ya = x2 * fftconv(zz, Hf[:, 1], f_bias[1])
    q = rope(rmsnorm(q.reshape(B, L, N_Q_HEADS, HEAD_DIM), q_gain))
    k = rope(rmsnorm(k.reshape(B, L, N_KV_HEADS, HEAD_DIM), k_gain))
    v = v.reshape(B, L, N_KV_HEADS, HEAD_DIM)
    yb = window_attention(q, k, v, sink)
    merged = jax.nn.sigmoid(ga) * (ya @ w_pa) + jax.nn.sigmoid(gb) * (yb @ w_pb)
    return merged @ w_out


def peer(h, wq, k1, k2, u_tab, v_tab):
    B, L, D = h.shape
    T = B * L
    ht = h.reshape(T, D)
    q = (ht @ wq).reshape(T, PEER_HEADS, PEER_QDIM)
    s1 = jnp.einsum('thd,nd->thn', q[..., :PEER_HALF], k1).astype(jnp.float32)
    s2 = jnp.einsum('thd,nd->thn', q[..., PEER_HALF:], k2).astype(jnp.float32)
    v1, i1 = lax.top_k(s1, PEER_TOPK)
    v2, i2 = lax.top_k(s2, PEER_TOPK)
    cand = (v1[..., :, None] + v2[..., None, :]).reshape(T, PEER_HEADS, PEER_TOPK * PEER_TOPK)
    vs, ic = lax.top_k(cand, PEER_TOPK)
    e1 = jnp.take_along_axis(i1, ic // PEER_TOPK, axis=-1)
    e2 = jnp.take_along_axis(i2, ic % PEER_TOPK, axis=-1)
    idx = e1 * N_KEYS + e2
    g = jax.nn.softmax(vs, axis=-1).astype(h.dtype)
    nc = T // PEER_CHUNK

    def chunk(args):
        xc, ec, gc = args
        a = jnp.einsum('td,thkd->thk', xc, u_tab[ec])
        w = gc * jax.nn.gelu(a, approximate=False)
        return jnp.einsum('thk,thkd->td', w, v_tab[ec])

    y = lax.map(chunk, (ht.reshape(nc, PEER_CHUNK, D),
                        idx.reshape(nc, PEER_CHUNK, PEER_HEADS, PEER_TOPK),
                        g.reshape(nc, PEER_CHUNK, PEER_HEADS, PEER_TOPK)))
    return y.reshape(B, L, D)


def trunk(x, c, w_mod, b_mod, g_norm1, g_norm2, w_in, conv_w, conv_b, f_w1, f_b1, f_freq, f_w2, f_b2, f_w3,
          f_bias, q_gain, k_gain, sink, w_pa, w_pb, w_out, peer_wq, peer_k1, peer_k2, peer_u, peer_v):
    for l in range(DEPTH):
        mod = jax.nn.silu(c) @ w_mod[l] + b_mod[l]
        sh1, sc1, gt1, sh2, sc2, gt2 = [m[:, None, :] for m in jnp.split(mod, 6, axis=-1)]
        h = rmsnorm(x, g_norm1[l]) * (1.0 + sc1) + sh1
        x = x + gt1 * token_mixer(h, w_in[l], conv_w[l], conv_b[l], f_w1[l], f_b1[l], f_freq[l], f_w2[l],
                                  f_b2[l], f_w3[l], f_bias[l], q_gain[l], k_gain[l], sink[l],
                                  w_pa[l], w_pb[l], w_out[l])
        h = rmsnorm(x, g_norm2[l]) * (1.0 + sc2) + sh2
        x = x + gt2 * peer(h, peer_wq[l], peer_k1[l], peer_k2[l], peer_u[l], peer_v[l])
    return x


def setup_inputs(seed: int = 0) -> dict:
    key = jax.random.key(seed)
    ks = iter(jax.random.split(key, 32))
    f32 = jnp.float32

    def nrm(shape, scale):
        return jax.random.normal(next(ks), shape, f32) * scale

    def gain(shape):
        return 1.0 + nrm(shape, 0.02)

    D = D_MODEL
    return {
        'x_prompt': nrm((BATCH, SEQ, D), 1.0),
        'x_sample': nrm((DEC_BATCH, DEC_SEQ, D), 1.0),
        'c_prompt': nrm((BATCH, D), 1.0),
        'c_sample': nrm((DEC_BATCH, D), 1.0),
        'w_mod': nrm((DEPTH, D, 6 * D), 0.5 * D ** -0.5),
        'b_mod': nrm((DEPTH, 6 * D), 0.02),
        'g_norm1': gain((DEPTH, D)),
        'g_norm2': gain((DEPTH, D)),
        'w_in': nrm((DEPTH, D, IN_COLS), D ** -0.5),
        'conv_w': nrm((DEPTH, 3, HY_COLS), 3 ** -0.5),
        'conv_b': nrm((DEPTH, HY_COLS), 0.02),
        'f_w1': nrm((DEPTH, FILT_EMB, FILT_HIDDEN), FILT_EMB ** -0.5),
        'f_b1': nrm((DEPTH, FILT_HIDDEN), 0.02),
        'f_freq': gain((DEPTH, FILT_HIDDEN)),
        'f_w2': nrm((DEPTH, FILT_HIDDEN, FILT_HIDDEN), FILT_HIDDEN ** -0.5),
        'f_b2': nrm((DEPTH, FILT_HIDDEN), 0.02),
        'f_w3': nrm((DEPTH, FILT_HIDDEN, HY_ORDER * N_DIR * HY_WIDTH), 0.02),
        'f_bias': nrm((DEPTH, HY_ORDER, HY_WIDTH), 0.5),
        'q_gain': gain((DEPTH, HEAD_DIM)),
        'k_gain': gain((DEPTH, HEAD_DIM)),
        'sink': nrm((DEPTH, N_Q_HEADS), 0.5),
        'w_pa': nrm((DEPTH, HY_WIDTH, D), HY_WIDTH ** -0.5),
        'w_pb': nrm((DEPTH, ATTN_WIDTH, D), ATTN_WIDTH ** -0.5),
        'w_out': nrm((DEPTH, D, D), D ** -0.5),
        'peer_wq': nrm((DEPTH, D, PEER_HEADS * PEER_QDIM), D ** -0.5),
        'peer_k1': nrm((DEPTH, N_KEYS, PEER_HALF), PEER_HALF ** -0.5),
        'peer_k2': nrm((DEPTH, N_KEYS, PEER_HALF), PEER_HALF ** -0.5),
        'peer_u': nrm((DEPTH, N_EXPERTS, D), D ** -0.5),
        'peer_v': nrm((DEPTH, N_EXPERTS, D), PEER_HEADS ** -0.5),
    }


def reference(x_prompt, x_sample, c_prompt, c_sample, w_mod, b_mod, g_norm1, g_norm2, w_in, conv_w, conv_b,
              f_w1, f_b1, f_freq, f_w2, f_b2, f_w3, f_bias, q_gain, k_gain, sink, w_pa, w_pb, w_out,
              peer_wq, peer_k1, peer_k2, peer_u, peer_v):
    y_prompt = trunk(x_prompt, c_prompt, w_mod, b_mod, g_norm1, g_norm2, w_in, conv_w, conv_b, f_w1, f_b1,
                     f_freq, f_w2, f_b2, f_w3, f_bias, q_gain, k_gain, sink, w_pa, w_pb, w_out,
                     peer_wq, peer_k1, peer_k2, peer_u, peer_v)
    y_sample = trunk(x_sample, c_sample, w_mod, b_mod, g_norm1, g_norm2, w_in, conv_w, conv_b, f_w1, f_b1,
                     f_freq, f_w2, f_b2, f_w3, f_bias, q_gain, k_gain, sink, w_pa, w_pb, w_out,
                     peer_wq, peer_k1, peer_k2, peer_u, peer_v)
    return (y_prompt, y_sample)
```

```cpp
#include <hip/hip_runtime.h>
#include <hip/hip_bf16.h>
#include <hip/hip_cooperative_groups.h>
#include <cstdio>
#include <cstdint>
namespace cg = cooperative_groups;

typedef unsigned short bf16_t;
using bf16x8 = __attribute__((ext_vector_type(8))) short;
using f32x16 = __attribute__((ext_vector_type(16))) float;

constexpr int DM = 1024;
constexpr int NB = 24;
constexpr int SEQ = 2048;
constexpr int NTOK = NB * SEQ;
constexpr int NBP = 16;
constexpr int INC = 4352;
constexpr int HYC = 1536;
constexpr int HYW = 512;
constexpr int QKVC = 768;
constexpr int TM = 192;
constexpr int NTILE = NTOK / TM;
constexpr int NTHR = 512;
constexpr int NEXP = 16384;
constexpr int SMEM_BYTES = 155648;

struct Params {
  const float *x_prompt, *x_sample, *c_prompt, *c_sample, *w_mod, *b_mod, *g1, *g2, *w_in, *conv_w, *conv_b;
  const float *f_w1, *f_b1, *f_freq, *f_w2, *f_b2, *f_w3, *f_bias, *q_gain, *k_gain, *sink, *w_pa, *w_pb, *w_out;
  const float *peer_wq, *peer_k1, *peer_k2, *peer_u, *peer_v;
  float* out;
  bf16_t *WinT, *WpaT, *WpbT, *WoutT, *WcT, *Gf, *tabU, *tabV, *zT, *zqkv, *yaT, *yb, *hbuf, *merged, *yatok;
  unsigned short* pidx;
  float *pg, *mod, *rope;
};

__device__ __forceinline__ float bf2f(bf16_t v) { return __uint_as_float(((unsigned)v) << 16); }
__device__ __forceinline__ bf16_t f2bf(float f) {
  unsigned u = __float_as_uint(f);
  u += 0x7FFFu + ((u >> 16) & 1u);
  return (bf16_t)(u >> 16);
}
__device__ __forceinline__ unsigned pack2(float a, float b) { return (unsigned)f2bf(a) | ((unsigned)f2bf(b) << 16); }
__device__ __forceinline__ float lo2f(unsigned u) { return __uint_as_float(u << 16); }
__device__ __forceinline__ float hi2f(unsigned u) { return __uint_as_float(u & 0xFFFF0000u); }

__device__ __forceinline__ int otid() { int t = threadIdx.x; asm volatile("" : "+v"(t)); return t; }
__device__ __forceinline__ int osgpr(int x) { asm volatile("" : "+s"(x)); return x; }
__device__ __forceinline__ float wave_sum(float v) {
#pragma unroll
  for (int m = 32; m >= 1; m >>= 1) v += __shfl_xor(v, m, 64);
  return v;
}

__device__ __forceinline__ const float* xrow_in(const Params& p, int tok) {
  return (tok < NBP * SEQ) ? (p.x_prompt + (size_t)tok * DM) : (p.x_sample + (size_t)(tok - NBP * SEQ) * DM);
}
__device__ __forceinline__ const float* crow(const Params& p, int b) {
  return (b < NBP) ? (p.c_prompt + (size_t)b * DM) : (p.c_sample + (size_t)(b - NBP) * DM);
}

constexpr int LDS_ROW = 72;
constexpr int STAGE_ELEMS = (192 + 128) * LDS_ROW;
constexpr int GEMM_LDS_BYTES = 2 * STAGE_ELEMS * 2;

__device__ __forceinline__ void gemm_core(const bf16_t* __restrict__ A, int lda, const bf16_t* __restrict__ B, int ldb,
                                          int K, bf16_t* lds, f32x16 (&acc)[3]) {
  const int tid = otid();
  const int lane = tid & 63, w = tid >> 6;
  const int wm = w >> 2, wn = w & 3;
#pragma unroll
  for (int i = 0; i < 3; ++i)
#pragma unroll
    for (int j = 0; j < 16; ++j) acc[i][j] = 0.f;

  const int crow_ = tid >> 3, ckc = (tid & 7) * 8;
  const bf16_t* pa0 = A + (size_t)crow_ * lda + ckc;
  const bf16_t* pa1 = A + (size_t)(crow_ + 64) * lda + ckc;
  const bf16_t* pa2 = A + (size_t)(crow_ + 128) * lda + ckc;
  const bf16_t* pb0 = B + (size_t)crow_ * ldb + ckc;
  const bf16_t* pb1 = B + (size_t)(crow_ + 64) * ldb + ckc;
  const int la = crow_ * LDS_ROW + ckc;
  const int nk = K >> 6;

  uint4 ra0, ra1, ra2, rb0, rb1;
  ra0 = *(const uint4*)pa0; ra1 = *(const uint4*)pa1; ra2 = *(const uint4*)pa2;
  rb0 = *(const uint4*)pb0; rb1 = *(const uint4*)pb1;
  __syncthreads();
  {
    bf16_t* As = lds; bf16_t* Bs = lds + 192 * LDS_ROW;
    *(uint4*)(As + la) = ra0; *(uint4*)(As + la + 64 * LDS_ROW) = ra1; *(uint4*)(As + la + 128 * LDS_ROW) = ra2;
    *(uint4*)(Bs + la) = rb0; *(uint4*)(Bs + la + 64 * LDS_ROW) = rb1;
  }
  __syncthreads();
  const int fr = lane & 31, fh = (lane >> 5) * 8;
  for (int kt = 0; kt < nk; ++kt) {
    if (kt + 1 < nk) {
      const int ko = (kt + 1) << 6;
      ra0 = *(const uint4*)(pa0 + ko); ra1 = *(const uint4*)(pa1 + ko); ra2 = *(const uint4*)(pa2 + ko);
      rb0 = *(const uint4*)(pb0 + ko); rb1 = *(const uint4*)(pb1 + ko);
    }
    const bf16_t* As = lds + (kt & 1) * STAGE_ELEMS;
    const bf16_t* Bs = As + 192 * LDS_ROW;
#pragma unroll
    for (int kk = 0; kk < 4; ++kk) {
      const int ko = kk * 16 + fh;
      bf16x8 bfrag = *(const bf16x8*)(Bs + (wn * 32 + fr) * LDS_ROW + ko);
#pragma unroll
      for (int mi = 0; mi < 3; ++mi) {
        bf16x8 afrag = *(const bf16x8*)(As + (wm * 96 + mi * 32 + fr) * LDS_ROW + ko);
        acc[mi] = __builtin_amdgcn_mfma_f32_32x32x16_bf16(afrag, bfrag, acc[mi], 0, 0, 0);
      }
    }
    if (kt + 1 < nk) {
      bf16_t* As2 = lds + ((kt + 1) & 1) * STAGE_ELEMS; bf16_t* Bs2 = As2 + 192 * LDS_ROW;
      *(uint4*)(As2 + la) = ra0; *(uint4*)(As2 + la + 64 * LDS_ROW) = ra1; *(uint4*)(As2 + la + 128 * LDS_ROW) = ra2;
      *(uint4*)(Bs2 + la) = rb0; *(uint4*)(Bs2 + la + 64 * LDS_ROW) = rb1;
    }
    __syncthreads();
  }
}
#define ACC_ROW(wm, mi, reg, lane) ((wm) * 96 + (mi) * 32 + ((reg) & 3) + 8 * ((reg) >> 2) + 4 * ((lane) >> 5))
#define ACC_COL(wn, lane) ((wn) * 32 + ((lane) & 31))

__device__ __forceinline__ void acc_to_lds(const f32x16 (&acc)[3], float* ct, int LD) {
  const int tid_ = otid(); const int lane = tid_ & 63, w = tid_ >> 6, wm = w >> 2, wn = w & 3;
  const int n = ACC_COL(wn, lane);
#pragma unroll
  for (int mi = 0; mi < 3; ++mi)
#pragma unroll
    for (int r = 0; r < 16; ++r) ct[ACC_ROW(wm, mi, r, lane) * LD + n] = acc[mi][r];
}
constexpr int LDT = 196;
__device__ __forceinline__ void acc_to_lds_T(const f32x16 (&acc)[3], float* ctT) {
  const int tid_ = otid(); const int lane = tid_ & 63, w = tid_ >> 6, wm = w >> 2, wn = w & 3;
  const int n = ACC_COL(wn, lane);
#pragma unroll
  for (int mi = 0; mi < 3; ++mi)
#pragma unroll
    for (int g4 = 0; g4 < 4; ++g4) {
      const int r0 = wm * 96 + mi * 32 + 8 * g4 + 4 * (lane >> 5);
      float4 v; v.x = acc[mi][g4 * 4 + 0]; v.y = acc[mi][g4 * 4 + 1]; v.z = acc[mi][g4 * 4 + 2]; v.w = acc[mi][g4 * 4 + 3];
      *(float4*)(ctT + n * LDT + r0) = v;
    }
}
__device__ __forceinline__ void store_tile_bf16(const float* ct, bf16_t* dst, int ldd, int tok0, int n0) {
#pragma unroll 1
  for (int it = otid(); it < 192 * 16; it += NTHR) {
    const int c8 = it & 15, r = it >> 4;
    const float4 a = *(const float4*)(ct + r * 132 + c8 * 8), b = *(const float4*)(ct + r * 132 + c8 * 8 + 4);
    uint4 o; o.x = pack2(a.x, a.y); o.y = pack2(a.z, a.w); o.z = pack2(b.x, b.y); o.w = pack2(b.z, b.w);
    *(uint4*)(dst + (size_t)(tok0 + r) * ldd + n0 + c8 * 8) = o;
  }
}

__device__ void p0_transpose_tile(const float* __restrict__ src, bf16_t* __restrict__ dst, int R, int C, int tr, int tc, char* smem) {
  float* t = (float*)smem;
  const int tid = otid();
  __syncthreads();
#pragma unroll
  for (int i = 0; i < 8; ++i) {
    int r = (tid >> 6) + 8 * i, c = tid & 63;
    t[r * 65 + c] = src[(size_t)(tr * 64 + r) * C + tc * 64 + c];
  }
  __syncthreads();
#pragma unroll
  for (int i = 0; i < 8; ++i) {
    int cc = (tid >> 6) + 8 * i, rr = tid & 63;
    dst[(size_t)(tc * 64 + cc) * R + tr * 64 + rr] = f2bf(t[rr * 65 + cc]);
  }
}

__device__ void p0_wc_item(const Params& p, int l, int ph, int kt, char* smem) {
  float* wqs = (float*)smem;
  float* ks = wqs + 64 * 129;
  const int tid = otid();
  const float* wq = p.peer_wq + (size_t)l * DM * 2048;
  const float* kk = ((ph & 1) ? p.peer_k2 : p.peer_k1) + (size_t)l * 128 * 128;
  __syncthreads();
  for (int e = tid; e < 64 * 128; e += NTHR) {
    int r = e >> 7, d = e & 127;
    wqs[r * 129 + d] = wq[(size_t)(kt * 64 + r) * 2048 + ph * 128 + d];
  }
  for (int e = tid; e < 128 * 128; e += NTHR) {
    int r = e >> 7, d = e & 127;
    ks[r * 129 + d] = kk[r * 128 + d];
  }
  __syncthreads();
  const int key = tid & 127, k0 = (tid >> 7) * 16;
  float acc[16];
#pragma unroll
  for (int i = 0; i < 16; ++i) acc[i] = 0.f;
  for (int d = 0; d < 128; ++d) {
    float kv = ks[key * 129 + d];
#pragma unroll
    for (int i = 0; i < 16; ++i) acc[i] += wqs[(k0 + i) * 129 + d] * kv;
  }
  bf16_t* dst = p.WcT + ((size_t)l * 2048 + ph * 128 + key) * DM + kt * 64 + k0;
  uint4 o0, o1;
  o0.x = pack2(acc[0], acc[1]); o0.y = pack2(acc[2], acc[3]); o0.z = pack2(acc[4], acc[5]); o0.w = pack2(acc[6], acc[7]);
  o1.x = pack2(acc[8], acc[9]); o1.y = pack2(acc[10], acc[11]); o1.z = pack2(acc[12], acc[13]); o1.w = pack2(acc[14], acc[15]);
  *(uint4*)dst = o0; *(uint4*)(dst + 8) = o1;
}

__device__ void p0_mod_item(const Params& p, int l, int cc, char* smem) {
  float* sc = (float*)smem;
  const int tid = otid();
  __syncthreads();
  for (int e = tid; e < NB * DM; e += NTHR) {
    int b = e >> 10, k = e & 1023;
    float v = crow(p, b)[k];
    sc[k * 24 + b] = v / (1.f + __expf(-v));
  }
  __syncthreads();
  const int n = cc * 512 + tid;
  float acc[24];
#pragma unroll
  for (int b = 0; b < 24; ++b) acc[b] = 0.f;
  const float* wm = p.w_mod + (size_t)l * DM * 6144 + n;
  for (int k0 = 0; k0 < DM; k0 += 8) {
    float wv[8];
#pragma unroll
    for (int j = 0; j < 8; ++j) wv[j] = wm[(size_t)(k0 + j) * 6144];
#pragma unroll
    for (int j = 0; j < 8; ++j) {
      const float4* s4 = (const float4*)(sc + (k0 + j) * 24);
#pragma unroll
      for (int q = 0; q < 6; ++q) {
        float4 s = s4[q];
        acc[q * 4 + 0] += s.x * wv[j]; acc[q * 4 + 1] += s.y * wv[j]; acc[q * 4 + 2] += s.z * wv[j]; acc[q * 4 + 3] += s.w * wv[j];
      }
    }
  }
  const float bm = p.b_mod[l * 6144 + n];
#pragma unroll
  for (int b = 0; b < 24; ++b) p.mod[((size_t)l * NB + b) * 6144 + n] = acc[b] + bm;
}

__device__ void p0_filter_item(const Params& p, int l, int tc, char* smem) {
  float* feat = (float*)smem;
  float* a1 = feat + 32 * 33;
  float* a2 = a1 + 32 * 64;
  bf16_t* stage = (bf16_t*)(a2 + 32 * 64);
  const int tid = otid();
  const int t0 = tc * 32;
  __syncthreads();
  for (int e = tid; e < 32 * 33; e += NTHR) {
    int pp = e / 33, f = e % 33;
    int ti = t0 + pp;
    float v;
    if (f == 0) v = (float)ti / (float)(SEQ - 1);
    else {
      int bi = (f - 1) & 15;
      float band = 1e-4f + (float)bi * ((15.f - 1e-4f) / 15.f);
      float wv = 2.0f * 3.14159265358979323846f * (float)ti / (float)SEQ;
      float arg = band * wv;
      v = (f <= 16) ? cosf(arg) : -sinf(arg);
    }
    feat[pp * 33 + f] = v;
  }
  __syncthreads();
  const float* w1 = p.f_w1 + l * 33 * 64; const float* b1 = p.f_b1 + l * 64; const float* fq = p.f_freq + l * 64;
  const float* w2 = p.f_w2 + l * 64 * 64; const float* b2 = p.f_b2 + l * 64;
  for (int e = tid; e < 32 * 64; e += NTHR) {
    int pp = e >> 6, j = e & 63;
    float s = b1[j];
    for (int f = 0; f < 33; ++f) s += feat[pp * 33 + f] * w1[f * 64 + j];
    a1[pp * 64 + j] = sinf(fq[j] * s);
  }
  __syncthreads();
  for (int e = tid; e < 32 * 64; e += NTHR) {
    int pp = e >> 6, j = e & 63;
    float s = b2[j];
    for (int i = 0; i < 64; ++i) s += a1[pp * 64 + i] * w2[i * 64 + j];
    a2[pp * 64 + j] = sinf(fq[j] * s);
  }
  __syncthreads();
  const float* w3 = p.f_w3 + (size_t)l * 64 * 2048;
  const float min_decay = logf(1e-2f) / 1.5f, max_decay = logf(1e-2f) / 0.3f;
  for (int q = 0; q < 4; ++q) {
    const int n = tid + 512 * q;
    const int c = n & 511;
    float wr[64];
#pragma unroll
    for (int i = 0; i < 64; ++i) wr[i] = w3[i * 2048 + n];
    const float delta = fabsf(min_decay + (max_decay - min_decay) * (float)c / 511.f);
    for (int pp = 0; pp < 32; ++pp) {
      float s = 0.f;
#pragma unroll
      for (int i = 0; i < 64; ++i) s += a2[pp * 64 + i] * wr[i];
      float tt = (float)(t0 + pp) / (float)(SEQ - 1);
      s *= __expf(-tt * delta);
      stage[n * 32 + pp] = f2bf(s);
    }
  }
  __syncthreads();
  for (int e = tid; e < 2048 * 32; e += NTHR) {
    int n = e >> 5, pp = e & 31;
    int o = n >> 10, d = (n >> 9) & 1, c = n & 511;
    int t = t0 + pp;
    bf16_t* g = p.Gf + ((size_t)((l * 2 + o) * 512 + c)) * 4096;
    if (d == 0) g[2048 - t] = stage[n * 32 + pp];
    else if (t >= 1) g[2048 + t] = stage[n * 32 + pp];
    if (t == 0 && d == 0) g[0] = 0;
  }
}

__device__ void p0_rope_item(const Params& p, int it) {
  int e = it * 512 + otid();
  int pos = e >> 5, i = e & 31;
  float inv = powf(10000.f, -(float)(2 * i) / 64.f);
  float ang = (float)pos * inv;
  p.rope[e * 2 + 0] = cosf(ang);
  p.rope[e * 2 + 1] = sinf(ang);
}

constexpr int P0_TR_PER_LAYER = 16 * 68 + 8 * 16 + 8 * 16 + 16 * 16;
constexpr int P0_N_TR = 2 * P0_TR_PER_LAYER;
constexpr int P0_N_WC = 2 * 16 * 16;
constexpr int P0_N_MOD = 2 * 12;
constexpr int P0_N_FILT = 2 * 64;
constexpr int P0_N_ROPE = 128;
constexpr int P0_TOTAL = P0_N_MOD + P0_N_FILT + P0_N_WC + P0_N_ROPE + P0_N_TR;

__device__ void phase_p0(const Params& p, char* smem) {
  for (int it = blockIdx.x; it < P0_TOTAL; it += gridDim.x) {
    int i = it;
    if (i < P0_N_MOD) { p0_mod_item(p, i / 12, i % 12, smem); continue; }
    i -= P0_N_MOD;
    if (i < P0_N_FILT) { p0_filter_item(p, i / 64, i % 64, smem); continue; }
    i -= P0_N_FILT;
    if (i < P0_N_WC) { p0_wc_item(p, i >> 8, (i >> 4) & 15, i & 15, smem); continue; }
    i -= P0_N_WC;
    if (i < P0_N_ROPE) { p0_rope_item(p, i); continue; }
    i -= P0_N_ROPE;
    {
      int l = i / P0_TR_PER_LAYER, j = i % P0_TR_PER_LAYER;
      if (j < 16 * 68) { p0_transpose_tile(p.w_in + (size_t)l * DM * INC, p.WinT + (size_t)l * INC * DM, DM, INC, j / 68, j % 68, smem); continue; }
      j -= 16 * 68;
      if (j < 128) { p0_transpose_tile(p.w_pa + (size_t)l * HYW * DM, p.WpaT + (size_t)l * DM * HYW, HYW, DM, j / 16, j % 16, smem); continue; }
      j -= 128;
      if (j < 128) { p0_transpose_tile(p.w_pb + (size_t)l * HYW * DM, p.WpbT + (size_t)l * DM * HYW, HYW, DM, j / 16, j % 16, smem); continue; }
      j -= 128;
      p0_transpose_tile(p.w_out + (size_t)l * DM * DM, p.WoutT + (size_t)l * DM * DM, DM, DM, j / 16, j % 16, smem);
    }
  }
}

__device__ void norm_rows(const Params& p, int tile, int l, int which, bool from_inputs, char* smem) {
  float* scl = (float*)smem;
  float* shf = scl + 2048;
  const int tid = otid(), lane = tid & 63, w = tid >> 6;
  const int tok0 = tile * TM;
  const int b0 = tok0 >> 11;
  const float* g = (which ? p.g2 : p.g1) + l * DM;
  __syncthreads();
  for (int e = tid; e < 2048; e += NTHR) {
    int bi = e >> 10, j = e & 1023;
    int b = b0 + bi; if (b > NB - 1) b = NB - 1;
    const float* m = p.mod + ((size_t)l * NB + b) * 6144 + which * 3072;
    scl[e] = g[j] * (1.f + m[1024 + j]);
    shf[e] = m[j];
  }
  __syncthreads();
  for (int r = w; r < TM; r += 8) {
    const int tok = tok0 + r;
    const int bi = (tok >> 11) - b0;
    const float* xr = from_inputs ? xrow_in(p, tok) : (p.out + (size_t)tok * DM);
    float4 v[4];
    float ss = 0.f;
#pragma unroll
    for (int i = 0; i < 4; ++i) {
      v[i] = *(const float4*)(xr + lane * 4 + 256 * i);
      ss += v[i].x * v[i].x + v[i].y * v[i].y + v[i].z * v[i].z + v[i].w * v[i].w;
    }
    ss = wave_sum(ss);
    const float rs = rsqrtf(ss * (1.f / DM) + 1e-6f);
#pragma unroll
    for (int i = 0; i < 4; ++i) {
      const int j = lane * 4 + 256 * i;
      const float4 sc4 = *(const float4*)(scl + bi * 1024 + j);
      const float4 sh4 = *(const float4*)(shf + bi * 1024 + j);
      uint2 o;
      o.x = pack2(v[i].x * rs * sc4.x + sh4.x, v[i].y * rs * sc4.y + sh4.y);
      o.y = pack2(v[i].z * rs * sc4.z + sh4.z, v[i].w * rs * sc4.w + sh4.w);
      *(uint2*)(p.hbuf + (size_t)tok * DM + j) = o;
    }
  }
  __syncthreads();
}

__device__ void phase_c(const Params& p, int tile, int l, bool from_inputs, char* smem) {
  norm_rows(p, tile, l, 0, from_inputs, smem);
  const int tid = otid();
  const int tok0 = tile * TM;
  const bf16_t* A = p.hbuf + (size_t)tok0 * DM;
  const bf16_t* W = p.WinT + (size_t)l * INC * DM;
  float* ct = (float*)smem;
  f32x16 acc[3];
#pragma unroll 1
  for (int nc = 0; nc < 18; ++nc) {
    gemm_core(A, DM, W + (size_t)nc * 128 * DM, DM, DM, (bf16_t*)smem, acc);
    if (nc < 12) {
      acc_to_lds_T(acc, ct);
      __syncthreads();
#pragma unroll 1
      for (int it = tid; it < 128 * 24; it += NTHR) {
        const int tg = it % 24, nl = it / 24;
        const float4 a = *(const float4*)(ct + nl * LDT + tg * 8), b4 = *(const float4*)(ct + nl * LDT + tg * 8 + 4);
        uint4 o; o.x = pack2(a.x, a.y); o.y = pack2(a.z, a.w); o.z = pack2(b4.x, b4.y); o.w = pack2(b4.z, b4.w);
        const int tok = tok0 + tg * 8;
        const int b = tok >> 11, sq = tok & 2047;
        *(uint4*)(p.zT + ((size_t)b * HYC + nc * 128 + nl) * SEQ + sq) = o;
      }
    } else {
      acc_to_lds(acc, ct, 132);
      __syncthreads();
      store_tile_bf16(ct, p.zqkv, QKVC, tok0, nc * 128 - HYC);
    }
  }
}

__device__ __forceinline__ void load_conv8(const bf16_t* __restrict__ zrow, int s0, float w0, float w1, float w2, float cb, float (&o)[8]) {
  uint4 v = *(const uint4*)(zrow + s0);
  float z[10];
  z[0] = (s0 > 0) ? bf2f(zrow[s0 - 1]) : 0.f;
  z[1] = lo2f(v.x); z[2] = hi2f(v.x); z[3] = lo2f(v.y); z[4] = hi2f(v.y);
  z[5] = lo2f(v.z); z[6] = hi2f(v.z); z[7] = lo2f(v.w); z[8] = hi2f(v.w);
  z[9] = (s0 + 8 < SEQ) ? bf2f(zrow[s0 + 8]) : 0.f;
#pragma unroll
  for (int i = 0; i < 8; ++i) o[i] = z[i] * w0 + z[i + 1] * w1 + z[i + 2] * w2 + cb;
}

__device__ void hyena_item(const Params& p, int l, int c, char* smem) {
  float* Gs = (float*)smem;
  bf16_t* us = (bf16_t*)(smem + 16512);
  constexpr int US = 2056;
  const int tid = otid();
  const float* cw = p.conv_w + (size_t)l * 3 * HYC;
  const float* cbp = p.conv_b + (size_t)l * HYC;
  for (int o = 0; o < 2; ++o) {
    __syncthreads();
    const bf16_t* g = p.Gf + ((size_t)((l * 2 + o) * 512 + c)) * 4096;
    for (int m = tid; m < 4096; m += NTHR) Gs[m] = bf2f(g[m]);
    if (tid < 16) Gs[4096 + tid] = 0.f;
    if (o == 0) {
      const float w0 = cw[c], w1 = cw[HYC + c], w2 = cw[2 * HYC + c], cb = cbp[c];
      for (int q = tid; q < 24 * 256; q += NTHR) {
        const int b = q >> 8, s0 = (q & 255) * 8;
        float v[8];
        load_conv8(p.zT + ((size_t)b * HYC + c) * SEQ, s0, w0, w1, w2, cb, v);
        uint4 pk; pk.x = pack2(v[0], v[1]); pk.y = pack2(v[2], v[3]); pk.z = pack2(v[4], v[5]); pk.w = pack2(v[6], v[7]);
        *(uint4*)(us + b * US + s0) = pk;
      }
    } else {
      for (int q = tid; q < 24 * 256; q += NTHR) {
        const int b = q >> 8, s0 = (q & 255) * 8;
        *(uint4*)(us + b * US + s0) = *(const uint4*)(p.yaT + ((size_t)b * HYW + c) * SEQ + s0);
      }
    }
    __syncthreads();
    const int xc = (o == 0 ? 512 : 1024) + c;
    const float xw0 = cw[xc], xw1 = cw[HYC + xc], xw2 = cw[2 * HYC + xc], xcb = cbp[xc];
    const float bias = p.f_bias[(l * 2 + o) * 512 + c];
    for (int j = 0; j < 12; ++j) {
      const int q = tid + 512 * j;
      const int b = q >> 8, t0 = (q & 255) * 8;
      float acc[8];
#pragma unroll
      for (int i = 0; i < 8; ++i) acc[i] = 0.f;
      const float* gb = Gs + (2048 - t0) - 8;
      const bf16_t* ub = us + b * US;
      for (int s = 0; s < SEQ; s += 8) {
        uint4 uv = *(const uint4*)(ub + s);
        float u[8];
        u[0] = lo2f(uv.x); u[1] = hi2f(uv.x); u[2] = lo2f(uv.y); u[3] = hi2f(uv.y);
        u[4] = lo2f(uv.z); u[5] = hi2f(uv.z); u[6] = lo2f(uv.w); u[7] = hi2f(uv.w);
        float gw[16];
#pragma unroll
        for (int k4 = 0; k4 < 4; ++k4) {
          float4 t4 = *(const float4*)(gb + s + k4 * 4);
          gw[k4 * 4 + 0] = t4.x; gw[k4 * 4 + 1] = t4.y; gw[k4 * 4 + 2] = t4.z; gw[k4 * 4 + 3] = t4.w;
        }
#pragma unroll
        for (int e = 0; e < 8; ++e)
#pragma unroll
          for (int i = 0; i < 8; ++i) acc[i] += u[e] * gw[8 + e - i];
      }
      float xv[8];
      load_conv8(p.zT + ((size_t)b * HYC + xc) * SEQ, t0, xw0, xw1, xw2, xcb, xv);
      uint4 uv = *(const uint4*)(ub + t0);
      float u[8];
      u[0] = lo2f(uv.x); u[1] = hi2f(uv.x); u[2] = lo2f(uv.y); u[3] = hi2f(uv.y);
      u[4] = lo2f(uv.z); u[5] = hi2f(uv.z); u[6] = lo2f(uv.w); u[7] = hi2f(uv.w);
      float r[8];
#pragma unroll
      for (int i = 0; i < 8; ++i) r[i] = xv[i] * (acc[i] + bias * u[i]);
      uint4 pk; pk.x = pack2(r[0], r[1]); pk.y = pack2(r[2], r[3]); pk.z = pack2(r[4], r[5]); pk.w = pack2(r[6], r[7]);
      *(uint4*)(p.yaT + ((size_t)b * HYW + c) * SEQ + t0) = pk;
    }
  }
}

__device__ void attn_item(const Params& p, int l, int item, char* smem) {
  constexpr int KS = 72;
  bf16_t* Ks = (bf16_t*)smem;
  bf16_t* Vs = Ks + 384 * KS;
  const int tid = otid();
  const int kh = item & 1, qb = (item >> 1) & 15, b = item >> 5;
  const int kpos0 = qb * 128 - 128;
  __syncthreads();
  if (tid < 384) {
    const int r = tid, kpos = kpos0 + r;
    if (kpos >= 0 && kpos < SEQ) {
      const bf16_t* kr = p.zqkv + ((size_t)(b * SEQ + kpos)) * QKVC + 512 + kh * 64;
      float kf[64];
      float ss = 0.f;
#pragma unroll
      for (int c8 = 0; c8 < 8; ++c8) {
        uint4 v = *(const uint4*)(kr + c8 * 8);
        kf[c8 * 8 + 0] = lo2f(v.x); kf[c8 * 8 + 1] = hi2f(v.x); kf[c8 * 8 + 2] = lo2f(v.y); kf[c8 * 8 + 3] = hi2f(v.y);
        kf[c8 * 8 + 4] = lo2f(v.z); kf[c8 * 8 + 5] = hi2f(v.z); kf[c8 * 8 + 6] = lo2f(v.w); kf[c8 * 8 + 7] = hi2f(v.w);
      }
#pragma unroll
      for (int d = 0; d < 64; ++d) ss += kf[d] * kf[d];
      const float rs = rsqrtf(ss * (1.f / 64.f) + 1e-6f);
      const float* kg = p.k_gain + l * 64;
#pragma unroll
      for (int d = 0; d < 64; ++d) kf[d] = kf[d] * rs * kg[d];
      const float* rp = p.rope + (size_t)kpos * 64;
#pragma unroll
      for (int i = 0; i < 32; ++i) {
        const float cs = rp[i * 2], sn = rp[i * 2 + 1];
        const float a = kf[i], bb = kf[i + 32];
        kf[i] = a * cs - bb * sn; kf[i + 32] = bb * cs + a * sn;
      }
#pragma unroll
      for (int c8 = 0; c8 < 8; ++c8) {
        uint4 pk;
        pk.x = pack2(kf[c8 * 8 + 0], kf[c8 * 8 + 1]); pk.y = pack2(kf[c8 * 8 + 2], kf[c8 * 8 + 3]);
        pk.z = pack2(kf[c8 * 8 + 4], kf[c8 * 8 + 5]); pk.w = pack2(kf[c8 * 8 + 6], kf[c8 * 8 + 7]);
        *(uint4*)(Ks + r * KS + c8 * 8) = pk;
      }
    }
  }
  for (int e = tid; e < 384 * 8; e += NTHR) {
    const int r = e >> 3, c8 = e & 7, kpos = kpos0 + r;
    if (kpos >= 0 && kpos < SEQ)
      *(uint4*)(Vs + r * KS + c8 * 8) = *(const uint4*)(p.zqkv + ((size_t)(b * SEQ + kpos)) * QKVC + 640 + kh * 64 + c8 * 8);
  }
  __syncthreads();
  const int hl = tid >> 7, qi = tid & 127;
  const int head = kh * 4 + hl;
  const int qpos = qb * 128 + qi;
  const int tok = b * SEQ + qpos;
  float qf[64];
  {
    const bf16_t* qr = p.zqkv + (size_t)tok * QKVC + head * 64;
    float ss = 0.f;
#pragma unroll
    for (int c8 = 0; c8 < 8; ++c8) {
      uint4 v = *(const uint4*)(qr + c8 * 8);
      qf[c8 * 8 + 0] = lo2f(v.x); qf[c8 * 8 + 1] = hi2f(v.x); qf[c8 * 8 + 2] = lo2f(v.y); qf[c8 * 8 + 3] = hi2f(v.y);
      qf[c8 * 8 + 4] = lo2f(v.z); qf[c8 * 8 + 5] = hi2f(v.z); qf[c8 * 8 + 6] = lo2f(v.w); qf[c8 * 8 + 7] = hi2f(v.w);
    }
#pragma unroll
    for (int d = 0; d < 64; ++d) ss += qf[d] * qf[d];
    const float rs = rsqrtf(ss * (1.f / 64.f) + 1e-6f) * 0.125f;
    const float* qg = p.q_gain + l * 64;
#pragma unroll
    for (int d = 0; d < 64; ++d) qf[d] = qf[d] * rs * qg[d];
    const float* rp = p.rope + (size_t)qpos * 64;
#pragma unroll
    for (int i = 0; i < 32; ++i) {
      const float cs = rp[i * 2], sn = rp[i * 2 + 1];
      const float a = qf[i], bb = qf[i + 32];
      qf[i] = a * cs - bb * sn; qf[i + 32] = bb * cs + a * sn;
    }
  }
  float m = p.sink[l * 8 + head], lsum = 1.f;
  float o[64];
#pragma unroll
  for (int d = 0; d < 64; ++d) o[d] = 0.f;
  const int qi0 = qi & 64;
  int rlo = qi0, rhi = qi0 + 63 + 256;
  if (kpos0 + rlo < 0) rlo = -kpos0;
  if (kpos0 + rhi > SEQ - 1) rhi = SEQ - 1 - kpos0;
  for (int r = rlo; r <= rhi; ++r) {
    const int kpos = kpos0 + r;
    float dot = 0.f;
#pragma unroll
    for (int c8 = 0; c8 < 8; ++c8) {
      uint4 v = *(const uint4*)(Ks + r * KS + c8 * 8);
      dot += qf[c8 * 8 + 0] * lo2f(v.x) + qf[c8 * 8 + 1] * hi2f(v.x) + qf[c8 * 8 + 2] * lo2f(v.y) + qf[c8 * 8 + 3] * hi2f(v.y)
           + qf[c8 * 8 + 4] * lo2f(v.z) + qf[c8 * 8 + 5] * hi2f(v.z) + qf[c8 * 8 + 6] * lo2f(v.w) + qf[c8 * 8 + 7] * hi2f(v.w);
    }
    int dd = kpos - qpos; dd = dd < 0 ? -dd : dd;
    const bool valid = dd <= 128;
    const float s = valid ? dot : -INFINITY;
    const float mn = fmaxf(m, s);
    const float corr = __expf(m - mn);
    const float pr = __expf(s - mn);
    lsum = lsum * corr + pr;
    m = mn;
#pragma unroll
    for (int c8 = 0; c8 < 8; ++c8) {
      uint4 v = *(const uint4*)(Vs + r * KS + c8 * 8);
      o[c8 * 8 + 0] = o[c8 * 8 + 0] * corr + pr * lo2f(v.x); o[c8 * 8 + 1] = o[c8 * 8 + 1] * corr + pr * hi2f(v.x);
      o[c8 * 8 + 2] = o[c8 * 8 + 2] * corr + pr * lo2f(v.y); o[c8 * 8 + 3] = o[c8 * 8 + 3] * corr + pr * hi2f(v.y);
      o[c8 * 8 + 4] = o[c8 * 8 + 4] * corr + pr * lo2f(v.z); o[c8 * 8 + 5] = o[c8 * 8 + 5] * corr + pr * hi2f(v.z);
      o[c8 * 8 + 6] = o[c8 * 8 + 6] * corr + pr * lo2f(v.w); o[c8 * 8 + 7] = o[c8 * 8 + 7] * corr + pr * hi2f(v.w);
    }
  }
  const float inv = 1.f / lsum;
  bf16_t* yo = p.yb + (size_t)tok * 512 + head * 64;
#pragma unroll
  for (int c8 = 0; c8 < 8; ++c8) {
    uint4 pk;
    pk.x = pack2(o[c8 * 8 + 0] * inv, o[c8 * 8 + 1] * inv); pk.y = pack2(o[c8 * 8 + 2] * inv, o[c8 * 8 + 3] * inv);
    pk.z = pack2(o[c8 * 8 + 4] * inv, o[c8 * 8 + 5] * inv); pk.w = pack2(o[c8 * 8 + 6] * inv, o[c8 * 8 + 7] * inv);
    *(uint4*)(yo + c8 * 8) = pk;
  }
}

__device__ void table_item(const Params& p, int l, int it) {
  const int tid = otid();
  const int which = it >> 10, chunk = it & 1023;
  const float* src = (which ? p.peer_v : p.peer_u) + (size_t)l * NEXP * DM + (size_t)chunk * 16384;
  bf16_t* dst = (which ? p.tabV : p.tabU) + (size_t)chunk * 16384;
#pragma unroll
  for (int i = 0; i < 4; ++i) {
    const int e = (tid + i * NTHR) * 8;
    float4 a = *(const float4*)(src + e), b = *(const float4*)(src + e + 4);
    uint4 o; o.x = pack2(a.x, a.y); o.y = pack2(a.z, a.w); o.z = pack2(b.x, b.y); o.w = pack2(b.z, b.w);
    *(uint4*)(dst + e) = o;
  }
}

constexpr int DE_N_HY = 512, DE_N_AT = 768, DE_N_TB = 2048;
__device__ void phase_de(const Params& p, int l, char* smem) {
  for (int it = blockIdx.x; it < DE_N_HY + DE_N_AT + DE_N_TB; it += gridDim.x) {
    if (it < DE_N_HY) hyena_item(p, l, it, smem);
    else if (it < DE_N_HY + DE_N_AT) attn_item(p, l, it - DE_N_HY, smem);
    else table_item(p, l, it - DE_N_HY - DE_N_AT);
  }
}

__device__ void phase_f(const Params& p, int tile, int l, bool from_inputs, char* smem) {
  const int tid = otid();
  const int tok0 = tile * TM;
#pragma unroll 1
  for (int e = tid; e < TM * 64; e += NTHR) {
    const int r = e % TM, cg8 = e / TM;
    const int tok = tok0 + r, b = tok >> 11, sq = tok & 2047;
    const bf16_t* src = p.yaT + ((size_t)b * HYW + cg8 * 8) * SEQ + sq;
    uint4 o;
    o.x = (unsigned)src[0] | ((unsigned)src[SEQ] << 16);
    o.y = (unsigned)src[2 * SEQ] | ((unsigned)src[3 * SEQ] << 16);
    o.z = (unsigned)src[4 * SEQ] | ((unsigned)src[5 * SEQ] << 16);
    o.w = (unsigned)src[6 * SEQ] | ((unsigned)src[7 * SEQ] << 16);
    *(uint4*)(p.yatok + (size_t)tok * HYW + cg8 * 8) = o;
  }
  __syncthreads();
  const bf16_t* Ah = p.hbuf + (size_t)tok0 * DM;
  const bf16_t* Aya = p.yatok + (size_t)tok0 * HYW;
  const bf16_t* Ayb = p.yb + (size_t)tok0 * HYW;
  const bf16_t* Win = p.WinT + (size_t)l * INC * DM;
  const bf16_t* Wpa = p.WpaT + (size_t)l * DM * HYW;
  const bf16_t* Wpb = p.WpbT + (size_t)l * DM * HYW;
  float* ct = (float*)smem;
  f32x16 acc[3], sg[3];
  unsigned mgp[3][8];
#pragma unroll 1
  for (int nc = 0; nc < 8; ++nc) {
    gemm_core(Ah, DM, Win + (size_t)(2304 + nc * 128) * DM, DM, DM, (bf16_t*)smem, acc);
#pragma unroll
    for (int mi = 0; mi < 3; ++mi)
#pragma unroll
      for (int r = 0; r < 16; ++r) sg[mi][r] = __builtin_amdgcn_rcpf(1.f + __expf(-acc[mi][r]));
    gemm_core(Aya, HYW, Wpa + (size_t)(nc * 128) * HYW, HYW, HYW, (bf16_t*)smem, acc);
#pragma unroll
    for (int mi = 0; mi < 3; ++mi)
#pragma unroll
      for (int q = 0; q < 8; ++q) mgp[mi][q] = pack2(sg[mi][2 * q] * acc[mi][2 * q], sg[mi][2 * q + 1] * acc[mi][2 * q + 1]);
    gemm_core(Ah, DM, Win + (size_t)(3328 + nc * 128) * DM, DM, DM, (bf16_t*)smem, acc);
#pragma unroll
    for (int mi = 0; mi < 3; ++mi)
#pragma unroll
      for (int r = 0; r < 16; ++r) sg[mi][r] = __builtin_amdgcn_rcpf(1.f + __expf(-acc[mi][r]));
    gemm_core(Ayb, HYW, Wpb + (size_t)(nc * 128) * HYW, HYW, HYW, (bf16_t*)smem, acc);
#pragma unroll
    for (int mi = 0; mi < 3; ++mi)
#pragma unroll
      for (int q = 0; q < 8; ++q) {
        acc[mi][2 * q] = lo2f(mgp[mi][q]) + sg[mi][2 * q] * acc[mi][2 * q];
        acc[mi][2 * q + 1] = hi2f(mgp[mi][q]) + sg[mi][2 * q + 1] * acc[mi][2 * q + 1];
      }
    acc_to_lds(acc, ct, 132);
    __syncthreads();
    store_tile_bf16(ct, p.merged, DM, tok0, nc * 128);
  }
  __syncthreads();
  const bf16_t* Am = p.merged + (size_t)tok0 * DM;
  const bf16_t* Wo = p.WoutT + (size_t)l * DM * DM;
#pragma unroll 1
  for (int nc = 0; nc < 8; ++nc) {
    gemm_core(Am, DM, Wo + (size_t)(nc * 128) * DM, DM, DM, (bf16_t*)smem, acc);
    acc_to_lds(acc, ct, 132);
    __syncthreads();
#pragma unroll 1
    for (int it = tid; it < 192 * 32; it += NTHR) {
      const int c4 = it & 31, r = it >> 5;
      const int tok = tok0 + r, b = tok >> 11;
      const int n = nc * 128 + c4 * 4;
      const float4 a = *(const float4*)(ct + r * 132 + c4 * 4);
      const float4 gt = *(const float4*)(p.mod + ((size_t)l * NB + b) * 6144 + 2048 + n);
      const float* xs = from_inputs ? xrow_in(p, tok) : (p.out + (size_t)tok * DM);
      float4 xo = *(const float4*)(xs + n);
      xo.x += gt.x * a.x; xo.y += gt.y * a.y; xo.z += gt.z * a.z; xo.w += gt.w * a.w;
      *(float4*)(p.out + (size_t)tok * DM + n) = xo;
    }
  }
  __syncthreads();
}

__device__ __forceinline__ void topk_insert(float (&key)[16], float kx) {
#pragma unroll
  for (int i = 0; i < 16; ++i) {
    const float hi = fmaxf(key[i], kx);
    kx = fminf(key[i], kx);
    key[i] = hi;
  }
}

__device__ void phase_g(const Params& p, int tile, int l, char* smem) {
  norm_rows(p, tile, l, 1, false, smem);
  const int tid = otid();
  const int tok0 = tile * TM;
  const bf16_t* Ah = p.hbuf + (size_t)tok0 * DM;
  const bf16_t* Wc = p.WcT + (size_t)l * 2048 * DM;
  float* sc = (float*)smem;
  f32x16 acc[3];
  float v1k[16], v2k[16];
#pragma unroll 1
  for (int ch = 0; ch < 16; ++ch) {
    gemm_core(Ah, DM, Wc + (size_t)(ch * 128) * DM, DM, DM, (bf16_t*)smem, acc);
    acc_to_lds(acc, sc, 129);
    __syncthreads();
    if (tid < TM) {
      float key[16];
#pragma unroll
      for (int i = 0; i < 16; ++i) key[i] = -INFINITY;
      const float* row = sc + tid * 129;
      for (int j = 0; j < 128; ++j) {
        const float x = row[j];
        const float kx = __uint_as_float((__float_as_uint(x) & 0xFFFFFF80u) | (unsigned)j);
        topk_insert(key, kx);
      }
      if ((ch & 1) == 0) {
#pragma unroll
        for (int i = 0; i < 16; ++i) v1k[i] = key[i];
      } else {
#pragma unroll
        for (int i = 0; i < 16; ++i) v2k[i] = key[i];
        float top[16];
#pragma unroll
        for (int i = 0; i < 16; ++i) top[i] = -INFINITY;
#pragma unroll
        for (int i = 0; i < 16; ++i)
#pragma unroll
          for (int j = 0; j < 16; ++j)
            if ((i + 1) * (j + 1) <= 16) {
              const float s = v1k[i] + v2k[j];
              const float ck = __uint_as_float((__float_as_uint(s) & 0xFFFFFF00u) | (unsigned)(i * 16 + j));
              topk_insert(top, ck);
            }
        const float mx = top[0];
        float ex[16], sum = 0.f;
#pragma unroll
        for (int k = 0; k < 16; ++k) { ex[k] = __expf(top[k] - mx); sum += ex[k]; }
        const float inv = 1.f / sum;
        const int hh = ch >> 1;
        const size_t ob = ((size_t)(tok0 + tid) * 8 + hh) * 16;
#pragma unroll
        for (int k = 0; k < 16; ++k) {
          const unsigned code = __float_as_uint(top[k]) & 0xFFu;
          const unsigned ii = code >> 4, jj = code & 15u;
          unsigned e1 = 0, e2 = 0;
#pragma unroll
          for (int q = 0; q < 16; ++q) {
            e1 = (ii == (unsigned)q) ? (__float_as_uint(v1k[q]) & 0x7Fu) : e1;
            e2 = (jj == (unsigned)q) ? (__float_as_uint(v2k[q]) & 0x7Fu) : e2;
          }
          p.pidx[ob + k] = (unsigned short)(e1 * 128 + e2);
          p.pg[ob + k] = ex[k] * inv;
        }
      }
    }
    __syncthreads();
  }
}

__device__ void phase_i(const Params& p, int tile, int l, char* smem) {
  const int tid = otid(), lane = tid & 63, w = tid >> 6;
  float* wsm = (float*)smem + w * 128;
  const int tok0 = tile * TM;
  __syncthreads();
  for (int r = w; r < TM; r += 8) {
    const int tok = tok0 + r;
    const int b = tok >> 11;
    float hx[16];
    {
      const bf16_t* hr = p.hbuf + (size_t)tok * DM;
      uint4 a = *(const uint4*)(hr + lane * 8), c = *(const uint4*)(hr + 512 + lane * 8);
      hx[0] = lo2f(a.x); hx[1] = hi2f(a.x); hx[2] = lo2f(a.y); hx[3] = hi2f(a.y);
      hx[4] = lo2f(a.z); hx[5] = hi2f(a.z); hx[6] = lo2f(a.w); hx[7] = hi2f(a.w);
      hx[8] = lo2f(c.x); hx[9] = hi2f(c.x); hx[10] = lo2f(c.y); hx[11] = hi2f(c.y);
      hx[12] = lo2f(c.z); hx[13] = hi2f(c.z); hx[14] = lo2f(c.w); hx[15] = hi2f(c.w);
    }
    const unsigned short* pi = p.pidx + (size_t)tok * 128;
    const float* pgp = p.pg + (size_t)tok * 128;
    for (int pp = 0; pp < 128; pp += 4) {
      uint4 ua[4], uc[4];
#pragma unroll
      for (int q = 0; q < 4; ++q) {
        const int e = pi[pp + q] & (NEXP - 1);
        const bf16_t* ur = p.tabU + (size_t)e * DM;
        ua[q] = *(const uint4*)(ur + lane * 8); uc[q] = *(const uint4*)(ur + 512 + lane * 8);
      }
#pragma unroll
      for (int q = 0; q < 4; ++q) {
        float d = hx[0] * lo2f(ua[q].x) + hx[1] * hi2f(ua[q].x) + hx[2] * lo2f(ua[q].y) + hx[3] * hi2f(ua[q].y)
                + hx[4] * lo2f(ua[q].z) + hx[5] * hi2f(ua[q].z) + hx[6] * lo2f(ua[q].w) + hx[7] * hi2f(ua[q].w)
                + hx[8] * lo2f(uc[q].x) + hx[9] * hi2f(uc[q].x) + hx[10] * lo2f(uc[q].y) + hx[11] * hi2f(uc[q].y)
                + hx[12] * lo2f(uc[q].z) + hx[13] * hi2f(uc[q].z) + hx[14] * lo2f(uc[q].w) + hx[15] * hi2f(uc[q].w);
        d = wave_sum(d);
        const float ge = 0.5f * d * (1.f + erff(d * 0.70710678118654752f));
        if (lane == 0) wsm[pp + q] = pgp[pp + q] * ge;
      }
    }
    float oa[16];
#pragma unroll
    for (int i = 0; i < 16; ++i) oa[i] = 0.f;
    for (int pp = 0; pp < 128; pp += 4) {
      uint4 va[4], vc[4];
      float wq[4];
#pragma unroll
      for (int q = 0; q < 4; ++q) {
        const int e = pi[pp + q] & (NEXP - 1);
        const bf16_t* vr = p.tabV + (size_t)e * DM;
        va[q] = *(const uint4*)(vr + lane * 8); vc[q] = *(const uint4*)(vr + 512 + lane * 8);
        wq[q] = wsm[pp + q];
      }
#pragma unroll
      for (int q = 0; q < 4; ++q) {
        const float ww = wq[q];
        oa[0] += ww * lo2f(va[q].x); oa[1] += ww * hi2f(va[q].x); oa[2] += ww * lo2f(va[q].y); oa[3] += ww * hi2f(va[q].y);
        oa[4] += ww * lo2f(va[q].z); oa[5] += ww * hi2f(va[q].z); oa[6] += ww * lo2f(va[q].w); oa[7] += ww * hi2f(va[q].w);
        oa[8] += ww * lo2f(vc[q].x); oa[9] += ww * hi2f(vc[q].x); oa[10] += ww * lo2f(vc[q].y); oa[11] += ww * hi2f(vc[q].y);
        oa[12] += ww * lo2f(vc[q].z); oa[13] += ww * hi2f(vc[q].z); oa[14] += ww * lo2f(vc[q].w); oa[15] += ww * hi2f(vc[q].w);
      }
    }
    const float* gt = p.mod + ((size_t)l * NB + b) * 6144 + 5 * 1024;
    float* xo = p.out + (size_t)tok * DM;
#pragma unroll
    for (int hsel = 0; hsel < 2; ++hsel) {
      const int j = hsel * 512 + lane * 8;
      float4 x0 = *(const float4*)(xo + j), x1 = *(const float4*)(xo + j + 4);
      const float4 g0 = *(const float4*)(gt + j), g1 = *(const float4*)(gt + j + 4);
      x0.x += g0.x * oa[hsel * 8 + 0]; x0.y += g0.y * oa[hsel * 8 + 1]; x0.z += g0.z * oa[hsel * 8 + 2]; x0.w += g0.w * oa[hsel * 8 + 3];
      x1.x += g1.x * oa[hsel * 8 + 4]; x1.y += g1.y * oa[hsel * 8 + 5]; x1.z += g1.z * oa[hsel * 8 + 6]; x1.w += g1.w * oa[hsel * 8 + 7];
      *(float4*)(xo + j) = x0; *(float4*)(xo + j + 4) = x1;
    }
  }
  __syncthreads();
}

__global__ void __launch_bounds__(NTHR) mega_kernel(Params p) {
  extern __shared__ __attribute__((aligned(16))) char smem[];
  cg::grid_group grid = cg::this_grid();
  phase_p0(p, smem);
  grid.sync();
  for (int l = 0; l < 2; ++l) {
    for (int tile = blockIdx.x; tile < NTILE; tile += gridDim.x) phase_c(p, tile, l, l == 0, smem);
    grid.sync();
    phase_de(p, l, smem);
    grid.sync();
    for (int tile = blockIdx.x; tile < NTILE; tile += gridDim.x) {
      phase_f(p, tile, l, l == 0, smem);
      phase_g(p, tile, l, smem);
      phase_i(p, tile, l, smem);
    }
    if (l == 0) grid.sync();
  }
}

extern "C" void kernel_launch(void* const* d_in, const int* in_sizes, int n_in, void* d_out, int out_size, void* d_ws,
                              size_t ws_size, hipStream_t stream) {
  Params p{};
  const float* const* in = (const float* const*)d_in;
  p.x_prompt = in[0]; p.x_sample = in[1]; p.c_prompt = in[2]; p.c_sample = in[3]; p.w_mod = in[4]; p.b_mod = in[5];
  p.g1 = in[6]; p.g2 = in[7]; p.w_in = in[8]; p.conv_w = in[9]; p.conv_b = in[10]; p.f_w1 = in[11]; p.f_b1 = in[12];
  p.f_freq = in[13]; p.f_w2 = in[14]; p.f_b2 = in[15]; p.f_w3 = in[16]; p.f_bias = in[17]; p.q_gain = in[18];
  p.k_gain = in[19]; p.sink = in[20]; p.w_pa = in[21]; p.w_pb = in[22]; p.w_out = in[23]; p.peer_wq = in[24];
  p.peer_k1 = in[25]; p.peer_k2 = in[26]; p.peer_u = in[27]; p.peer_v = in[28];
  p.out = (float*)d_out;
  char* ws = (char*)d_ws;
  size_t off = 0;
  auto carve = [&](size_t bytes) { char* r = ws + off; off += (bytes + 255) & ~(size_t)255; return r; };
  p.WinT = (bf16_t*)carve((size_t)2 * INC * DM * 2);
  p.WpaT = (bf16_t*)carve((size_t)2 * DM * HYW * 2);
  p.WpbT = (bf16_t*)carve((size_t)2 * DM * HYW * 2);
  p.WoutT = (bf16_t*)carve((size_t)2 * DM * DM * 2);
  p.WcT = (bf16_t*)carve((size_t)2 * 2048 * DM * 2);
  p.Gf = (bf16_t*)carve((size_t)2 * 2 * 512 * 4096 * 2);
  p.mod = (float*)carve((size_t)2 * NB * 6144 * 4);
  p.rope = (float*)carve((size_t)SEQ * 64 * 4);
  p.tabU = (bf16_t*)carve((size_t)NEXP * DM * 2);
  p.tabV = (bf16_t*)carve((size_t)NEXP * DM * 2);
  p.zT = (bf16_t*)carve((size_t)NB * HYC * SEQ * 2);
  p.zqkv = (bf16_t*)carve((size_t)NTOK * QKVC * 2);
  p.yaT = (bf16_t*)carve((size_t)NTOK * HYW * 2);
  p.yb = (bf16_t*)carve((size_t)NTOK * HYW * 2);
  p.hbuf = (bf16_t*)carve((size_t)NTOK * DM * 2);
  p.merged = p.zT;
  p.yatok = p.zT + (size_t)NTOK * DM;
  p.pidx = (unsigned short*)p.zqkv;
  p.pg = (float*)(p.zqkv + (size_t)NTOK * 128);
  if (off > ws_size) fprintf(stderr, "workspace too small: need %zu have %zu\n", off, ws_size);

  static int grid_blocks = 0;
  if (!grid_blocks) {
    int dev = 0, cus = 0, per_cu = 0;
    hipGetDevice(&dev);
    hipDeviceGetAttribute(&cus, hipDeviceAttributeMultiprocessorCount, dev);
    hipFuncSetAttribute((const void*)mega_kernel, hipFuncAttributeMaxDynamicSharedMemorySize, SMEM_BYTES);
    hipOccupancyMaxActiveBlocksPerMultiprocessor(&per_cu, mega_kernel, NTHR, SMEM_BYTES);
    if (per_cu < 1) per_cu = 1;
    grid_blocks = cus * 1;
    if (grid_blocks > NTILE) grid_blocks = NTILE;
  }
  void* args[] = {&p};
  hipError_t e = hipLaunchCooperativeKernel((const void*)mega_kernel, dim3(grid_blocks), dim3(NTHR), args, SMEM_BYTES, stream);
  if (e != hipSuccess) fprintf(stderr, "cooperative launch failed: %s (grid %d)\n", hipGetErrorString(e), grid_blocks);
}
```

```cpp
#include <hip/hip_runtime.h>
#include <hip/hip_bf16.h>
#include <hip/hip_cooperative_groups.h>
#include <cstdio>
#include <cstdint>
namespace cg = cooperative_groups;

typedef unsigned short bf16_t;
using bf16x8 = __attribute__((ext_vector_type(8))) short;
using f32x16 = __attribute__((ext_vector_type(16))) float;

constexpr int DM = 1024;
constexpr int NB = 24;
constexpr int SEQ = 2048;
constexpr int NTOK = NB * SEQ;
constexpr int NBP = 16;
constexpr int INC = 4352;
constexpr int HYC = 1536;
constexpr int HYW = 512;
constexpr int QKVC = 768;
constexpr int TM = 192;
constexpr int NTILE = NTOK / TM;
constexpr int NTHR = 512;
constexpr int NEXP = 16384;
constexpr int SMEM_BYTES = 155648;
#ifndef REP_DE
#define REP_DE 1
#endif
#ifndef REP_C
#define REP_C 1
#endif
#ifndef REP_G
#define REP_G 1
#endif

struct Params {
  const float *x_prompt, *x_sample, *c_prompt, *c_sample, *w_mod, *b_mod, *g1, *g2, *w_in, *conv_w, *conv_b;
  const float *f_w1, *f_b1, *f_freq, *f_w2, *f_b2, *f_w3, *f_bias, *q_gain, *k_gain, *sink, *w_pa, *w_pb, *w_out;
  const float *peer_wq, *peer_k1, *peer_k2, *peer_u, *peer_v;
  float* out;
  bf16_t *WinT, *WpaT, *WpbT, *WoutT, *WcT, *Gf, *tabU, *tabV, *zT, *zqkv, *yaT, *yb, *hbuf, *merged, *yatok;
  unsigned short* pidx;
  float *pg, *mod, *rope;
};

__device__ __forceinline__ float bf2f(bf16_t v) { return __uint_as_float(((unsigned)v) << 16); }
__device__ __forceinline__ bf16_t f2bf(float f) {
  unsigned u = __float_as_uint(f);
  u += 0x7FFFu + ((u >> 16) & 1u);
  return (bf16_t)(u >> 16);
}
__device__ __forceinline__ unsigned pack2(float a, float b) { return (unsigned)f2bf(a) | ((unsigned)f2bf(b) << 16); }
__device__ __forceinline__ float lo2f(unsigned u) { return __uint_as_float(u << 16); }
__device__ __forceinline__ float hi2f(unsigned u) { return __uint_as_float(u & 0xFFFF0000u); }

__device__ __forceinline__ int otid() { int t = threadIdx.x; asm volatile("" : "+v"(t)); return t; }
__device__ __forceinline__ int osgpr(int x) { asm volatile("" : "+s"(x)); return x; }
__device__ __forceinline__ float wave_sum(float v) {
#pragma unroll
  for (int m = 32; m >= 1; m >>= 1) v += __shfl_xor(v, m, 64);
  return v;
}

__device__ __forceinline__ const float* xrow_in(const Params& p, int tok) {
  return (tok < NBP * SEQ) ? (p.x_prompt + (size_t)tok * DM) : (p.x_sample + (size_t)(tok - NBP * SEQ) * DM);
}
__device__ __forceinline__ const float* crow(const Params& p, int b) {
  return (b < NBP) ? (p.c_prompt + (size_t)b * DM) : (p.c_sample + (size_t)(b - NBP) * DM);
}

constexpr int LDS_ROW = 72;
constexpr int STAGE_ELEMS = (192 + 128) * LDS_ROW;
constexpr int GEMM_LDS_BYTES = 2 * STAGE_ELEMS * 2;

__device__ __forceinline__ void gemm_core(const bf16_t* __restrict__ A, int lda, const bf16_t* __restrict__ B, int ldb,
                                          int K, bf16_t* lds, f32x16 (&acc)[3]) {
  const int tid = otid();
  const int lane = tid & 63, w = tid >> 6;
  const int wm = w >> 2, wn = w & 3;
#pragma unroll
  for (int i = 0; i < 3; ++i)
#pragma unroll
    for (int j = 0; j < 16; ++j) acc[i][j] = 0.f;

  const int crow_ = tid >> 3, ckc = (tid & 7) * 8;
  const bf16_t* pa0 = A + (size_t)crow_ * lda + ckc;
  const bf16_t* pa1 = A + (size_t)(crow_ + 64) * lda + ckc;
  const bf16_t* pa2 = A + (size_t)(crow_ + 128) * lda + ckc;
  const bf16_t* pb0 = B + (size_t)crow_ * ldb + ckc;
  const bf16_t* pb1 = B + (size_t)(crow_ + 64) * ldb + ckc;
  const int la = crow_ * LDS_ROW + ckc;
  const int nk = K >> 6;

  uint4 ra0, ra1, ra2, rb0, rb1;
  ra0 = *(const uint4*)pa0; ra1 = *(const uint4*)pa1; ra2 = *(const uint4*)pa2;
  rb0 = *(const uint4*)pb0; rb1 = *(const uint4*)pb1;
  __syncthreads();
  {
    bf16_t* As = lds; bf16_t* Bs = lds + 192 * LDS_ROW;
    *(uint4*)(As + la) = ra0; *(uint4*)(As + la + 64 * LDS_ROW) = ra1; *(uint4*)(As + la + 128 * LDS_ROW) = ra2;
    *(uint4*)(Bs + la) = rb0; *(uint4*)(Bs + la + 64 * LDS_ROW) = rb1;
  }
  __syncthreads();
  const int fr = lane & 31, fh = (lane >> 5) * 8;
  for (int kt = 0; kt < nk; ++kt) {
    if (kt + 1 < nk) {
      const int ko = (kt + 1) << 6;
      ra0 = *(const uint4*)(pa0 + ko); ra1 = *(const uint4*)(pa1 + ko); ra2 = *(const uint4*)(pa2 + ko);
      rb0 = *(const uint4*)(pb0 + ko); rb1 = *(const uint4*)(pb1 + ko);
    }
    const bf16_t* As = lds + (kt & 1) * STAGE_ELEMS;
    const bf16_t* Bs = As + 192 * LDS_ROW;
#pragma unroll
    for (int kk = 0; kk < 4; ++kk) {
      const int ko = kk * 16 + fh;
      bf16x8 bfrag = *(const bf16x8*)(Bs + (wn * 32 + fr) * LDS_ROW + ko);
#pragma unroll
      for (int mi = 0; mi < 3; ++mi) {
        bf16x8 afrag = *(const bf16x8*)(As + (wm * 96 + mi * 32 + fr) * LDS_ROW + ko);
        acc[mi] = __builtin_amdgcn_mfma_f32_32x32x16_bf16(afrag, bfrag, acc[mi], 0, 0, 0);
      }
    }
    if (kt + 1 < nk) {
      bf16_t* As2 = lds + ((kt + 1) & 1) * STAGE_ELEMS; bf16_t* Bs2 = As2 + 192 * LDS_ROW;
      *(uint4*)(As2 + la) = ra0; *(uint4*)(As2 + la + 64 * LDS_ROW) = ra1; *(uint4*)(As2 + la + 128 * LDS_ROW) = ra2;
      *(uint4*)(Bs2 + la) = rb0; *(uint4*)(Bs2 + la + 64 * LDS_ROW) = rb1;
    }
    __syncthreads();
  }
}
#define ACC_ROW(wm, mi, reg, lane) ((wm) * 96 + (mi) * 32 + ((reg) & 3) + 8 * ((reg) >> 2) + 4 * ((lane) >> 5))
#define ACC_COL(wn, lane) ((wn) * 32 + ((lane) & 31))

__device__ __forceinline__ void acc_to_lds(const f32x16 (&acc)[3], float* ct, int LD) {
  const int tid_ = otid(); const int lane = tid_ & 63, w = tid_ >> 6, wm = w >> 2, wn = w & 3;
  const int n = ACC_COL(wn, lane);
#pragma unroll
  for (int mi = 0; mi < 3; ++mi)
#pragma unroll
    for (int r = 0; r < 16; ++r) ct[ACC_ROW(wm, mi, r, lane) * LD + n] = acc[mi][r];
}
constexpr int LDT = 196;
__device__ __forceinline__ void acc_to_lds_T(const f32x16 (&acc)[3], float* ctT) {
  const int tid_ = otid(); const int lane = tid_ & 63, w = tid_ >> 6, wm = w >> 2, wn = w & 3;
  const int n = ACC_COL(wn, lane);
#pragma unroll
  for (int mi = 0; mi < 3; ++mi)
#pragma unroll
    for (int g4 = 0; g4 < 4; ++g4) {
      const int r0 = wm * 96 + mi * 32 + 8 * g4 + 4 * (lane >> 5);
      float4 v; v.x = acc[mi][g4 * 4 + 0]; v.y = acc[mi][g4 * 4 + 1]; v.z = acc[mi][g4 * 4 + 2]; v.w = acc[mi][g4 * 4 + 3];
      *(float4*)(ctT + n * LDT + r0) = v;
    }
}
__device__ __forceinline__ void store_tile_bf16(const float* ct, bf16_t* dst, int ldd, int tok0, int n0) {
#pragma unroll 1
  for (int it = otid(); it < 192 * 16; it += NTHR) {
    const int c8 = it & 15, r = it >> 4;
    const float4 a = *(const float4*)(ct + r * 132 + c8 * 8), b = *(const float4*)(ct + r * 132 + c8 * 8 + 4);
    uint4 o; o.x = pack2(a.x, a.y); o.y = pack2(a.z, a.w); o.z = pack2(b.x, b.y); o.w = pack2(b.z, b.w);
    *(uint4*)(dst + (size_t)(tok0 + r) * ldd + n0 + c8 * 8) = o;
  }
}

__device__ void p0_transpose_tile(const float* __restrict__ src, bf16_t* __restrict__ dst, int R, int C, int tr, int tc, char* smem) {
  float* t = (float*)smem;
  const int tid = otid();
  __syncthreads();
#pragma unroll
  for (int i = 0; i < 8; ++i) {
    int r = (tid >> 6) + 8 * i, c = tid & 63;
    t[r * 65 + c] = src[(size_t)(tr * 64 + r) * C + tc * 64 + c];
  }
  __syncthreads();
#pragma unroll
  for (int i = 0; i < 8; ++i) {
    int cc = (tid >> 6) + 8 * i, rr = tid & 63;
    dst[(size_t)(tc * 64 + cc) * R + tr * 64 + rr] = f2bf(t[rr * 65 + cc]);
  }
}

__device__ void p0_wc_item(const Params& p, int l, int ph, int kt, char* smem) {
  float* wqs = (float*)smem;
  float* ks = wqs + 64 * 129;
  const int tid = otid();
  const float* wq = p.peer_wq + (size_t)l * DM * 2048;
  const float* kk = ((ph & 1) ? p.peer_k2 : p.peer_k1) + (size_t)l * 128 * 128;
  __syncthreads();
  for (int e = tid; e < 64 * 128; e += NTHR) {
    int r = e >> 7, d = e & 127;
    wqs[r * 129 + d] = wq[(size_t)(kt * 64 + r) * 2048 + ph * 128 + d];
  }
  for (int e = tid; e < 128 * 128; e += NTHR) {
    int r = e >> 7, d = e & 127;
    ks[r * 129 + d] = kk[r * 128 + d];
  }
  __syncthreads();
  const int key = tid & 127, k0 = (tid >> 7) * 16;
  float acc[16];
#pragma unroll
  for (int i = 0; i < 16; ++i) acc[i] = 0.f;
  for (int d = 0; d < 128; ++d) {
    float kv = ks[key * 129 + d];
#pragma unroll
    for (int i = 0; i < 16; ++i) acc[i] += wqs[(k0 + i) * 129 + d] * kv;
  }
  bf16_t* dst = p.WcT + ((size_t)l * 2048 + ph * 128 + key) * DM + kt * 64 + k0;
  uint4 o0, o1;
  o0.x = pack2(acc[0], acc[1]); o0.y = pack2(acc[2], acc[3]); o0.z = pack2(acc[4], acc[5]); o0.w = pack2(acc[6], acc[7]);
  o1.x = pack2(acc[8], acc[9]); o1.y = pack2(acc[10], acc[11]); o1.z = pack2(acc[12], acc[13]); o1.w = pack2(acc[14], acc[15]);
  *(uint4*)dst = o0; *(uint4*)(dst + 8) = o1;
}

__device__ void p0_mod_item(const Params& p, int l, int cc, char* smem) {
  float* sc = (float*)smem;
  const int tid = otid();
  __syncthreads();
  for (int e = tid; e < NB * DM; e += NTHR) {
    int b = e >> 10, k = e & 1023;
    float v = crow(p, b)[k];
    sc[k * 24 + b] = v / (1.f + __expf(-v));
  }
  __syncthreads();
  const int n = cc * 512 + tid;
  float acc[24];
#pragma unroll
  for (int b = 0; b < 24; ++b) acc[b] = 0.f;
  const float* wm = p.w_mod + (size_t)l * DM * 6144 + n;
  for (int k0 = 0; k0 < DM; k0 += 8) {
    float wv[8];
#pragma unroll
    for (int j = 0; j < 8; ++j) wv[j] = wm[(size_t)(k0 + j) * 6144];
#pragma unroll
    for (int j = 0; j < 8; ++j) {
      const float4* s4 = (const float4*)(sc + (k0 + j) * 24);
#pragma unroll
      for (int q = 0; q < 6; ++q) {
        float4 s = s4[q];
        acc[q * 4 + 0] += s.x * wv[j]; acc[q * 4 + 1] += s.y * wv[j]; acc[q * 4 + 2] += s.z * wv[j]; acc[q * 4 + 3] += s.w * wv[j];
      }
    }
  }
  const float bm = p.b_mod[l * 6144 + n];
#pragma unroll
  for (int b = 0; b < 24; ++b) p.mod[((size_t)l * NB + b) * 6144 + n] = acc[b] + bm;
}

__device__ void p0_filter_item(const Params& p, int l, int tc, char* smem) {
  float* feat = (float*)smem;
  float* a1 = feat + 32 * 33;
  float* a2 = a1 + 32 * 64;
  bf16_t* stage = (bf16_t*)(a2 + 32 * 64);
  const int tid = otid();
  const int t0 = tc * 32;
  __syncthreads();
  for (int e = tid; e < 32 * 33; e += NTHR) {
    int pp = e / 33, f = e % 33;
    int ti = t0 + pp;
    float v;
    if (f == 0) v = (float)ti / (float)(SEQ - 1);
    else {
      int bi = (f - 1) & 15;
      float band = 1e-4f + (float)bi * ((15.f - 1e-4f) / 15.f);
      float wv = 2.0f * 3.14159265358979323846f * (float)ti / (float)SEQ;
      float arg = band * wv;
      v = (f <= 16) ? cosf(arg) : -sinf(arg);
    }
    feat[pp * 33 + f] = v;
  }
  __syncthreads();
  const float* w1 = p.f_w1 + l * 33 * 64; const float* b1 = p.f_b1 + l * 64; const float* fq = p.f_freq + l * 64;
  const float* w2 = p.f_w2 + l * 64 * 64; const float* b2 = p.f_b2 + l * 64;
  for (int e = tid; e < 32 * 64; e += NTHR) {
    int pp = e >> 6, j = e & 63;
    float s = b1[j];
    for (int f = 0; f < 33; ++f) s += feat[pp * 33 + f] * w1[f * 64 + j];
    a1[pp * 64 + j] = sinf(fq[j] * s);
  }
  __syncthreads();
  for (int e = tid; e < 32 * 64; e += NTHR) {
    int pp = e >> 6, j = e & 63;
    float s = b2[j];
    for (int i = 0; i < 64; ++i) s += a1[pp * 64 + i] * w2[i * 64 + j];
    a2[pp * 64 + j] = sinf(fq[j] * s);
  }
  __syncthreads();
  const float* w3 = p.f_w3 + (size_t)l * 64 * 2048;
  const float min_decay = logf(1e-2f) / 1.5f, max_decay = logf(1e-2f) / 0.3f;
  for (int q = 0; q < 4; ++q) {
    const int n = tid + 512 * q;
    const int c = n & 511;
    float wr[64];
#pragma unroll
    for (int i = 0; i < 64; ++i) wr[i] = w3[i * 2048 + n];
    const float delta = fabsf(min_decay + (max_decay - min_decay) * (float)c / 511.f);
    for (int pp = 0; pp < 32; ++pp) {
      float s = 0.f;
#pragma unroll
      for (int i = 0; i < 64; ++i) s += a2[pp * 64 + i] * wr[i];
      float tt = (float)(t0 + pp) / (float)(SEQ - 1);
      s *= __expf(-tt * delta);
      if (t0 + pp == 0 && ((n >> 9) & 1) == 0) s += p.f_bias[(l * 2 + (n >> 10)) * 512 + c];
      stage[n * 32 + pp] = f2bf(s);
    }
  }
  __syncthreads();
  for (int e = tid; e < 2048 * 32; e += NTHR) {
    int n = e >> 5, pp = e & 31;
    int o = n >> 10, d = (n >> 9) & 1, c = n & 511;
    int t = t0 + pp;
    bf16_t* g = p.Gf + ((size_t)((l * 2 + o) * 512 + c)) * 4096;
    if (d == 0) g[2048 - t] = stage[n * 32 + pp];
    else if (t >= 1) g[2048 + t] = stage[n * 32 + pp];
    if (t == 0 && d == 0) g[0] = 0;
  }
}

__device__ void p0_rope_item(const Params& p, int it) {
  int e = it * 512 + otid();
  int pos = e >> 5, i = e & 31;
  float inv = powf(10000.f, -(float)(2 * i) / 64.f);
  float ang = (float)pos * inv;
  p.rope[e * 2 + 0] = cosf(ang);
  p.rope[e * 2 + 1] = sinf(ang);
}

constexpr int P0_TR_PER_LAYER = 16 * 68 + 8 * 16 + 8 * 16 + 16 * 16;
constexpr int P0_N_TR = 2 * P0_TR_PER_LAYER;
constexpr int P0_N_WC = 2 * 16 * 16;
constexpr int P0_N_MOD = 2 * 12;
constexpr int P0_N_FILT = 2 * 64;
constexpr int P0_N_ROPE = 128;
constexpr int P0_TOTAL = P0_N_MOD + P0_N_FILT + P0_N_WC + P0_N_ROPE + P0_N_TR;

__device__ void phase_p0(const Params& p, char* smem) {
  for (int it = blockIdx.x; it < P0_TOTAL; it += gridDim.x) {
    int i = it;
    if (i < P0_N_MOD) { p0_mod_item(p, i / 12, i % 12, smem); continue; }
    i -= P0_N_MOD;
    if (i < P0_N_FILT) { p0_filter_item(p, i / 64, i % 64, smem); continue; }
    i -= P0_N_FILT;
    if (i < P0_N_WC) { p0_wc_item(p, i >> 8, (i >> 4) & 15, i & 15, smem); continue; }
    i -= P0_N_WC;
    if (i < P0_N_ROPE) { p0_rope_item(p, i); continue; }
    i -= P0_N_ROPE;
    {
      int l = i / P0_TR_PER_LAYER, j = i % P0_TR_PER_LAYER;
      if (j < 16 * 68) { p0_transpose_tile(p.w_in + (size_t)l * DM * INC, p.WinT + (size_t)l * INC * DM, DM, INC, j / 68, j % 68, smem); continue; }
      j -= 16 * 68;
      if (j < 128) { p0_transpose_tile(p.w_pa + (size_t)l * HYW * DM, p.WpaT + (size_t)l * DM * HYW, HYW, DM, j / 16, j % 16, smem); continue; }
      j -= 128;
      if (j < 128) { p0_transpose_tile(p.w_pb + (size_t)l * HYW * DM, p.WpbT + (size_t)l * DM * HYW, HYW, DM, j / 16, j % 16, smem); continue; }
      j -= 128;
      p0_transpose_tile(p.w_out + (size_t)l * DM * DM, p.WoutT + (size_t)l * DM * DM, DM, DM, j / 16, j % 16, smem);
    }
  }
}

__device__ void norm_rows(const Params& p, int tile, int l, int which, bool from_inputs, char* smem) {
  float* scl = (float*)smem;
  float* shf = scl + 2048;
  const int tid = otid(), lane = tid & 63, w = tid >> 6;
  const int tok0 = tile * TM;
  const int b0 = tok0 >> 11;
  const float* g = (which ? p.g2 : p.g1) + l * DM;
  __syncthreads();
  for (int e = tid; e < 2048; e += NTHR) {
    int bi = e >> 10, j = e & 1023;
    int b = b0 + bi; if (b > NB - 1) b = NB - 1;
    const float* m = p.mod + ((size_t)l * NB + b) * 6144 + which * 3072;
    scl[e] = g[j] * (1.f + m[1024 + j]);
    shf[e] = m[j];
  }
  __syncthreads();
  for (int r = w; r < TM; r += 8) {
    const int tok = tok0 + r;
    const int bi = (tok >> 11) - b0;
    const float* xr = from_inputs ? xrow_in(p, tok) : (p.out + (size_t)tok * DM);
    float4 v[4];
    float ss = 0.f;
#pragma unroll
    for (int i = 0; i < 4; ++i) {
      v[i] = *(const float4*)(xr + lane * 4 + 256 * i);
      ss += v[i].x * v[i].x + v[i].y * v[i].y + v[i].z * v[i].z + v[i].w * v[i].w;
    }
    ss = wave_sum(ss);
    const float rs = rsqrtf(ss * (1.f / DM) + 1e-6f);
#pragma unroll
    for (int i = 0; i < 4; ++i) {
      const int j = lane * 4 + 256 * i;
      const float4 sc4 = *(const float4*)(scl + bi * 1024 + j);
      const float4 sh4 = *(const float4*)(shf + bi * 1024 + j);
      uint2 o;
      o.x = pack2(v[i].x * rs * sc4.x + sh4.x, v[i].y * rs * sc4.y + sh4.y);
      o.y = pack2(v[i].z * rs * sc4.z + sh4.z, v[i].w * rs * sc4.w + sh4.w);
      *(uint2*)(p.hbuf + (size_t)tok * DM + j) = o;
    }
  }
  __syncthreads();
}

__device__ void phase_c(const Params& p, int tile, int l, bool from_inputs, char* smem) {
  norm_rows(p, tile, l, 0, from_inputs, smem);
  const int tid = otid();
  const int tok0 = tile * TM;
  const bf16_t* A = p.hbuf + (size_t)tok0 * DM;
  const bf16_t* W = p.WinT + (size_t)l * INC * DM;
  float* ct = (float*)smem;
  f32x16 acc[3];
#pragma unroll 1
  for (int nc = 0; nc < 18; ++nc) {
    gemm_core(A, DM, W + (size_t)nc * 128 * DM, DM, DM, (bf16_t*)smem, acc);
    if (nc < 12) {
      acc_to_lds_T(acc, ct);
      __syncthreads();
#pragma unroll 1
      for (int it = tid; it < 128 * 24; it += NTHR) {
        const int tg = it % 24, nl = it / 24;
        const float4 a = *(const float4*)(ct + nl * LDT + tg * 8), b4 = *(const float4*)(ct + nl * LDT + tg * 8 + 4);
        uint4 o; o.x = pack2(a.x, a.y); o.y = pack2(a.z, a.w); o.z = pack2(b4.x, b4.y); o.w = pack2(b4.z, b4.w);
        const int tok = tok0 + tg * 8;
        const int b = tok >> 11, sq = tok & 2047;
        *(uint4*)(p.zT + ((size_t)b * HYC + nc * 128 + nl) * SEQ + sq) = o;
      }
    } else {
      acc_to_lds(acc, ct, 132);
      __syncthreads();
      store_tile_bf16(ct, p.zqkv, QKVC, tok0, nc * 128 - HYC);
    }
  }
}

__device__ __forceinline__ void load_conv8(const bf16_t* __restrict__ zrow, int s0, float w0, float w1, float w2, float cb, float (&o)[8]) {
  uint4 v = *(const uint4*)(zrow + s0);
  float z[10];
  z[0] = (s0 > 0) ? bf2f(zrow[s0 - 1]) : 0.f;
  z[1] = lo2f(v.x); z[2] = hi2f(v.x); z[3] = lo2f(v.y); z[4] = hi2f(v.y);
  z[5] = lo2f(v.z); z[6] = hi2f(v.z); z[7] = lo2f(v.w); z[8] = hi2f(v.w);
  z[9] = (s0 + 8 < SEQ) ? bf2f(zrow[s0 + 8]) : 0.f;
#pragma unroll
  for (int i = 0; i < 8; ++i) o[i] = z[i] * w0 + z[i + 1] * w1 + z[i + 2] * w2 + cb;
}

typedef short s16x4 __attribute__((ext_vector_type(4)));
__device__ __forceinline__ s16x4 tr_read4(const bf16_t* lds_ptr) {
  return __builtin_amdgcn_ds_read_tr16_b64_v4i16((__attribute__((address_space(3))) s16x4*)(lds_ptr));
}

constexpr int HY_GS_ELEMS = 4112;
constexpr int HY_US_ROWS = 2072;
__device__ __forceinline__ void hyena_load_g(const Params& p, int l, int o, int c, bf16_t* Gs, int tid) {
  const bf16_t* g = p.Gf + ((size_t)((l * 2 + o) * 512 + c)) * 4096;
  *(uint4*)(Gs + 8 + tid * 8) = *(const uint4*)(g + tid * 8);
  if (tid == 0) { *(uint4*)Gs = make_uint4(0, 0, 0, 0); *(uint4*)(Gs + 4104) = make_uint4(0, 0, 0, 0); }
}

__device__ __forceinline__ void hyena_kloop(const bf16_t* Gs, const bf16_t* us, int rho, int lane, f32x16 (&acc)[8]) {
#pragma unroll
  for (int a = 0; a < 8; ++a)
#pragma unroll
    for (int j = 0; j < 16; ++j) acc[a][j] = 0.f;
  const int i = lane & 31, hh = lane >> 5;
  const bf16_t* ga = Gs + (2040 - 8 * i + 8 * hh) - 1792;
  const int l16 = lane & 15, q = l16 >> 2, pq = l16 & 3, g4 = lane >> 4;
  const bf16_t* ub = us + (rho + 8 * (g4 >> 1) + q) * 24 + 16 * (g4 & 1) + 4 * pq;
#pragma unroll 1
  for (int kap = 0; kap < 129; ++kap) {
    const s16x4 b0 = tr_read4(ub + kap * 384);
    const s16x4 b1 = tr_read4(ub + kap * 384 + 96);
    bf16x8 bfrag;
    bfrag[0] = b0[0]; bfrag[1] = b0[1]; bfrag[2] = b0[2]; bfrag[3] = b0[3];
    bfrag[4] = b1[0]; bfrag[5] = b1[1]; bfrag[6] = b1[2]; bfrag[7] = b1[3];
#pragma unroll
    for (int a = 0; a < 8; ++a) {
      const bf16x8 af = *(const bf16x8*)(ga + kap * 16 + 256 * (7 - a));
      acc[a] = __builtin_amdgcn_mfma_f32_32x32x16_bf16(af, bfrag, acc[a], 0, 0, 0);
    }
  }
}

__device__ __forceinline__ void hyena_acc_to_us(const f32x16 (&acc)[8], bf16_t* us, int rho, int lane) {
  const int n = lane & 31, hh = lane >> 5;
  if (n < 24) {
#pragma unroll
    for (int a = 0; a < 8; ++a)
#pragma unroll
      for (int r = 0; r < 16; ++r) {
        const int t = 256 * a + rho + 8 * ((r & 3) + 8 * (r >> 2) + 4 * hh);
        us[(t + 16) * 24 + n] = f2bf(acc[a][r]);
      }
  }
}

__device__ void hyena_item(const Params& p, int l, int c, char* smem) {
  bf16_t* Gs = (bf16_t*)smem;
  bf16_t* us = (bf16_t*)(smem + 8256);
  const int tid = otid();
  const int lane = tid & 63, w = tid >> 6;
  const float* cw = p.conv_w + (size_t)l * 3 * HYC;
  const float* cbp = p.conv_b + (size_t)l * HYC;
  __syncthreads();
  hyena_load_g(p, l, 0, c, Gs, tid);
  if (tid < 48) *(uint4*)(us + tid * 8) = make_uint4(0, 0, 0, 0);
  else if (tid < 48 + 26) *(uint4*)(us + 2064 * 24 + (tid - 48) * 8) = make_uint4(0, 0, 0, 0);
  {
    const float w0 = cw[c], w1 = cw[HYC + c], w2 = cw[2 * HYC + c], cb = cbp[c];
#pragma unroll 1
    for (int qq = tid; qq < 24 * 256; qq += NTHR) {
      const int b = qq % 24, s0 = (qq / 24) * 8;
      float v[8];
      load_conv8(p.zT + ((size_t)b * HYC + c) * SEQ, s0, w0, w1, w2, cb, v);
#pragma unroll
      for (int i = 0; i < 8; ++i) us[(s0 + i + 16) * 24 + b] = f2bf(v[i]);
    }
  }
  __syncthreads();
  f32x16 acc[8];
#pragma unroll 1
  for (int o = 0; o < 2; ++o) {
    hyena_kloop(Gs, us, w, lane, acc);
    __syncthreads();
    hyena_acc_to_us(acc, us, w, lane);
    if (o == 0) hyena_load_g(p, l, 1, c, Gs, tid);
    __syncthreads();
    const int xc = (o == 0 ? 512 : 1024) + c;
    const float xw0 = cw[xc], xw1 = cw[HYC + xc], xw2 = cw[2 * HYC + xc], xcb = cbp[xc];
#pragma unroll 1
    for (int qq = tid; qq < 24 * 256; qq += NTHR) {
      const int b = qq % 24, s0 = (qq / 24) * 8;
      float xv[8];
      load_conv8(p.zT + ((size_t)b * HYC + xc) * SEQ, s0, xw0, xw1, xw2, xcb, xv);
      if (o == 0) {
#pragma unroll
        for (int i = 0; i < 8; ++i) {
          bf16_t* e = us + (s0 + i + 16) * 24 + b;
          *e = f2bf(bf2f(*e) * xv[i]);
        }
      } else {
        float r[8];
#pragma unroll
        for (int i = 0; i < 8; ++i) r[i] = bf2f(us[(s0 + i + 16) * 24 + b]) * xv[i];
        uint4 pk; pk.x = pack2(r[0], r[1]); pk.y = pack2(r[2], r[3]); pk.z = pack2(r[4], r[5]); pk.w = pack2(r[6], r[7]);
        *(uint4*)(p.yaT + ((size_t)b * HYW + c) * SEQ + s0) = pk;
      }
    }
    __syncthreads();
  }
}

__device__ void attn_item(const Params& p, int l, int item, char* smem) {
  constexpr int KS = 72;
  bf16_t* Ks = (bf16_t*)smem;
  bf16_t* Vs = Ks + 384 * KS;
  const int tid = otid();
  const int kh = item & 1, qb = (item >> 1) & 15, b = item >> 5;
  const int kpos0 = qb * 128 - 128;
  __syncthreads();
  if (tid < 384) {
    const int r = tid, kpos = kpos0 + r;
    if (kpos >= 0 && kpos < SEQ) {
      const bf16_t* kr = p.zqkv + ((size_t)(b * SEQ + kpos)) * QKVC + 512 + kh * 64;
      float kf[64];
      float ss = 0.f;
#pragma unroll
      for (int c8 = 0; c8 < 8; ++c8) {
        uint4 v = *(const uint4*)(kr + c8 * 8);
        kf[c8 * 8 + 0] = lo2f(v.x); kf[c8 * 8 + 1] = hi2f(v.x); kf[c8 * 8 + 2] = lo2f(v.y); kf[c8 * 8 + 3] = hi2f(v.y);
        kf[c8 * 8 + 4] = lo2f(v.z); kf[c8 * 8 + 5] = hi2f(v.z); kf[c8 * 8 + 6] = lo2f(v.w); kf[c8 * 8 + 7] = hi2f(v.w);
      }
#pragma unroll
      for (int d = 0; d < 64; ++d) ss += kf[d] * kf[d];
      const float rs = rsqrtf(ss * (1.f / 64.f) + 1e-6f);
      const float* kg = p.k_gain + l * 64;
#pragma unroll
      for (int d = 0; d < 64; ++d) kf[d] = kf[d] * rs * kg[d];
      const float* rp = p.rope + (size_t)kpos * 64;
#pragma unroll
      for (int i = 0; i < 32; ++i) {
        const float cs = rp[i * 2], sn = rp[i * 2 + 1];
        const float a = kf[i], bb = kf[i + 32];
        kf[i] = a * cs - bb * sn; kf[i + 32] = bb * cs + a * sn;
      }
#pragma unroll
      for (int c8 = 0; c8 < 8; ++c8) {
        uint4 pk;
        pk.x = pack2(kf[c8 * 8 + 0], kf[c8 * 8 + 1]); pk.y = pack2(kf[c8 * 8 + 2], kf[c8 * 8 + 3]);
        pk.z = pack2(kf[c8 * 8 + 4], kf[c8 * 8 + 5]); pk.w = pack2(kf[c8 * 8 + 6], kf[c8 * 8 + 7]);
        *(uint4*)(Ks + r * KS + c8 * 8) = pk;
      }
    }
  }
  for (int e = tid; e < 384 * 8; e += NTHR) {
    const int r = e >> 3, c8 = e & 7, kpos = kpos0 + r;
    if (kpos >= 0 && kpos < SEQ)
      *(uint4*)(Vs + r * KS + c8 * 8) = *(const uint4*)(p.zqkv + ((size_t)(b * SEQ + kpos)) * QKVC + 640 + kh * 64 + c8 * 8);
  }
  __syncthreads();
  const int hl = tid >> 7, qi = tid & 127;
  const int head = kh * 4 + hl;
  const int qpos = qb * 128 + qi;
  const int tok = b * SEQ + qpos;
  float qf[64];
  {
    const bf16_t* qr = p.zqkv + (size_t)tok * QKVC + head * 64;
    float ss = 0.f;
#pragma unroll
    for (int c8 = 0; c8 < 8; ++c8) {
      uint4 v = *(const uint4*)(qr + c8 * 8);
      qf[c8 * 8 + 0] = lo2f(v.x); qf[c8 * 8 + 1] = hi2f(v.x); qf[c8 * 8 + 2] = lo2f(v.y); qf[c8 * 8 + 3] = hi2f(v.y);
      qf[c8 * 8 + 4] = lo2f(v.z); qf[c8 * 8 + 5] = hi2f(v.z); qf[c8 * 8 + 6] = lo2f(v.w); qf[c8 * 8 + 7] = hi2f(v.w);
    }
#pragma unroll
    for (int d = 0; d < 64; ++d) ss += qf[d] * qf[d];
    const float rs = rsqrtf(ss * (1.f / 64.f) + 1e-6f) * 0.125f;
    const float* qg = p.q_gain + l * 64;
#pragma unroll
    for (int d = 0; d < 64; ++d) qf[d] = qf[d] * rs * qg[d];
    const float* rp = p.rope + (size_t)qpos * 64;
#pragma unroll
    for (int i = 0; i < 32; ++i) {
      const float cs = rp[i * 2], sn = rp[i * 2 + 1];
      const float a = qf[i], bb = qf[i + 32];
      qf[i] = a * cs - bb * sn; qf[i + 32] = bb * cs + a * sn;
    }
  }
  float m = p.sink[l * 8 + head], lsum = 1.f;
  float o[64];
#pragma unroll
  for (int d = 0; d < 64; ++d) o[d] = 0.f;
  const int qi0 = qi & 64;
  int rlo = qi0, rhi = qi0 + 63 + 256;
  if (kpos0 + rlo < 0) rlo = -kpos0;
  if (kpos0 + rhi > SEQ - 1) rhi = SEQ - 1 - kpos0;
  for (int r = rlo; r <= rhi; ++r) {
    const int kpos = kpos0 + r;
    float dot = 0.f;
#pragma unroll
    for (int c8 = 0; c8 < 8; ++c8) {
      uint4 v = *(const uint4*)(Ks + r * KS + c8 * 8);
      dot += qf[c8 * 8 + 0] * lo2f(v.x) + qf[c8 * 8 + 1] * hi2f(v.x) + qf[c8 * 8 + 2] * lo2f(v.y) + qf[c8 * 8 + 3] * hi2f(v.y)
           + qf[c8 * 8 + 4] * lo2f(v.z) + qf[c8 * 8 + 5] * hi2f(v.z) + qf[c8 * 8 + 6] * lo2f(v.w) + qf[c8 * 8 + 7] * hi2f(v.w);
    }
    int dd = kpos - qpos; dd = dd < 0 ? -dd : dd;
    const bool valid = dd <= 128;
    const float s = valid ? dot : -INFINITY;
    const float mn = fmaxf(m, s);
    const float corr = __expf(m - mn);
    const float pr = __expf(s - mn);
    lsum = lsum * corr + pr;
    m = mn;
#pragma unroll
    for (int c8 = 0; c8 < 8; ++c8) {
      uint4 v = *(const uint4*)(Vs + r * KS + c8 * 8);
      o[c8 * 8 + 0] = o[c8 * 8 + 0] * corr + pr * lo2f(v.x); o[c8 * 8 + 1] = o[c8 * 8 + 1] * corr + pr * hi2f(v.x);
      o[c8 * 8 + 2] = o[c8 * 8 + 2] * corr + pr * lo2f(v.y); o[c8 * 8 + 3] = o[c8 * 8 + 3] * corr + pr * hi2f(v.y);
      o[c8 * 8 + 4] = o[c8 * 8 + 4] * corr + pr * lo2f(v.z); o[c8 * 8 + 5] = o[c8 * 8 + 5] * corr + pr * hi2f(v.z);
      o[c8 * 8 + 6] = o[c8 * 8 + 6] * corr + pr * lo2f(v.w); o[c8 * 8 + 7] = o[c8 * 8 + 7] * corr + pr * hi2f(v.w);
    }
  }
  const float inv = 1.f / lsum;
  bf16_t* yo = p.yb + (size_t)tok * 512 + head * 64;
#pragma unroll
  for (int c8 = 0; c8 < 8; ++c8) {
    uint4 pk;
    pk.x = pack2(o[c8 * 8 + 0] * inv, o[c8 * 8 + 1] * inv); pk.y = pack2(o[c8 * 8 + 2] * inv, o[c8 * 8 + 3] * inv);
    pk.z = pack2(o[c8 * 8 + 4] * inv, o[c8 * 8 + 5] * inv); pk.w = pack2(o[c8 * 8 + 6] * inv, o[c8 * 8 + 7] * inv);
    *(uint4*)(yo + c8 * 8) = pk;
  }
}

__device__ void table_item(const Params& p, int l, int it) {
  const int tid = otid();
  const int which = it >> 10, chunk = it & 1023;
  const float* src = (which ? p.peer_v : p.peer_u) + (size_t)l * NEXP * DM + (size_t)chunk * 16384;
  bf16_t* dst = (which ? p.tabV : p.tabU) + (size_t)chunk * 16384;
#pragma unroll
  for (int i = 0; i < 4; ++i) {
    const int e = (tid + i * NTHR) * 8;
    float4 a = *(const float4*)(src + e), b = *(const float4*)(src + e + 4);
    uint4 o; o.x = pack2(a.x, a.y); o.y = pack2(a.z, a.w); o.z = pack2(b.x, b.y); o.w = pack2(b.z, b.w);
    *(uint4*)(dst + e) = o;
  }
}

constexpr int DE_N_HY = 512, DE_N_AT = 768, DE_N_TB = 2048;
__device__ void phase_de(const Params& p, int l, char* smem) {
  for (int it = blockIdx.x; it < DE_N_HY + DE_N_AT + DE_N_TB; it += gridDim.x) {
    if (it < DE_N_HY) hyena_item(p, l, it, smem);
    else if (it < DE_N_HY + DE_N_AT) attn_item(p, l, it - DE_N_HY, smem);
    else table_item(p, l, it - DE_N_HY - DE_N_AT);
  }
}

__device__ void phase_f(const Params& p, int tile, int l, bool from_inputs, char* smem) {
  const int tid = otid();
  const int tok0 = tile * TM;
#pragma unroll 1
  for (int e = tid; e < TM * 64; e += NTHR) {
    const int r = e % TM, cg8 = e / TM;
    const int tok = tok0 + r, b = tok >> 11, sq = tok & 2047;
    const bf16_t* src = p.yaT + ((size_t)b * HYW + cg8 * 8) * SEQ + sq;
    uint4 o;
    o.x = (unsigned)src[0] | ((unsigned)src[SEQ] << 16);
    o.y = (unsigned)src[2 * SEQ] | ((unsigned)src[3 * SEQ] << 16);
    o.z = (unsigned)src[4 * SEQ] | ((unsigned)src[5 * SEQ] << 16);
    o.w = (unsigned)src[6 * SEQ] | ((unsigned)src[7 * SEQ] << 16);
    *(uint4*)(p.yatok + (size_t)tok * HYW + cg8 * 8) = o;
  }
  __syncthreads();
  const bf16_t* Ah = p.hbuf + (size_t)tok0 * DM;
  const bf16_t* Aya = p.yatok + (size_t)tok0 * HYW;
  const bf16_t* Ayb = p.yb + (size_t)tok0 * HYW;
  const bf16_t* Win = p.WinT + (size_t)l * INC * DM;
  const bf16_t* Wpa = p.WpaT + (size_t)l * DM * HYW;
  const bf16_t* Wpb = p.WpbT + (size_t)l * DM * HYW;
  float* ct = (float*)smem;
  f32x16 acc[3], sg[3];
  unsigned mgp[3][8];
#pragma unroll 1
  for (int nc = 0; nc < 8; ++nc) {
    gemm_core(Ah, DM, Win + (size_t)(2304 + nc * 128) * DM, DM, DM, (bf16_t*)smem, acc);
#pragma unroll
    for (int mi = 0; mi < 3; ++mi)
#pragma unroll
      for (int r = 0; r < 16; ++r) sg[mi][r] = __builtin_amdgcn_rcpf(1.f + __expf(-acc[mi][r]));
    gemm_core(Aya, HYW, Wpa + (size_t)(nc * 128) * HYW, HYW, HYW, (bf16_t*)smem, acc);
#pragma unroll
    for (int mi = 0; mi < 3; ++mi)
#pragma unroll
      for (int q = 0; q < 8; ++q) mgp[mi][q] = pack2(sg[mi][2 * q] * acc[mi][2 * q], sg[mi][2 * q + 1] * acc[mi][2 * q + 1]);
    gemm_core(Ah, DM, Win + (size_t)(3328 + nc * 128) * DM, DM, DM, (bf16_t*)smem, acc);
#pragma unroll
    for (int mi = 0; mi < 3; ++mi)
#pragma unroll
      for (int r = 0; r < 16; ++r) sg[mi][r] = __builtin_amdgcn_rcpf(1.f + __expf(-acc[mi][r]));
    gemm_core(Ayb, HYW, Wpb + (size_t)(nc * 128) * HYW, HYW, HYW, (bf16_t*)smem, acc);
#pragma unroll
    for (int mi = 0; mi < 3; ++mi)
#pragma unroll
      for (int q = 0; q < 8; ++q) {
        acc[mi][2 * q] = lo2f(mgp[mi][q]) + sg[mi][2 * q] * acc[mi][2 * q];
        acc[mi][2 * q + 1] = hi2f(mgp[mi][q]) + sg[mi][2 * q + 1] * acc[mi][2 * q + 1];
      }
    acc_to_lds(acc, ct, 132);
    __syncthreads();
    store_tile_bf16(ct, p.merged, DM, tok0, nc * 128);
  }
  __syncthreads();
  const bf16_t* Am = p.merged + (size_t)tok0 * DM;
  const bf16_t* Wo = p.WoutT + (size_t)l * DM * DM;
#pragma unroll 1
  for (int nc = 0; nc < 8; ++nc) {
    gemm_core(Am, DM, Wo + (size_t)(nc * 128) * DM, DM, DM, (bf16_t*)smem, acc);
    acc_to_lds(acc, ct, 132);
    __syncthreads();
#pragma unroll 1
    for (int it = tid; it < 192 * 32; it += NTHR) {
      const int c4 = it & 31, r = it >> 5;
      const int tok = tok0 + r, b = tok >> 11;
      const int n = nc * 128 + c4 * 4;
      const float4 a = *(const float4*)(ct + r * 132 + c4 * 4);
      const float4 gt = *(const float4*)(p.mod + ((size_t)l * NB + b) * 6144 + 2048 + n);
      const float* xs = from_inputs ? xrow_in(p, tok) : (p.out + (size_t)tok * DM);
      float4 xo = *(const float4*)(xs + n);
      xo.x += gt.x * a.x; xo.y += gt.y * a.y; xo.z += gt.z * a.z; xo.w += gt.w * a.w;
      *(float4*)(p.out + (size_t)tok * DM + n) = xo;
    }
  }
  __syncthreads();
}

__device__ __forceinline__ void topk_insert(float (&key)[16], float kx) {
#pragma unroll
  for (int i = 0; i < 16; ++i) {
    const float hi = fmaxf(key[i], kx);
    kx = fminf(key[i], kx);
    key[i] = hi;
  }
}

__device__ void phase_g(const Params& p, int tile, int l, char* smem) {
  norm_rows(p, tile, l, 1, false, smem);
  const int tid = otid();
  const int tok0 = tile * TM;
  const bf16_t* Ah = p.hbuf + (size_t)tok0 * DM;
  const bf16_t* Wc = p.WcT + (size_t)l * 2048 * DM;
  float* sc = (float*)smem;
  f32x16 acc[3];
  float v1k[16], v2k[16];
#pragma unroll 1
  for (int ch = 0; ch < 16; ++ch) {
    gemm_core(Ah, DM, Wc + (size_t)(ch * 128) * DM, DM, DM, (bf16_t*)smem, acc);
    acc_to_lds(acc, sc, 129);
    __syncthreads();
    if (tid < TM) {
      float key[16];
#pragma unroll
      for (int i = 0; i < 16; ++i) key[i] = -INFINITY;
      const float* row = sc + tid * 129;
      for (int j = 0; j < 128; ++j) {
        const float x = row[j];
        const float kx = __uint_as_float((__float_as_uint(x) & 0xFFFFFF80u) | (unsigned)j);
        topk_insert(key, kx);
      }
      if ((ch & 1) == 0) {
#pragma unroll
        for (int i = 0; i < 16; ++i) v1k[i] = key[i];
      } else {
#pragma unroll
        for (int i = 0; i < 16; ++i) v2k[i] = key[i];
        float top[16];
#pragma unroll
        for (int i = 0; i < 16; ++i) top[i] = -INFINITY;
#pragma unroll
        for (int i = 0; i < 16; ++i)
#pragma unroll
          for (int j = 0; j < 16; ++j)
            if ((i + 1) * (j + 1) <= 16) {
              const float s = v1k[i] + v2k[j];
              const float ck = __uint_as_float((__float_as_uint(s) & 0xFFFFFF00u) | (unsigned)(i * 16 + j));
              topk_insert(top, ck);
            }
        const float mx = top[0];
        float ex[16], sum = 0.f;
#pragma unroll
        for (int k = 0; k < 16; ++k) { ex[k] = __expf(top[k] - mx); sum += ex[k]; }
        const float inv = 1.f / sum;
        const int hh = ch >> 1;
        const size_t ob = ((size_t)(tok0 + tid) * 8 + hh) * 16;
#pragma unroll
        for (int k = 0; k < 16; ++k) {
          const unsigned code = __float_as_uint(top[k]) & 0xFFu;
          const unsigned ii = code >> 4, jj = code & 15u;
          unsigned e1 = 0, e2 = 0;
#pragma unroll
          for (int q = 0; q < 16; ++q) {
            e1 = (ii == (unsigned)q) ? (__float_as_uint(v1k[q]) & 0x7Fu) : e1;
            e2 = (jj == (unsigned)q) ? (__float_as_uint(v2k[q]) & 0x7Fu) : e2;
          }
          p.pidx[ob + k] = (unsigned short)(e1 * 128 + e2);
          p.pg[ob + k] = ex[k] * inv;
        }
      }
    }
    __syncthreads();
  }
}

__device__ void phase_i(const Params& p, int tile, int l, char* smem) {
  const int tid = otid(), lane = tid & 63, w = tid >> 6;
  float* wsm = (float*)smem + w * 128;
  const int tok0 = tile * TM;
  __syncthreads();
  for (int r = w; r < TM; r += 8) {
    const int tok = tok0 + r;
    const int b = tok >> 11;
    float hx[16];
    {
      const bf16_t* hr = p.hbuf + (size_t)tok * DM;
      uint4 a = *(const uint4*)(hr + lane * 8), c = *(const uint4*)(hr + 512 + lane * 8);
      hx[0] = lo2f(a.x); hx[1] = hi2f(a.x); hx[2] = lo2f(a.y); hx[3] = hi2f(a.y);
      hx[4] = lo2f(a.z); hx[5] = hi2f(a.z); hx[6] = lo2f(a.w); hx[7] = hi2f(a.w);
      hx[8] = lo2f(c.x); hx[9] = hi2f(c.x); hx[10] = lo2f(c.y); hx[11] = hi2f(c.y);
      hx[12] = lo2f(c.z); hx[13] = hi2f(c.z); hx[14] = lo2f(c.w); hx[15] = hi2f(c.w);
    }
    const unsigned short* pi = p.pidx + (size_t)tok * 128;
    const float* pgp = p.pg + (size_t)tok * 128;
    for (int pp = 0; pp < 128; pp += 4) {
      uint4 ua[4], uc[4];
#pragma unroll
      for (int q = 0; q < 4; ++q) {
        const int e = pi[pp + q] & (NEXP - 1);
        const bf16_t* ur = p.tabU + (size_t)e * DM;
        ua[q] = *(const uint4*)(ur + lane * 8); uc[q] = *(const uint4*)(ur + 512 + lane * 8);
      }
#pragma unroll
      for (int q = 0; q < 4; ++q) {
        float d = hx[0] * lo2f(ua[q].x) + hx[1] * hi2f(ua[q].x) + hx[2] * lo2f(ua[q].y) + hx[3] * hi2f(ua[q].y)
                + hx[4] * lo2f(ua[q].z) + hx[5] * hi2f(ua[q].z) + hx[6] * lo2f(ua[q].w) + hx[7] * hi2f(ua[q].w)
                + hx[8] * lo2f(uc[q].x) + hx[9] * hi2f(uc[q].x) + hx[10] * lo2f(uc[q].y) + hx[11] * hi2f(uc[q].y)
                + hx[12] * lo2f(uc[q].z) + hx[13] * hi2f(uc[q].z) + hx[14] * lo2f(uc[q].w) + hx[15] * hi2f(uc[q].w);
        d = wave_sum(d);
        const float ge = 0.5f * d * (1.f + erff(d * 0.70710678118654752f));
        if (lane == 0) wsm[pp + q] = pgp[pp + q] * ge;
      }
    }
    float oa[16];
#pragma unroll
    for (int i = 0; i < 16; ++i) oa[i] = 0.f;
    for (int pp = 0; pp < 128; pp += 4) {
      uint4 va[4], vc[4];
      float wq[4];
#pragma unroll
      for (int q = 0; q < 4; ++q) {
        const int e = pi[pp + q] & (NEXP - 1);
        const bf16_t* vr = p.tabV + (size_t)e * DM;
        va[q] = *(const uint4*)(vr + lane * 8); vc[q] = *(const uint4*)(vr + 512 + lane * 8);
        wq[q] = wsm[pp + q];
      }
#pragma unroll
      for (int q = 0; q < 4; ++q) {
        const float ww = wq[q];
        oa[0] += ww * lo2f(va[q].x); oa[1] += ww * hi2f(va[q].x); oa[2] += ww * lo2f(va[q].y); oa[3] += ww * hi2f(va[q].y);
        oa[4] += ww * lo2f(va[q].z); oa[5] += ww * hi2f(va[q].z); oa[6] += ww * lo2f(va[q].w); oa[7] += ww * hi2f(va[q].w);
        oa[8] += ww * lo2f(vc[q].x); oa[9] += ww * hi2f(vc[q].x); oa[10] += ww * lo2f(vc[q].y); oa[11] += ww * hi2f(vc[q].y);
        oa[12] += ww * lo2f(vc[q].z); oa[13] += ww * hi2f(vc[q].z); oa[14] += ww * lo2f(vc[q].w); oa[15] += ww * hi2f(vc[q].w);
      }
    }
    const float* gt = p.mod + ((size_t)l * NB + b) * 6144 + 5 * 1024;
    float* xo = p.out + (size_t)tok * DM;
#pragma unroll
    for (int hsel = 0; hsel < 2; ++hsel) {
      const int j = hsel * 512 + lane * 8;
      float4 x0 = *(const float4*)(xo + j), x1 = *(const float4*)(xo + j + 4);
      const float4 g0 = *(const float4*)(gt + j), g1 = *(const float4*)(gt + j + 4);
      x0.x += g0.x * oa[hsel * 8 + 0]; x0.y += g0.y * oa[hsel * 8 + 1]; x0.z += g0.z * oa[hsel * 8 + 2]; x0.w += g0.w * oa[hsel * 8 + 3];
      x1.x += g1.x * oa[hsel * 8 + 4]; x1.y += g1.y * oa[hsel * 8 + 5]; x1.z += g1.z * oa[hsel * 8 + 6]; x1.w += g1.w * oa[hsel * 8 + 7];
      *(float4*)(xo + j) = x0; *(float4*)(xo + j + 4) = x1;
    }
  }
  __syncthreads();
}

__global__ void __launch_bounds__(NTHR) mega_kernel(Params p) {
  extern __shared__ __attribute__((aligned(16))) char smem[];
  cg::grid_group grid = cg::this_grid();
  phase_p0(p, smem);
  grid.sync();
  for (int l = 0; l < 2; ++l) {
    for (int rep = 0; rep < REP_C; ++rep)
    for (int tile = blockIdx.x; tile < NTILE; tile += gridDim.x) phase_c(p, tile, l, l == 0, smem);
    grid.sync();
    for (int rep = 0; rep < REP_DE; ++rep) phase_de(p, l, smem);
    grid.sync();
    for (int tile = blockIdx.x; tile < NTILE; tile += gridDim.x) {
      phase_f(p, tile, l, l == 0, smem);
      for (int rep = 0; rep < REP_G; ++rep) phase_g(p, tile, l, smem);
      phase_i(p, tile, l, smem);
    }
    if (l == 0) grid.sync();
  }
}

extern "C" void kernel_launch(void* const* d_in, const int* in_sizes, int n_in, void* d_out, int out_size, void* d_ws,
                              size_t ws_size, hipStream_t stream) {
  Params p{};
  const float* const* in = (const float* const*)d_in;
  p.x_prompt = in[0]; p.x_sample = in[1]; p.c_prompt = in[2]; p.c_sample = in[3]; p.w_mod = in[4]; p.b_mod = in[5];
  p.g1 = in[6]; p.g2 = in[7]; p.w_in = in[8]; p.conv_w = in[9]; p.conv_b = in[10]; p.f_w1 = in[11]; p.f_b1 = in[12];
  p.f_freq = in[13]; p.f_w2 = in[14]; p.f_b2 = in[15]; p.f_w3 = in[16]; p.f_bias = in[17]; p.q_gain = in[18];
  p.k_gain = in[19]; p.sink = in[20]; p.w_pa = in[21]; p.w_pb = in[22]; p.w_out = in[23]; p.peer_wq = in[24];
  p.peer_k1 = in[25]; p.peer_k2 = in[26]; p.peer_u = in[27]; p.peer_v = in[28];
  p.out = (float*)d_out;
  char* ws = (char*)d_ws;
  size_t off = 0;
  auto carve = [&](size_t bytes) { char* r = ws + off; off += (bytes + 255) & ~(size_t)255; return r; };
  p.WinT = (bf16_t*)carve((size_t)2 * INC * DM * 2);
  p.WpaT = (bf16_t*)carve((size_t)2 * DM * HYW * 2);
  p.WpbT = (bf16_t*)carve((size_t)2 * DM * HYW * 2);
  p.WoutT = (bf16_t*)carve((size_t)2 * DM * DM * 2);
  p.WcT = (bf16_t*)carve((size_t)2 * 2048 * DM * 2);
  p.Gf = (bf16_t*)carve((size_t)2 * 2 * 512 * 4096 * 2);
  p.mod = (float*)carve((size_t)2 * NB * 6144 * 4);
  p.rope = (float*)carve((size_t)SEQ * 64 * 4);
  p.tabU = (bf16_t*)carve((size_t)NEXP * DM * 2);
  p.tabV = (bf16_t*)carve((size_t)NEXP * DM * 2);
  p.zT = (bf16_t*)carve((size_t)NB * HYC * SEQ * 2);
  p.zqkv = (bf16_t*)carve((size_t)NTOK * QKVC * 2);
  p.yaT = (bf16_t*)carve((size_t)NTOK * HYW * 2);
  p.yb = (bf16_t*)carve((size_t)NTOK * HYW * 2);
  p.hbuf = (bf16_t*)carve((size_t)NTOK * DM * 2);
  p.merged = p.zT;
  p.yatok = p.zT + (size_t)NTOK * DM;
  p.pidx = (unsigned short*)p.zqkv;
  p.pg = (float*)(p.zqkv + (size_t)NTOK * 128);
  if (off > ws_size) fprintf(stderr, "workspace too small: need %zu have %zu\n", off, ws_size);

  static int grid_blocks = 0;
  if (!grid_blocks) {
    int dev = 0, cus = 0, per_cu = 0;
    hipGetDevice(&dev);
    hipDeviceGetAttribute(&cus, hipDeviceAttributeMultiprocessorCount, dev);
    hipFuncSetAttribute((const void*)mega_kernel, hipFuncAttributeMaxDynamicSharedMemorySize, SMEM_BYTES);
    hipOccupancyMaxActiveBlocksPerMultiprocessor(&per_cu, mega_kernel, NTHR, SMEM_BYTES);
    if (per_cu < 1) per_cu = 1;
    grid_blocks = cus * 1;
    if (grid_blocks > NTILE) grid_blocks = NTILE;
  }
  void* args[] = {&p};
  hipError_t e = hipLaunchCooperativeKernel((const void*)mega_kernel, dim3(grid_blocks), dim3(NTHR), args, SMEM_BYTES, stream);
  if (e != hipSuccess) fprintf(stderr, "cooperative launch failed: %s (grid %d)\n", hipGetErrorString(e), grid_blocks);
}
```

```cpp
#include <hip/hip_runtime.h>
#include <hip/hip_bf16.h>
#include <hip/hip_cooperative_groups.h>
#include <cstdio>
#include <cstdint>
namespace cg = cooperative_groups;

typedef unsigned short bf16_t;
using bf16x8 = __attribute__((ext_vector_type(8))) short;
using f32x16 = __attribute__((ext_vector_type(16))) float;

constexpr int DM = 1024;
constexpr int NB = 24;
constexpr int SEQ = 2048;
constexpr int NTOK = NB * SEQ;
constexpr int NBP = 16;
constexpr int INC = 4352;
constexpr int HYC = 1536;
constexpr int HYW = 512;
constexpr int QKVC = 768;
constexpr int TM = 192;
constexpr int NTILE = NTOK / TM;
constexpr int NTHR = 512;
constexpr int NEXP = 16384;
constexpr int SMEM_BYTES = 155648;
#ifndef REP_DE
#define REP_DE 1
#endif
#ifndef REP_C
#define REP_C 1
#endif
#ifndef REP_G
#define REP_G 1
#endif

struct Params {
  const float *x_prompt, *x_sample, *c_prompt, *c_sample, *w_mod, *b_mod, *g1, *g2, *w_in, *conv_w, *conv_b;
  const float *f_w1, *f_b1, *f_freq, *f_w2, *f_b2, *f_w3, *f_bias, *q_gain, *k_gain, *sink, *w_pa, *w_pb, *w_out;
  const float *peer_wq, *peer_k1, *peer_k2, *peer_u, *peer_v;
  float* out;
  bf16_t *WinT, *WpaT, *WpbT, *WoutT, *WcT, *Gf, *tabU, *tabV, *zT, *zqkv, *yaT, *yb, *hbuf, *merged, *yatok;
  unsigned short* pidx;
  float *pg, *mod, *rope;
};

__device__ __forceinline__ float bf2f(bf16_t v) { return __uint_as_float(((unsigned)v) << 16); }
__device__ __forceinline__ bf16_t f2bf(float f) {
  unsigned u = __float_as_uint(f);
  u += 0x7FFFu + ((u >> 16) & 1u);
  return (bf16_t)(u >> 16);
}
__device__ __forceinline__ unsigned pack2(float a, float b) { return (unsigned)f2bf(a) | ((unsigned)f2bf(b) << 16); }
__device__ __forceinline__ float lo2f(unsigned u) { return __uint_as_float(u << 16); }
__device__ __forceinline__ float hi2f(unsigned u) { return __uint_as_float(u & 0xFFFF0000u); }

__device__ __forceinline__ int otid() { int t = threadIdx.x; asm volatile("" : "+v"(t)); return t; }
__device__ __forceinline__ int osgpr(int x) { asm volatile("" : "+s"(x)); return x; }
__device__ __forceinline__ float wave_sum(float v) {
#pragma unroll
  for (int m = 32; m >= 1; m >>= 1) v += __shfl_xor(v, m, 64);
  return v;
}

__device__ __forceinline__ const float* xrow_in(const Params& p, int tok) {
  return (tok < NBP * SEQ) ? (p.x_prompt + (size_t)tok * DM) : (p.x_sample + (size_t)(tok - NBP * SEQ) * DM);
}
__device__ __forceinline__ const float* crow(const Params& p, int b) {
  return (b < NBP) ? (p.c_prompt + (size_t)b * DM) : (p.c_sample + (size_t)(b - NBP) * DM);
}

constexpr int LDS_ROW = 72;
constexpr int STAGE_ELEMS = (192 + 128) * LDS_ROW;
constexpr int GEMM_LDS_BYTES = 2 * STAGE_ELEMS * 2;

__device__ __forceinline__ void gemm_core(const bf16_t* __restrict__ A, int lda, const bf16_t* __restrict__ B, int ldb,
                                          int K, bf16_t* lds, f32x16 (&acc)[3]) {
  const int tid = otid();
  const int lane = tid & 63, w = tid >> 6;
  const int wm = w >> 2, wn = w & 3;
#pragma unroll
  for (int i = 0; i < 3; ++i)
#pragma unroll
    for (int j = 0; j < 16; ++j) acc[i][j] = 0.f;

  const int crow_ = tid >> 3, ckc = (tid & 7) * 8;
  const bf16_t* pa0 = A + (size_t)crow_ * lda + ckc;
  const bf16_t* pa1 = A + (size_t)(crow_ + 64) * lda + ckc;
  const bf16_t* pa2 = A + (size_t)(crow_ + 128) * lda + ckc;
  const bf16_t* pb0 = B + (size_t)crow_ * ldb + ckc;
  const bf16_t* pb1 = B + (size_t)(crow_ + 64) * ldb + ckc;
  const int la = crow_ * LDS_ROW + ckc;
  const int nk = K >> 6;

  uint4 ra0, ra1, ra2, rb0, rb1;
  ra0 = *(const uint4*)pa0; ra1 = *(const uint4*)pa1; ra2 = *(const uint4*)pa2;
  rb0 = *(const uint4*)pb0; rb1 = *(const uint4*)pb1;
  __syncthreads();
  {
    bf16_t* As = lds; bf16_t* Bs = lds + 192 * LDS_ROW;
    *(uint4*)(As + la) = ra0; *(uint4*)(As + la + 64 * LDS_ROW) = ra1; *(uint4*)(As + la + 128 * LDS_ROW) = ra2;
    *(uint4*)(Bs + la) = rb0; *(uint4*)(Bs + la + 64 * LDS_ROW) = rb1;
  }
  __syncthreads();
  const int fr = lane & 31, fh = (lane >> 5) * 8;
  for (int kt = 0; kt < nk; ++kt) {
    if (kt + 1 < nk) {
      const int ko = (kt + 1) << 6;
      ra0 = *(const uint4*)(pa0 + ko); ra1 = *(const uint4*)(pa1 + ko); ra2 = *(const uint4*)(pa2 + ko);
      rb0 = *(const uint4*)(pb0 + ko); rb1 = *(const uint4*)(pb1 + ko);
    }
    const bf16_t* As = lds + (kt & 1) * STAGE_ELEMS;
    const bf16_t* Bs = As + 192 * LDS_ROW;
#pragma unroll
    for (int kk = 0; kk < 4; ++kk) {
      const int ko = kk * 16 + fh;
      bf16x8 bfrag = *(const bf16x8*)(Bs + (wn * 32 + fr) * LDS_ROW + ko);
#pragma unroll
      for (int mi = 0; mi < 3; ++mi) {
        bf16x8 afrag = *(const bf16x8*)(As + (wm * 96 + mi * 32 + fr) * LDS_ROW + ko);
        acc[mi] = __builtin_amdgcn_mfma_f32_32x32x16_bf16(afrag, bfrag, acc[mi], 0, 0, 0);
      }
    }
    if (kt + 1 < nk) {
      bf16_t* As2 = lds + ((kt + 1) & 1) * STAGE_ELEMS; bf16_t* Bs2 = As2 + 192 * LDS_ROW;
      *(uint4*)(As2 + la) = ra0; *(uint4*)(As2 + la + 64 * LDS_ROW) = ra1; *(uint4*)(As2 + la + 128 * LDS_ROW) = ra2;
      *(uint4*)(Bs2 + la) = rb0; *(uint4*)(Bs2 + la + 64 * LDS_ROW) = rb1;
    }
    __syncthreads();
  }
}
#define ACC_ROW(wm, mi, reg, lane) ((wm) * 96 + (mi) * 32 + ((reg) & 3) + 8 * ((reg) >> 2) + 4 * ((lane) >> 5))
#define ACC_COL(wn, lane) ((wn) * 32 + ((lane) & 31))

__device__ __forceinline__ void acc_to_lds(const f32x16 (&acc)[3], float* ct, int LD) {
  const int tid_ = otid(); const int lane = tid_ & 63, w = tid_ >> 6, wm = w >> 2, wn = w & 3;
  const int n = ACC_COL(wn, lane);
#pragma unroll
  for (int mi = 0; mi < 3; ++mi)
#pragma unroll
    for (int r = 0; r < 16; ++r) ct[ACC_ROW(wm, mi, r, lane) * LD + n] = acc[mi][r];
}
constexpr int LDT = 196;
__device__ __forceinline__ void acc_to_lds_T(const f32x16 (&acc)[3], float* ctT) {
  const int tid_ = otid(); const int lane = tid_ & 63, w = tid_ >> 6, wm = w >> 2, wn = w & 3;
  const int n = ACC_COL(wn, lane);
#pragma unroll
  for (int mi = 0; mi < 3; ++mi)
#pragma unroll
    for (int g4 = 0; g4 < 4; ++g4) {
      const int r0 = wm * 96 + mi * 32 + 8 * g4 + 4 * (lane >> 5);
      float4 v; v.x = acc[mi][g4 * 4 + 0]; v.y = acc[mi][g4 * 4 + 1]; v.z = acc[mi][g4 * 4 + 2]; v.w = acc[mi][g4 * 4 + 3];
      *(float4*)(ctT + n * LDT + r0) = v;
    }
}
__device__ __forceinline__ void store_tile_bf16(const float* ct, bf16_t* dst, int ldd, int tok0, int n0) {
#pragma unroll 1
  for (int it = otid(); it < 192 * 16; it += NTHR) {
    const int c8 = it & 15, r = it >> 4;
    const float4 a = *(const float4*)(ct + r * 132 + c8 * 8), b = *(const float4*)(ct + r * 132 + c8 * 8 + 4);
    uint4 o; o.x = pack2(a.x, a.y); o.y = pack2(a.z, a.w); o.z = pack2(b.x, b.y); o.w = pack2(b.z, b.w);
    *(uint4*)(dst + (size_t)(tok0 + r) * ldd + n0 + c8 * 8) = o;
  }
}

__device__ void p0_transpose_tile(const float* __restrict__ src, bf16_t* __restrict__ dst, int R, int C, int tr, int tc, char* smem) {
  float* t = (float*)smem;
  const int tid = otid();
  __syncthreads();
#pragma unroll
  for (int i = 0; i < 8; ++i) {
    int r = (tid >> 6) + 8 * i, c = tid & 63;
    t[r * 65 + c] = src[(size_t)(tr * 64 + r) * C + tc * 64 + c];
  }
  __syncthreads();
#pragma unroll
  for (int i = 0; i < 8; ++i) {
    int cc = (tid >> 6) + 8 * i, rr = tid & 63;
    dst[(size_t)(tc * 64 + cc) * R + tr * 64 + rr] = f2bf(t[rr * 65 + cc]);
  }
}

__device__ void p0_wc_item(const Params& p, int l, int ph, int kt, char* smem) {
  float* wqs = (float*)smem;
  float* ks = wqs + 64 * 129;
  const int tid = otid();
  const float* wq = p.peer_wq + (size_t)l * DM * 2048;
  const float* kk = ((ph & 1) ? p.peer_k2 : p.peer_k1) + (size_t)l * 128 * 128;
  __syncthreads();
  for (int e = tid; e < 64 * 128; e += NTHR) {
    int r = e >> 7, d = e & 127;
    wqs[r * 129 + d] = wq[(size_t)(kt * 64 + r) * 2048 + ph * 128 + d];
  }
  for (int e = tid; e < 128 * 128; e += NTHR) {
    int r = e >> 7, d = e & 127;
    ks[r * 129 + d] = kk[r * 128 + d];
  }
  __syncthreads();
  const int key = tid & 127, k0 = (tid >> 7) * 16;
  float acc[16];
#pragma unroll
  for (int i = 0; i < 16; ++i) acc[i] = 0.f;
  for (int d = 0; d < 128; ++d) {
    float kv = ks[key * 129 + d];
#pragma unroll
    for (int i = 0; i < 16; ++i) acc[i] += wqs[(k0 + i) * 129 + d] * kv;
  }
  bf16_t* dst = p.WcT + ((size_t)l * 2048 + ph * 128 + key) * DM + kt * 64 + k0;
  uint4 o0, o1;
  o0.x = pack2(acc[0], acc[1]); o0.y = pack2(acc[2], acc[3]); o0.z = pack2(acc[4], acc[5]); o0.w = pack2(acc[6], acc[7]);
  o1.x = pack2(acc[8], acc[9]); o1.y = pack2(acc[10], acc[11]); o1.z = pack2(acc[12], acc[13]); o1.w = pack2(acc[14], acc[15]);
  *(uint4*)dst = o0; *(uint4*)(dst + 8) = o1;
}

__device__ void p0_mod_item(const Params& p, int l, int cc, char* smem) {
  float* sc = (float*)smem;
  const int tid = otid();
  __syncthreads();
  for (int e = tid; e < NB * DM; e += NTHR) {
    int b = e >> 10, k = e & 1023;
    float v = crow(p, b)[k];
    sc[k * 24 + b] = v / (1.f + __expf(-v));
  }
  __syncthreads();
  const int n = cc * 512 + tid;
  float acc[24];
#pragma unroll
  for (int b = 0; b < 24; ++b) acc[b] = 0.f;
  const float* wm = p.w_mod + (size_t)l * DM * 6144 + n;
  for (int k0 = 0; k0 < DM; k0 += 8) {
    float wv[8];
#pragma unroll
    for (int j = 0; j < 8; ++j) wv[j] = wm[(size_t)(k0 + j) * 6144];
#pragma unroll
    for (int j = 0; j < 8; ++j) {
      const float4* s4 = (const float4*)(sc + (k0 + j) * 24);
#pragma unroll
      for (int q = 0; q < 6; ++q) {
        float4 s = s4[q];
        acc[q * 4 + 0] += s.x * wv[j]; acc[q * 4 + 1] += s.y * wv[j]; acc[q * 4 + 2] += s.z * wv[j]; acc[q * 4 + 3] += s.w * wv[j];
      }
    }
  }
  const float bm = p.b_mod[l * 6144 + n];
#pragma unroll
  for (int b = 0; b < 24; ++b) p.mod[((size_t)l * NB + b) * 6144 + n] = acc[b] + bm;
}

__device__ void p0_filter_item(const Params& p, int l, int tc, char* smem) {
  float* feat = (float*)smem;
  float* a1 = feat + 32 * 33;
  float* a2 = a1 + 32 * 64;
  bf16_t* stage = (bf16_t*)(a2 + 32 * 64);
  const int tid = otid();
  const int t0 = tc * 32;
  __syncthreads();
  for (int e = tid; e < 32 * 33; e += NTHR) {
    int pp = e / 33, f = e % 33;
    int ti = t0 + pp;
    float v;
    if (f == 0) v = (float)ti / (float)(SEQ - 1);
    else {
      int bi = (f - 1) & 15;
      float band = 1e-4f + (float)bi * ((15.f - 1e-4f) / 15.f);
      float wv = 2.0f * 3.14159265358979323846f * (float)ti / (float)SEQ;
      float arg = band * wv;
      v = (f <= 16) ? cosf(arg) : -sinf(arg);
    }
    feat[pp * 33 + f] = v;
  }
  __syncthreads();
  const float* w1 = p.f_w1 + l * 33 * 64; const float* b1 = p.f_b1 + l * 64; const float* fq = p.f_freq + l * 64;
  const float* w2 = p.f_w2 + l * 64 * 64; const float* b2 = p.f_b2 + l * 64;
  for (int e = tid; e < 32 * 64; e += NTHR) {
    int pp = e >> 6, j = e & 63;
    float s = b1[j];
    for (int f = 0; f < 33; ++f) s += feat[pp * 33 + f] * w1[f * 64 + j];
    a1[pp * 64 + j] = sinf(fq[j] * s);
  }
  __syncthreads();
  for (int e = tid; e < 32 * 64; e += NTHR) {
    int pp = e >> 6, j = e & 63;
    float s = b2[j];
    for (int i = 0; i < 64; ++i) s += a1[pp * 64 + i] * w2[i * 64 + j];
    a2[pp * 64 + j] = sinf(fq[j] * s);
  }
  __syncthreads();
  const float* w3 = p.f_w3 + (size_t)l * 64 * 2048;
  const float min_decay = logf(1e-2f) / 1.5f, max_decay = logf(1e-2f) / 0.3f;
  for (int q = 0; q < 4; ++q) {
    const int n = tid + 512 * q;
    const int c = n & 511;
    float wr[64];
#pragma unroll
    for (int i = 0; i < 64; ++i) wr[i] = w3[i * 2048 + n];
    const float delta = fabsf(min_decay + (max_decay - min_decay) * (float)c / 511.f);
    for (int pp = 0; pp < 32; ++pp) {
      float s = 0.f;
#pragma unroll
      for (int i = 0; i < 64; ++i) s += a2[pp * 64 + i] * wr[i];
      float tt = (float)(t0 + pp) / (float)(SEQ - 1);
      s *= __expf(-tt * delta);
      if (t0 + pp == 0 && ((n >> 9) & 1) == 0) s += p.f_bias[(l * 2 + (n >> 10)) * 512 + c];
      stage[n * 32 + pp] = f2bf(s);
    }
  }
  __syncthreads();
  for (int e = tid; e < 2048 * 32; e += NTHR) {
    int n = e >> 5, pp = e & 31;
    int o = n >> 10, d = (n >> 9) & 1, c = n & 511;
    int t = t0 + pp;
    bf16_t* g = p.Gf + ((size_t)((l * 2 + o) * 512 + c)) * 4096;
    if (d == 0) g[2048 - t] = stage[n * 32 + pp];
    else if (t >= 1) g[2048 + t] = stage[n * 32 + pp];
    if (t == 0 && d == 0) g[0] = 0;
  }
}

__device__ void p0_rope_item(const Params& p, int it) {
  int e = it * 512 + otid();
  int pos = e >> 5, i = e & 31;
  float inv = powf(10000.f, -(float)(2 * i) / 64.f);
  float ang = (float)pos * inv;
  p.rope[e * 2 + 0] = cosf(ang);
  p.rope[e * 2 + 1] = sinf(ang);
}

constexpr int P0_TR_PER_LAYER = 16 * 68 + 8 * 16 + 8 * 16 + 16 * 16;
constexpr int P0_N_TR = 2 * P0_TR_PER_LAYER;
constexpr int P0_N_WC = 2 * 16 * 16;
constexpr int P0_N_MOD = 2 * 12;
constexpr int P0_N_FILT = 2 * 64;
constexpr int P0_N_ROPE = 128;
constexpr int P0_TOTAL = P0_N_MOD + P0_N_FILT + P0_N_WC + P0_N_ROPE + P0_N_TR;

__device__ void phase_p0(const Params& p, char* smem) {
  for (int it = blockIdx.x; it < P0_TOTAL; it += gridDim.x) {
    int i = it;
    if (i < P0_N_MOD) { p0_mod_item(p, i / 12, i % 12, smem); continue; }
    i -= P0_N_MOD;
    if (i < P0_N_FILT) { p0_filter_item(p, i / 64, i % 64, smem); continue; }
    i -= P0_N_FILT;
    if (i < P0_N_WC) { p0_wc_item(p, i >> 8, (i >> 4) & 15, i & 15, smem); continue; }
    i -= P0_N_WC;
    if (i < P0_N_ROPE) { p0_rope_item(p, i); continue; }
    i -= P0_N_ROPE;
    {
      int l = i / P0_TR_PER_LAYER, j = i % P0_TR_PER_LAYER;
      if (j < 16 * 68) { p0_transpose_tile(p.w_in + (size_t)l * DM * INC, p.WinT + (size_t)l * INC * DM, DM, INC, j / 68, j % 68, smem); continue; }
      j -= 16 * 68;
      if (j < 128) { p0_transpose_tile(p.w_pa + (size_t)l * HYW * DM, p.WpaT + (size_t)l * DM * HYW, HYW, DM, j / 16, j % 16, smem); continue; }
      j -= 128;
      if (j < 128) { p0_transpose_tile(p.w_pb + (size_t)l * HYW * DM, p.WpbT + (size_t)l * DM * HYW, HYW, DM, j / 16, j % 16, smem); continue; }
      j -= 128;
      p0_transpose_tile(p.w_out + (size_t)l * DM * DM, p.WoutT + (size_t)l * DM * DM, DM, DM, j / 16, j % 16, smem);
    }
  }
}

__device__ void norm_rows(const Params& p, int tile, int l, int which, bool from_inputs, char* smem) {
  float* scl = (float*)smem;
  float* shf = scl + 2048;
  const int tid = otid(), lane = tid & 63, w = tid >> 6;
  const int tok0 = tile * TM;
  const int b0 = tok0 >> 11;
  const float* g = (which ? p.g2 : p.g1) + l * DM;
  __syncthreads();
  for (int e = tid; e < 2048; e += NTHR) {
    int bi = e >> 10, j = e & 1023;
    int b = b0 + bi; if (b > NB - 1) b = NB - 1;
    const float* m = p.mod + ((size_t)l * NB + b) * 6144 + which * 3072;
    scl[e] = g[j] * (1.f + m[1024 + j]);
    shf[e] = m[j];
  }
  __syncthreads();
  for (int r = w; r < TM; r += 8) {
    const int tok = tok0 + r;
    const int bi = (tok >> 11) - b0;
    const float* xr = from_inputs ? xrow_in(p, tok) : (p.out + (size_t)tok * DM);
    float4 v[4];
    float ss = 0.f;
#pragma unroll
    for (int i = 0; i < 4; ++i) {
      v[i] = *(const float4*)(xr + lane * 4 + 256 * i);
      ss += v[i].x * v[i].x + v[i].y * v[i].y + v[i].z * v[i].z + v[i].w * v[i].w;
    }
    ss = wave_sum(ss);
    const float rs = rsqrtf(ss * (1.f / DM) + 1e-6f);
#pragma unroll
    for (int i = 0; i < 4; ++i) {
      const int j = lane * 4 + 256 * i;
      const float4 sc4 = *(const float4*)(scl + bi * 1024 + j);
      const float4 sh4 = *(const float4*)(shf + bi * 1024 + j);
      uint2 o;
      o.x = pack2(v[i].x * rs * sc4.x + sh4.x, v[i].y * rs * sc4.y + sh4.y);
      o.y = pack2(v[i].z * rs * sc4.z + sh4.z, v[i].w * rs * sc4.w + sh4.w);
      *(uint2*)(p.hbuf + (size_t)tok * DM + j) = o;
    }
  }
  __syncthreads();
}

__device__ void phase_c(const Params& p, int tile, int l, bool from_inputs, char* smem) {
  norm_rows(p, tile, l, 0, from_inputs, smem);
  const int tid = otid();
  const int tok0 = tile * TM;
  const bf16_t* A = p.hbuf + (size_t)tok0 * DM;
  const bf16_t* W = p.WinT + (size_t)l * INC * DM;
  float* ct = (float*)smem;
  f32x16 acc[3];
#pragma unroll 1
  for (int nc = 0; nc < 18; ++nc) {
    gemm_core(A, DM, W + (size_t)nc * 128 * DM, DM, DM, (bf16_t*)smem, acc);
    if (nc < 12) {
      acc_to_lds_T(acc, ct);
      __syncthreads();
#pragma unroll 1
      for (int it = tid; it < 128 * 24; it += NTHR) {
        const int tg = it % 24, nl = it / 24;
        const float4 a = *(const float4*)(ct + nl * LDT + tg * 8), b4 = *(const float4*)(ct + nl * LDT + tg * 8 + 4);
        uint4 o; o.x = pack2(a.x, a.y); o.y = pack2(a.z, a.w); o.z = pack2(b4.x, b4.y); o.w = pack2(b4.z, b4.w);
        const int tok = tok0 + tg * 8;
        const int b = tok >> 11, sq = tok & 2047;
        *(uint4*)(p.zT + ((size_t)b * HYC + nc * 128 + nl) * SEQ + sq) = o;
      }
    } else {
      acc_to_lds(acc, ct, 132);
      __syncthreads();
      store_tile_bf16(ct, p.zqkv, QKVC, tok0, nc * 128 - HYC);
    }
  }
}

__device__ __forceinline__ void load_conv8(const bf16_t* __restrict__ zrow, int s0, float w0, float w1, float w2, float cb, float (&o)[8]) {
  uint4 v = *(const uint4*)(zrow + s0);
  float z[10];
  z[0] = (s0 > 0) ? bf2f(zrow[s0 - 1]) : 0.f;
  z[1] = lo2f(v.x); z[2] = hi2f(v.x); z[3] = lo2f(v.y); z[4] = hi2f(v.y);
  z[5] = lo2f(v.z); z[6] = hi2f(v.z); z[7] = lo2f(v.w); z[8] = hi2f(v.w);
  z[9] = (s0 + 8 < SEQ) ? bf2f(zrow[s0 + 8]) : 0.f;
#pragma unroll
  for (int i = 0; i < 8; ++i) o[i] = z[i] * w0 + z[i + 1] * w1 + z[i + 2] * w2 + cb;
}

typedef short s16x4 __attribute__((ext_vector_type(4)));
__device__ __forceinline__ s16x4 tr_read4(const bf16_t* lds_ptr) {
  return __builtin_amdgcn_ds_read_tr16_b64_v4i16((__attribute__((address_space(3))) s16x4*)(lds_ptr));
}

constexpr int HY_GS_ELEMS = 4112;
constexpr int HY_US_ROWS = 2072;
__device__ __forceinline__ void hyena_load_g(const Params& p, int l, int o, int c, bf16_t* Gs, int tid) {
  const bf16_t* g = p.Gf + ((size_t)((l * 2 + o) * 512 + c)) * 4096;
  *(uint4*)(Gs + 8 + tid * 8) = *(const uint4*)(g + tid * 8);
  if (tid == 0) { unsigned z = 0; asm volatile("" : "+v"(z)); const uint4 z4 = make_uint4(z, z, z, z); *(uint4*)Gs = z4; *(uint4*)(Gs + 4104) = z4; }
}

__device__ __forceinline__ void hyena_kloop(const bf16_t* Gs, const bf16_t* us, int rho, int lane, f32x16 (&acc)[8]) {
#pragma unroll
  for (int a = 0; a < 8; ++a)
#pragma unroll
    for (int j = 0; j < 16; ++j) acc[a][j] = 0.f;
  const int i = lane & 31, hh = lane >> 5;
  const bf16_t* ga = Gs + (2040 - 8 * i + 8 * hh) - 1792;
  const int l16 = lane & 15, q = l16 >> 2, pq = l16 & 3, g4 = lane >> 4;
  const bf16_t* ub = us + (rho + 8 * (g4 >> 1) + q) * 24 + 16 * (g4 & 1) + 4 * pq;
#pragma unroll 1
  for (int kap = 0; kap < 129; ++kap) {
    const s16x4 b0 = tr_read4(ub + kap * 384);
    const s16x4 b1 = tr_read4(ub + kap * 384 + 96);
    bf16x8 bfrag;
    bfrag[0] = b0[0]; bfrag[1] = b0[1]; bfrag[2] = b0[2]; bfrag[3] = b0[3];
    bfrag[4] = b1[0]; bfrag[5] = b1[1]; bfrag[6] = b1[2]; bfrag[7] = b1[3];
#pragma unroll
    for (int a = 0; a < 8; ++a) {
      const bf16x8 af = *(const bf16x8*)(ga + kap * 16 + 256 * (7 - a));
      acc[a] = __builtin_amdgcn_mfma_f32_32x32x16_bf16(af, bfrag, acc[a], 0, 0, 0);
    }
  }
}

__device__ __forceinline__ void hyena_acc_to_us(const f32x16 (&acc)[8], bf16_t* us, int rho, int lane) {
  const int n = lane & 31, hh = lane >> 5;
  if (n < 24) {
#pragma unroll
    for (int a = 0; a < 8; ++a)
#pragma unroll
      for (int r = 0; r < 16; ++r) {
        const int t = 256 * a + rho + 8 * ((r & 3) + 8 * (r >> 2) + 4 * hh);
        us[(t + 16) * 24 + n] = f2bf(acc[a][r]);
      }
  }
}

__device__ void hyena_item(const Params& p, int l, int c, char* smem) {
  bf16_t* Gs = (bf16_t*)smem;
  bf16_t* us = (bf16_t*)(smem + 8256);
  const int tid = otid();
  const int lane = tid & 63, w = tid >> 6;
  const float* cw = p.conv_w + (size_t)l * 3 * HYC;
  const float* cbp = p.conv_b + (size_t)l * HYC;
  __syncthreads();
  hyena_load_g(p, l, 0, c, Gs, tid);
  {
    unsigned z = 0; asm volatile("" : "+v"(z)); const uint4 z4 = make_uint4(z, z, z, z);
    if (tid < 48) *(uint4*)(us + tid * 8) = z4;
    else if (tid < 48 + 26) *(uint4*)(us + 2064 * 24 + (tid - 48) * 8) = z4;
  }
  {
    const float w0 = cw[c], w1 = cw[HYC + c], w2 = cw[2 * HYC + c], cb = cbp[c];
#pragma unroll 1
    for (int qq = tid; qq < 24 * 256; qq += NTHR) {
      const int b = qq % 24, s0 = (qq / 24) * 8;
      float v[8];
      load_conv8(p.zT + ((size_t)b * HYC + c) * SEQ, s0, w0, w1, w2, cb, v);
#pragma unroll
      for (int i = 0; i < 8; ++i) us[(s0 + i + 16) * 24 + b] = f2bf(v[i]);
    }
  }
  __syncthreads();
  f32x16 acc[8];
#pragma unroll 1
  for (int o = 0; o < 2; ++o) {
    hyena_kloop(Gs, us, w, lane, acc);
    __syncthreads();
    hyena_acc_to_us(acc, us, w, lane);
    if (o == 0) hyena_load_g(p, l, 1, c, Gs, tid);
    __syncthreads();
    const int xc = (o == 0 ? 512 : 1024) + c;
    const float xw0 = cw[xc], xw1 = cw[HYC + xc], xw2 = cw[2 * HYC + xc], xcb = cbp[xc];
#pragma unroll 1
    for (int qq = tid; qq < 24 * 256; qq += NTHR) {
      const int b = qq % 24, s0 = (qq / 24) * 8;
      float xv[8];
      load_conv8(p.zT + ((size_t)b * HYC + xc) * SEQ, s0, xw0, xw1, xw2, xcb, xv);
      if (o == 0) {
#pragma unroll
        for (int i = 0; i < 8; ++i) {
          bf16_t* e = us + (s0 + i + 16) * 24 + b;
          *e = f2bf(bf2f(*e) * xv[i]);
        }
      } else {
        float r[8];
#pragma unroll
        for (int i = 0; i < 8; ++i) r[i] = bf2f(us[(s0 + i + 16) * 24 + b]) * xv[i];
        uint4 pk; pk.x = pack2(r[0], r[1]); pk.y = pack2(r[2], r[3]); pk.z = pack2(r[4], r[5]); pk.w = pack2(r[6], r[7]);
        *(uint4*)(p.yaT + ((size_t)b * HYW + c) * SEQ + s0) = pk;
      }
    }
    __syncthreads();
  }
}

__device__ void attn_item(const Params& p, int l, int item, char* smem) {
  constexpr int KS = 72, VS = 96;
  bf16_t* Ks = (bf16_t*)smem;
  bf16_t* Vs = Ks + 384 * KS;
  const int tid = otid();
  const int lane = tid & 63, w = tid >> 6;
  const int kh = item & 1, qb = (item >> 1) & 15, b = item >> 5;
  const int kpos0 = qb * 128 - 128;
  __syncthreads();
  if (tid < 384) {
    const int r = tid, kpos = kpos0 + r;
    if (kpos >= 0 && kpos < SEQ) {
      const bf16_t* kr = p.zqkv + ((size_t)(b * SEQ + kpos)) * QKVC + 512 + kh * 64;
      float kf[64];
      float ss = 0.f;
#pragma unroll
      for (int c8 = 0; c8 < 8; ++c8) {
        uint4 v = *(const uint4*)(kr + c8 * 8);
        kf[c8 * 8 + 0] = lo2f(v.x); kf[c8 * 8 + 1] = hi2f(v.x); kf[c8 * 8 + 2] = lo2f(v.y); kf[c8 * 8 + 3] = hi2f(v.y);
        kf[c8 * 8 + 4] = lo2f(v.z); kf[c8 * 8 + 5] = hi2f(v.z); kf[c8 * 8 + 6] = lo2f(v.w); kf[c8 * 8 + 7] = hi2f(v.w);
      }
#pragma unroll
      for (int d = 0; d < 64; ++d) ss += kf[d] * kf[d];
      const float rs = rsqrtf(ss * (1.f / 64.f) + 1e-6f);
      const float* kg = p.k_gain + l * 64;
#pragma unroll
      for (int d = 0; d < 64; ++d) kf[d] = kf[d] * rs * kg[d];
      const float* rp = p.rope + (size_t)kpos * 64;
#pragma unroll
      for (int i = 0; i < 32; ++i) {
        const float cs = rp[i * 2], sn = rp[i * 2 + 1];
        const float a = kf[i], bb = kf[i + 32];
        kf[i] = a * cs - bb * sn; kf[i + 32] = bb * cs + a * sn;
      }
#pragma unroll
      for (int c8 = 0; c8 < 8; ++c8) {
        uint4 pk;
        pk.x = pack2(kf[c8 * 8 + 0], kf[c8 * 8 + 1]); pk.y = pack2(kf[c8 * 8 + 2], kf[c8 * 8 + 3]);
        pk.z = pack2(kf[c8 * 8 + 4], kf[c8 * 8 + 5]); pk.w = pack2(kf[c8 * 8 + 6], kf[c8 * 8 + 7]);
        *(uint4*)(Ks + r * KS + c8 * 8) = pk;
      }
    }
  }
#pragma unroll 1
  for (int e = tid; e < 384 * 8; e += NTHR) {
    const int r = e >> 3, c8 = e & 7, kpos = kpos0 + r;
    if (kpos >= 0 && kpos < SEQ)
      *(uint4*)(Vs + r * VS + c8 * 8) = *(const uint4*)(p.zqkv + ((size_t)(b * SEQ + kpos)) * QKVC + 640 + kh * 64 + c8 * 8);
  }
  __syncthreads();
  const int hl = w & 3, qh = w >> 2;
  const int head = kh * 4 + hl;
  const int n = lane & 31, hh = lane >> 5;
  const int Q0 = qb * 128 + 64 * qh;
  bf16x8 qf[2][4];
#pragma unroll
  for (int nt = 0; nt < 2; ++nt) {
    const int qpos = Q0 + 32 * nt + n;
    const bf16_t* qr = p.zqkv + ((size_t)(b * SEQ + qpos)) * QKVC + head * 64;
    float qv[4][8];
    float ss = 0.f;
#pragma unroll
    for (int kk = 0; kk < 4; ++kk) {
      uint4 v = *(const uint4*)(qr + 16 * kk + 8 * hh);
      qv[kk][0] = lo2f(v.x); qv[kk][1] = hi2f(v.x); qv[kk][2] = lo2f(v.y); qv[kk][3] = hi2f(v.y);
      qv[kk][4] = lo2f(v.z); qv[kk][5] = hi2f(v.z); qv[kk][6] = lo2f(v.w); qv[kk][7] = hi2f(v.w);
#pragma unroll
      for (int j = 0; j < 8; ++j) ss += qv[kk][j] * qv[kk][j];
    }
    ss += __shfl_xor(ss, 32, 64);
    const float rs = rsqrtf(ss * (1.f / 64.f) + 1e-6f) * 0.125f;
    const float* qg = p.q_gain + l * 64;
#pragma unroll
    for (int kk = 0; kk < 4; ++kk)
#pragma unroll
      for (int j = 0; j < 8; ++j) qv[kk][j] *= rs * qg[16 * kk + 8 * hh + j];
    const float* rp = p.rope + (size_t)qpos * 64;
#pragma unroll
    for (int kk = 0; kk < 2; ++kk)
#pragma unroll
      for (int j = 0; j < 8; ++j) {
        const int d = 16 * kk + 8 * hh + j;
        const float cs = rp[d * 2], sn = rp[d * 2 + 1];
        const float a = qv[kk][j], bb = qv[kk + 2][j];
        qv[kk][j] = a * cs - bb * sn; qv[kk + 2][j] = bb * cs + a * sn;
      }
#pragma unroll
    for (int kk = 0; kk < 4; ++kk)
#pragma unroll
      for (int j = 0; j < 8; ++j) qf[nt][kk][j] = (short)f2bf(qv[kk][j]);
  }
  f32x16 O[2][2];
#pragma unroll
  for (int dm = 0; dm < 2; ++dm)
#pragma unroll
    for (int nt = 0; nt < 2; ++nt)
#pragma unroll
      for (int r = 0; r < 16; ++r) O[dm][nt][r] = 0.f;
  float mrun[2], lsum[2];
  mrun[0] = mrun[1] = p.sink[l * 8 + head];
  lsum[0] = lsum[1] = (hh == 0) ? 1.f : 0.f;
  const int l16 = lane & 15, tq = l16 >> 2, tp = l16 & 3, g4 = lane >> 4;
  const bf16_t* vbase = Vs + (4 * (g4 >> 1) + tq) * VS + 16 * (g4 & 1) + 4 * tp;
#pragma unroll 1
  for (int kt = 2 * qh; kt < 2 * qh + 10; ++kt) {
    const int kp_t = kpos0 + 32 * kt;
    if (kp_t < 0 || kp_t >= SEQ) continue;
    bf16x8 kfr[4];
#pragma unroll
    for (int kk = 0; kk < 4; ++kk) kfr[kk] = *(const bf16x8*)(Ks + (32 * kt + n) * KS + 16 * kk + 8 * hh);
    bf16x8 pf[2][2];
#pragma unroll
    for (int nt = 0; nt < 2; ++nt) {
      f32x16 S;
#pragma unroll
      for (int r = 0; r < 16; ++r) S[r] = 0.f;
#pragma unroll
      for (int kk = 0; kk < 4; ++kk) S = __builtin_amdgcn_mfma_f32_32x32x16_bf16(kfr[kk], qf[nt][kk], S, 0, 0, 0);
      const int qpos = Q0 + 32 * nt + n;
      float mloc = -INFINITY;
#pragma unroll
      for (int r = 0; r < 16; ++r) {
        const int kpos = kp_t + (r & 3) + 8 * (r >> 2) + 4 * hh;
        int dd = kpos - qpos; dd = dd < 0 ? -dd : dd;
        S[r] = (dd <= 128) ? S[r] : -INFINITY;
        mloc = fmaxf(mloc, S[r]);
      }
      mloc = fmaxf(mloc, __shfl_xor(mloc, 32, 64));
      const float mnew = fmaxf(mrun[nt], mloc);
      const float corr = __expf(mrun[nt] - mnew);
      mrun[nt] = mnew;
      float psum = 0.f;
#pragma unroll
      for (int r = 0; r < 16; ++r) { S[r] = __expf(S[r] - mnew); psum += S[r]; }
      lsum[nt] = lsum[nt] * corr + psum;
#pragma unroll
      for (int dm = 0; dm < 2; ++dm)
#pragma unroll
        for (int r = 0; r < 16; ++r) O[dm][nt][r] *= corr;
#pragma unroll
      for (int s2 = 0; s2 < 2; ++s2)
#pragma unroll
        for (int j = 0; j < 8; ++j) pf[nt][s2][j] = (short)f2bf(S[8 * s2 + j]);
    }
#pragma unroll
    for (int dm = 0; dm < 2; ++dm)
#pragma unroll
      for (int s2 = 0; s2 < 2; ++s2) {
        const bf16_t* vp = vbase + (32 * kt + 16 * s2) * VS + 32 * dm;
        const s16x4 v0 = tr_read4(vp);
        const s16x4 v1 = tr_read4(vp + 8 * VS);
        bf16x8 vf;
        vf[0] = v0[0]; vf[1] = v0[1]; vf[2] = v0[2]; vf[3] = v0[3];
        vf[4] = v1[0]; vf[5] = v1[1]; vf[6] = v1[2]; vf[7] = v1[3];
#pragma unroll
        for (int nt = 0; nt < 2; ++nt) O[dm][nt] = __builtin_amdgcn_mfma_f32_32x32x16_bf16(vf, pf[nt][s2], O[dm][nt], 0, 0, 0);
      }
  }
#pragma unroll
  for (int nt = 0; nt < 2; ++nt) {
    const float ltot = lsum[nt] + __shfl_xor(lsum[nt], 32, 64);
    const float inv = 1.f / ltot;
    const int qpos = Q0 + 32 * nt + n;
    bf16_t* yo = p.yb + ((size_t)(b * SEQ + qpos)) * 512 + head * 64;
#pragma unroll
    for (int dm = 0; dm < 2; ++dm)
#pragma unroll
      for (int g = 0; g < 4; ++g) {
        uint2 o;
        o.x = pack2(O[dm][nt][4 * g + 0] * inv, O[dm][nt][4 * g + 1] * inv);
        o.y = pack2(O[dm][nt][4 * g + 2] * inv, O[dm][nt][4 * g + 3] * inv);
        *(uint2*)(yo + 32 * dm + 8 * g + 4 * hh) = o;
      }
  }
}

__device__ void table_item(const Params& p, int l, int it) {
  const int tid = otid();
  const int which = it >> 10, chunk = it & 1023;
  const float* src = (which ? p.peer_v : p.peer_u) + (size_t)l * NEXP * DM + (size_t)chunk * 16384;
  bf16_t* dst = (which ? p.tabV : p.tabU) + (size_t)chunk * 16384;
#pragma unroll
  for (int i = 0; i < 4; ++i) {
    const int e = (tid + i * NTHR) * 8;
    float4 a = *(const float4*)(src + e), b = *(const float4*)(src + e + 4);
    uint4 o; o.x = pack2(a.x, a.y); o.y = pack2(a.z, a.w); o.z = pack2(b.x, b.y); o.w = pack2(b.z, b.w);
    *(uint4*)(dst + e) = o;
  }
}

constexpr int DE_N_HY = 512, DE_N_AT = 768, DE_N_TB = 2048;
__device__ void phase_de(const Params& p, int l, char* smem) {
  for (int it = blockIdx.x; it < DE_N_HY + DE_N_AT + DE_N_TB; it += gridDim.x) {
    if (it < DE_N_HY) hyena_item(p, l, it, smem);
    else if (it < DE_N_HY + DE_N_AT) attn_item(p, l, it - DE_N_HY, smem);
    else table_item(p, l, it - DE_N_HY - DE_N_AT);
  }
}

__device__ void phase_f(const Params& p, int tile, int l, bool from_inputs, char* smem) {
  const int tid = otid();
  const int tok0 = tile * TM;
#pragma unroll 1
  for (int e = tid; e < TM * 64; e += NTHR) {
    const int r = e % TM, cg8 = e / TM;
    const int tok = tok0 + r, b = tok >> 11, sq = tok & 2047;
    const bf16_t* src = p.yaT + ((size_t)b * HYW + cg8 * 8) * SEQ + sq;
    uint4 o;
    o.x = (unsigned)src[0] | ((unsigned)src[SEQ] << 16);
    o.y = (unsigned)src[2 * SEQ] | ((unsigned)src[3 * SEQ] << 16);
    o.z = (unsigned)src[4 * SEQ] | ((unsigned)src[5 * SEQ] << 16);
    o.w = (unsigned)src[6 * SEQ] | ((unsigned)src[7 * SEQ] << 16);
    *(uint4*)(p.yatok + (size_t)tok * HYW + cg8 * 8) = o;
  }
  __syncthreads();
  const bf16_t* Ah = p.hbuf + (size_t)tok0 * DM;
  const bf16_t* Aya = p.yatok + (size_t)tok0 * HYW;
  const bf16_t* Ayb = p.yb + (size_t)tok0 * HYW;
  const bf16_t* Win = p.WinT + (size_t)l * INC * DM;
  const bf16_t* Wpa = p.WpaT + (size_t)l * DM * HYW;
  const bf16_t* Wpb = p.WpbT + (size_t)l * DM * HYW;
  float* ct = (float*)smem;
  f32x16 acc[3], sg[3];
  unsigned* aux = (unsigned*)(smem + 101376) + tid;
#pragma unroll 1
  for (int nc = 0; nc < 8; ++nc) {
    gemm_core(Ah, DM, Win + (size_t)(2304 + nc * 128) * DM, DM, DM, (bf16_t*)smem, acc);
#pragma unroll
    for (int mi = 0; mi < 3; ++mi)
#pragma unroll
      for (int q = 0; q < 8; ++q)
        aux[(mi * 8 + q) * 512] = pack2(__builtin_amdgcn_rcpf(1.f + __expf(-acc[mi][2 * q])), __builtin_amdgcn_rcpf(1.f + __expf(-acc[mi][2 * q + 1])));
    gemm_core(Aya, HYW, Wpa + (size_t)(nc * 128) * HYW, HYW, HYW, (bf16_t*)smem, acc);
#pragma unroll
    for (int mi = 0; mi < 3; ++mi)
#pragma unroll
      for (int q = 0; q < 8; ++q) {
        const unsigned g = aux[(mi * 8 + q) * 512];
        aux[(mi * 8 + q) * 512] = pack2(lo2f(g) * acc[mi][2 * q], hi2f(g) * acc[mi][2 * q + 1]);
      }
    gemm_core(Ah, DM, Win + (size_t)(3328 + nc * 128) * DM, DM, DM, (bf16_t*)smem, acc);
#pragma unroll
    for (int mi = 0; mi < 3; ++mi)
#pragma unroll
      for (int r = 0; r < 16; ++r) sg[mi][r] = __builtin_amdgcn_rcpf(1.f + __expf(-acc[mi][r]));
    gemm_core(Ayb, HYW, Wpb + (size_t)(nc * 128) * HYW, HYW, HYW, (bf16_t*)smem, acc);
#pragma unroll
    for (int mi = 0; mi < 3; ++mi)
#pragma unroll
      for (int q = 0; q < 8; ++q) {
        const unsigned g = aux[(mi * 8 + q) * 512];
        acc[mi][2 * q] = lo2f(g) + sg[mi][2 * q] * acc[mi][2 * q];
        acc[mi][2 * q + 1] = hi2f(g) + sg[mi][2 * q + 1] * acc[mi][2 * q + 1];
      }
    acc_to_lds(acc, ct, 132);
    __syncthreads();
    store_tile_bf16(ct, p.merged, DM, tok0, nc * 128);
  }
  __syncthreads();
  const bf16_t* Am = p.merged + (size_t)tok0 * DM;
  const bf16_t* Wo = p.WoutT + (size_t)l * DM * DM;
#pragma unroll 1
  for (int nc = 0; nc < 8; ++nc) {
    gemm_core(Am, DM, Wo + (size_t)(nc * 128) * DM, DM, DM, (bf16_t*)smem, acc);
    acc_to_lds(acc, ct, 132);
    __syncthreads();
#pragma unroll 1
    for (int it = tid; it < 192 * 32; it += NTHR) {
      const int c4 = it & 31, r = it >> 5;
      const int tok = tok0 + r, b = tok >> 11;
      const int n = nc * 128 + c4 * 4;
      const float4 a = *(const float4*)(ct + r * 132 + c4 * 4);
      const float4 gt = *(const float4*)(p.mod + ((size_t)l * NB + b) * 6144 + 2048 + n);
      const float* xs = from_inputs ? xrow_in(p, tok) : (p.out + (size_t)tok * DM);
      float4 xo = *(const float4*)(xs + n);
      xo.x += gt.x * a.x; xo.y += gt.y * a.y; xo.z += gt.z * a.z; xo.w += gt.w * a.w;
      *(float4*)(p.out + (size_t)tok * DM + n) = xo;
    }
  }
  __syncthreads();
}

__device__ __forceinline__ void topk_insert(float (&key)[16], float kx) {
#pragma unroll
  for (int i = 0; i < 16; ++i) {
    const float hi = fmaxf(key[i], kx);
    kx = fminf(key[i], kx);
    key[i] = hi;
  }
}

__device__ void phase_g(const Params& p, int tile, int l, char* smem) {
  norm_rows(p, tile, l, 1, false, smem);
  const int tid = otid();
  const int tok0 = tile * TM;
  const bf16_t* Ah = p.hbuf + (size_t)tok0 * DM;
  const bf16_t* Wc = p.WcT + (size_t)l * 2048 * DM;
  float* sc = (float*)smem;
  f32x16 acc[3];
  float v1k[16], v2k[16];
#pragma unroll 1
  for (int ch = 0; ch < 16; ++ch) {
    gemm_core(Ah, DM, Wc + (size_t)(ch * 128) * DM, DM, DM, (bf16_t*)smem, acc);
    acc_to_lds(acc, sc, 129);
    __syncthreads();
    if (tid < TM) {
      float key[16];
#pragma unroll
      for (int i = 0; i < 16; ++i) key[i] = -INFINITY;
      const float* row = sc + tid * 129;
      for (int j = 0; j < 128; ++j) {
        const float x = row[j];
        const float kx = __uint_as_float((__float_as_uint(x) & 0xFFFFFF80u) | (unsigned)j);
        topk_insert(key, kx);
      }
      if ((ch & 1) == 0) {
#pragma unroll
        for (int i = 0; i < 16; ++i) v1k[i] = key[i];
      } else {
#pragma unroll
        for (int i = 0; i < 16; ++i) v2k[i] = key[i];
        float top[16];
#pragma unroll
        for (int i = 0; i < 16; ++i) top[i] = -INFINITY;
#pragma unroll
        for (int i = 0; i < 16; ++i)
#pragma unroll
          for (int j = 0; j < 16; ++j)
            if ((i + 1) * (j + 1) <= 16) {
              const float s = v1k[i] + v2k[j];
              const float ck = __uint_as_float((__float_as_uint(s) & 0xFFFFFF00u) | (unsigned)(i * 16 + j));
              topk_insert(top, ck);
            }
        const float mx = top[0];
        float ex[16], sum = 0.f;
#pragma unroll
        for (int k = 0; k < 16; ++k) { ex[k] = __expf(top[k] - mx); sum += ex[k]; }
        const float inv = 1.f / sum;
        const int hh = ch >> 1;
        const size_t ob = ((size_t)(tok0 + tid) * 8 + hh) * 16;
#pragma unroll
        for (int k = 0; k < 16; ++k) {
          const unsigned code = __float_as_uint(top[k]) & 0xFFu;
          const unsigned ii = code >> 4, jj = code & 15u;
          unsigned e1 = 0, e2 = 0;
#pragma unroll
          for (int q = 0; q < 16; ++q) {
            e1 = (ii == (unsigned)q) ? (__float_as_uint(v1k[q]) & 0x7Fu) : e1;
            e2 = (jj == (unsigned)q) ? (__float_as_uint(v2k[q]) & 0x7Fu) : e2;
          }
          p.pidx[ob + k] = (unsigned short)(e1 * 128 + e2);
          p.pg[ob + k] = ex[k] * inv;
        }
      }
    }
    __syncthreads();
  }
}

__device__ void phase_i(const Params& p, int tile, int l, char* smem) {
  const int tid = otid(), lane = tid & 63, w = tid >> 6;
  float* wsm = (float*)smem + w * 128;
  const int tok0 = tile * TM;
  __syncthreads();
  for (int r = w; r < TM; r += 8) {
    const int tok = tok0 + r;
    const int b = tok >> 11;
    float hx[16];
    {
      const bf16_t* hr = p.hbuf + (size_t)tok * DM;
      uint4 a = *(const uint4*)(hr + lane * 8), c = *(const uint4*)(hr + 512 + lane * 8);
      hx[0] = lo2f(a.x); hx[1] = hi2f(a.x); hx[2] = lo2f(a.y); hx[3] = hi2f(a.y);
      hx[4] = lo2f(a.z); hx[5] = hi2f(a.z); hx[6] = lo2f(a.w); hx[7] = hi2f(a.w);
      hx[8] = lo2f(c.x); hx[9] = hi2f(c.x); hx[10] = lo2f(c.y); hx[11] = hi2f(c.y);
      hx[12] = lo2f(c.z); hx[13] = hi2f(c.z); hx[14] = lo2f(c.w); hx[15] = hi2f(c.w);
    }
    const unsigned short* pi = p.pidx + (size_t)tok * 128;
    const float* pgp = p.pg + (size_t)tok * 128;
    for (int pp = 0; pp < 128; pp += 4) {
      uint4 ua[4], uc[4];
#pragma unroll
      for (int q = 0; q < 4; ++q) {
        const int e = pi[pp + q] & (NEXP - 1);
        const bf16_t* ur = p.tabU + (size_t)e * DM;
        ua[q] = *(const uint4*)(ur + lane * 8); uc[q] = *(const uint4*)(ur + 512 + lane * 8);
      }
#pragma unroll
      for (int q = 0; q < 4; ++q) {
        float d = hx[0] * lo2f(ua[q].x) + hx[1] * hi2f(ua[q].x) + hx[2] * lo2f(ua[q].y) + hx[3] * hi2f(ua[q].y)
                + hx[4] * lo2f(ua[q].z) + hx[5] * hi2f(ua[q].z) + hx[6] * lo2f(ua[q].w) + hx[7] * hi2f(ua[q].w)
                + hx[8] * lo2f(uc[q].x) + hx[9] * hi2f(uc[q].x) + hx[10] * lo2f(uc[q].y) + hx[11] * hi2f(uc[q].y)
                + hx[12] * lo2f(uc[q].z) + hx[13] * hi2f(uc[q].z) + hx[14] * lo2f(uc[q].w) + hx[15] * hi2f(uc[q].w);
        d = wave_sum(d);
        const float ge = 0.5f * d * (1.f + erff(d * 0.70710678118654752f));
        if (lane == 0) wsm[pp + q] = pgp[pp + q] * ge;
      }
    }
    float oa[16];
#pragma unroll
    for (int i = 0; i < 16; ++i) oa[i] = 0.f;
    for (int pp = 0; pp < 128; pp += 4) {
      uint4 va[4], vc[4];
      float wq[4];
#pragma unroll
      for (int q = 0; q < 4; ++q) {
        const int e = pi[pp + q] & (NEXP - 1);
        const bf16_t* vr = p.tabV + (size_t)e * DM;
        va[q] = *(const uint4*)(vr + lane * 8); vc[q] = *(const uint4*)(vr + 512 + lane * 8);
        wq[q] = wsm[pp + q];
      }
#pragma unroll
      for (int q = 0; q < 4; ++q) {
        const float ww = wq[q];
        oa[0] += ww * lo2f(va[q].x); oa[1] += ww * hi2f(va[q].x); oa[2] += ww * lo2f(va[q].y); oa[3] += ww * hi2f(va[q].y);
        oa[4] += ww * lo2f(va[q].z); oa[5] += ww * hi2f(va[q].z); oa[6] += ww * lo2f(va[q].w); oa[7] += ww * hi2f(va[q].w);
        oa[8] += ww * lo2f(vc[q].x); oa[9] += ww * hi2f(vc[q].x); oa[10] += ww * lo2f(vc[q].y); oa[11] += ww * hi2f(vc[q].y);
        oa[12] += ww * lo2f(vc[q].z); oa[13] += ww * hi2f(vc[q].z); oa[14] += ww * lo2f(vc[q].w); oa[15] += ww * hi2f(vc[q].w);
      }
    }
    const float* gt = p.mod + ((size_t)l * NB + b) * 6144 + 5 * 1024;
    float* xo = p.out + (size_t)tok * DM;
#pragma unroll
    for (int hsel = 0; hsel < 2; ++hsel) {
      const int j = hsel * 512 + lane * 8;
      float4 x0 = *(const float4*)(xo + j), x1 = *(const float4*)(xo + j + 4);
      const float4 g0 = *(const float4*)(gt + j), g1 = *(const float4*)(gt + j + 4);
      x0.x += g0.x * oa[hsel * 8 + 0]; x0.y += g0.y * oa[hsel * 8 + 1]; x0.z += g0.z * oa[hsel * 8 + 2]; x0.w += g0.w * oa[hsel * 8 + 3];
      x1.x += g1.x * oa[hsel * 8 + 4]; x1.y += g1.y * oa[hsel * 8 + 5]; x1.z += g1.z * oa[hsel * 8 + 6]; x1.w += g1.w * oa[hsel * 8 + 7];
      *(float4*)(xo + j) = x0; *(float4*)(xo + j + 4) = x1;
    }
  }
  __syncthreads();
}

__global__ void __launch_bounds__(NTHR) mega_kernel(Params p) {
  extern __shared__ __attribute__((aligned(16))) char smem[];
  cg::grid_group grid = cg::this_grid();
  phase_p0(p, smem);
  grid.sync();
  for (int l = 0; l < 2; ++l) {
    for (int rep = 0; rep < REP_C; ++rep)
    for (int tile = blockIdx.x; tile < NTILE; tile += gridDim.x) phase_c(p, tile, l, l == 0, smem);
    grid.sync();
    for (int rep = 0; rep < REP_DE; ++rep) phase_de(p, l, smem);
    grid.sync();
    for (int tile = blockIdx.x; tile < NTILE; tile += gridDim.x) {
      phase_f(p, tile, l, l == 0, smem);
      for (int rep = 0; rep < REP_G; ++rep) phase_g(p, tile, l, smem);
      phase_i(p, tile, l, smem);
    }
    if (l == 0) grid.sync();
  }
}

extern "C" void kernel_launch(void* const* d_in, const int* in_sizes, int n_in, void* d_out, int out_size, void* d_ws,
                              size_t ws_size, hipStream_t stream) {
  Params p{};
  const float* const* in = (const float* const*)d_in;
  p.x_prompt = in[0]; p.x_sample = in[1]; p.c_prompt = in[2]; p.c_sample = in[3]; p.w_mod = in[4]; p.b_mod = in[5];
  p.g1 = in[6]; p.g2 = in[7]; p.w_in = in[8]; p.conv_w = in[9]; p.conv_b = in[10]; p.f_w1 = in[11]; p.f_b1 = in[12];
  p.f_freq = in[13]; p.f_w2 = in[14]; p.f_b2 = in[15]; p.f_w3 = in[16]; p.f_bias = in[17]; p.q_gain = in[18];
  p.k_gain = in[19]; p.sink = in[20]; p.w_pa = in[21]; p.w_pb = in[22]; p.w_out = in[23]; p.peer_wq = in[24];
  p.peer_k1 = in[25]; p.peer_k2 = in[26]; p.peer_u = in[27]; p.peer_v = in[28];
  p.out = (float*)d_out;
  char* ws = (char*)d_ws;
  size_t off = 0;
  auto carve = [&](size_t bytes) { char* r = ws + off; off += (bytes + 255) & ~(size_t)255; return r; };
  p.WinT = (bf16_t*)carve((size_t)2 * INC * DM * 2);
  p.WpaT = (bf16_t*)carve((size_t)2 * DM * HYW * 2);
  p.WpbT = (bf16_t*)carve((size_t)2 * DM * HYW * 2);
  p.WoutT = (bf16_t*)carve((size_t)2 * DM * DM * 2);
  p.WcT = (bf16_t*)carve((size_t)2 * 2048 * DM * 2);
  p.Gf = (bf16_t*)carve((size_t)2 * 2 * 512 * 4096 * 2);
  p.mod = (float*)carve((size_t)2 * NB * 6144 * 4);
  p.rope = (float*)carve((size_t)SEQ * 64 * 4);
  p.tabU = (bf16_t*)carve((size_t)NEXP * DM * 2);
  p.tabV = (bf16_t*)carve((size_t)NEXP * DM * 2);
  p.zT = (bf16_t*)carve((size_t)NB * HYC * SEQ * 2);
  p.zqkv = (bf16_t*)carve((size_t)NTOK * QKVC * 2);
  p.yaT = (bf16_t*)carve((size_t)NTOK * HYW * 2);
  p.yb = (bf16_t*)carve((size_t)NTOK * HYW * 2);
  p.hbuf = (bf16_t*)carve((size_t)NTOK * DM * 2);
  p.merged = p.zT;
  p.yatok = p.zT + (size_t)NTOK * DM;
  p.pidx = (unsigned short*)p.zqkv;
  p.pg = (float*)(p.zqkv + (size_t)NTOK * 128);
  if (off > ws_size) fprintf(stderr, "workspace too small: need %zu have %zu\n", off, ws_size);

  static int grid_blocks = 0;
  if (!grid_blocks) {
    int dev = 0, cus = 0, per_cu = 0;
    hipGetDevice(&dev);
    hipDeviceGetAttribute(&cus, hipDeviceAttributeMultiprocessorCount, dev);
    hipFuncSetAttribute((const void*)mega_kernel, hipFuncAttributeMaxDynamicSharedMemorySize, SMEM_BYTES);
    hipOccupancyMaxActiveBlocksPerMultiprocessor(&per_cu, mega_kernel, NTHR, SMEM_BYTES);
    if (per_cu < 1) per_cu = 1;
    grid_blocks = cus * 1;
    if (grid_blocks > NTILE) grid_blocks = NTILE;
  }
  void* args[] = {&p};
  hipError_t e = hipLaunchCooperativeKernel((const void*)mega_kernel, dim3(grid_blocks), dim3(NTHR), args, SMEM_BYTES, stream);
  if (e != hipSuccess) fprintf(stderr, "cooperative launch failed: %s (grid %d)\n", hipGetErrorString(e), grid_blocks);
}
```

```cpp
#include <hip/hip_runtime.h>
#include <hip/hip_bf16.h>
#include <hip/hip_cooperative_groups.h>
#include <cstdio>
#include <cstdint>
namespace cg = cooperative_groups;

typedef unsigned short bf16_t;
using bf16x8 = __attribute__((ext_vector_type(8))) short;
using f32x16 = __attribute__((ext_vector_type(16))) float;

constexpr int DM = 1024;
constexpr int NB = 24;
constexpr int SEQ = 2048;
constexpr int NTOK = NB * SEQ;
constexpr int NBP = 16;
constexpr int INC = 4352;
constexpr int HYC = 1536;
constexpr int HYW = 512;
constexpr int QKVC = 768;
constexpr int TM = 192;
constexpr int NTILE = NTOK / TM;
constexpr int NTHR = 512;
constexpr int NEXP = 16384;
constexpr int SMEM_BYTES = 155648;
#ifndef REP_DE
#define REP_DE 1
#endif
#ifndef REP_C
#define REP_C 1
#endif
#ifndef REP_G
#define REP_G 1
#endif

struct Params {
  const float *x_prompt, *x_sample, *c_prompt, *c_sample, *w_mod, *b_mod, *g1, *g2, *w_in, *conv_w, *conv_b;
  const float *f_w1, *f_b1, *f_freq, *f_w2, *f_b2, *f_w3, *f_bias, *q_gain, *k_gain, *sink, *w_pa, *w_pb, *w_out;
  const float *peer_wq, *peer_k1, *peer_k2, *peer_u, *peer_v;
  float* out;
  bf16_t *WinT, *WpaT, *WpbT, *WoutT, *WcT, *Gf, *zT, *zqkv, *yaT, *yb, *hbuf, *merged, *yatok;
  unsigned char *tabU8, *tabV8;
  unsigned short* pidx;
  float *pg, *mod, *rope, *sclU, *sclV, *apart;
};

__device__ __forceinline__ float bf2f(bf16_t v) { return __uint_as_float(((unsigned)v) << 16); }
__device__ __forceinline__ bf16_t f2bf(float f) {
  unsigned u = __float_as_uint(f);
  u += 0x7FFFu + ((u >> 16) & 1u);
  return (bf16_t)(u >> 16);
}
__device__ __forceinline__ unsigned pack2(float a, float b) { return (unsigned)f2bf(a) | ((unsigned)f2bf(b) << 16); }
__device__ __forceinline__ float lo2f(unsigned u) { return __uint_as_float(u << 16); }
__device__ __forceinline__ float hi2f(unsigned u) { return __uint_as_float(u & 0xFFFF0000u); }

__device__ __forceinline__ int otid() { int t = threadIdx.x; asm volatile("" : "+v"(t)); return t; }
__device__ __forceinline__ int osgpr(int x) { asm volatile("" : "+s"(x)); return x; }
__device__ __forceinline__ float wave_sum(float v) {
#pragma unroll
  for (int m = 32; m >= 1; m >>= 1) v += __shfl_xor(v, m, 64);
  return v;
}

__device__ __forceinline__ const float* xrow_in(const Params& p, int tok) {
  return (tok < NBP * SEQ) ? (p.x_prompt + (size_t)tok * DM) : (p.x_sample + (size_t)(tok - NBP * SEQ) * DM);
}
__device__ __forceinline__ const float* crow(const Params& p, int b) {
  return (b < NBP) ? (p.c_prompt + (size_t)b * DM) : (p.c_sample + (size_t)(b - NBP) * DM);
}

constexpr int LDS_ROW = 72;
constexpr int STAGE_ELEMS = (192 + 128) * LDS_ROW;
constexpr int GEMM_LDS_BYTES = 2 * STAGE_ELEMS * 2;

__device__ __forceinline__ void gemm_core(const bf16_t* __restrict__ A, int lda, const bf16_t* __restrict__ B, int ldb,
                                          int K, bf16_t* lds, f32x16 (&acc)[3]) {
  const int tid = otid();
  const int lane = tid & 63, w = tid >> 6;
  const int wm = w >> 2, wn = w & 3;
#pragma unroll
  for (int i = 0; i < 3; ++i)
#pragma unroll
    for (int j = 0; j < 16; ++j) acc[i][j] = 0.f;

  const int crow_ = tid >> 3, ckc = (tid & 7) * 8;
  const bf16_t* pa0 = A + (size_t)crow_ * lda + ckc;
  const bf16_t* pa1 = A + (size_t)(crow_ + 64) * lda + ckc;
  const bf16_t* pa2 = A + (size_t)(crow_ + 128) * lda + ckc;
  const bf16_t* pb0 = B + (size_t)crow_ * ldb + ckc;
  const bf16_t* pb1 = B + (size_t)(crow_ + 64) * ldb + ckc;
  const int la = crow_ * LDS_ROW + ckc;
  const int nk = K >> 6;

  uint4 ra0, ra1, ra2, rb0, rb1;
  ra0 = *(const uint4*)pa0; ra1 = *(const uint4*)pa1; ra2 = *(const uint4*)pa2;
  rb0 = *(const uint4*)pb0; rb1 = *(const uint4*)pb1;
  __syncthreads();
  {
    bf16_t* As = lds; bf16_t* Bs = lds + 192 * LDS_ROW;
    *(uint4*)(As + la) = ra0; *(uint4*)(As + la + 64 * LDS_ROW) = ra1; *(uint4*)(As + la + 128 * LDS_ROW) = ra2;
    *(uint4*)(Bs + la) = rb0; *(uint4*)(Bs + la + 64 * LDS_ROW) = rb1;
  }
  __syncthreads();
  const int fr = lane & 31, fh = (lane >> 5) * 8;
  for (int kt = 0; kt < nk; ++kt) {
    if (kt + 1 < nk) {
      const int ko = (kt + 1) << 6;
      ra0 = *(const uint4*)(pa0 + ko); ra1 = *(const uint4*)(pa1 + ko); ra2 = *(const uint4*)(pa2 + ko);
      rb0 = *(const uint4*)(pb0 + ko); rb1 = *(const uint4*)(pb1 + ko);
    }
    const bf16_t* As = lds + (kt & 1) * STAGE_ELEMS;
    const bf16_t* Bs = As + 192 * LDS_ROW;
#pragma unroll
    for (int kk = 0; kk < 4; ++kk) {
      const int ko = kk * 16 + fh;
      bf16x8 bfrag = *(const bf16x8*)(Bs + (wn * 32 + fr) * LDS_ROW + ko);
#pragma unroll
      for (int mi = 0; mi < 3; ++mi) {
        bf16x8 afrag = *(const bf16x8*)(As + (wm * 96 + mi * 32 + fr) * LDS_ROW + ko);
        acc[mi] = __builtin_amdgcn_mfma_f32_32x32x16_bf16(afrag, bfrag, acc[mi], 0, 0, 0);
      }
    }
    if (kt + 1 < nk) {
      bf16_t* As2 = lds + ((kt + 1) & 1) * STAGE_ELEMS; bf16_t* Bs2 = As2 + 192 * LDS_ROW;
      *(uint4*)(As2 + la) = ra0; *(uint4*)(As2 + la + 64 * LDS_ROW) = ra1; *(uint4*)(As2 + la + 128 * LDS_ROW) = ra2;
      *(uint4*)(Bs2 + la) = rb0; *(uint4*)(Bs2 + la + 64 * LDS_ROW) = rb1;
    }
    __syncthreads();
  }
}
#define ACC_ROW(wm, mi, reg, lane) ((wm) * 96 + (mi) * 32 + ((reg) & 3) + 8 * ((reg) >> 2) + 4 * ((lane) >> 5))
#define ACC_COL(wn, lane) ((wn) * 32 + ((lane) & 31))

__device__ __forceinline__ void acc_to_lds(const f32x16 (&acc)[3], float* ct, int LD) {
  const int tid_ = otid(); const int lane = tid_ & 63, w = tid_ >> 6, wm = w >> 2, wn = w & 3;
  const int n = ACC_COL(wn, lane);
#pragma unroll
  for (int mi = 0; mi < 3; ++mi)
#pragma unroll
    for (int r = 0; r < 16; ++r) ct[ACC_ROW(wm, mi, r, lane) * LD + n] = acc[mi][r];
}
constexpr int LDT = 196;
__device__ __forceinline__ void acc_to_lds_T(const f32x16 (&acc)[3], float* ctT) {
  const int tid_ = otid(); const int lane = tid_ & 63, w = tid_ >> 6, wm = w >> 2, wn = w & 3;
  const int n = ACC_COL(wn, lane);
#pragma unroll
  for (int mi = 0; mi < 3; ++mi)
#pragma unroll
    for (int g4 = 0; g4 < 4; ++g4) {
      const int r0 = wm * 96 + mi * 32 + 8 * g4 + 4 * (lane >> 5);
      float4 v; v.x = acc[mi][g4 * 4 + 0]; v.y = acc[mi][g4 * 4 + 1]; v.z = acc[mi][g4 * 4 + 2]; v.w = acc[mi][g4 * 4 + 3];
      *(float4*)(ctT + n * LDT + r0) = v;
    }
}
__device__ __forceinline__ void store_tile_bf16(const float* ct, bf16_t* dst, int ldd, int tok0, int n0) {
#pragma unroll 1
  for (int it = otid(); it < 192 * 16; it += NTHR) {
    const int c8 = it & 15, r = it >> 4;
    const float4 a = *(const float4*)(ct + r * 132 + c8 * 8), b = *(const float4*)(ct + r * 132 + c8 * 8 + 4);
    uint4 o; o.x = pack2(a.x, a.y); o.y = pack2(a.z, a.w); o.z = pack2(b.x, b.y); o.w = pack2(b.z, b.w);
    *(uint4*)(dst + (size_t)(tok0 + r) * ldd + n0 + c8 * 8) = o;
  }
}

__device__ void p0_transpose_tile(const float* __restrict__ src, bf16_t* __restrict__ dst, int R, int C, int tr, int tc, char* smem) {
  float* t = (float*)smem;
  const int tid = otid();
  __syncthreads();
#pragma unroll
  for (int i = 0; i < 8; ++i) {
    int r = (tid >> 6) + 8 * i, c = tid & 63;
    t[r * 65 + c] = src[(size_t)(tr * 64 + r) * C + tc * 64 + c];
  }
  __syncthreads();
#pragma unroll
  for (int i = 0; i < 8; ++i) {
    int cc = (tid >> 6) + 8 * i, rr = tid & 63;
    dst[(size_t)(tc * 64 + cc) * R + tr * 64 + rr] = f2bf(t[rr * 65 + cc]);
  }
}

__device__ void p0_wc_item(const Params& p, int l, int ph, int kt, char* smem) {
  float* wqs = (float*)smem;
  float* ks = wqs + 64 * 129;
  const int tid = otid();
  const float* wq = p.peer_wq + (size_t)l * DM * 2048;
  const float* kk = ((ph & 1) ? p.peer_k2 : p.peer_k1) + (size_t)l * 128 * 128;
  __syncthreads();
  for (int e = tid; e < 64 * 128; e += NTHR) {
    int r = e >> 7, d = e & 127;
    wqs[r * 129 + d] = wq[(size_t)(kt * 64 + r) * 2048 + ph * 128 + d];
  }
  for (int e = tid; e < 128 * 128; e += NTHR) {
    int r = e >> 7, d = e & 127;
    ks[r * 129 + d] = kk[r * 128 + d];
  }
  __syncthreads();
  const int key = tid & 127, k0 = (tid >> 7) * 16;
  float acc[16];
#pragma unroll
  for (int i = 0; i < 16; ++i) acc[i] = 0.f;
  for (int d = 0; d < 128; ++d) {
    float kv = ks[key * 129 + d];
#pragma unroll
    for (int i = 0; i < 16; ++i) acc[i] += wqs[(k0 + i) * 129 + d] * kv;
  }
  bf16_t* dst = p.WcT + ((size_t)l * 2048 + ph * 128 + key) * DM + kt * 64 + k0;
  uint4 o0, o1;
  o0.x = pack2(acc[0], acc[1]); o0.y = pack2(acc[2], acc[3]); o0.z = pack2(acc[4], acc[5]); o0.w = pack2(acc[6], acc[7]);
  o1.x = pack2(acc[8], acc[9]); o1.y = pack2(acc[10], acc[11]); o1.z = pack2(acc[12], acc[13]); o1.w = pack2(acc[14], acc[15]);
  *(uint4*)dst = o0; *(uint4*)(dst + 8) = o1;
}

__device__ void p0_mod_item(const Params& p, int l, int cc, char* smem) {
  float* sc = (float*)smem;
  const int tid = otid();
  __syncthreads();
  for (int e = tid; e < NB * DM; e += NTHR) {
    int b = e >> 10, k = e & 1023;
    float v = crow(p, b)[k];
    sc[k * 24 + b] = v / (1.f + __expf(-v));
  }
  __syncthreads();
  const int n = cc * 512 + tid;
  float acc[24];
#pragma unroll
  for (int b = 0; b < 24; ++b) acc[b] = 0.f;
  const float* wm = p.w_mod + (size_t)l * DM * 6144 + n;
  for (int k0 = 0; k0 < DM; k0 += 8) {
    float wv[8];
#pragma unroll
    for (int j = 0; j < 8; ++j) wv[j] = wm[(size_t)(k0 + j) * 6144];
#pragma unroll
    for (int j = 0; j < 8; ++j) {
      const float4* s4 = (const float4*)(sc + (k0 + j) * 24);
#pragma unroll
      for (int q = 0; q < 6; ++q) {
        float4 s = s4[q];
        acc[q * 4 + 0] += s.x * wv[j]; acc[q * 4 + 1] += s.y * wv[j]; acc[q * 4 + 2] += s.z * wv[j]; acc[q * 4 + 3] += s.w * wv[j];
      }
    }
  }
  const float bm = p.b_mod[l * 6144 + n];
#pragma unroll
  for (int b = 0; b < 24; ++b) p.mod[((size_t)l * NB + b) * 6144 + n] = acc[b] + bm;
}

__device__ void p0_filter_item(const Params& p, int l, int tc, char* smem) {
  float* feat = (float*)smem;
  float* a1 = feat + 32 * 33;
  float* a2 = a1 + 32 * 64;
  bf16_t* stage = (bf16_t*)(a2 + 32 * 64);
  const int tid = otid();
  const int t0 = tc * 32;
  __syncthreads();
  for (int e = tid; e < 32 * 33; e += NTHR) {
    int pp = e / 33, f = e % 33;
    int ti = t0 + pp;
    float v;
    if (f == 0) v = (float)ti / (float)(SEQ - 1);
    else {
      int bi = (f - 1) & 15;
      float band = 1e-4f + (float)bi * ((15.f - 1e-4f) / 15.f);
      float wv = 2.0f * 3.14159265358979323846f * (float)ti / (float)SEQ;
      float arg = band * wv;
      v = (f <= 16) ? cosf(arg) : -sinf(arg);
    }
    feat[pp * 33 + f] = v;
  }
  __syncthreads();
  const float* w1 = p.f_w1 + l * 33 * 64; const float* b1 = p.f_b1 + l * 64; const float* fq = p.f_freq + l * 64;
  const float* w2 = p.f_w2 + l * 64 * 64; const float* b2 = p.f_b2 + l * 64;
  for (int e = tid; e < 32 * 64; e += NTHR) {
    int pp = e >> 6, j = e & 63;
    float s = b1[j];
    for (int f = 0; f < 33; ++f) s += feat[pp * 33 + f] * w1[f * 64 + j];
    a1[pp * 64 + j] = sinf(fq[j] * s);
  }
  __syncthreads();
  for (int e = tid; e < 32 * 64; e += NTHR) {
    int pp = e >> 6, j = e & 63;
    float s = b2[j];
    for (int i = 0; i < 64; ++i) s += a1[pp * 64 + i] * w2[i * 64 + j];
    a2[pp * 64 + j] = sinf(fq[j] * s);
  }
  __syncthreads();
  const float* w3 = p.f_w3 + (size_t)l * 64 * 2048;
  const float min_decay = logf(1e-2f) / 1.5f, max_decay = logf(1e-2f) / 0.3f;
  for (int q = 0; q < 4; ++q) {
    const int n = tid + 512 * q;
    const int c = n & 511;
    float wr[64];
#pragma unroll
    for (int i = 0; i < 64; ++i) wr[i] = w3[i * 2048 + n];
    const float delta = fabsf(min_decay + (max_decay - min_decay) * (float)c / 511.f);
    for (int pp = 0; pp < 32; ++pp) {
      float s = 0.f;
#pragma unroll
      for (int i = 0; i < 64; ++i) s += a2[pp * 64 + i] * wr[i];
      float tt = (float)(t0 + pp) / (float)(SEQ - 1);
      s *= __expf(-tt * delta);
      if (t0 + pp == 0 && ((n >> 9) & 1) == 0) s += p.f_bias[(l * 2 + (n >> 10)) * 512 + c];
      stage[n * 32 + pp] = f2bf(s);
    }
  }
  __syncthreads();
  for (int e = tid; e < 2048 * 32; e += NTHR) {
    int n = e >> 5, pp = e & 31;
    int o = n >> 10, d = (n >> 9) & 1, c = n & 511;
    int t = t0 + pp;
    bf16_t* g = p.Gf + ((size_t)((l * 2 + o) * 512 + c)) * 4096;
    if (d == 0) g[2048 - t] = stage[n * 32 + pp];
    else if (t >= 1) g[2048 + t] = stage[n * 32 + pp];
    if (t == 0 && d == 0) g[0] = 0;
  }
}

__device__ void p0_rope_item(const Params& p, int it) {
  int e = it * 512 + otid();
  int pos = e >> 5, i = e & 31;
  float inv = powf(10000.f, -(float)(2 * i) / 64.f);
  float ang = (float)pos * inv;
  p.rope[e * 2 + 0] = cosf(ang);
  p.rope[e * 2 + 1] = sinf(ang);
}

constexpr int P0_TR_PER_LAYER = 16 * 68 + 8 * 16 + 8 * 16 + 16 * 16;
constexpr int P0_N_TR = 2 * P0_TR_PER_LAYER;
constexpr int P0_N_WC = 2 * 16 * 16;
constexpr int P0_N_MOD = 2 * 12;
constexpr int P0_N_FILT = 2 * 64;
constexpr int P0_N_ROPE = 128;
constexpr int P0_TOTAL = P0_N_MOD + P0_N_FILT + P0_N_WC + P0_N_ROPE + P0_N_TR;

__device__ void phase_p0(const Params& p, char* smem) {
  for (int it = blockIdx.x; it < P0_TOTAL; it += gridDim.x) {
    int i = it;
    if (i < P0_N_MOD) { p0_mod_item(p, i / 12, i % 12, smem); continue; }
    i -= P0_N_MOD;
    if (i < P0_N_FILT) { p0_filter_item(p, i / 64, i % 64, smem); continue; }
    i -= P0_N_FILT;
    if (i < P0_N_WC) { p0_wc_item(p, i >> 8, (i >> 4) & 15, i & 15, smem); continue; }
    i -= P0_N_WC;
    if (i < P0_N_ROPE) { p0_rope_item(p, i); continue; }
    i -= P0_N_ROPE;
    {
      int l = i / P0_TR_PER_LAYER, j = i % P0_TR_PER_LAYER;
      if (j < 16 * 68) { p0_transpose_tile(p.w_in + (size_t)l * DM * INC, p.WinT + (size_t)l * INC * DM, DM, INC, j / 68, j % 68, smem); continue; }
      j -= 16 * 68;
      if (j < 128) { p0_transpose_tile(p.w_pa + (size_t)l * HYW * DM, p.WpaT + (size_t)l * DM * HYW, HYW, DM, j / 16, j % 16, smem); continue; }
      j -= 128;
      if (j < 128) { p0_transpose_tile(p.w_pb + (size_t)l * HYW * DM, p.WpbT + (size_t)l * DM * HYW, HYW, DM, j / 16, j % 16, smem); continue; }
      j -= 128;
      p0_transpose_tile(p.w_out + (size_t)l * DM * DM, p.WoutT + (size_t)l * DM * DM, DM, DM, j / 16, j % 16, smem);
    }
  }
}

__device__ void norm_rows(const Params& p, int tile, int l, int which, bool from_inputs, char* smem) {
  float* scl = (float*)smem;
  float* shf = scl + 2048;
  const int tid = otid(), lane = tid & 63, w = tid >> 6;
  const int tok0 = tile * TM;
  const int b0 = tok0 >> 11;
  const float* g = (which ? p.g2 : p.g1) + l * DM;
  __syncthreads();
  for (int e = tid; e < 2048; e += NTHR) {
    int bi = e >> 10, j = e & 1023;
    int b = b0 + bi; if (b > NB - 1) b = NB - 1;
    const float* m = p.mod + ((size_t)l * NB + b) * 6144 + which * 3072;
    scl[e] = g[j] * (1.f + m[1024 + j]);
    shf[e] = m[j];
  }
  __syncthreads();
  for (int r = w; r < TM; r += 8) {
    const int tok = tok0 + r;
    const int bi = (tok >> 11) - b0;
    const float* xr = from_inputs ? xrow_in(p, tok) : (p.out + (size_t)tok * DM);
    float4 v[4];
    float ss = 0.f;
#pragma unroll
    for (int i = 0; i < 4; ++i) {
      v[i] = *(const float4*)(xr + lane * 4 + 256 * i);
      ss += v[i].x * v[i].x + v[i].y * v[i].y + v[i].z * v[i].z + v[i].w * v[i].w;
    }
    ss = wave_sum(ss);
    const float rs = rsqrtf(ss * (1.f / DM) + 1e-6f);
#pragma unroll
    for (int i = 0; i < 4; ++i) {
      const int j = lane * 4 + 256 * i;
      const float4 sc4 = *(const float4*)(scl + bi * 1024 + j);
      const float4 sh4 = *(const float4*)(shf + bi * 1024 + j);
      uint2 o;
      o.x = pack2(v[i].x * rs * sc4.x + sh4.x, v[i].y * rs * sc4.y + sh4.y);
      o.y = pack2(v[i].z * rs * sc4.z + sh4.z, v[i].w * rs * sc4.w + sh4.w);
      *(uint2*)(p.hbuf + (size_t)tok * DM + j) = o;
    }
  }
  __syncthreads();
}

__device__ void phase_c(const Params& p, int tile, int l, bool from_inputs, char* smem) {
  norm_rows(p, tile, l, 0, from_inputs, smem);
  const int tid = otid();
  const int tok0 = tile * TM;
  const bf16_t* A = p.hbuf + (size_t)tok0 * DM;
  const bf16_t* W = p.WinT + (size_t)l * INC * DM;
  float* ct = (float*)smem;
  f32x16 acc[3];
#pragma unroll 1
  for (int nc = 0; nc < 18; ++nc) {
    gemm_core(A, DM, W + (size_t)nc * 128 * DM, DM, DM, (bf16_t*)smem, acc);
    if (nc < 12) {
      acc_to_lds_T(acc, ct);
      __syncthreads();
#pragma unroll 1
      for (int it = tid; it < 128 * 24; it += NTHR) {
        const int tg = it % 24, nl = it / 24;
        const float4 a = *(const float4*)(ct + nl * LDT + tg * 8), b4 = *(const float4*)(ct + nl * LDT + tg * 8 + 4);
        uint4 o; o.x = pack2(a.x, a.y); o.y = pack2(a.z, a.w); o.z = pack2(b4.x, b4.y); o.w = pack2(b4.z, b4.w);
        const int tok = tok0 + tg * 8;
        const int b = tok >> 11, sq = tok & 2047;
        *(uint4*)(p.zT + ((size_t)b * HYC + nc * 128 + nl) * SEQ + sq) = o;
      }
    } else {
      acc_to_lds(acc, ct, 132);
      __syncthreads();
      store_tile_bf16(ct, p.zqkv, QKVC, tok0, nc * 128 - HYC);
    }
  }
}

__device__ __forceinline__ void load_conv8(const bf16_t* __restrict__ zrow, int s0, float w0, float w1, float w2, float cb, float (&o)[8]) {
  uint4 v = *(const uint4*)(zrow + s0);
  float z[10];
  z[0] = (s0 > 0) ? bf2f(zrow[s0 - 1]) : 0.f;
  z[1] = lo2f(v.x); z[2] = hi2f(v.x); z[3] = lo2f(v.y); z[4] = hi2f(v.y);
  z[5] = lo2f(v.z); z[6] = hi2f(v.z); z[7] = lo2f(v.w); z[8] = hi2f(v.w);
  z[9] = (s0 + 8 < SEQ) ? bf2f(zrow[s0 + 8]) : 0.f;
#pragma unroll
  for (int i = 0; i < 8; ++i) o[i] = z[i] * w0 + z[i + 1] * w1 + z[i + 2] * w2 + cb;
}

typedef short s16x4 __attribute__((ext_vector_type(4)));
__device__ __forceinline__ s16x4 tr_read4(const bf16_t* lds_ptr) {
  return __builtin_amdgcn_ds_read_tr16_b64_v4i16((__attribute__((address_space(3))) s16x4*)(lds_ptr));
}

constexpr int HY_GS_ELEMS = 4112;
constexpr int HY_US_ROWS = 2072;
__device__ __forceinline__ void hyena_load_g(const Params& p, int l, int o, int c, bf16_t* Gs, int tid) {
  const bf16_t* g = p.Gf + ((size_t)((l * 2 + o) * 512 + c)) * 4096;
  *(uint4*)(Gs + 8 + tid * 8) = *(const uint4*)(g + tid * 8);
  if (tid == 0) { unsigned z = 0; asm volatile("" : "+v"(z)); const uint4 z4 = make_uint4(z, z, z, z); *(uint4*)Gs = z4; *(uint4*)(Gs + 4104) = z4; }
}

__device__ __forceinline__ void hyena_kloop(const bf16_t* Gs, const bf16_t* us, int rho, int lane, f32x16 (&acc)[8]) {
#pragma unroll
  for (int a = 0; a < 8; ++a)
#pragma unroll
    for (int j = 0; j < 16; ++j) acc[a][j] = 0.f;
  const int i = lane & 31, hh = lane >> 5;
  const bf16_t* ga = Gs + (2040 - 8 * i + 8 * hh) - 1792;
  const int l16 = lane & 15, q = l16 >> 2, pq = l16 & 3, g4 = lane >> 4;
  const bf16_t* ub = us + (rho + 8 * (g4 >> 1) + q) * 24 + 16 * (g4 & 1) + 4 * pq;
#pragma unroll 1
  for (int kap = 0; kap < 129; ++kap) {
    const s16x4 b0 = tr_read4(ub + kap * 384);
    const s16x4 b1 = tr_read4(ub + kap * 384 + 96);
    bf16x8 bfrag;
    bfrag[0] = b0[0]; bfrag[1] = b0[1]; bfrag[2] = b0[2]; bfrag[3] = b0[3];
    bfrag[4] = b1[0]; bfrag[5] = b1[1]; bfrag[6] = b1[2]; bfrag[7] = b1[3];
#pragma unroll
    for (int a = 0; a < 8; ++a) {
      const bf16x8 af = *(const bf16x8*)(ga + kap * 16 + 256 * (7 - a));
      acc[a] = __builtin_amdgcn_mfma_f32_32x32x16_bf16(af, bfrag, acc[a], 0, 0, 0);
    }
  }
}

__device__ __forceinline__ void hyena_acc_to_us(const f32x16 (&acc)[8], bf16_t* us, int rho, int lane) {
  const int n = lane & 31, hh = lane >> 5;
  if (n < 24) {
#pragma unroll
    for (int a = 0; a < 8; ++a)
#pragma unroll
      for (int r = 0; r < 16; ++r) {
        const int t = 256 * a + rho + 8 * ((r & 3) + 8 * (r >> 2) + 4 * hh);
        us[(t + 16) * 24 + n] = f2bf(acc[a][r]);
      }
  }
}

__device__ void hyena_item(const Params& p, int l, int c, char* smem) {
  bf16_t* Gs = (bf16_t*)smem;
  bf16_t* us = (bf16_t*)(smem + 8256);
  const int tid = otid();
  const int lane = tid & 63, w = tid >> 6;
  const float* cw = p.conv_w + (size_t)l * 3 * HYC;
  const float* cbp = p.conv_b + (size_t)l * HYC;
  __syncthreads();
  hyena_load_g(p, l, 0, c, Gs, tid);
  {
    unsigned z = 0; asm volatile("" : "+v"(z)); const uint4 z4 = make_uint4(z, z, z, z);
    if (tid < 48) *(uint4*)(us + tid * 8) = z4;
    else if (tid < 48 + 26) *(uint4*)(us + 2064 * 24 + (tid - 48) * 8) = z4;
  }
  {
    const float w0 = cw[c], w1 = cw[HYC + c], w2 = cw[2 * HYC + c], cb = cbp[c];
#pragma unroll 1
    for (int qq = tid; qq < 24 * 256; qq += NTHR) {
      const int b = qq % 24, s0 = (qq / 24) * 8;
      float v[8];
      load_conv8(p.zT + ((size_t)b * HYC + c) * SEQ, s0, w0, w1, w2, cb, v);
#pragma unroll
      for (int i = 0; i < 8; ++i) us[(s0 + i + 16) * 24 + b] = f2bf(v[i]);
    }
  }
  __syncthreads();
  f32x16 acc[8];
#pragma unroll 1
  for (int o = 0; o < 2; ++o) {
    hyena_kloop(Gs, us, w, lane, acc);
    __syncthreads();
    hyena_acc_to_us(acc, us, w, lane);
    if (o == 0) hyena_load_g(p, l, 1, c, Gs, tid);
    __syncthreads();
    const int xc = (o == 0 ? 512 : 1024) + c;
    const float xw0 = cw[xc], xw1 = cw[HYC + xc], xw2 = cw[2 * HYC + xc], xcb = cbp[xc];
#pragma unroll 1
    for (int qq = tid; qq < 24 * 256; qq += NTHR) {
      const int b = qq % 24, s0 = (qq / 24) * 8;
      float xv[8];
      load_conv8(p.zT + ((size_t)b * HYC + xc) * SEQ, s0, xw0, xw1, xw2, xcb, xv);
      if (o == 0) {
#pragma unroll
        for (int i = 0; i < 8; ++i) {
          bf16_t* e = us + (s0 + i + 16) * 24 + b;
          *e = f2bf(bf2f(*e) * xv[i]);
        }
      } else {
        float r[8];
#pragma unroll
        for (int i = 0; i < 8; ++i) r[i] = bf2f(us[(s0 + i + 16) * 24 + b]) * xv[i];
        uint4 pk; pk.x = pack2(r[0], r[1]); pk.y = pack2(r[2], r[3]); pk.z = pack2(r[4], r[5]); pk.w = pack2(r[6], r[7]);
        *(uint4*)(p.yaT + ((size_t)b * HYW + c) * SEQ + s0) = pk;
      }
    }
    __syncthreads();
  }
}

__device__ void attn_item(const Params& p, int l, int item, char* smem) {
  constexpr int KS = 72, VS = 96;
  bf16_t* Ks = (bf16_t*)smem;
  bf16_t* Vs = Ks + 384 * KS;
  const int tid = otid();
  const int lane = tid & 63, w = tid >> 6;
  const int kh = item & 1, qb = (item >> 1) & 15, b = item >> 5;
  const int kpos0 = qb * 128 - 128;
  __syncthreads();
  if (tid < 384) {
    const int r = tid, kpos = kpos0 + r;
    if (kpos >= 0 && kpos < SEQ) {
      const bf16_t* kr = p.zqkv + ((size_t)(b * SEQ + kpos)) * QKVC + 512 + kh * 64;
      float kf[64];
      float ss = 0.f;
#pragma unroll
      for (int c8 = 0; c8 < 8; ++c8) {
        uint4 v = *(const uint4*)(kr + c8 * 8);
        kf[c8 * 8 + 0] = lo2f(v.x); kf[c8 * 8 + 1] = hi2f(v.x); kf[c8 * 8 + 2] = lo2f(v.y); kf[c8 * 8 + 3] = hi2f(v.y);
        kf[c8 * 8 + 4] = lo2f(v.z); kf[c8 * 8 + 5] = hi2f(v.z); kf[c8 * 8 + 6] = lo2f(v.w); kf[c8 * 8 + 7] = hi2f(v.w);
      }
#pragma unroll
      for (int d = 0; d < 64; ++d) ss += kf[d] * kf[d];
      const float rs = rsqrtf(ss * (1.f / 64.f) + 1e-6f);
      const float* kg = p.k_gain + l * 64;
#pragma unroll
      for (int d = 0; d < 64; ++d) kf[d] = kf[d] * rs * kg[d];
      const float* rp = p.rope + (size_t)kpos * 64;
#pragma unroll
      for (int i = 0; i < 32; ++i) {
        const float cs = rp[i * 2], sn = rp[i * 2 + 1];
        const float a = kf[i], bb = kf[i + 32];
        kf[i] = a * cs - bb * sn; kf[i + 32] = bb * cs + a * sn;
      }
#pragma unroll
      for (int c8 = 0; c8 < 8; ++c8) {
        uint4 pk;
        pk.x = pack2(kf[c8 * 8 + 0], kf[c8 * 8 + 1]); pk.y = pack2(kf[c8 * 8 + 2], kf[c8 * 8 + 3]);
        pk.z = pack2(kf[c8 * 8 + 4], kf[c8 * 8 + 5]); pk.w = pack2(kf[c8 * 8 + 6], kf[c8 * 8 + 7]);
        *(uint4*)(Ks + r * KS + c8 * 8) = pk;
      }
    }
  }
#pragma unroll 1
  for (int e = tid; e < 384 * 8; e += NTHR) {
    const int r = e >> 3, c8 = e & 7, kpos = kpos0 + r;
    if (kpos >= 0 && kpos < SEQ)
      *(uint4*)(Vs + r * VS + c8 * 8) = *(const uint4*)(p.zqkv + ((size_t)(b * SEQ + kpos)) * QKVC + 640 + kh * 64 + c8 * 8);
  }
  __syncthreads();
  const int hl = w & 3, qh = w >> 2;
  const int head = kh * 4 + hl;
  const int n = lane & 31, hh = lane >> 5;
  const int Q0 = qb * 128 + 64 * qh;
  bf16x8 qf[2][4];
#pragma unroll
  for (int nt = 0; nt < 2; ++nt) {
    const int qpos = Q0 + 32 * nt + n;
    const bf16_t* qr = p.zqkv + ((size_t)(b * SEQ + qpos)) * QKVC + head * 64;
    float qv[4][8];
    float ss = 0.f;
#pragma unroll
    for (int kk = 0; kk < 4; ++kk) {
      uint4 v = *(const uint4*)(qr + 16 * kk + 8 * hh);
      qv[kk][0] = lo2f(v.x); qv[kk][1] = hi2f(v.x); qv[kk][2] = lo2f(v.y); qv[kk][3] = hi2f(v.y);
      qv[kk][4] = lo2f(v.z); qv[kk][5] = hi2f(v.z); qv[kk][6] = lo2f(v.w); qv[kk][7] = hi2f(v.w);
#pragma unroll
      for (int j = 0; j < 8; ++j) ss += qv[kk][j] * qv[kk][j];
    }
    ss += __shfl_xor(ss, 32, 64);
    const float rs = rsqrtf(ss * (1.f / 64.f) + 1e-6f) * 0.125f;
    const float* qg = p.q_gain + l * 64;
#pragma unroll
    for (int kk = 0; kk < 4; ++kk)
#pragma unroll
      for (int j = 0; j < 8; ++j) qv[kk][j] *= rs * qg[16 * kk + 8 * hh + j];
    const float* rp = p.rope + (size_t)qpos * 64;
#pragma unroll
    for (int kk = 0; kk < 2; ++kk)
#pragma unroll
      for (int j = 0; j < 8; ++j) {
        const int d = 16 * kk + 8 * hh + j;
        const float cs = rp[d * 2], sn = rp[d * 2 + 1];
        const float a = qv[kk][j], bb = qv[kk + 2][j];
        qv[kk][j] = a * cs - bb * sn; qv[kk + 2][j] = bb * cs + a * sn;
      }
#pragma unroll
    for (int kk = 0; kk < 4; ++kk)
#pragma unroll
      for (int j = 0; j < 8; ++j) qf[nt][kk][j] = (short)f2bf(qv[kk][j]);
  }
  f32x16 O[2][2];
#pragma unroll
  for (int dm = 0; dm < 2; ++dm)
#pragma unroll
    for (int nt = 0; nt < 2; ++nt)
#pragma unroll
      for (int r = 0; r < 16; ++r) O[dm][nt][r] = 0.f;
  float mrun[2], lsum[2];
  mrun[0] = mrun[1] = p.sink[l * 8 + head];
  lsum[0] = lsum[1] = (hh == 0) ? 1.f : 0.f;
  const int l16 = lane & 15, tq = l16 >> 2, tp = l16 & 3, g4 = lane >> 4;
  const bf16_t* vbase = Vs + (4 * (g4 >> 1) + tq) * VS + 16 * (g4 & 1) + 4 * tp;
#pragma unroll 1
  for (int kt = 2 * qh; kt < 2 * qh + 10; ++kt) {
    const int kp_t = kpos0 + 32 * kt;
    if (kp_t < 0 || kp_t >= SEQ) continue;
    bf16x8 kfr[4];
#pragma unroll
    for (int kk = 0; kk < 4; ++kk) kfr[kk] = *(const bf16x8*)(Ks + (32 * kt + n) * KS + 16 * kk + 8 * hh);
    bf16x8 pf[2][2];
#pragma unroll
    for (int nt = 0; nt < 2; ++nt) {
      f32x16 S;
#pragma unroll
      for (int r = 0; r < 16; ++r) S[r] = 0.f;
#pragma unroll
      for (int kk = 0; kk < 4; ++kk) S = __builtin_amdgcn_mfma_f32_32x32x16_bf16(kfr[kk], qf[nt][kk], S, 0, 0, 0);
      const int qpos = Q0 + 32 * nt + n;
      float mloc = -INFINITY;
#pragma unroll
      for (int r = 0; r < 16; ++r) {
        const int kpos = kp_t + (r & 3) + 8 * (r >> 2) + 4 * hh;
        int dd = kpos - qpos; dd = dd < 0 ? -dd : dd;
        S[r] = (dd <= 128) ? S[r] : -INFINITY;
        mloc = fmaxf(mloc, S[r]);
      }
      mloc = fmaxf(mloc, __shfl_xor(mloc, 32, 64));
      const float mnew = fmaxf(mrun[nt], mloc);
      const float corr = __expf(mrun[nt] - mnew);
      mrun[nt] = mnew;
      float psum = 0.f;
#pragma unroll
      for (int r = 0; r < 16; ++r) { S[r] = __expf(S[r] - mnew); psum += S[r]; }
      lsum[nt] = lsum[nt] * corr + psum;
#pragma unroll
      for (int dm = 0; dm < 2; ++dm)
#pragma unroll
        for (int r = 0; r < 16; ++r) O[dm][nt][r] *= corr;
#pragma unroll
      for (int s2 = 0; s2 < 2; ++s2)
#pragma unroll
        for (int j = 0; j < 8; ++j) pf[nt][s2][j] = (short)f2bf(S[8 * s2 + j]);
    }
#pragma unroll
    for (int dm = 0; dm < 2; ++dm)
#pragma unroll
      for (int s2 = 0; s2 < 2; ++s2) {
        const bf16_t* vp = vbase + (32 * kt + 16 * s2) * VS + 32 * dm;
        const s16x4 v0 = tr_read4(vp);
        const s16x4 v1 = tr_read4(vp + 8 * VS);
        bf16x8 vf;
        vf[0] = v0[0]; vf[1] = v0[1]; vf[2] = v0[2]; vf[3] = v0[3];
        vf[4] = v1[0]; vf[5] = v1[1]; vf[6] = v1[2]; vf[7] = v1[3];
#pragma unroll
        for (int nt = 0; nt < 2; ++nt) O[dm][nt] = __builtin_amdgcn_mfma_f32_32x32x16_bf16(vf, pf[nt][s2], O[dm][nt], 0, 0, 0);
      }
  }
#pragma unroll
  for (int nt = 0; nt < 2; ++nt) {
    const float ltot = lsum[nt] + __shfl_xor(lsum[nt], 32, 64);
    const float inv = 1.f / ltot;
    const int qpos = Q0 + 32 * nt + n;
    bf16_t* yo = p.yb + ((size_t)(b * SEQ + qpos)) * 512 + head * 64;
#pragma unroll
    for (int dm = 0; dm < 2; ++dm)
#pragma unroll
      for (int g = 0; g < 4; ++g) {
        uint2 o;
        o.x = pack2(O[dm][nt][4 * g + 0] * inv, O[dm][nt][4 * g + 1] * inv);
        o.y = pack2(O[dm][nt][4 * g + 2] * inv, O[dm][nt][4 * g + 3] * inv);
        *(uint2*)(yo + 32 * dm + 8 * g + 4 * hh) = o;
      }
  }
}

typedef float f32x2 __attribute__((ext_vector_type(2)));
__device__ void table_item(const Params& p, int l, int it) {
  const int tid = otid();
  const int lane = tid & 63, w = tid >> 6;
  const int which = it >> 9, r0 = (it & 511) * 32 + w * 4;
  const float* src = (which ? p.peer_v : p.peer_u) + (size_t)l * NEXP * DM;
  unsigned char* dst = which ? p.tabV8 : p.tabU8;
  float* sc = which ? p.sclV : p.sclU;
#pragma unroll 1
  for (int rr = 0; rr < 4; ++rr) {
    const int e = r0 + rr;
    float4 v[4];
    float mx = 0.f;
#pragma unroll
    for (int i = 0; i < 4; ++i) {
      v[i] = *(const float4*)(src + (size_t)e * DM + lane * 4 + 256 * i);
      mx = fmaxf(mx, fmaxf(fmaxf(fabsf(v[i].x), fabsf(v[i].y)), fmaxf(fabsf(v[i].z), fabsf(v[i].w))));
    }
#pragma unroll
    for (int m = 32; m >= 1; m >>= 1) mx = fmaxf(mx, __shfl_xor(mx, m, 64));
    const float scale = (mx > 0.f) ? 440.f / mx : 1.f;
#pragma unroll
    for (int i = 0; i < 4; ++i) {
      int pk = __builtin_amdgcn_cvt_pk_fp8_f32(v[i].x * scale, v[i].y * scale, 0, false);
      pk = __builtin_amdgcn_cvt_pk_fp8_f32(v[i].z * scale, v[i].w * scale, pk, true);
      const int x = 2 * i + (lane >> 5);
      *(int*)(dst + ((size_t)x * NEXP + e) * 128 + (lane & 31) * 4) = pk;
    }
    if (lane == 0) sc[e] = (mx > 0.f) ? mx * (1.f / 440.f) : 1.f;
  }
}

constexpr int DE_N_HY = 512, DE_N_AT = 768, DE_N_TB = 1024;
__device__ void phase_de(const Params& p, int l, char* smem) {
  for (int it = blockIdx.x; it < DE_N_HY + DE_N_AT + DE_N_TB; it += gridDim.x) {
    if (it < DE_N_HY) hyena_item(p, l, it, smem);
    else if (it < DE_N_HY + DE_N_AT) attn_item(p, l, it - DE_N_HY, smem);
    else table_item(p, l, it - DE_N_HY - DE_N_AT);
  }
}

__device__ void phase_f(const Params& p, int tile, int l, bool from_inputs, char* smem) {
  const int tid = otid();
  const int tok0 = tile * TM;
#pragma unroll 1
  for (int e = tid; e < TM * 64; e += NTHR) {
    const int r = e % TM, cg8 = e / TM;
    const int tok = tok0 + r, b = tok >> 11, sq = tok & 2047;
    const bf16_t* src = p.yaT + ((size_t)b * HYW + cg8 * 8) * SEQ + sq;
    uint4 o;
    o.x = (unsigned)src[0] | ((unsigned)src[SEQ] << 16);
    o.y = (unsigned)src[2 * SEQ] | ((unsigned)src[3 * SEQ] << 16);
    o.z = (unsigned)src[4 * SEQ] | ((unsigned)src[5 * SEQ] << 16);
    o.w = (unsigned)src[6 * SEQ] | ((unsigned)src[7 * SEQ] << 16);
    *(uint4*)(p.yatok + (size_t)tok * HYW + cg8 * 8) = o;
  }
  __syncthreads();
  const bf16_t* Ah = p.hbuf + (size_t)tok0 * DM;
  const bf16_t* Aya = p.yatok + (size_t)tok0 * HYW;
  const bf16_t* Ayb = p.yb + (size_t)tok0 * HYW;
  const bf16_t* Win = p.WinT + (size_t)l * INC * DM;
  const bf16_t* Wpa = p.WpaT + (size_t)l * DM * HYW;
  const bf16_t* Wpb = p.WpbT + (size_t)l * DM * HYW;
  float* ct = (float*)smem;
  f32x16 acc[3], sg[3];
  unsigned* aux = (unsigned*)(smem + 101376) + tid;
#pragma unroll 1
  for (int nc = 0; nc < 8; ++nc) {
    gemm_core(Ah, DM, Win + (size_t)(2304 + nc * 128) * DM, DM, DM, (bf16_t*)smem, acc);
#pragma unroll
    for (int mi = 0; mi < 3; ++mi)
#pragma unroll
      for (int q = 0; q < 8; ++q)
        aux[(mi * 8 + q) * 512] = pack2(__builtin_amdgcn_rcpf(1.f + __expf(-acc[mi][2 * q])), __builtin_amdgcn_rcpf(1.f + __expf(-acc[mi][2 * q + 1])));
    gemm_core(Aya, HYW, Wpa + (size_t)(nc * 128) * HYW, HYW, HYW, (bf16_t*)smem, acc);
#pragma unroll
    for (int mi = 0; mi < 3; ++mi)
#pragma unroll
      for (int q = 0; q < 8; ++q) {
        const unsigned g = aux[(mi * 8 + q) * 512];
        aux[(mi * 8 + q) * 512] = pack2(lo2f(g) * acc[mi][2 * q], hi2f(g) * acc[mi][2 * q + 1]);
      }
    gemm_core(Ah, DM, Win + (size_t)(3328 + nc * 128) * DM, DM, DM, (bf16_t*)smem, acc);
#pragma unroll
    for (int mi = 0; mi < 3; ++mi)
#pragma unroll
      for (int r = 0; r < 16; ++r) sg[mi][r] = __builtin_amdgcn_rcpf(1.f + __expf(-acc[mi][r]));
    gemm_core(Ayb, HYW, Wpb + (size_t)(nc * 128) * HYW, HYW, HYW, (bf16_t*)smem, acc);
#pragma unroll
    for (int mi = 0; mi < 3; ++mi)
#pragma unroll
      for (int q = 0; q < 8; ++q) {
        const unsigned g = aux[(mi * 8 + q) * 512];
        acc[mi][2 * q] = lo2f(g) + sg[mi][2 * q] * acc[mi][2 * q];
        acc[mi][2 * q + 1] = hi2f(g) + sg[mi][2 * q + 1] * acc[mi][2 * q + 1];
      }
    acc_to_lds(acc, ct, 132);
    __syncthreads();
    store_tile_bf16(ct, p.merged, DM, tok0, nc * 128);
  }
  __syncthreads();
  const bf16_t* Am = p.merged + (size_t)tok0 * DM;
  const bf16_t* Wo = p.WoutT + (size_t)l * DM * DM;
#pragma unroll 1
  for (int nc = 0; nc < 8; ++nc) {
    gemm_core(Am, DM, Wo + (size_t)(nc * 128) * DM, DM, DM, (bf16_t*)smem, acc);
    acc_to_lds(acc, ct, 132);
    __syncthreads();
#pragma unroll 1
    for (int it = tid; it < 192 * 32; it += NTHR) {
      const int c4 = it & 31, r = it >> 5;
      const int tok = tok0 + r, b = tok >> 11;
      const int n = nc * 128 + c4 * 4;
      const float4 a = *(const float4*)(ct + r * 132 + c4 * 4);
      const float4 gt = *(const float4*)(p.mod + ((size_t)l * NB + b) * 6144 + 2048 + n);
      const float* xs = from_inputs ? xrow_in(p, tok) : (p.out + (size_t)tok * DM);
      float4 xo = *(const float4*)(xs + n);
      xo.x += gt.x * a.x; xo.y += gt.y * a.y; xo.z += gt.z * a.z; xo.w += gt.w * a.w;
      *(float4*)(p.out + (size_t)tok * DM + n) = xo;
    }
  }
  __syncthreads();
}

__device__ __forceinline__ void topk_insert(float (&key)[16], float kx) {
#pragma unroll
  for (int i = 0; i < 16; ++i) {
    const float hi = fmaxf(key[i], kx);
    kx = fminf(key[i], kx);
    key[i] = hi;
  }
}

__device__ void phase_g(const Params& p, int tile, int l, char* smem) {
  norm_rows(p, tile, l, 1, false, smem);
  const int tid = otid();
  const int tok0 = tile * TM;
  const bf16_t* Ah = p.hbuf + (size_t)tok0 * DM;
  const bf16_t* Wc = p.WcT + (size_t)l * 2048 * DM;
  float* sc = (float*)smem;
  f32x16 acc[3];
  float v1k[16], v2k[16];
#pragma unroll 1
  for (int ch = 0; ch < 16; ++ch) {
    gemm_core(Ah, DM, Wc + (size_t)(ch * 128) * DM, DM, DM, (bf16_t*)smem, acc);
    acc_to_lds(acc, sc, 129);
    __syncthreads();
    if (tid < TM) {
      float key[16];
#pragma unroll
      for (int i = 0; i < 16; ++i) key[i] = -INFINITY;
      const float* row = sc + tid * 129;
      for (int j = 0; j < 128; ++j) {
        const float x = row[j];
        const float kx = __uint_as_float((__float_as_uint(x) & 0xFFFFFF80u) | (unsigned)j);
        topk_insert(key, kx);
      }
      if ((ch & 1) == 0) {
#pragma unroll
        for (int i = 0; i < 16; ++i) v1k[i] = key[i];
      } else {
#pragma unroll
        for (int i = 0; i < 16; ++i) v2k[i] = key[i];
        float top[16];
#pragma unroll
        for (int i = 0; i < 16; ++i) top[i] = -INFINITY;
#pragma unroll
        for (int i = 0; i < 16; ++i)
#pragma unroll
          for (int j = 0; j < 16; ++j)
            if ((i + 1) * (j + 1) <= 16) {
              const float s = v1k[i] + v2k[j];
              const float ck = __uint_as_float((__float_as_uint(s) & 0xFFFFFF00u) | (unsigned)(i * 16 + j));
              topk_insert(top, ck);
            }
        const float mx = top[0];
        float ex[16], sum = 0.f;
#pragma unroll
        for (int k = 0; k < 16; ++k) { ex[k] = __expf(top[k] - mx); sum += ex[k]; }
        const float inv = 1.f / sum;
        const int hh = ch >> 1;
        const size_t ob = ((size_t)(tok0 + tid) * 8 + hh) * 16;
#pragma unroll
        for (int k = 0; k < 16; ++k) {
          const unsigned code = __float_as_uint(top[k]) & 0xFFu;
          const unsigned ii = code >> 4, jj = code & 15u;
          unsigned e1 = 0, e2 = 0;
#pragma unroll
          for (int q = 0; q < 16; ++q) {
            e1 = (ii == (unsigned)q) ? (__float_as_uint(v1k[q]) & 0x7Fu) : e1;
            e2 = (jj == (unsigned)q) ? (__float_as_uint(v2k[q]) & 0x7Fu) : e2;
          }
          p.pidx[ob + k] = (unsigned short)(e1 * 128 + e2);
          p.pg[ob + k] = ex[k] * inv;
        }
      }
    }
    __syncthreads();
  }
}

__device__ __forceinline__ void fp8x16_to_f32(const uint4& u, float (&f)[16]) {
  const unsigned wd[4] = {u.x, u.y, u.z, u.w};
#pragma unroll
  for (int q = 0; q < 4; ++q) {
    const f32x2 a = __builtin_amdgcn_cvt_pk_f32_fp8((int)wd[q], false);
    const f32x2 b = __builtin_amdgcn_cvt_pk_f32_fp8((int)wd[q], true);
    f[4 * q + 0] = a[0]; f[4 * q + 1] = a[1]; f[4 * q + 2] = b[0]; f[4 * q + 3] = b[1];
  }
}

__device__ void phase_i1(const Params& p, char* smem) {
  const int tid = otid();
  const int lane = tid & 63, w = tid >> 6;
  const int g = lane >> 3, ch = lane & 7;
  for (int it = blockIdx.x; it < 256; it += gridDim.x) {
    const int x = it & 7, j = it >> 3;
    const unsigned char* Ux = p.tabU8 + (size_t)x * NEXP * 128 + ch * 16;
    float* ap = p.apart + (size_t)x * NTOK * 128;
#pragma unroll 1
    for (int t = w; t < 1536; t += 8) {
      const int tok = j * 1536 + t;
      const bf16_t* hr = p.hbuf + (size_t)tok * DM + x * 128 + ch * 16;
      const uint4 h0 = *(const uint4*)hr, h1 = *(const uint4*)(hr + 8);
      float hs[16];
      hs[0] = lo2f(h0.x); hs[1] = hi2f(h0.x); hs[2] = lo2f(h0.y); hs[3] = hi2f(h0.y);
      hs[4] = lo2f(h0.z); hs[5] = hi2f(h0.z); hs[6] = lo2f(h0.w); hs[7] = hi2f(h0.w);
      hs[8] = lo2f(h1.x); hs[9] = hi2f(h1.x); hs[10] = lo2f(h1.y); hs[11] = hi2f(h1.y);
      hs[12] = lo2f(h1.z); hs[13] = hi2f(h1.z); hs[14] = lo2f(h1.w); hs[15] = hi2f(h1.w);
      const uint4* pi = (const uint4*)(p.pidx + (size_t)tok * 128 + g * 16);
      const uint4 e0 = pi[0], e1 = pi[1];
      const unsigned ew[8] = {e0.x, e0.y, e0.z, e0.w, e1.x, e1.y, e1.z, e1.w};
      float res[16];
#pragma unroll
      for (int rd = 0; rd < 16; ++rd) {
        const unsigned e = (ew[rd >> 1] >> (16 * (rd & 1))) & 0x3FFFu;
        const uint4 u = *(const uint4*)(Ux + (size_t)e * 128);
        float f[16];
        fp8x16_to_f32(u, f);
        float d = 0.f;
#pragma unroll
        for (int i = 0; i < 16; ++i) d += f[i] * hs[i];
        d += __shfl_xor(d, 1, 64); d += __shfl_xor(d, 2, 64); d += __shfl_xor(d, 4, 64);
        res[rd] = d * p.sclU[e];
      }
      if (ch == 0) {
        float4* o = (float4*)(ap + (size_t)tok * 128 + g * 16);
        o[0] = make_float4(res[0], res[1], res[2], res[3]); o[1] = make_float4(res[4], res[5], res[6], res[7]);
        o[2] = make_float4(res[8], res[9], res[10], res[11]); o[3] = make_float4(res[12], res[13], res[14], res[15]);
      }
    }
  }
}

__device__ void phase_i2(const Params& p, int l, char* smem) {
  const int tid = otid();
  const int lane = tid & 63, w = tid >> 6;
  const int g = lane >> 3, ch = lane & 7;
  float* wl = (float*)smem + w * 128;
  __syncthreads();
  for (int it = blockIdx.x; it < 256; it += gridDim.x) {
    const int x = it & 7, j = it >> 3;
    const unsigned char* Vx = p.tabV8 + (size_t)x * NEXP * 128 + ch * 16;
#pragma unroll 1
    for (int t = w; t < 1536; t += 8) {
      const int tok = j * 1536 + t;
      const int b = tok >> 11;
      float a0 = 0.f, a1 = 0.f;
#pragma unroll
      for (int xx = 0; xx < 8; ++xx) {
        const float2 v = *(const float2*)(p.apart + ((size_t)xx * NTOK + tok) * 128 + lane * 2);
        a0 += v.x; a1 += v.y;
      }
      const float2 gg = *(const float2*)(p.pg + (size_t)tok * 128 + lane * 2);
      float2 wv2;
      wv2.x = gg.x * 0.5f * a0 * (1.f + erff(a0 * 0.70710678118654752f));
      wv2.y = gg.y * 0.5f * a1 * (1.f + erff(a1 * 0.70710678118654752f));
      *(float2*)(wl + lane * 2) = wv2;
      const uint4* pi = (const uint4*)(p.pidx + (size_t)tok * 128 + g * 16);
      const uint4 e0 = pi[0], e1 = pi[1];
      const unsigned ew[8] = {e0.x, e0.y, e0.z, e0.w, e1.x, e1.y, e1.z, e1.w};
      float wv[16];
#pragma unroll
      for (int q = 0; q < 4; ++q) {
        const float4 t4 = *(const float4*)(wl + g * 16 + q * 4);
        wv[4 * q] = t4.x; wv[4 * q + 1] = t4.y; wv[4 * q + 2] = t4.z; wv[4 * q + 3] = t4.w;
      }
      float acc[16];
#pragma unroll
      for (int i = 0; i < 16; ++i) acc[i] = 0.f;
#pragma unroll
      for (int rd = 0; rd < 16; ++rd) {
        const unsigned e = (ew[rd >> 1] >> (16 * (rd & 1))) & 0x3FFFu;
        const uint4 u = *(const uint4*)(Vx + (size_t)e * 128);
        float f[16];
        fp8x16_to_f32(u, f);
        const float sw = wv[rd] * p.sclV[e];
#pragma unroll
        for (int i = 0; i < 16; ++i) acc[i] += sw * f[i];
      }
#pragma unroll
      for (int i = 0; i < 16; ++i) {
        acc[i] += __shfl_xor(acc[i], 8, 64); acc[i] += __shfl_xor(acc[i], 16, 64); acc[i] += __shfl_xor(acc[i], 32, 64);
      }
      if (g == 0) {
        const int col = x * 128 + ch * 16;
        const float* gt = p.mod + ((size_t)l * NB + b) * 6144 + 5 * 1024 + col;
        float* xo = p.out + (size_t)tok * DM + col;
#pragma unroll
        for (int q = 0; q < 4; ++q) {
          float4 xv = *(const float4*)(xo + 4 * q);
          const float4 gv = *(const float4*)(gt + 4 * q);
          xv.x += gv.x * acc[4 * q]; xv.y += gv.y * acc[4 * q + 1]; xv.z += gv.z * acc[4 * q + 2]; xv.w += gv.w * acc[4 * q + 3];
          *(float4*)(xo + 4 * q) = xv;
        }
      }
    }
  }
}

__global__ void __launch_bounds__(NTHR) mega_kernel(Params p) {
  extern __shared__ __attribute__((aligned(16))) char smem[];
  cg::grid_group grid = cg::this_grid();
  phase_p0(p, smem);
  grid.sync();
  for (int l = 0; l < 2; ++l) {
    for (int rep = 0; rep < REP_C; ++rep)
    for (int tile = blockIdx.x; tile < NTILE; tile += gridDim.x) phase_c(p, tile, l, l == 0, smem);
    grid.sync();
    for (int rep = 0; rep < REP_DE; ++rep) phase_de(p, l, smem);
    grid.sync();
    for (int tile = blockIdx.x; tile < NTILE; tile += gridDim.x) {
      phase_f(p, tile, l, l == 0, smem);
      for (int rep = 0; rep < REP_G; ++rep) phase_g(p, tile, l, smem);
    }
    grid.sync();
    phase_i1(p, smem);
    grid.sync();
    phase_i2(p, l, smem);
    if (l == 0) grid.sync();
  }
}

extern "C" void kernel_launch(void* const* d_in, const int* in_sizes, int n_in, void* d_out, int out_size, void* d_ws,
                              size_t ws_size, hipStream_t stream) {
  Params p{};
  const float* const* in = (const float* const*)d_in;
  p.x_prompt = in[0]; p.x_sample = in[1]; p.c_prompt = in[2]; p.c_sample = in[3]; p.w_mod = in[4]; p.b_mod = in[5];
  p.g1 = in[6]; p.g2 = in[7]; p.w_in = in[8]; p.conv_w = in[9]; p.conv_b = in[10]; p.f_w1 = in[11]; p.f_b1 = in[12];
  p.f_freq = in[13]; p.f_w2 = in[14]; p.f_b2 = in[15]; p.f_w3 = in[16]; p.f_bias = in[17]; p.q_gain = in[18];
  p.k_gain = in[19]; p.sink = in[20]; p.w_pa = in[21]; p.w_pb = in[22]; p.w_out = in[23]; p.peer_wq = in[24];
  p.peer_k1 = in[25]; p.peer_k2 = in[26]; p.peer_u = in[27]; p.peer_v = in[28];
  p.out = (float*)d_out;
  char* ws = (char*)d_ws;
  size_t off = 0;
  auto carve = [&](size_t bytes) { char* r = ws + off; off += (bytes + 255) & ~(size_t)255; return r; };
  p.WinT = (bf16_t*)carve((size_t)2 * INC * DM * 2);
  p.WpaT = (bf16_t*)carve((size_t)2 * DM * HYW * 2);
  p.WpbT = (bf16_t*)carve((size_t)2 * DM * HYW * 2);
  p.WoutT = (bf16_t*)carve((size_t)2 * DM * DM * 2);
  p.WcT = (bf16_t*)carve((size_t)2 * 2048 * DM * 2);
  p.Gf = (bf16_t*)carve((size_t)2 * 2 * 512 * 4096 * 2);
  p.mod = (float*)carve((size_t)2 * NB * 6144 * 4);
  p.rope = (float*)carve((size_t)SEQ * 64 * 4);
  p.tabU8 = (unsigned char*)carve((size_t)NEXP * DM);
  p.tabV8 = (unsigned char*)carve((size_t)NEXP * DM);
  p.sclU = (float*)carve((size_t)NEXP * 4);
  p.sclV = (float*)carve((size_t)NEXP * 4);
  p.zT = (bf16_t*)carve((size_t)NB * HYC * SEQ * 2);
  p.yaT = (bf16_t*)carve((size_t)NTOK * HYW * 2);
  p.yb = (bf16_t*)carve((size_t)NTOK * HYW * 2);
  p.zqkv = (bf16_t*)carve((size_t)NTOK * QKVC * 2);
  p.hbuf = (bf16_t*)carve((size_t)NTOK * DM * 2);
  p.merged = p.zT;
  p.yatok = p.zT + (size_t)NTOK * DM;
  p.apart = (float*)p.zT;
  p.pidx = (unsigned short*)p.zqkv;
  p.pg = (float*)(p.zqkv + (size_t)NTOK * 128);
  if (off > ws_size) fprintf(stderr, "workspace too small: need %zu have %zu\n", off, ws_size);

  static int grid_blocks = 0;
  if (!grid_blocks) {
    int dev = 0, cus = 0, per_cu = 0;
    hipGetDevice(&dev);
    hipDeviceGetAttribute(&cus, hipDeviceAttributeMultiprocessorCount, dev);
    hipFuncSetAttribute((const void*)mega_kernel, hipFuncAttributeMaxDynamicSharedMemorySize, SMEM_BYTES);
    hipOccupancyMaxActiveBlocksPerMultiprocessor(&per_cu, mega_kernel, NTHR, SMEM_BYTES);
    if (per_cu < 1) per_cu = 1;
    grid_blocks = cus * 1;
    if (grid_blocks > NTILE) grid_blocks = NTILE;
  }
  void* args[] = {&p};
  hipError_t e = hipLaunchCooperativeKernel((const void*)mega_kernel, dim3(grid_blocks), dim3(NTHR), args, SMEM_BYTES, stream);
  if (e != hipSuccess) fprintf(stderr, "cooperative launch failed: %s (grid %d)\n", hipGetErrorString(e), grid_blocks);
}
```

```cpp
#include <hip/hip_runtime.h>
#include <hip/hip_bf16.h>
#include <hip/hip_cooperative_groups.h>
#include <cstdio>
#include <cstdint>
namespace cg = cooperative_groups;

typedef unsigned short bf16_t;
using bf16x8 = __attribute__((ext_vector_type(8))) short;
using f32x16 = __attribute__((ext_vector_type(16))) float;

constexpr int DM = 1024;
constexpr int NB = 24;
constexpr int SEQ = 2048;
constexpr int NTOK = NB * SEQ;
constexpr int NBP = 16;
constexpr int INC = 4352;
constexpr int HYC = 1536;
constexpr int HYW = 512;
constexpr int QKVC = 768;
constexpr int TM = 192;
constexpr int NTILE = NTOK / TM;
constexpr int NTHR = 512;
constexpr int NEXP = 16384;
constexpr int SMEM_BYTES = 155648;
#ifndef REP_DE
#define REP_DE 1
#endif
#ifndef REP_C
#define REP_C 1
#endif
#ifndef REP_G
#define REP_G 1
#endif
#ifndef REP_I1
#define REP_I1 1
#endif
#ifndef REP_P0
#define REP_P0 1
#endif

struct Params {
  const float *x_prompt, *x_sample, *c_prompt, *c_sample, *w_mod, *b_mod, *g1, *g2, *w_in, *conv_w, *conv_b;
  const float *f_w1, *f_b1, *f_freq, *f_w2, *f_b2, *f_w3, *f_bias, *q_gain, *k_gain, *sink, *w_pa, *w_pb, *w_out;
  const float *peer_wq, *peer_k1, *peer_k2, *peer_u, *peer_v;
  float* out;
  bf16_t *WinT, *WpaT, *WpbT, *WoutT, *WcT, *Gf, *zT, *zqkv, *yaT, *yb, *hbuf, *merged, *yatok;
  unsigned char *tabU8, *tabV8;
  unsigned short* pidx;
  bf16_t* wbuf;
  float *pg, *pgu, *mod, *rope, *sclU, *sclV, *apart;
  unsigned* wq;
};

__device__ __forceinline__ float bf2f(bf16_t v) { return __uint_as_float(((unsigned)v) << 16); }
__device__ __forceinline__ bf16_t f2bf(float f) {
  unsigned u = __float_as_uint(f);
  u += 0x7FFFu + ((u >> 16) & 1u);
  return (bf16_t)(u >> 16);
}
__device__ __forceinline__ unsigned pack2(float a, float b) { return (unsigned)f2bf(a) | ((unsigned)f2bf(b) << 16); }
__device__ __forceinline__ float lo2f(unsigned u) { return __uint_as_float(u << 16); }
__device__ __forceinline__ float hi2f(unsigned u) { return __uint_as_float(u & 0xFFFF0000u); }

__device__ __forceinline__ int otid() { int t = threadIdx.x; asm volatile("" : "+v"(t)); return t; }
__device__ __forceinline__ int osgpr(int x) { asm volatile("" : "+s"(x)); return x; }
__device__ __forceinline__ float wave_sum(float v) {
#pragma unroll
  for (int m = 32; m >= 1; m >>= 1) v += __shfl_xor(v, m, 64);
  return v;
}

__device__ __forceinline__ const float* xrow_in(const Params& p, int tok) {
  return (tok < NBP * SEQ) ? (p.x_prompt + (size_t)tok * DM) : (p.x_sample + (size_t)(tok - NBP * SEQ) * DM);
}
__device__ __forceinline__ const float* crow(const Params& p, int b) {
  return (b < NBP) ? (p.c_prompt + (size_t)b * DM) : (p.c_sample + (size_t)(b - NBP) * DM);
}

constexpr int LDS_ROW = 72;
constexpr int STAGE_ELEMS = (192 + 128) * LDS_ROW;
constexpr int GEMM_LDS_BYTES = 2 * STAGE_ELEMS * 2;

__device__ __forceinline__ void gemm_core(const bf16_t* __restrict__ A, int lda, const bf16_t* __restrict__ B, int ldb,
                                          int K, bf16_t* lds, f32x16 (&acc)[3]) {
  const int tid = otid();
  const int lane = tid & 63, w = tid >> 6;
  const int wm = w >> 2, wn = w & 3;
#pragma unroll
  for (int i = 0; i < 3; ++i)
#pragma unroll
    for (int j = 0; j < 16; ++j) acc[i][j] = 0.f;

  const int crow_ = tid >> 3, ckc = (tid & 7) * 8;
  const bf16_t* pa0 = A + (size_t)crow_ * lda + ckc;
  const bf16_t* pa1 = A + (size_t)(crow_ + 64) * lda + ckc;
  const bf16_t* pa2 = A + (size_t)(crow_ + 128) * lda + ckc;
  const bf16_t* pb0 = B + (size_t)crow_ * ldb + ckc;
  const bf16_t* pb1 = B + (size_t)(crow_ + 64) * ldb + ckc;
  const int la = crow_ * LDS_ROW + ckc;
  const int nk = K >> 6;

  uint4 ra0, ra1, ra2, rb0, rb1;
  ra0 = *(const uint4*)pa0; ra1 = *(const uint4*)pa1; ra2 = *(const uint4*)pa2;
  rb0 = *(const uint4*)pb0; rb1 = *(const uint4*)pb1;
  __syncthreads();
  {
    bf16_t* As = lds; bf16_t* Bs = lds + 192 * LDS_ROW;
    *(uint4*)(As + la) = ra0; *(uint4*)(As + la + 64 * LDS_ROW) = ra1; *(uint4*)(As + la + 128 * LDS_ROW) = ra2;
    *(uint4*)(Bs + la) = rb0; *(uint4*)(Bs + la + 64 * LDS_ROW) = rb1;
  }
  __syncthreads();
  const int fr = lane & 31, fh = (lane >> 5) * 8;
  for (int kt = 0; kt < nk; ++kt) {
    if (kt + 1 < nk) {
      const int ko = (kt + 1) << 6;
      ra0 = *(const uint4*)(pa0 + ko); ra1 = *(const uint4*)(pa1 + ko); ra2 = *(const uint4*)(pa2 + ko);
      rb0 = *(const uint4*)(pb0 + ko); rb1 = *(const uint4*)(pb1 + ko);
    }
    const bf16_t* As = lds + (kt & 1) * STAGE_ELEMS;
    const bf16_t* Bs = As + 192 * LDS_ROW;
#pragma unroll
    for (int kk = 0; kk < 4; ++kk) {
      const int ko = kk * 16 + fh;
      bf16x8 bfrag = *(const bf16x8*)(Bs + (wn * 32 + fr) * LDS_ROW + ko);
#pragma unroll
      for (int mi = 0; mi < 3; ++mi) {
        bf16x8 afrag = *(const bf16x8*)(As + (wm * 96 + mi * 32 + fr) * LDS_ROW + ko);
        acc[mi] = __builtin_amdgcn_mfma_f32_32x32x16_bf16(afrag, bfrag, acc[mi], 0, 0, 0);
      }
    }
    if (kt + 1 < nk) {
      bf16_t* As2 = lds + ((kt + 1) & 1) * STAGE_ELEMS; bf16_t* Bs2 = As2 + 192 * LDS_ROW;
      *(uint4*)(As2 + la) = ra0; *(uint4*)(As2 + la + 64 * LDS_ROW) = ra1; *(uint4*)(As2 + la + 128 * LDS_ROW) = ra2;
      *(uint4*)(Bs2 + la) = rb0; *(uint4*)(Bs2 + la + 64 * LDS_ROW) = rb1;
    }
    __syncthreads();
  }
}
#define ACC_ROW(wm, mi, reg, lane) ((wm) * 96 + (mi) * 32 + ((reg) & 3) + 8 * ((reg) >> 2) + 4 * ((lane) >> 5))
#define ACC_COL(wn, lane) ((wn) * 32 + ((lane) & 31))

__device__ __forceinline__ void acc_to_lds(const f32x16 (&acc)[3], float* ct, int LD) {
  const int tid_ = otid(); const int lane = tid_ & 63, w = tid_ >> 6, wm = w >> 2, wn = w & 3;
  const int n = ACC_COL(wn, lane);
#pragma unroll
  for (int mi = 0; mi < 3; ++mi)
#pragma unroll
    for (int r = 0; r < 16; ++r) ct[ACC_ROW(wm, mi, r, lane) * LD + n] = acc[mi][r];
}
constexpr int LDT = 196;
__device__ __forceinline__ void acc_to_lds_T(const f32x16 (&acc)[3], float* ctT) {
  const int tid_ = otid(); const int lane = tid_ & 63, w = tid_ >> 6, wm = w >> 2, wn = w & 3;
  const int n = ACC_COL(wn, lane);
#pragma unroll
  for (int mi = 0; mi < 3; ++mi)
#pragma unroll
    for (int g4 = 0; g4 < 4; ++g4) {
      const int r0 = wm * 96 + mi * 32 + 8 * g4 + 4 * (lane >> 5);
      float4 v; v.x = acc[mi][g4 * 4 + 0]; v.y = acc[mi][g4 * 4 + 1]; v.z = acc[mi][g4 * 4 + 2]; v.w = acc[mi][g4 * 4 + 3];
      *(float4*)(ctT + n * LDT + r0) = v;
    }
}
__device__ __forceinline__ void store_tile_bf16(const float* ct, bf16_t* dst, int ldd, int tok0, int n0) {
#pragma unroll 1
  for (int it = otid(); it < 192 * 16; it += NTHR) {
    const int c8 = it & 15, r = it >> 4;
    const float4 a = *(const float4*)(ct + r * 132 + c8 * 8), b = *(const float4*)(ct + r * 132 + c8 * 8 + 4);
    uint4 o; o.x = pack2(a.x, a.y); o.y = pack2(a.z, a.w); o.z = pack2(b.x, b.y); o.w = pack2(b.z, b.w);
    *(uint4*)(dst + (size_t)(tok0 + r) * ldd + n0 + c8 * 8) = o;
  }
}

__device__ void p0_transpose_tile(const float* __restrict__ src, bf16_t* __restrict__ dst, int R, int C, int tr, int tc, char* smem) {
  float* t = (float*)smem;
  const int tid = otid();
  __syncthreads();
#pragma unroll
  for (int i = 0; i < 8; ++i) {
    int r = (tid >> 6) + 8 * i, c = tid & 63;
    t[r * 65 + c] = src[(size_t)(tr * 64 + r) * C + tc * 64 + c];
  }
  __syncthreads();
#pragma unroll
  for (int i = 0; i < 8; ++i) {
    int cc = (tid >> 6) + 8 * i, rr = tid & 63;
    dst[(size_t)(tc * 64 + cc) * R + tr * 64 + rr] = f2bf(t[rr * 65 + cc]);
  }
}

__device__ void p0_wc_item(const Params& p, int l, int ph, int kt, char* smem) {
  float* wqs = (float*)smem;
  float* ks = wqs + 64 * 129;
  const int tid = otid();
  const float* wq = p.peer_wq + (size_t)l * DM * 2048;
  const float* kk = ((ph & 1) ? p.peer_k2 : p.peer_k1) + (size_t)l * 128 * 128;
  __syncthreads();
  for (int e = tid; e < 64 * 128; e += NTHR) {
    int r = e >> 7, d = e & 127;
    wqs[r * 129 + d] = wq[(size_t)(kt * 64 + r) * 2048 + ph * 128 + d];
  }
  for (int e = tid; e < 128 * 128; e += NTHR) {
    int r = e >> 7, d = e & 127;
    ks[r * 129 + d] = kk[r * 128 + d];
  }
  __syncthreads();
  const int key = tid & 127, k0 = (tid >> 7) * 16;
  float acc[16];
#pragma unroll
  for (int i = 0; i < 16; ++i) acc[i] = 0.f;
  for (int d = 0; d < 128; ++d) {
    float kv = ks[key * 129 + d];
#pragma unroll
    for (int i = 0; i < 16; ++i) acc[i] += wqs[(k0 + i) * 129 + d] * kv;
  }
  bf16_t* dst = p.WcT + ((size_t)l * 2048 + ph * 128 + key) * DM + kt * 64 + k0;
  uint4 o0, o1;
  o0.x = pack2(acc[0], acc[1]); o0.y = pack2(acc[2], acc[3]); o0.z = pack2(acc[4], acc[5]); o0.w = pack2(acc[6], acc[7]);
  o1.x = pack2(acc[8], acc[9]); o1.y = pack2(acc[10], acc[11]); o1.z = pack2(acc[12], acc[13]); o1.w = pack2(acc[14], acc[15]);
  *(uint4*)dst = o0; *(uint4*)(dst + 8) = o1;
}

__device__ void p0_mod_item(const Params& p, int l, int cc, char* smem) {
  float* sc = (float*)smem;
  const int tid = otid();
  __syncthreads();
  for (int e = tid; e < NB * DM; e += NTHR) {
    int b = e >> 10, k = e & 1023;
    float v = crow(p, b)[k];
    sc[k * 24 + b] = v / (1.f + __expf(-v));
  }
  __syncthreads();
  const int n = cc * 512 + tid;
  float acc[24];
#pragma unroll
  for (int b = 0; b < 24; ++b) acc[b] = 0.f;
  const float* wm = p.w_mod + (size_t)l * DM * 6144 + n;
  for (int k0 = 0; k0 < DM; k0 += 8) {
    float wv[8];
#pragma unroll
    for (int j = 0; j < 8; ++j) wv[j] = wm[(size_t)(k0 + j) * 6144];
#pragma unroll
    for (int j = 0; j < 8; ++j) {
      const float4* s4 = (const float4*)(sc + (k0 + j) * 24);
#pragma unroll
      for (int q = 0; q < 6; ++q) {
        float4 s = s4[q];
        acc[q * 4 + 0] += s.x * wv[j]; acc[q * 4 + 1] += s.y * wv[j]; acc[q * 4 + 2] += s.z * wv[j]; acc[q * 4 + 3] += s.w * wv[j];
      }
    }
  }
  const float bm = p.b_mod[l * 6144 + n];
#pragma unroll
  for (int b = 0; b < 24; ++b) p.mod[((size_t)l * NB + b) * 6144 + n] = acc[b] + bm;
}

__device__ void p0_filter_item(const Params& p, int l, int tc, char* smem) {
  float* feat = (float*)smem;
  float* a1 = feat + 32 * 33;
  float* a2 = a1 + 32 * 64;
  bf16_t* stage = (bf16_t*)(a2 + 32 * 64);
  const int tid = otid();
  const int t0 = tc * 32;
  __syncthreads();
  for (int e = tid; e < 32 * 33; e += NTHR) {
    int pp = e / 33, f = e % 33;
    int ti = t0 + pp;
    float v;
    if (f == 0) v = (float)ti / (float)(SEQ - 1);
    else {
      int bi = (f - 1) & 15;
      float band = 1e-4f + (float)bi * ((15.f - 1e-4f) / 15.f);
      float wv = 2.0f * 3.14159265358979323846f * (float)ti / (float)SEQ;
      float arg = band * wv;
      v = (f <= 16) ? cosf(arg) : -sinf(arg);
    }
    feat[pp * 33 + f] = v;
  }
  __syncthreads();
  const float* w1 = p.f_w1 + l * 33 * 64; const float* b1 = p.f_b1 + l * 64; const float* fq = p.f_freq + l * 64;
  const float* w2 = p.f_w2 + l * 64 * 64; const float* b2 = p.f_b2 + l * 64;
  for (int e = tid; e < 32 * 64; e += NTHR) {
    int pp = e >> 6, j = e & 63;
    float s = b1[j];
    for (int f = 0; f < 33; ++f) s += feat[pp * 33 + f] * w1[f * 64 + j];
    a1[pp * 64 + j] = sinf(fq[j] * s);
  }
  __syncthreads();
  for (int e = tid; e < 32 * 64; e += NTHR) {
    int pp = e >> 6, j = e & 63;
    float s = b2[j];
    for (int i = 0; i < 64; ++i) s += a1[pp * 64 + i] * w2[i * 64 + j];
    a2[pp * 64 + j] = sinf(fq[j] * s);
  }
  __syncthreads();
  const float* w3 = p.f_w3 + (size_t)l * 64 * 2048;
  const float min_decay = logf(1e-2f) / 1.5f, max_decay = logf(1e-2f) / 0.3f;
  for (int q = 0; q < 4; ++q) {
    const int n = tid + 512 * q;
    const int c = n & 511;
    float wr[64];
#pragma unroll
    for (int i = 0; i < 64; ++i) wr[i] = w3[i * 2048 + n];
    const float delta = fabsf(min_decay + (max_decay - min_decay) * (float)c / 511.f);
    for (int pp = 0; pp < 32; ++pp) {
      float s = 0.f;
#pragma unroll
      for (int i = 0; i < 64; ++i) s += a2[pp * 64 + i] * wr[i];
      float tt = (float)(t0 + pp) / (float)(SEQ - 1);
      s *= __expf(-tt * delta);
      if (t0 + pp == 0 && ((n >> 9) & 1) == 0) s += p.f_bias[(l * 2 + (n >> 10)) * 512 + c];
      stage[n * 32 + pp] = f2bf(s);
    }
  }
  __syncthreads();
  for (int e = tid; e < 2048 * 32; e += NTHR) {
    int n = e >> 5, pp = e & 31;
    int o = n >> 10, d = (n >> 9) & 1, c = n & 511;
    int t = t0 + pp;
    bf16_t* g = p.Gf + ((size_t)((l * 2 + o) * 512 + c)) * 4096;
    if (d == 0) g[2048 - t] = stage[n * 32 + pp];
    else if (t >= 1) g[2048 + t] = stage[n * 32 + pp];
    if (t == 0 && d == 0) g[0] = 0;
  }
}

__device__ void p0_rope_item(const Params& p, int it) {
  int e = it * 512 + otid();
  int pos = e >> 5, i = e & 31;
  float inv = powf(10000.f, -(float)(2 * i) / 64.f);
  float ang = (float)pos * inv;
  p.rope[e * 2 + 0] = cosf(ang);
  p.rope[e * 2 + 1] = sinf(ang);
}

constexpr int P0_TR_PER_LAYER = 16 * 68 + 8 * 16 + 8 * 16 + 16 * 16;
constexpr int P0_N_TR = 2 * P0_TR_PER_LAYER;
constexpr int P0_N_WC = 2 * 16 * 16;
constexpr int P0_N_MOD = 2 * 12;
constexpr int P0_N_FILT = 2 * 64;
constexpr int P0_N_ROPE = 128;
constexpr int P0_TOTAL = P0_N_MOD + P0_N_FILT + P0_N_WC + P0_N_ROPE + P0_N_TR;

__device__ void phase_p0(const Params& p, char* smem) {
  if (blockIdx.x == 0 && threadIdx.x < 32) p.wq[threadIdx.x] = 0u;
  for (int it = blockIdx.x; it < P0_TOTAL; it += gridDim.x) {
    int i = it;
    if (i < P0_N_MOD) { p0_mod_item(p, i / 12, i % 12, smem); continue; }
    i -= P0_N_MOD;
    if (i < P0_N_FILT) { p0_filter_item(p, i / 64, i % 64, smem); continue; }
    i -= P0_N_FILT;
    if (i < P0_N_WC) { p0_wc_item(p, i >> 8, (i >> 4) & 15, i & 15, smem); continue; }
    i -= P0_N_WC;
    if (i < P0_N_ROPE) { p0_rope_item(p, i); continue; }
    i -= P0_N_ROPE;
    {
      int l = i / P0_TR_PER_LAYER, j = i % P0_TR_PER_LAYER;
      if (j < 16 * 68) { p0_transpose_tile(p.w_in + (size_t)l * DM * INC, p.WinT + (size_t)l * INC * DM, DM, INC, j / 68, j % 68, smem); continue; }
      j -= 16 * 68;
      if (j < 128) { p0_transpose_tile(p.w_pa + (size_t)l * HYW * DM, p.WpaT + (size_t)l * DM * HYW, HYW, DM, j / 16, j % 16, smem); continue; }
      j -= 128;
      if (j < 128) { p0_transpose_tile(p.w_pb + (size_t)l * HYW * DM, p.WpbT + (size_t)l * DM * HYW, HYW, DM, j / 16, j % 16, smem); continue; }
      j -= 128;
      p0_transpose_tile(p.w_out + (size_t)l * DM * DM, p.WoutT + (size_t)l * DM * DM, DM, DM, j / 16, j % 16, smem);
    }
  }
}

__device__ void norm_rows(const Params& p, int tile, int l, int which, bool from_inputs, char* smem) {
  float* scl = (float*)smem;
  float* shf = scl + 2048;
  const int tid = otid(), lane = tid & 63, w = tid >> 6;
  const int tok0 = tile * TM;
  const int b0 = tok0 >> 11;
  const float* g = (which ? p.g2 : p.g1) + l * DM;
  __syncthreads();
  for (int e = tid; e < 2048; e += NTHR) {
    int bi = e >> 10, j = e & 1023;
    int b = b0 + bi; if (b > NB - 1) b = NB - 1;
    const float* m = p.mod + ((size_t)l * NB + b) * 6144 + which * 3072;
    scl[e] = g[j] * (1.f + m[1024 + j]);
    shf[e] = m[j];
  }
  __syncthreads();
  for (int r = w; r < TM; r += 8) {
    const int tok = tok0 + r;
    const int bi = (tok >> 11) - b0;
    const float* xr = from_inputs ? xrow_in(p, tok) : (p.out + (size_t)tok * DM);
    float4 v[4];
    float ss = 0.f;
#pragma unroll
    for (int i = 0; i < 4; ++i) {
      v[i] = *(const float4*)(xr + lane * 4 + 256 * i);
      ss += v[i].x * v[i].x + v[i].y * v[i].y + v[i].z * v[i].z + v[i].w * v[i].w;
    }
    ss = wave_sum(ss);
    const float rs = rsqrtf(ss * (1.f / DM) + 1e-6f);
#pragma unroll
    for (int i = 0; i < 4; ++i) {
      const int j = lane * 4 + 256 * i;
      const float4 sc4 = *(const float4*)(scl + bi * 1024 + j);
      const float4 sh4 = *(const float4*)(shf + bi * 1024 + j);
      uint2 o;
      o.x = pack2(v[i].x * rs * sc4.x + sh4.x, v[i].y * rs * sc4.y + sh4.y);
      o.y = pack2(v[i].z * rs * sc4.z + sh4.z, v[i].w * rs * sc4.w + sh4.w);
      *(uint2*)(p.hbuf + (size_t)tok * DM + j) = o;
    }
  }
  __syncthreads();
}

__device__ void phase_c(const Params& p, int tile, int l, bool from_inputs, char* smem) {
  norm_rows(p, tile, l, 0, from_inputs, smem);
  const int tid = otid();
  const int tok0 = tile * TM;
  const bf16_t* A = p.hbuf + (size_t)tok0 * DM;
  const bf16_t* W = p.WinT + (size_t)l * INC * DM;
  float* ct = (float*)smem;
  f32x16 acc[3];
#pragma unroll 1
  for (int nc = 0; nc < 18; ++nc) {
    gemm_core(A, DM, W + (size_t)nc * 128 * DM, DM, DM, (bf16_t*)smem, acc);
    if (nc < 12) {
      acc_to_lds_T(acc, ct);
      __syncthreads();
#pragma unroll 1
      for (int it = tid; it < 128 * 24; it += NTHR) {
        const int tg = it % 24, nl = it / 24;
        const float4 a = *(const float4*)(ct + nl * LDT + tg * 8), b4 = *(const float4*)(ct + nl * LDT + tg * 8 + 4);
        uint4 o; o.x = pack2(a.x, a.y); o.y = pack2(a.z, a.w); o.z = pack2(b4.x, b4.y); o.w = pack2(b4.z, b4.w);
        const int tok = tok0 + tg * 8;
        const int b = tok >> 11, sq = tok & 2047;
        *(uint4*)(p.zT + ((size_t)b * HYC + nc * 128 + nl) * SEQ + sq) = o;
      }
    } else {
      acc_to_lds(acc, ct, 132);
      __syncthreads();
      store_tile_bf16(ct, p.zqkv, QKVC, tok0, nc * 128 - HYC);
    }
  }
}

__device__ __forceinline__ void load_conv8(const bf16_t* __restrict__ zrow, int s0, float w0, float w1, float w2, float cb, float (&o)[8]) {
  uint4 v = *(const uint4*)(zrow + s0);
  float z[10];
  z[0] = (s0 > 0) ? bf2f(zrow[s0 - 1]) : 0.f;
  z[1] = lo2f(v.x); z[2] = hi2f(v.x); z[3] = lo2f(v.y); z[4] = hi2f(v.y);
  z[5] = lo2f(v.z); z[6] = hi2f(v.z); z[7] = lo2f(v.w); z[8] = hi2f(v.w);
  z[9] = (s0 + 8 < SEQ) ? bf2f(zrow[s0 + 8]) : 0.f;
#pragma unroll
  for (int i = 0; i < 8; ++i) o[i] = z[i] * w0 + z[i + 1] * w1 + z[i + 2] * w2 + cb;
}

typedef short s16x4 __attribute__((ext_vector_type(4)));
__device__ __forceinline__ s16x4 tr_read4(const bf16_t* lds_ptr) {
  return __builtin_amdgcn_ds_read_tr16_b64_v4i16((__attribute__((address_space(3))) s16x4*)(lds_ptr));
}

constexpr int HY_GS_ELEMS = 4112;
constexpr int HY_US_ROWS = 2072;
__device__ __forceinline__ void hyena_load_g(const Params& p, int l, int o, int c, bf16_t* Gs, int tid) {
  const bf16_t* g = p.Gf + ((size_t)((l * 2 + o) * 512 + c)) * 4096;
  *(uint4*)(Gs + 8 + tid * 8) = *(const uint4*)(g + tid * 8);
  if (tid == 0) { unsigned z = 0; asm volatile("" : "+v"(z)); const uint4 z4 = make_uint4(z, z, z, z); *(uint4*)Gs = z4; *(uint4*)(Gs + 4104) = z4; }
}

__device__ __forceinline__ void hyena_kloop(const bf16_t* Gs, const bf16_t* us, int rho, int lane, f32x16 (&acc)[8]) {
#pragma unroll
  for (int a = 0; a < 8; ++a)
#pragma unroll
    for (int j = 0; j < 16; ++j) acc[a][j] = 0.f;
  const int i = lane & 31, hh = lane >> 5;
  const bf16_t* ga = Gs + (2040 - 8 * i + 8 * hh) - 1792;
  const int l16 = lane & 15, q = l16 >> 2, pq = l16 & 3, g4 = lane >> 4;
  const bf16_t* ub = us + (rho + 8 * (g4 >> 1) + q) * 24 + 16 * (g4 & 1) + 4 * pq;
#pragma unroll 1
  for (int kap = 0; kap < 129; ++kap) {
    const s16x4 b0 = tr_read4(ub + kap * 384);
    const s16x4 b1 = tr_read4(ub + kap * 384 + 96);
    bf16x8 bfrag;
    bfrag[0] = b0[0]; bfrag[1] = b0[1]; bfrag[2] = b0[2]; bfrag[3] = b0[3];
    bfrag[4] = b1[0]; bfrag[5] = b1[1]; bfrag[6] = b1[2]; bfrag[7] = b1[3];
#pragma unroll
    for (int a = 0; a < 8; ++a) {
      const bf16x8 af = *(const bf16x8*)(ga + kap * 16 + 256 * (7 - a));
      acc[a] = __builtin_amdgcn_mfma_f32_32x32x16_bf16(af, bfrag, acc[a], 0, 0, 0);
    }
  }
}

__device__ __forceinline__ void hyena_acc_to_us(const f32x16 (&acc)[8], bf16_t* us, int rho, int lane) {
  const int n = lane & 31, hh = lane >> 5;
  if (n < 24) {
#pragma unroll
    for (int a = 0; a < 8; ++a)
#pragma unroll
      for (int r = 0; r < 16; ++r) {
        const int t = 256 * a + rho + 8 * ((r & 3) + 8 * (r >> 2) + 4 * hh);
        us[(t + 16) * 24 + n] = f2bf(acc[a][r]);
      }
  }
}

__device__ void hyena_item(const Params& p, int l, int c, char* smem) {
  bf16_t* Gs = (bf16_t*)smem;
  bf16_t* us = (bf16_t*)(smem + 8256);
  const int tid = otid();
  const int lane = tid & 63, w = tid >> 6;
  const float* cw = p.conv_w + (size_t)l * 3 * HYC;
  const float* cbp = p.conv_b + (size_t)l * HYC;
  __syncthreads();
  hyena_load_g(p, l, 0, c, Gs, tid);
  {
    unsigned z = 0; asm volatile("" : "+v"(z)); const uint4 z4 = make_uint4(z, z, z, z);
    if (tid < 48) *(uint4*)(us + tid * 8) = z4;
    else if (tid < 48 + 26) *(uint4*)(us + 2064 * 24 + (tid - 48) * 8) = z4;
  }
  {
    const float w0 = cw[c], w1 = cw[HYC + c], w2 = cw[2 * HYC + c], cb = cbp[c];
#pragma unroll 1
    for (int qq = tid; qq < 24 * 256; qq += NTHR) {
      const int b = qq % 24, s0 = (qq / 24) * 8;
      float v[8];
      load_conv8(p.zT + ((size_t)b * HYC + c) * SEQ, s0, w0, w1, w2, cb, v);
#pragma unroll
      for (int i = 0; i < 8; ++i) us[(s0 + i + 16) * 24 + b] = f2bf(v[i]);
    }
  }
  __syncthreads();
  f32x16 acc[8];
#pragma unroll 1
  for (int o = 0; o < 2; ++o) {
    hyena_kloop(Gs, us, w, lane, acc);
    __syncthreads();
    hyena_acc_to_us(acc, us, w, lane);
    if (o == 0) hyena_load_g(p, l, 1, c, Gs, tid);
    __syncthreads();
    const int xc = (o == 0 ? 512 : 1024) + c;
    const float xw0 = cw[xc], xw1 = cw[HYC + xc], xw2 = cw[2 * HYC + xc], xcb = cbp[xc];
#pragma unroll 1
    for (int qq = tid; qq < 24 * 256; qq += NTHR) {
      const int b = qq % 24, s0 = (qq / 24) * 8;
      float xv[8];
      load_conv8(p.zT + ((size_t)b * HYC + xc) * SEQ, s0, xw0, xw1, xw2, xcb, xv);
      if (o == 0) {
#pragma unroll
        for (int i = 0; i < 8; ++i) {
          bf16_t* e = us + (s0 + i + 16) * 24 + b;
          *e = f2bf(bf2f(*e) * xv[i]);
        }
      } else {
        float r[8];
#pragma unroll
        for (int i = 0; i < 8; ++i) r[i] = bf2f(us[(s0 + i + 16) * 24 + b]) * xv[i];
        uint4 pk; pk.x = pack2(r[0], r[1]); pk.y = pack2(r[2], r[3]); pk.z = pack2(r[4], r[5]); pk.w = pack2(r[6], r[7]);
        *(uint4*)(p.yaT + ((size_t)b * HYW + c) * SEQ + s0) = pk;
      }
    }
    __syncthreads();
  }
}

__device__ void attn_item(const Params& p, int l, int item, char* smem) {
  constexpr int KS = 72, VS = 96;
  bf16_t* Ks = (bf16_t*)smem;
  bf16_t* Vs = Ks + 384 * KS;
  const int tid = otid();
  const int lane = tid & 63, w = tid >> 6;
  const int kh = item & 1, qb = (item >> 1) & 15, b = item >> 5;
  const int kpos0 = qb * 128 - 128;
  __syncthreads();
  if (tid < 384) {
    const int r = tid, kpos = kpos0 + r;
    if (kpos >= 0 && kpos < SEQ) {
      const bf16_t* kr = p.zqkv + ((size_t)(b * SEQ + kpos)) * QKVC + 512 + kh * 64;
      float kf[64];
      float ss = 0.f;
#pragma unroll
      for (int c8 = 0; c8 < 8; ++c8) {
        uint4 v = *(const uint4*)(kr + c8 * 8);
        kf[c8 * 8 + 0] = lo2f(v.x); kf[c8 * 8 + 1] = hi2f(v.x); kf[c8 * 8 + 2] = lo2f(v.y); kf[c8 * 8 + 3] = hi2f(v.y);
        kf[c8 * 8 + 4] = lo2f(v.z); kf[c8 * 8 + 5] = hi2f(v.z); kf[c8 * 8 + 6] = lo2f(v.w); kf[c8 * 8 + 7] = hi2f(v.w);
      }
#pragma unroll
      for (int d = 0; d < 64; ++d) ss += kf[d] * kf[d];
      const float rs = rsqrtf(ss * (1.f / 64.f) + 1e-6f);
      const float* kg = p.k_gain + l * 64;
#pragma unroll
      for (int d = 0; d < 64; ++d) kf[d] = kf[d] * rs * kg[d];
      const float* rp = p.rope + (size_t)kpos * 64;
#pragma unroll
      for (int i = 0; i < 32; ++i) {
        const float cs = rp[i * 2], sn = rp[i * 2 + 1];
        const float a = kf[i], bb = kf[i + 32];
        kf[i] = a * cs - bb * sn; kf[i + 32] = bb * cs + a * sn;
      }
#pragma unroll
      for (int c8 = 0; c8 < 8; ++c8) {
        uint4 pk;
        pk.x = pack2(kf[c8 * 8 + 0], kf[c8 * 8 + 1]); pk.y = pack2(kf[c8 * 8 + 2], kf[c8 * 8 + 3]);
        pk.z = pack2(kf[c8 * 8 + 4], kf[c8 * 8 + 5]); pk.w = pack2(kf[c8 * 8 + 6], kf[c8 * 8 + 7]);
        *(uint4*)(Ks + r * KS + c8 * 8) = pk;
      }
    }
  }
#pragma unroll 1
  for (int e = tid; e < 384 * 8; e += NTHR) {
    const int r = e >> 3, c8 = e & 7, kpos = kpos0 + r;
    if (kpos >= 0 && kpos < SEQ)
      *(uint4*)(Vs + r * VS + c8 * 8) = *(const uint4*)(p.zqkv + ((size_t)(b * SEQ + kpos)) * QKVC + 640 + kh * 64 + c8 * 8);
  }
  __syncthreads();
  const int hl = w & 3, qh = w >> 2;
  const int head = kh * 4 + hl;
  const int n = lane & 31, hh = lane >> 5;
  const int Q0 = qb * 128 + 64 * qh;
  bf16x8 qf[2][4];
#pragma unroll
  for (int nt = 0; nt < 2; ++nt) {
    const int qpos = Q0 + 32 * nt + n;
    const bf16_t* qr = p.zqkv + ((size_t)(b * SEQ + qpos)) * QKVC + head * 64;
    float qv[4][8];
    float ss = 0.f;
#pragma unroll
    for (int kk = 0; kk < 4; ++kk) {
      uint4 v = *(const uint4*)(qr + 16 * kk + 8 * hh);
      qv[kk][0] = lo2f(v.x); qv[kk][1] = hi2f(v.x); qv[kk][2] = lo2f(v.y); qv[kk][3] = hi2f(v.y);
      qv[kk][4] = lo2f(v.z); qv[kk][5] = hi2f(v.z); qv[kk][6] = lo2f(v.w); qv[kk][7] = hi2f(v.w);
#pragma unroll
      for (int j = 0; j < 8; ++j) ss += qv[kk][j] * qv[kk][j];
    }
    ss += __shfl_xor(ss, 32, 64);
    const float rs = rsqrtf(ss * (1.f / 64.f) + 1e-6f) * 0.125f;
    const float* qg = p.q_gain + l * 64;
#pragma unroll
    for (int kk = 0; kk < 4; ++kk)
#pragma unroll
      for (int j = 0; j < 8; ++j) qv[kk][j] *= rs * qg[16 * kk + 8 * hh + j];
    const float* rp = p.rope + (size_t)qpos * 64;
#pragma unroll
    for (int kk = 0; kk < 2; ++kk)
#pragma unroll
      for (int j = 0; j < 8; ++j) {
        const int d = 16 * kk + 8 * hh + j;
        const float cs = rp[d * 2], sn = rp[d * 2 + 1];
        const float a = qv[kk][j], bb = qv[kk + 2][j];
        qv[kk][j] = a * cs - bb * sn; qv[kk + 2][j] = bb * cs + a * sn;
      }
#pragma unroll
    for (int kk = 0; kk < 4; ++kk)
#pragma unroll
      for (int j = 0; j < 8; ++j) qf[nt][kk][j] = (short)f2bf(qv[kk][j]);
  }
  f32x16 O[2][2];
#pragma unroll
  for (int dm = 0; dm < 2; ++dm)
#pragma unroll
    for (int nt = 0; nt < 2; ++nt)
#pragma unroll
      for (int r = 0; r < 16; ++r) O[dm][nt][r] = 0.f;
  float mrun[2], lsum[2];
  mrun[0] = mrun[1] = p.sink[l * 8 + head];
  lsum[0] = lsum[1] = (hh == 0) ? 1.f : 0.f;
  const int l16 = lane & 15, tq = l16 >> 2, tp = l16 & 3, g4 = lane >> 4;
  const bf16_t* vbase = Vs + (4 * (g4 >> 1) + tq) * VS + 16 * (g4 & 1) + 4 * tp;
#pragma unroll 1
  for (int kt = 2 * qh; kt < 2 * qh + 10; ++kt) {
    const int kp_t = kpos0 + 32 * kt;
    if (kp_t < 0 || kp_t >= SEQ) continue;
    bf16x8 kfr[4];
#pragma unroll
    for (int kk = 0; kk < 4; ++kk) kfr[kk] = *(const bf16x8*)(Ks + (32 * kt + n) * KS + 16 * kk + 8 * hh);
    bf16x8 pf[2][2];
#pragma unroll
    for (int nt = 0; nt < 2; ++nt) {
      f32x16 S;
#pragma unroll
      for (int r = 0; r < 16; ++r) S[r] = 0.f;
#pragma unroll
      for (int kk = 0; kk < 4; ++kk) S = __builtin_amdgcn_mfma_f32_32x32x16_bf16(kfr[kk], qf[nt][kk], S, 0, 0, 0);
      const int qpos = Q0 + 32 * nt + n;
      float mloc = -INFINITY;
#pragma unroll
      for (int r = 0; r < 16; ++r) {
        const int kpos = kp_t + (r & 3) + 8 * (r >> 2) + 4 * hh;
        int dd = kpos - qpos; dd = dd < 0 ? -dd : dd;
        S[r] = (dd <= 128) ? S[r] : -INFINITY;
        mloc = fmaxf(mloc, S[r]);
      }
      mloc = fmaxf(mloc, __shfl_xor(mloc, 32, 64));
      const float mnew = fmaxf(mrun[nt], mloc);
      const float corr = __expf(mrun[nt] - mnew);
      mrun[nt] = mnew;
      float psum = 0.f;
#pragma unroll
      for (int r = 0; r < 16; ++r) { S[r] = __expf(S[r] - mnew); psum += S[r]; }
      lsum[nt] = lsum[nt] * corr + psum;
#pragma unroll
      for (int dm = 0; dm < 2; ++dm)
#pragma unroll
        for (int r = 0; r < 16; ++r) O[dm][nt][r] *= corr;
#pragma unroll
      for (int s2 = 0; s2 < 2; ++s2)
#pragma unroll
        for (int j = 0; j < 8; ++j) pf[nt][s2][j] = (short)f2bf(S[8 * s2 + j]);
    }
#pragma unroll
    for (int dm = 0; dm < 2; ++dm)
#pragma unroll
      for (int s2 = 0; s2 < 2; ++s2) {
        const bf16_t* vp = vbase + (32 * kt + 16 * s2) * VS + 32 * dm;
        const s16x4 v0 = tr_read4(vp);
        const s16x4 v1 = tr_read4(vp + 8 * VS);
        bf16x8 vf;
        vf[0] = v0[0]; vf[1] = v0[1]; vf[2] = v0[2]; vf[3] = v0[3];
        vf[4] = v1[0]; vf[5] = v1[1]; vf[6] = v1[2]; vf[7] = v1[3];
#pragma unroll
        for (int nt = 0; nt < 2; ++nt) O[dm][nt] = __builtin_amdgcn_mfma_f32_32x32x16_bf16(vf, pf[nt][s2], O[dm][nt], 0, 0, 0);
      }
  }
#pragma unroll
  for (int nt = 0; nt < 2; ++nt) {
    const float ltot = lsum[nt] + __shfl_xor(lsum[nt], 32, 64);
    const float inv = 1.f / ltot;
    const int qpos = Q0 + 32 * nt + n;
    bf16_t* yo = p.yb + ((size_t)(b * SEQ + qpos)) * 512 + head * 64;
#pragma unroll
    for (int dm = 0; dm < 2; ++dm)
#pragma unroll
      for (int g = 0; g < 4; ++g) {
        uint2 o;
        o.x = pack2(O[dm][nt][4 * g + 0] * inv, O[dm][nt][4 * g + 1] * inv);
        o.y = pack2(O[dm][nt][4 * g + 2] * inv, O[dm][nt][4 * g + 3] * inv);
        *(uint2*)(yo + 32 * dm + 8 * g + 4 * hh) = o;
      }
  }
}

typedef float f32x2 __attribute__((ext_vector_type(2)));
__device__ void table_item(const Params& p, int l, int it) {
  const int tid = otid();
  const int lane = tid & 63, w = tid >> 6;
  const int which = it >> 9, r0 = (it & 511) * 32 + w * 4;
  const float* src = (which ? p.peer_v : p.peer_u) + (size_t)l * NEXP * DM;
  unsigned char* dst = which ? p.tabV8 : p.tabU8;
  float* sc = which ? p.sclV : p.sclU;
#pragma unroll 1
  for (int rr = 0; rr < 4; ++rr) {
    const int e = r0 + rr;
    float4 v[4];
    float mx = 0.f;
#pragma unroll
    for (int i = 0; i < 4; ++i) {
      v[i] = *(const float4*)(src + (size_t)e * DM + lane * 4 + 256 * i);
      mx = fmaxf(mx, fmaxf(fmaxf(fabsf(v[i].x), fabsf(v[i].y)), fmaxf(fabsf(v[i].z), fabsf(v[i].w))));
    }
#pragma unroll
    for (int m = 32; m >= 1; m >>= 1) mx = fmaxf(mx, __shfl_xor(mx, m, 64));
    const float scale = (mx > 0.f) ? 440.f / mx : 1.f;
#pragma unroll
    for (int i = 0; i < 4; ++i) {
      int pk = __builtin_amdgcn_cvt_pk_fp8_f32(v[i].x * scale, v[i].y * scale, 0, false);
      pk = __builtin_amdgcn_cvt_pk_fp8_f32(v[i].z * scale, v[i].w * scale, pk, true);
      const int x = 2 * i + (lane >> 5);
      *(int*)(dst + ((size_t)x * NEXP + e) * 128 + (lane & 31) * 4) = pk;
    }
    if (lane == 0) sc[e] = (mx > 0.f) ? mx * (1.f / 440.f) : 1.f;
  }
}

constexpr int DE_N_HY = 512, DE_N_AT = 768, DE_N_TB = 1024;
__device__ void phase_de(const Params& p, int l, char* smem) {
  for (int it = blockIdx.x; it < DE_N_HY + DE_N_AT + DE_N_TB; it += gridDim.x) {
    if (it < DE_N_HY) hyena_item(p, l, it, smem);
    else if (it < DE_N_HY + DE_N_AT) attn_item(p, l, it - DE_N_HY, smem);
    else table_item(p, l, it - DE_N_HY - DE_N_AT);
  }
}

__device__ void phase_f(const Params& p, int tile, int l, bool from_inputs, char* smem) {
  const int tid = otid();
  const int tok0 = tile * TM;
#pragma unroll 1
  for (int e = tid; e < TM * 64; e += NTHR) {
    const int r = e % TM, cg8 = e / TM;
    const int tok = tok0 + r, b = tok >> 11, sq = tok & 2047;
    const bf16_t* src = p.yaT + ((size_t)b * HYW + cg8 * 8) * SEQ + sq;
    uint4 o;
    o.x = (unsigned)src[0] | ((unsigned)src[SEQ] << 16);
    o.y = (unsigned)src[2 * SEQ] | ((unsigned)src[3 * SEQ] << 16);
    o.z = (unsigned)src[4 * SEQ] | ((unsigned)src[5 * SEQ] << 16);
    o.w = (unsigned)src[6 * SEQ] | ((unsigned)src[7 * SEQ] << 16);
    *(uint4*)(p.yatok + (size_t)tok * HYW + cg8 * 8) = o;
  }
  __syncthreads();
  const bf16_t* Ah = p.hbuf + (size_t)tok0 * DM;
  const bf16_t* Aya = p.yatok + (size_t)tok0 * HYW;
  const bf16_t* Ayb = p.yb + (size_t)tok0 * HYW;
  const bf16_t* Win = p.WinT + (size_t)l * INC * DM;
  const bf16_t* Wpa = p.WpaT + (size_t)l * DM * HYW;
  const bf16_t* Wpb = p.WpbT + (size_t)l * DM * HYW;
  float* ct = (float*)smem;
  f32x16 acc[3], sg[3];
  unsigned* aux = (unsigned*)(smem + 101376) + tid;
#pragma unroll 1
  for (int nc = 0; nc < 8; ++nc) {
    gemm_core(Ah, DM, Win + (size_t)(2304 + nc * 128) * DM, DM, DM, (bf16_t*)smem, acc);
#pragma unroll
    for (int mi = 0; mi < 3; ++mi)
#pragma unroll
      for (int q = 0; q < 8; ++q)
        aux[(mi * 8 + q) * 512] = pack2(__builtin_amdgcn_rcpf(1.f + __expf(-acc[mi][2 * q])), __builtin_amdgcn_rcpf(1.f + __expf(-acc[mi][2 * q + 1])));
    gemm_core(Aya, HYW, Wpa + (size_t)(nc * 128) * HYW, HYW, HYW, (bf16_t*)smem, acc);
#pragma unroll
    for (int mi = 0; mi < 3; ++mi)
#pragma unroll
      for (int q = 0; q < 8; ++q) {
        const unsigned g = aux[(mi * 8 + q) * 512];
        aux[(mi * 8 + q) * 512] = pack2(lo2f(g) * acc[mi][2 * q], hi2f(g) * acc[mi][2 * q + 1]);
      }
    gemm_core(Ah, DM, Win + (size_t)(3328 + nc * 128) * DM, DM, DM, (bf16_t*)smem, acc);
#pragma unroll
    for (int mi = 0; mi < 3; ++mi)
#pragma unroll
      for (int r = 0; r < 16; ++r) sg[mi][r] = __builtin_amdgcn_rcpf(1.f + __expf(-acc[mi][r]));
    gemm_core(Ayb, HYW, Wpb + (size_t)(nc * 128) * HYW, HYW, HYW, (bf16_t*)smem, acc);
#pragma unroll
    for (int mi = 0; mi < 3; ++mi)
#pragma unroll
      for (int q = 0; q < 8; ++q) {
        const unsigned g = aux[(mi * 8 + q) * 512];
        acc[mi][2 * q] = lo2f(g) + sg[mi][2 * q] * acc[mi][2 * q];
        acc[mi][2 * q + 1] = hi2f(g) + sg[mi][2 * q + 1] * acc[mi][2 * q + 1];
      }
    acc_to_lds(acc, ct, 132);
    __syncthreads();
    store_tile_bf16(ct, p.merged, DM, tok0, nc * 128);
  }
  __syncthreads();
  const bf16_t* Am = p.merged + (size_t)tok0 * DM;
  const bf16_t* Wo = p.WoutT + (size_t)l * DM * DM;
#pragma unroll 1
  for (int nc = 0; nc < 8; ++nc) {
    gemm_core(Am, DM, Wo + (size_t)(nc * 128) * DM, DM, DM, (bf16_t*)smem, acc);
    acc_to_lds(acc, ct, 132);
    __syncthreads();
#pragma unroll 1
    for (int it = tid; it < 192 * 32; it += NTHR) {
      const int c4 = it & 31, r = it >> 5;
      const int tok = tok0 + r, b = tok >> 11;
      const int n = nc * 128 + c4 * 4;
      const float4 a = *(const float4*)(ct + r * 132 + c4 * 4);
      const float4 gt = *(const float4*)(p.mod + ((size_t)l * NB + b) * 6144 + 2048 + n);
      const float* xs = from_inputs ? xrow_in(p, tok) : (p.out + (size_t)tok * DM);
      float4 xo = *(const float4*)(xs + n);
      xo.x += gt.x * a.x; xo.y += gt.y * a.y; xo.z += gt.z * a.z; xo.w += gt.w * a.w;
      *(float4*)(p.out + (size_t)tok * DM + n) = xo;
    }
  }
  __syncthreads();
}

__device__ __forceinline__ void topk_insert(float (&key)[16], float kx) {
#pragma unroll
  for (int i = 0; i < 16; ++i) {
    const float hi = fmaxf(key[i], kx);
    kx = fminf(key[i], kx);
    key[i] = hi;
  }
}

__device__ void phase_g(const Params& p, int tile, int l, char* smem) {
  norm_rows(p, tile, l, 1, false, smem);
  const int tid = otid();
  const int tok0 = tile * TM;
  const bf16_t* Ah = p.hbuf + (size_t)tok0 * DM;
  const bf16_t* Wc = p.WcT + (size_t)l * 2048 * DM;
  float* sc = (float*)smem;
  f32x16 acc[3];
  float v1k[16], v2k[16];
#pragma unroll 1
  for (int ch = 0; ch < 16; ++ch) {
    gemm_core(Ah, DM, Wc + (size_t)(ch * 128) * DM, DM, DM, (bf16_t*)smem, acc);
    acc_to_lds(acc, sc, 129);
    __syncthreads();
    if (tid < TM) {
      float key[16];
#pragma unroll
      for (int i = 0; i < 16; ++i) key[i] = -INFINITY;
      const float* row = sc + tid * 129;
      for (int j = 0; j < 128; ++j) {
        const float x = row[j];
        const float kx = __uint_as_float((__float_as_uint(x) & 0xFFFFFF80u) | (unsigned)j);
        topk_insert(key, kx);
      }
      if ((ch & 1) == 0) {
#pragma unroll
        for (int i = 0; i < 16; ++i) v1k[i] = key[i];
      } else {
#pragma unroll
        for (int i = 0; i < 16; ++i) v2k[i] = key[i];
        float top[16];
#pragma unroll
        for (int i = 0; i < 16; ++i) top[i] = -INFINITY;
#pragma unroll
        for (int i = 0; i < 16; ++i)
#pragma unroll
          for (int j = 0; j < 16; ++j)
            if ((i + 1) * (j + 1) <= 16) {
              const float s = v1k[i] + v2k[j];
              const float ck = __uint_as_float((__float_as_uint(s) & 0xFFFFFF00u) | (unsigned)(i * 16 + j));
              topk_insert(top, ck);
            }
        const float mx = top[0];
        float ex[16], sum = 0.f;
#pragma unroll
        for (int k = 0; k < 16; ++k) { ex[k] = __expf(top[k] - mx); sum += ex[k]; }
        const float inv = 1.f / sum;
        const int hh = ch >> 1;
        const size_t ob = ((size_t)(tok0 + tid) * 8 + hh) * 16;
#pragma unroll
        for (int k = 0; k < 16; ++k) {
          const unsigned code = __float_as_uint(top[k]) & 0xFFu;
          const unsigned ii = code >> 4, jj = code & 15u;
          unsigned e1 = 0, e2 = 0;
#pragma unroll
          for (int q = 0; q < 16; ++q) {
            e1 = (ii == (unsigned)q) ? (__float_as_uint(v1k[q]) & 0x7Fu) : e1;
            e2 = (jj == (unsigned)q) ? (__float_as_uint(v2k[q]) & 0x7Fu) : e2;
          }
          const unsigned ee = e1 * 128 + e2;
          p.pidx[ob + k] = (unsigned short)ee;
          p.pg[ob + k] = ex[k] * inv * p.sclV[ee];
          p.pgu[ob + k] = p.sclU[ee];
        }
      }
    }
    __syncthreads();
  }
}

__device__ __forceinline__ unsigned xcc_id() { return (unsigned)__builtin_amdgcn_s_getreg((3 << 11) | 20) & 7u; }
__device__ __forceinline__ bool next_slice_item(unsigned* cnt, int& x, int& j, int& tries, char* smem, int tid) {
  int* sh = (int*)(smem + 8192);
  while (tries < 8) {
    __syncthreads();
    if (tid == 0) *sh = (int)atomicAdd(cnt + x, 1u);
    __syncthreads();
    j = *sh;
    if (j < 32) return true;
    x = (x + 1) & 7; ++tries;
  }
  return false;
}
__device__ __forceinline__ float dpp_xor1(float v) { return __builtin_bit_cast(float, __builtin_amdgcn_update_dpp(0, __builtin_bit_cast(int, v), 0xB1, 0xF, 0xF, true)); }
__device__ __forceinline__ float dpp_xor2(float v) { return __builtin_bit_cast(float, __builtin_amdgcn_update_dpp(0, __builtin_bit_cast(int, v), 0x4E, 0xF, 0xF, true)); }
__device__ __forceinline__ float dpp_hmirror(float v) { return __builtin_bit_cast(float, __builtin_amdgcn_update_dpp(0, __builtin_bit_cast(int, v), 0x141, 0xF, 0xF, true)); }
__device__ __forceinline__ float dpp_ror8(float v) { return __builtin_bit_cast(float, __builtin_amdgcn_update_dpp(0, __builtin_bit_cast(int, v), 0x128, 0xF, 0xF, true)); }

struct I1Ctx { uint4 h0, h1, e0, e1; };
__device__ __forceinline__ void i1_load_ctx(const Params& p, int tok, int x, int g, int ch, I1Ctx& c) {
  const bf16_t* hr = p.hbuf + (size_t)tok * DM + x * 128 + ch * 16;
  c.h0 = *(const uint4*)hr; c.h1 = *(const uint4*)(hr + 8);
  const uint4* pi = (const uint4*)(p.pidx + (size_t)tok * 128 + g * 16);
  c.e0 = pi[0]; c.e1 = pi[1];
}
__device__ __forceinline__ void peer_issue_rows(const unsigned char* Tx, const uint4& e0, const uint4& e1, uint4 (&rows)[16]) {
  const unsigned ew[8] = {e0.x, e0.y, e0.z, e0.w, e1.x, e1.y, e1.z, e1.w};
#pragma unroll
  for (int rd = 0; rd < 16; ++rd) {
    const unsigned e = (ew[rd >> 1] >> (16 * (rd & 1))) & 0x3FFFu;
    rows[rd] = *(const uint4*)(Tx + (size_t)e * 128);
  }
}
__device__ __forceinline__ void i1_compute(const I1Ctx& c, const uint4 (&rows)[16], float* dst, int ch) {
  f32x2 hs[8];
  hs[0][0] = lo2f(c.h0.x); hs[0][1] = hi2f(c.h0.x); hs[1][0] = lo2f(c.h0.y); hs[1][1] = hi2f(c.h0.y);
  hs[2][0] = lo2f(c.h0.z); hs[2][1] = hi2f(c.h0.z); hs[3][0] = lo2f(c.h0.w); hs[3][1] = hi2f(c.h0.w);
  hs[4][0] = lo2f(c.h1.x); hs[4][1] = hi2f(c.h1.x); hs[5][0] = lo2f(c.h1.y); hs[5][1] = hi2f(c.h1.y);
  hs[6][0] = lo2f(c.h1.z); hs[6][1] = hi2f(c.h1.z); hs[7][0] = lo2f(c.h1.w); hs[7][1] = hi2f(c.h1.w);
  float res[16];
#pragma unroll
  for (int rd = 0; rd < 16; ++rd) {
    const unsigned wd[4] = {rows[rd].x, rows[rd].y, rows[rd].z, rows[rd].w};
    f32x2 acc2 = {0.f, 0.f};
#pragma unroll
    for (int q = 0; q < 4; ++q) {
      acc2 += __builtin_amdgcn_cvt_pk_f32_fp8((int)wd[q], false) * hs[2 * q];
      acc2 += __builtin_amdgcn_cvt_pk_f32_fp8((int)wd[q], true) * hs[2 * q + 1];
    }
    float d = acc2[0] + acc2[1];
    d += dpp_xor1(d); d += dpp_xor2(d); d += dpp_hmirror(d);
    res[rd] = d;
  }
  if (ch == 0) {
    float4* o = (float4*)dst;
    o[0] = make_float4(res[0], res[1], res[2], res[3]); o[1] = make_float4(res[4], res[5], res[6], res[7]);
    o[2] = make_float4(res[8], res[9], res[10], res[11]); o[3] = make_float4(res[12], res[13], res[14], res[15]);
  }
}

__device__ void phase_i1(const Params& p, int pass, char* smem) {
  const int tid = otid();
  const int lane = tid & 63, w = tid >> 6;
  const int g = lane >> 3, ch = lane & 7;
  int x = (int)xcc_id(), j = 0, tries = 0;
  while (next_slice_item(p.wq + pass * 8, x, j, tries, smem, tid)) {
    const unsigned char* Ux = p.tabU8 + (size_t)x * NEXP * 128 + ch * 16;
    float* ap = p.apart + (size_t)x * NTOK * 128 + g * 16;
    const int tokb = j * 1536 + w;
    I1Ctx c0, c1, c2;
    uint4 rowsA[16], rowsB[16];
    i1_load_ctx(p, tokb, x, g, ch, c0);
    i1_load_ctx(p, tokb + 8, x, g, ch, c1);
    i1_load_ctx(p, tokb + 16, x, g, ch, c2);
    peer_issue_rows(Ux, c0.e0, c0.e1, rowsA);
#pragma unroll 1
    for (int i = 0; i < 192; i += 2) {
      I1Ctx c3, c4;
      peer_issue_rows(Ux, c1.e0, c1.e1, rowsB);
      i1_load_ctx(p, tokb + 8 * min(i + 3, 191), x, g, ch, c3);
      i1_compute(c0, rowsA, ap + (size_t)(tokb + 8 * i) * 128, ch);
      peer_issue_rows(Ux, c2.e0, c2.e1, rowsA);
      i1_load_ctx(p, tokb + 8 * min(i + 4, 191), x, g, ch, c4);
      i1_compute(c1, rowsB, ap + (size_t)(tokb + 8 * (i + 1)) * 128, ch);
      c0 = c2; c1 = c3; c2 = c4;
    }
  }
}

__device__ void phase_w(const Params& p) {
  const int tid = otid();
  const size_t npair8 = (size_t)NTOK * 128 / 8;
  for (size_t q8 = (size_t)blockIdx.x * NTHR + tid; q8 < npair8; q8 += (size_t)gridDim.x * NTHR) {
    const size_t q = q8 * 8;
    float a[8];
#pragma unroll
    for (int i = 0; i < 8; ++i) a[i] = 0.f;
#pragma unroll
    for (int xx = 0; xx < 8; ++xx) {
      const float4 v0 = *(const float4*)(p.apart + (size_t)xx * NTOK * 128 + q);
      const float4 v1 = *(const float4*)(p.apart + (size_t)xx * NTOK * 128 + q + 4);
      a[0] += v0.x; a[1] += v0.y; a[2] += v0.z; a[3] += v0.w; a[4] += v1.x; a[5] += v1.y; a[6] += v1.z; a[7] += v1.w;
    }
    const float4 u0 = *(const float4*)(p.pgu + q), u1 = *(const float4*)(p.pgu + q + 4);
    const float4 g0 = *(const float4*)(p.pg + q), g1 = *(const float4*)(p.pg + q + 4);
    const float su[8] = {u0.x, u0.y, u0.z, u0.w, u1.x, u1.y, u1.z, u1.w};
    const float sg[8] = {g0.x, g0.y, g0.z, g0.w, g1.x, g1.y, g1.z, g1.w};
    float wv[8];
#pragma unroll
    for (int i = 0; i < 8; ++i) {
      const float av = a[i] * su[i];
      wv[i] = sg[i] * 0.5f * av * (1.f + erff(av * 0.70710678118654752f));
    }
    uint4 o; o.x = pack2(wv[0], wv[1]); o.y = pack2(wv[2], wv[3]); o.z = pack2(wv[4], wv[5]); o.w = pack2(wv[6], wv[7]);
    *(uint4*)(p.wbuf + q) = o;
  }
}

struct I2Ctx { uint4 e0, e1, w0, w1; };
__device__ __forceinline__ void i2_load_ctx(const Params& p, int tok, int g, I2Ctx& c) {
  const uint4* pi = (const uint4*)(p.pidx + (size_t)tok * 128 + g * 16);
  c.e0 = pi[0]; c.e1 = pi[1];
  const uint4* pw = (const uint4*)(p.wbuf + (size_t)tok * 128 + g * 16);
  c.w0 = pw[0]; c.w1 = pw[1];
}
__device__ __forceinline__ void i2_compute(const Params& p, const I2Ctx& c, const uint4 (&rows)[16], int tok, int l,
                                           int x, int g, int ch) {
  const unsigned ww[8] = {c.w0.x, c.w0.y, c.w0.z, c.w0.w, c.w1.x, c.w1.y, c.w1.z, c.w1.w};
  f32x2 acc[8];
#pragma unroll
  for (int i = 0; i < 8; ++i) acc[i] = f32x2{0.f, 0.f};
#pragma unroll
  for (int rd = 0; rd < 16; ++rd) {
    const unsigned wd[4] = {rows[rd].x, rows[rd].y, rows[rd].z, rows[rd].w};
    const float wsc = (rd & 1) ? hi2f(ww[rd >> 1]) : lo2f(ww[rd >> 1]);
    const f32x2 sw = {wsc, wsc};
#pragma unroll
    for (int q = 0; q < 4; ++q) {
      acc[2 * q] += sw * __builtin_amdgcn_cvt_pk_f32_fp8((int)wd[q], false);
      acc[2 * q + 1] += sw * __builtin_amdgcn_cvt_pk_f32_fp8((int)wd[q], true);
    }
  }
  float r[16];
#pragma unroll
  for (int i = 0; i < 8; ++i) { r[2 * i] = acc[i][0]; r[2 * i + 1] = acc[i][1]; }
#pragma unroll
  for (int i = 0; i < 16; ++i) {
    r[i] += dpp_ror8(r[i]); r[i] += __shfl_xor(r[i], 16, 64); r[i] += __shfl_xor(r[i], 32, 64);
  }
  if (g == 0) {
    const int b = tok >> 11;
    const int col = x * 128 + ch * 16;
    const float* gt = p.mod + ((size_t)l * NB + b) * 6144 + 5 * 1024 + col;
    float* xo = p.out + (size_t)tok * DM + col;
#pragma unroll
    for (int q = 0; q < 4; ++q) {
      float4 xv = *(const float4*)(xo + 4 * q);
      const float4 gv = *(const float4*)(gt + 4 * q);
      xv.x += gv.x * r[4 * q]; xv.y += gv.y * r[4 * q + 1]; xv.z += gv.z * r[4 * q + 2]; xv.w += gv.w * r[4 * q + 3];
      *(float4*)(xo + 4 * q) = xv;
    }
  }
}

__device__ void phase_i2(const Params& p, int l, int pass, char* smem) {
  const int tid = otid();
  const int lane = tid & 63, w = tid >> 6;
  const int g = lane >> 3, ch = lane & 7;
  int x = (int)xcc_id(), j = 0, tries = 0;
  while (next_slice_item(p.wq + pass * 8, x, j, tries, smem, tid)) {
    const unsigned char* Vx = p.tabV8 + (size_t)x * NEXP * 128 + ch * 16;
    const int tokb = j * 1536 + w;
    I2Ctx c0, c1, c2;
    uint4 rowsA[16], rowsB[16];
    i2_load_ctx(p, tokb, g, c0);
    i2_load_ctx(p, tokb + 8, g, c1);
    i2_load_ctx(p, tokb + 16, g, c2);
    peer_issue_rows(Vx, c0.e0, c0.e1, rowsA);
#pragma unroll 1
    for (int i = 0; i < 192; i += 2) {
      I2Ctx c3, c4;
      peer_issue_rows(Vx, c1.e0, c1.e1, rowsB);
      i2_load_ctx(p, tokb + 8 * min(i + 3, 191), g, c3);
      i2_compute(p, c0, rowsA, tokb + 8 * i, l, x, g, ch);
      peer_issue_rows(Vx, c2.e0, c2.e1, rowsA);
      i2_load_ctx(p, tokb + 8 * min(i + 4, 191), g, c4);
      i2_compute(p, c1, rowsB, tokb + 8 * (i + 1), l, x, g, ch);
      c0 = c2; c1 = c3; c2 = c4;
    }
  }
}

__global__ void __launch_bounds__(NTHR) mega_kernel(Params p) {
  extern __shared__ __attribute__((aligned(16))) char smem[];
  cg::grid_group grid = cg::this_grid();
  for (int rep = 0; rep < REP_P0; ++rep) phase_p0(p, smem);
  grid.sync();
  for (int l = 0; l < 2; ++l) {
    for (int rep = 0; rep < REP_C; ++rep)
    for (int tile = blockIdx.x; tile < NTILE; tile += gridDim.x) phase_c(p, tile, l, l == 0, smem);
    grid.sync();
    for (int rep = 0; rep < REP_DE; ++rep) phase_de(p, l, smem);
    grid.sync();
    for (int tile = blockIdx.x; tile < NTILE; tile += gridDim.x) {
      phase_f(p, tile, l, l == 0, smem);
      for (int rep = 0; rep < REP_G; ++rep) phase_g(p, tile, l, smem);
    }
    grid.sync();
    phase_i1(p, 2 * l, smem);
    grid.sync();
    phase_w(p);
    grid.sync();
    phase_i2(p, l, 2 * l + 1, smem);
    if (l == 0) grid.sync();
  }
}

extern "C" void kernel_launch(void* const* d_in, const int* in_sizes, int n_in, void* d_out, int out_size, void* d_ws,
                              size_t ws_size, hipStream_t stream) {
  Params p{};
  const float* const* in = (const float* const*)d_in;
  p.x_prompt = in[0]; p.x_sample = in[1]; p.c_prompt = in[2]; p.c_sample = in[3]; p.w_mod = in[4]; p.b_mod = in[5];
  p.g1 = in[6]; p.g2 = in[7]; p.w_in = in[8]; p.conv_w = in[9]; p.conv_b = in[10]; p.f_w1 = in[11]; p.f_b1 = in[12];
  p.f_freq = in[13]; p.f_w2 = in[14]; p.f_b2 = in[15]; p.f_w3 = in[16]; p.f_bias = in[17]; p.q_gain = in[18];
  p.k_gain = in[19]; p.sink = in[20]; p.w_pa = in[21]; p.w_pb = in[22]; p.w_out = in[23]; p.peer_wq = in[24];
  p.peer_k1 = in[25]; p.peer_k2 = in[26]; p.peer_u = in[27]; p.peer_v = in[28];
  p.out = (float*)d_out;
  char* ws = (char*)d_ws;
  size_t off = 0;
  auto carve = [&](size_t bytes) { char* r = ws + off; off += (bytes + 255) & ~(size_t)255; return r; };
  p.WinT = (bf16_t*)carve((size_t)2 * INC * DM * 2);
  p.WpaT = (bf16_t*)carve((size_t)2 * DM * HYW * 2);
  p.WpbT = (bf16_t*)carve((size_t)2 * DM * HYW * 2);
  p.WoutT = (bf16_t*)carve((size_t)2 * DM * DM * 2);
  p.WcT = (bf16_t*)carve((size_t)2 * 2048 * DM * 2);
  p.Gf = (bf16_t*)carve((size_t)2 * 2 * 512 * 4096 * 2);
  p.mod = (float*)carve((size_t)2 * NB * 6144 * 4);
  p.rope = (float*)carve((size_t)SEQ * 64 * 4);
  p.tabU8 = (unsigned char*)carve((size_t)NEXP * DM);
  p.tabV8 = (unsigned char*)carve((size_t)NEXP * DM);
  p.sclU = (float*)carve((size_t)NEXP * 4);
  p.sclV = (float*)carve((size_t)NEXP * 4);
  p.wq = (unsigned*)carve(256);
  p.zT = (bf16_t*)carve((size_t)NB * HYC * SEQ * 2);
  p.yaT = (bf16_t*)carve((size_t)NTOK * HYW * 2);
  p.yb = (bf16_t*)carve((size_t)NTOK * HYW * 2);
  p.zqkv = (bf16_t*)carve((size_t)NTOK * QKVC * 2);
  p.hbuf = (bf16_t*)carve((size_t)NTOK * DM * 2);
  p.merged = p.zT;
  p.yatok = p.zT + (size_t)NTOK * DM;
  p.apart = (float*)p.zT;
  p.pidx = (unsigned short*)p.zqkv;
  p.pg = (float*)(p.zqkv + (size_t)NTOK * 128);
  p.pgu = p.pg + (size_t)NTOK * 128;
  p.wbuf = (bf16_t*)(p.pgu + (size_t)NTOK * 128);
  if (off > ws_size) fprintf(stderr, "workspace too small: need %zu have %zu\n", off, ws_size);

  static int grid_blocks = 0;
  if (!grid_blocks) {
    int dev = 0, cus = 0, per_cu = 0;
    hipGetDevice(&dev);
    hipDeviceGetAttribute(&cus, hipDeviceAttributeMultiprocessorCount, dev);
    hipFuncSetAttribute((const void*)mega_kernel, hipFuncAttributeMaxDynamicSharedMemorySize, SMEM_BYTES);
    hipOccupancyMaxActiveBlocksPerMultiprocessor(&per_cu, mega_kernel, NTHR, SMEM_BYTES);
    if (per_cu < 1) per_cu = 1;
    grid_blocks = cus * 1;
    if (grid_blocks > NTILE) grid_blocks = NTILE;
  }
  void* args[] = {&p};
  hipError_t e = hipLaunchCooperativeKernel((const void*)mega_kernel, dim3(grid_blocks), dim3(NTHR), args, SMEM_BYTES, stream);
  if (e != hipSuccess) fprintf(stderr, "cooperative launch failed: %s (grid %d)\n", hipGetErrorString(e), grid_blocks);
}
```

```cpp
#include <hip/hip_runtime.h>
#include <hip/hip_bf16.h>
#include <hip/hip_cooperative_groups.h>
#include <cstdio>
#include <cstdint>
namespace cg = cooperative_groups;

typedef unsigned short bf16_t;
using bf16x8 = __attribute__((ext_vector_type(8))) short;
using f32x16 = __attribute__((ext_vector_type(16))) float;

constexpr int DM = 1024;
constexpr int NB = 24;
constexpr int SEQ = 2048;
constexpr int NTOK = NB * SEQ;
constexpr int NBP = 16;
constexpr int INC = 4352;
constexpr int HYC = 1536;
constexpr int HYW = 512;
constexpr int QKVC = 768;
constexpr int TM = 192;
constexpr int NTILE = NTOK / TM;
constexpr int NTHR = 512;
constexpr int NEXP = 16384;
constexpr int SMEM_BYTES = 155648;
#ifndef REP_DE
#define REP_DE 1
#endif
#ifndef REP_C
#define REP_C 1
#endif
#ifndef REP_G
#define REP_G 1
#endif
#ifndef REP_I1
#define REP_I1 1
#endif
#ifndef REP_P0
#define REP_P0 1
#endif

struct Params {
  const float *x_prompt, *x_sample, *c_prompt, *c_sample, *w_mod, *b_mod, *g1, *g2, *w_in, *conv_w, *conv_b;
  const float *f_w1, *f_b1, *f_freq, *f_w2, *f_b2, *f_w3, *f_bias, *q_gain, *k_gain, *sink, *w_pa, *w_pb, *w_out;
  const float *peer_wq, *peer_k1, *peer_k2, *peer_u, *peer_v;
  float* out;
  bf16_t *WinT, *WpaT, *WpbT, *WoutT, *WcT, *Gf, *zT, *zqkv, *yaT, *yb, *hbuf, *merged, *yatok;
  unsigned char *tabU8, *tabV8;
  unsigned short* pidx;
  bf16_t* wbuf;
  float *pg, *pgu, *mod, *rope, *sclU, *sclV, *apart;
  unsigned* wq;
};

__device__ __forceinline__ float bf2f(bf16_t v) { return __uint_as_float(((unsigned)v) << 16); }
__device__ __forceinline__ bf16_t f2bf(float f) {
  unsigned u = __float_as_uint(f);
  u += 0x7FFFu + ((u >> 16) & 1u);
  return (bf16_t)(u >> 16);
}
__device__ __forceinline__ unsigned pack2(float a, float b) { return (unsigned)f2bf(a) | ((unsigned)f2bf(b) << 16); }
__device__ __forceinline__ float lo2f(unsigned u) { return __uint_as_float(u << 16); }
__device__ __forceinline__ float hi2f(unsigned u) { return __uint_as_float(u & 0xFFFF0000u); }

__device__ __forceinline__ int otid() { int t = threadIdx.x; asm volatile("" : "+v"(t)); return t; }
__device__ __forceinline__ int osgpr(int x) { asm volatile("" : "+s"(x)); return x; }
__device__ __forceinline__ void lds_barrier() { asm volatile("s_waitcnt lgkmcnt(0)\n\ts_barrier" ::: "memory"); }
__device__ __forceinline__ float wave_sum(float v) {
#pragma unroll
  for (int m = 32; m >= 1; m >>= 1) v += __shfl_xor(v, m, 64);
  return v;
}

__device__ __forceinline__ const float* xrow_in(const Params& p, int tok) {
  return (tok < NBP * SEQ) ? (p.x_prompt + (size_t)tok * DM) : (p.x_sample + (size_t)(tok - NBP * SEQ) * DM);
}
__device__ __forceinline__ const float* crow(const Params& p, int b) {
  return (b < NBP) ? (p.c_prompt + (size_t)b * DM) : (p.c_sample + (size_t)(b - NBP) * DM);
}

__device__ __forceinline__ void glds16(const bf16_t* g, char* l) {
  __builtin_amdgcn_global_load_lds((const __attribute__((address_space(1))) void*)g, (__attribute__((address_space(3))) void*)l, 16, 0, 0);
}
template <int NT>
__device__ __forceinline__ void gemm_core2(const bf16_t* __restrict__ A, int lda, const bf16_t* __restrict__ B, int ldb,
                                           int K, char* lds, f32x16 (&acc)[3][NT]) {
  constexpr int BROWS = 128 * NT;
  constexpr int STAGE = (192 + BROWS) * 128;
  const int tid = otid();
  const int lane = tid & 63, w = tid >> 6;
  const int wm = w >> 2, wn = w & 3;
#pragma unroll
  for (int i = 0; i < 3; ++i)
#pragma unroll
    for (int n = 0; n < NT; ++n)
#pragma unroll
      for (int j = 0; j < 16; ++j) acc[i][n][j] = 0.f;
  const int lr = lane >> 3, lc = lane & 7;
  const bf16_t* pa[3];
  const bf16_t* pb[2 * NT];
#pragma unroll
  for (int i = 0; i < 3; ++i) {
    const int row = (w + 8 * i) * 8 + lr;
    pa[i] = A + (size_t)row * lda + ((lc ^ ((row >> 1) & 7)) * 8);
  }
#pragma unroll
  for (int i = 0; i < 2 * NT; ++i) {
    const int row = (w + 8 * i) * 8 + lr;
    pb[i] = B + (size_t)row * ldb + ((lc ^ ((row >> 1) & 7)) * 8);
  }
  const int nk = K >> 6;
  lds_barrier();
  {
#pragma unroll
    for (int i = 0; i < 3; ++i) glds16(pa[i], lds + (w + 8 * i) * 1024);
#pragma unroll
    for (int i = 0; i < 2 * NT; ++i) glds16(pb[i], lds + 192 * 128 + (w + 8 * i) * 1024);
  }
  asm volatile("s_waitcnt vmcnt(0)" ::: "memory");
  __syncthreads();
  const int fr = lane & 31, hh = lane >> 5;
  int aoff[3], akey[3], boff[NT], bkey[NT];
#pragma unroll
  for (int mi = 0; mi < 3; ++mi) { const int r = wm * 96 + mi * 32 + fr; aoff[mi] = r * 128; akey[mi] = (r >> 1) & 7; }
#pragma unroll
  for (int ni = 0; ni < NT; ++ni) { const int r = wn * 32 * NT + ni * 32 + fr; boff[ni] = 192 * 128 + r * 128; bkey[ni] = (r >> 1) & 7; }
#pragma unroll 1
  for (int kt = 0; kt < nk; ++kt) {
    if (kt + 1 < nk) {
      char* sb = lds + ((kt + 1) & 1) * STAGE;
      const int ko = (kt + 1) << 6;
#pragma unroll
      for (int i = 0; i < 3; ++i) glds16(pa[i] + ko, sb + (w + 8 * i) * 1024);
#pragma unroll
      for (int i = 0; i < 2 * NT; ++i) glds16(pb[i] + ko, sb + 192 * 128 + (w + 8 * i) * 1024);
    }
    const char* st = lds + (kt & 1) * STAGE;
    bf16x8 afr[2][3], bfr[2][NT];
#pragma unroll
    for (int ni = 0; ni < NT; ++ni) bfr[0][ni] = *(const bf16x8*)(st + boff[ni] + ((hh ^ bkey[ni]) << 4));
#pragma unroll
    for (int mi = 0; mi < 3; ++mi) afr[0][mi] = *(const bf16x8*)(st + aoff[mi] + ((hh ^ akey[mi]) << 4));
#pragma unroll
    for (int kk = 0; kk < 4; ++kk) {
      const int cur = kk & 1, nxt = cur ^ 1;
      if (kk < 3) {
        const int kc = 2 * (kk + 1) + hh;
#pragma unroll
        for (int ni = 0; ni < NT; ++ni) bfr[nxt][ni] = *(const bf16x8*)(st + boff[ni] + ((kc ^ bkey[ni]) << 4));
#pragma unroll
        for (int mi = 0; mi < 3; ++mi) afr[nxt][mi] = *(const bf16x8*)(st + aoff[mi] + ((kc ^ akey[mi]) << 4));
      }
      __builtin_amdgcn_sched_barrier(0);
#pragma unroll
      for (int mi = 0; mi < 3; ++mi)
#pragma unroll
        for (int ni = 0; ni < NT; ++ni) acc[mi][ni] = __builtin_amdgcn_mfma_f32_32x32x16_bf16(afr[cur][mi], bfr[cur][ni], acc[mi][ni], 0, 0, 0);
      __builtin_amdgcn_sched_barrier(0);
    }
    asm volatile("s_waitcnt vmcnt(0)" ::: "memory");
    __syncthreads();
  }
}
#define ACC_ROW(wm, mi, reg, lane) ((wm) * 96 + (mi) * 32 + ((reg) & 3) + 8 * ((reg) >> 2) + 4 * ((lane) >> 5))

template <int NT>
__device__ __forceinline__ void acc_to_lds(const f32x16 (&acc)[3][NT], float* ct, int LD, int half) {
  const int tid_ = otid(); const int lane = tid_ & 63, w = tid_ >> 6, wm = w >> 2, wn = w & 3;
  if (NT == 2 && (wn >> 1) != half) return;
#pragma unroll
  for (int ni = 0; ni < NT; ++ni) {
    const int n = (NT == 2 ? (wn & 1) * 64 : wn * 32) + ni * 32 + (lane & 31);
#pragma unroll
    for (int mi = 0; mi < 3; ++mi)
#pragma unroll
      for (int r = 0; r < 16; ++r) ct[ACC_ROW(wm, mi, r, lane) * LD + n] = acc[mi][ni][r];
  }
}
constexpr int LDT = 196;
template <int NT>
__device__ __forceinline__ void acc_to_lds_T(const f32x16 (&acc)[3][NT], float* ctT, int half) {
  const int tid_ = otid(); const int lane = tid_ & 63, w = tid_ >> 6, wm = w >> 2, wn = w & 3;
  if (NT == 2 && (wn >> 1) != half) return;
#pragma unroll
  for (int ni = 0; ni < NT; ++ni) {
    const int n = (NT == 2 ? (wn & 1) * 64 : wn * 32) + ni * 32 + (lane & 31);
#pragma unroll
    for (int mi = 0; mi < 3; ++mi)
#pragma unroll
      for (int g4 = 0; g4 < 4; ++g4) {
        const int r0 = wm * 96 + mi * 32 + 8 * g4 + 4 * (lane >> 5);
        float4 v; v.x = acc[mi][ni][g4 * 4 + 0]; v.y = acc[mi][ni][g4 * 4 + 1]; v.z = acc[mi][ni][g4 * 4 + 2]; v.w = acc[mi][ni][g4 * 4 + 3];
        *(float4*)(ctT + n * LDT + r0) = v;
      }
  }
}
__device__ __forceinline__ void store_tile_bf16(const float* ct, bf16_t* dst, int ldd, int tok0, int n0) {
#pragma unroll 1
  for (int it = otid(); it < 192 * 16; it += NTHR) {
    const int c8 = it & 15, r = it >> 4;
    const float4 a = *(const float4*)(ct + r * 132 + c8 * 8), b = *(const float4*)(ct + r * 132 + c8 * 8 + 4);
    uint4 o; o.x = pack2(a.x, a.y); o.y = pack2(a.z, a.w); o.z = pack2(b.x, b.y); o.w = pack2(b.z, b.w);
    *(uint4*)(dst + (size_t)(tok0 + r) * ldd + n0 + c8 * 8) = o;
  }
}

__device__ void p0_transpose_tile(const float* __restrict__ src, bf16_t* __restrict__ dst, int R, int C, int tr, int tc, char* smem) {
  float* t = (float*)smem;
  const int tid = otid();
  __syncthreads();
#pragma unroll
  for (int i = 0; i < 8; ++i) {
    int r = (tid >> 6) + 8 * i, c = tid & 63;
    t[r * 65 + c] = src[(size_t)(tr * 64 + r) * C + tc * 64 + c];
  }
  __syncthreads();
#pragma unroll
  for (int i = 0; i < 8; ++i) {
    int cc = (tid >> 6) + 8 * i, rr = tid & 63;
    dst[(size_t)(tc * 64 + cc) * R + tr * 64 + rr] = f2bf(t[rr * 65 + cc]);
  }
}

__device__ void p0_wc_item(const Params& p, int l, int ph, int kt, char* smem) {
  float* wqs = (float*)smem;
  float* ks = wqs + 64 * 129;
  const int tid = otid();
  const float* wq = p.peer_wq + (size_t)l * DM * 2048;
  const float* kk = ((ph & 1) ? p.peer_k2 : p.peer_k1) + (size_t)l * 128 * 128;
  __syncthreads();
  for (int e = tid; e < 64 * 128; e += NTHR) {
    int r = e >> 7, d = e & 127;
    wqs[r * 129 + d] = wq[(size_t)(kt * 64 + r) * 2048 + ph * 128 + d];
  }
  for (int e = tid; e < 128 * 128; e += NTHR) {
    int r = e >> 7, d = e & 127;
    ks[r * 129 + d] = kk[r * 128 + d];
  }
  __syncthreads();
  const int key = tid & 127, k0 = (tid >> 7) * 16;
  float acc[16];
#pragma unroll
  for (int i = 0; i < 16; ++i) acc[i] = 0.f;
  for (int d = 0; d < 128; ++d) {
    float kv = ks[key * 129 + d];
#pragma unroll
    for (int i = 0; i < 16; ++i) acc[i] += wqs[(k0 + i) * 129 + d] * kv;
  }
  bf16_t* dst = p.WcT + ((size_t)l * 2048 + ph * 128 + key) * DM + kt * 64 + k0;
  uint4 o0, o1;
  o0.x = pack2(acc[0], acc[1]); o0.y = pack2(acc[2], acc[3]); o0.z = pack2(acc[4], acc[5]); o0.w = pack2(acc[6], acc[7]);
  o1.x = pack2(acc[8], acc[9]); o1.y = pack2(acc[10], acc[11]); o1.z = pack2(acc[12], acc[13]); o1.w = pack2(acc[14], acc[15]);
  *(uint4*)dst = o0; *(uint4*)(dst + 8) = o1;
}

__device__ void p0_mod_item(const Params& p, int l, int cc, char* smem) {
  float* sc = (float*)smem;
  const int tid = otid();
  __syncthreads();
  for (int e = tid; e < NB * DM; e += NTHR) {
    int b = e >> 10, k = e & 1023;
    float v = crow(p, b)[k];
    sc[k * 24 + b] = v / (1.f + __expf(-v));
  }
  __syncthreads();
  const int n = cc * 512 + tid;
  float acc[24];
#pragma unroll
  for (int b = 0; b < 24; ++b) acc[b] = 0.f;
  const float* wm = p.w_mod + (size_t)l * DM * 6144 + n;
  for (int k0 = 0; k0 < DM; k0 += 8) {
    float wv[8];
#pragma unroll
    for (int j = 0; j < 8; ++j) wv[j] = wm[(size_t)(k0 + j) * 6144];
#pragma unroll
    for (int j = 0; j < 8; ++j) {
      const float4* s4 = (const float4*)(sc + (k0 + j) * 24);
#pragma unroll
      for (int q = 0; q < 6; ++q) {
        float4 s = s4[q];
        acc[q * 4 + 0] += s.x * wv[j]; acc[q * 4 + 1] += s.y * wv[j]; acc[q * 4 + 2] += s.z * wv[j]; acc[q * 4 + 3] += s.w * wv[j];
      }
    }
  }
  const float bm = p.b_mod[l * 6144 + n];
#pragma unroll
  for (int b = 0; b < 24; ++b) p.mod[((size_t)l * NB + b) * 6144 + n] = acc[b] + bm;
}

__device__ void p0_filter_item(const Params& p, int l, int tc, char* smem) {
  float* feat = (float*)smem;
  float* a1 = feat + 32 * 33;
  float* a2 = a1 + 32 * 64;
  bf16_t* stage = (bf16_t*)(a2 + 32 * 64);
  const int tid = otid();
  const int t0 = tc * 32;
  __syncthreads();
  for (int e = tid; e < 32 * 33; e += NTHR) {
    int pp = e / 33, f = e % 33;
    int ti = t0 + pp;
    float v;
    if (f == 0) v = (float)ti / (float)(SEQ - 1);
    else {
      int bi = (f - 1) & 15;
      float band = 1e-4f + (float)bi * ((15.f - 1e-4f) / 15.f);
      float wv = 2.0f * 3.14159265358979323846f * (float)ti / (float)SEQ;
      float arg = band * wv;
      v = (f <= 16) ? cosf(arg) : -sinf(arg);
    }
    feat[pp * 33 + f] = v;
  }
  __syncthreads();
  const float* w1 = p.f_w1 + l * 33 * 64; const float* b1 = p.f_b1 + l * 64; const float* fq = p.f_freq + l * 64;
  const float* w2 = p.f_w2 + l * 64 * 64; const float* b2 = p.f_b2 + l * 64;
  for (int e = tid; e < 32 * 64; e += NTHR) {
    int pp = e >> 6, j = e & 63;
    float s = b1[j];
    for (int f = 0; f < 33; ++f) s += feat[pp * 33 + f] * w1[f * 64 + j];
    a1[pp * 64 + j] = sinf(fq[j] * s);
  }
  __syncthreads();
  for (int e = tid; e < 32 * 64; e += NTHR) {
    int pp = e >> 6, j = e & 63;
    float s = b2[j];
    for (int i = 0; i < 64; ++i) s += a1[pp * 64 + i] * w2[i * 64 + j];
    a2[pp * 64 + j] = sinf(fq[j] * s);
  }
  __syncthreads();
  const float* w3 = p.f_w3 + (size_t)l * 64 * 2048;
  const float min_decay = logf(1e-2f) / 1.5f, max_decay = logf(1e-2f) / 0.3f;
  for (int q = 0; q < 4; ++q) {
    const int n = tid + 512 * q;
    const int c = n & 511;
    float wr[64];
#pragma unroll
    for (int i = 0; i < 64; ++i) wr[i] = w3[i * 2048 + n];
    const float delta = fabsf(min_decay + (max_decay - min_decay) * (float)c / 511.f);
    for (int pp = 0; pp < 32; ++pp) {
      float s = 0.f;
#pragma unroll
      for (int i = 0; i < 64; ++i) s += a2[pp * 64 + i] * wr[i];
      float tt = (float)(t0 + pp) / (float)(SEQ - 1);
      s *= __expf(-tt * delta);
      if (t0 + pp == 0 && ((n >> 9) & 1) == 0) s += p.f_bias[(l * 2 + (n >> 10)) * 512 + c];
      stage[n * 32 + pp] = f2bf(s);
    }
  }
  __syncthreads();
  for (int e = tid; e < 2048 * 32; e += NTHR) {
    int n = e >> 5, pp = e & 31;
    int o = n >> 10, d = (n >> 9) & 1, c = n & 511;
    int t = t0 + pp;
    bf16_t* g = p.Gf + ((size_t)((l * 2 + o) * 512 + c)) * 4096;
    if (d == 0) g[2048 - t] = stage[n * 32 + pp];
    else if (t >= 1) g[2048 + t] = stage[n * 32 + pp];
    if (t == 0 && d == 0) g[0] = 0;
  }
}

__device__ void p0_rope_item(const Params& p, int it) {
  int e = it * 512 + otid();
  int pos = e >> 5, i = e & 31;
  float inv = powf(10000.f, -(float)(2 * i) / 64.f);
  float ang = (float)pos * inv;
  p.rope[e * 2 + 0] = cosf(ang);
  p.rope[e * 2 + 1] = sinf(ang);
}

constexpr int P0_TR_PER_LAYER = 16 * 68 + 8 * 16 + 8 * 16 + 16 * 16;
constexpr int P0_N_TR = 2 * P0_TR_PER_LAYER;
constexpr int P0_N_WC = 2 * 16 * 16;
constexpr int P0_N_MOD = 2 * 12;
constexpr int P0_N_FILT = 2 * 64;
constexpr int P0_N_ROPE = 128;
constexpr int P0_TOTAL = P0_N_MOD + P0_N_FILT + P0_N_WC + P0_N_ROPE + P0_N_TR;

__device__ void phase_p0(const Params& p, char* smem) {
  if (blockIdx.x == 0 && threadIdx.x < 32) p.wq[threadIdx.x] = 0u;
  if (blockIdx.x == 0 && threadIdx.x == 64) p.wq[64] = 0u;
  for (int it = blockIdx.x; it < P0_TOTAL; it += gridDim.x) {
    int i = it;
    if (i < P0_N_MOD) { p0_mod_item(p, i / 12, i % 12, smem); continue; }
    i -= P0_N_MOD;
    if (i < P0_N_FILT) { p0_filter_item(p, i / 64, i % 64, smem); continue; }
    i -= P0_N_FILT;
    if (i < P0_N_WC) { p0_wc_item(p, i >> 8, (i >> 4) & 15, i & 15, smem); continue; }
    i -= P0_N_WC;
    if (i < P0_N_ROPE) { p0_rope_item(p, i); continue; }
    i -= P0_N_ROPE;
    {
      int l = i / P0_TR_PER_LAYER, j = i % P0_TR_PER_LAYER;
      if (j < 16 * 68) { p0_transpose_tile(p.w_in + (size_t)l * DM * INC, p.WinT + (size_t)l * INC * DM, DM, INC, j / 68, j % 68, smem); continue; }
      j -= 16 * 68;
      if (j < 128) { p0_transpose_tile(p.w_pa + (size_t)l * HYW * DM, p.WpaT + (size_t)l * DM * HYW, HYW, DM, j / 16, j % 16, smem); continue; }
      j -= 128;
      if (j < 128) { p0_transpose_tile(p.w_pb + (size_t)l * HYW * DM, p.WpbT + (size_t)l * DM * HYW, HYW, DM, j / 16, j % 16, smem); continue; }
      j -= 128;
      p0_transpose_tile(p.w_out + (size_t)l * DM * DM, p.WoutT + (size_t)l * DM * DM, DM, DM, j / 16, j % 16, smem);
    }
  }
}

__device__ void norm_rows(const Params& p, int tile, int l, int which, bool from_inputs, char* smem) {
  float* scl = (float*)smem;
  float* shf = scl + 2048;
  const int tid = otid(), lane = tid & 63, w = tid >> 6;
  const int tok0 = tile * TM;
  const int b0 = tok0 >> 11;
  const float* g = (which ? p.g2 : p.g1) + l * DM;
  __syncthreads();
  for (int e = tid; e < 2048; e += NTHR) {
    int bi = e >> 10, j = e & 1023;
    int b = b0 + bi; if (b > NB - 1) b = NB - 1;
    const float* m = p.mod + ((size_t)l * NB + b) * 6144 + which * 3072;
    scl[e] = g[j] * (1.f + m[1024 + j]);
    shf[e] = m[j];
  }
  __syncthreads();
  for (int r = w; r < TM; r += 8) {
    const int tok = tok0 + r;
    const int bi = (tok >> 11) - b0;
    const float* xr = from_inputs ? xrow_in(p, tok) : (p.out + (size_t)tok * DM);
    float4 v[4];
    float ss = 0.f;
#pragma unroll
    for (int i = 0; i < 4; ++i) {
      v[i] = *(const float4*)(xr + lane * 4 + 256 * i);
      ss += v[i].x * v[i].x + v[i].y * v[i].y + v[i].z * v[i].z + v[i].w * v[i].w;
    }
    ss = wave_sum(ss);
    const float rs = rsqrtf(ss * (1.f / DM) + 1e-6f);
#pragma unroll
    for (int i = 0; i < 4; ++i) {
      const int j = lane * 4 + 256 * i;
      const float4 sc4 = *(const float4*)(scl + bi * 1024 + j);
      const float4 sh4 = *(const float4*)(shf + bi * 1024 + j);
      uint2 o;
      o.x = pack2(v[i].x * rs * sc4.x + sh4.x, v[i].y * rs * sc4.y + sh4.y);
      o.y = pack2(v[i].z * rs * sc4.z + sh4.z, v[i].w * rs * sc4.w + sh4.w);
      *(uint2*)(p.hbuf + (size_t)tok * DM + j) = o;
    }
  }
  __syncthreads();
}

__device__ void phase_c(const Params& p, int tile, int l, bool from_inputs, char* smem) {
  norm_rows(p, tile, l, 0, from_inputs, smem);
  const int tid = otid();
  const int tok0 = tile * TM;
  const bf16_t* A = p.hbuf + (size_t)tok0 * DM;
  const bf16_t* W = p.WinT + (size_t)l * INC * DM;
  float* ct = (float*)smem;
  f32x16 acc[3][2];
#pragma unroll 1
  for (int nt = 0; nt < 9; ++nt) {
    gemm_core2<2>(A, DM, W + (size_t)nt * 256 * DM, DM, DM, smem, acc);
#pragma unroll 1
    for (int half = 0; half < 2; ++half) {
      const int nc = nt * 2 + half;
      if (nc < 12) {
        acc_to_lds_T<2>(acc, ct, half);
        lds_barrier();
#pragma unroll 1
        for (int it = tid; it < 128 * 24; it += NTHR) {
          const int tg = it % 24, nl = it / 24;
          const float4 a = *(const float4*)(ct + nl * LDT + tg * 8), b4 = *(const float4*)(ct + nl * LDT + tg * 8 + 4);
          uint4 o; o.x = pack2(a.x, a.y); o.y = pack2(a.z, a.w); o.z = pack2(b4.x, b4.y); o.w = pack2(b4.z, b4.w);
          const int tok = tok0 + tg * 8;
          const int b = tok >> 11, sq = tok & 2047;
          *(uint4*)(p.zT + ((size_t)b * HYC + nc * 128 + nl) * SEQ + sq) = o;
        }
      } else {
        acc_to_lds<2>(acc, ct, 132, half);
        lds_barrier();
        store_tile_bf16(ct, p.zqkv, QKVC, tok0, nc * 128 - HYC);
      }
      lds_barrier();
    }
  }
}

__device__ __forceinline__ void load_conv8(const bf16_t* __restrict__ zrow, int s0, float w0, float w1, float w2, float cb, float (&o)[8]) {
  uint4 v = *(const uint4*)(zrow + s0);
  float z[10];
  z[0] = (s0 > 0) ? bf2f(zrow[s0 - 1]) : 0.f;
  z[1] = lo2f(v.x); z[2] = hi2f(v.x); z[3] = lo2f(v.y); z[4] = hi2f(v.y);
  z[5] = lo2f(v.z); z[6] = hi2f(v.z); z[7] = lo2f(v.w); z[8] = hi2f(v.w);
  z[9] = (s0 + 8 < SEQ) ? bf2f(zrow[s0 + 8]) : 0.f;
#pragma unroll
  for (int i = 0; i < 8; ++i) o[i] = z[i] * w0 + z[i + 1] * w1 + z[i + 2] * w2 + cb;
}

typedef short s16x4 __attribute__((ext_vector_type(4)));
__device__ __forceinline__ s16x4 tr_read4(const bf16_t* lds_ptr) {
  return __builtin_amdgcn_ds_read_tr16_b64_v4i16((__attribute__((address_space(3))) s16x4*)(lds_ptr));
}

constexpr int HY_GS_ELEMS = 4112;
constexpr int HY_US_ROWS = 2072;
__device__ __forceinline__ void hyena_load_g(const Params& p, int l, int o, int c, bf16_t* Gs, int tid) {
  const bf16_t* g = p.Gf + ((size_t)((l * 2 + o) * 512 + c)) * 4096;
  *(uint4*)(Gs + 8 + tid * 8) = *(const uint4*)(g + tid * 8);
  if (tid == 0) { unsigned z = 0; asm volatile("" : "+v"(z)); const uint4 z4 = make_uint4(z, z, z, z); *(uint4*)Gs = z4; *(uint4*)(Gs + 4104) = z4; }
}

__device__ __forceinline__ void hyena_kloop(const bf16_t* Gs, const bf16_t* us, int rho, int lane, f32x16 (&acc)[8]) {
#pragma unroll
  for (int a = 0; a < 8; ++a)
#pragma unroll
    for (int j = 0; j < 16; ++j) acc[a][j] = 0.f;
  const int i = lane & 31, hh = lane >> 5;
  const bf16_t* ga = Gs + (2040 - 8 * i + 8 * hh) - 1792;
  const int l16 = lane & 15, q = l16 >> 2, pq = l16 & 3, g4 = lane >> 4;
  const bf16_t* ub = us + (rho + 8 * (g4 >> 1) + q) * 24 + 16 * (g4 & 1) + 4 * pq;
#pragma unroll 1
  for (int kap = 0; kap < 129; ++kap) {
    const s16x4 b0 = tr_read4(ub + kap * 384);
    const s16x4 b1 = tr_read4(ub + kap * 384 + 96);
    bf16x8 bfrag;
    bfrag[0] = b0[0]; bfrag[1] = b0[1]; bfrag[2] = b0[2]; bfrag[3] = b0[3];
    bfrag[4] = b1[0]; bfrag[5] = b1[1]; bfrag[6] = b1[2]; bfrag[7] = b1[3];
#pragma unroll
    for (int a = 0; a < 8; ++a) {
      const bf16x8 af = *(const bf16x8*)(ga + kap * 16 + 256 * (7 - a));
      acc[a] = __builtin_amdgcn_mfma_f32_32x32x16_bf16(af, bfrag, acc[a], 0, 0, 0);
    }
  }
}

__device__ __forceinline__ void hyena_acc_to_us(const f32x16 (&acc)[8], bf16_t* us, int rho, int lane) {
  const int n = lane & 31, hh = lane >> 5;
  if (n < 24) {
#pragma unroll
    for (int a = 0; a < 8; ++a)
#pragma unroll
      for (int r = 0; r < 16; ++r) {
        const int t = 256 * a + rho + 8 * ((r & 3) + 8 * (r >> 2) + 4 * hh);
        us[(t + 16) * 24 + n] = f2bf(acc[a][r]);
      }
  }
}

__device__ void hyena_item(const Params& p, int l, int c, char* smem) {
  bf16_t* Gs = (bf16_t*)smem;
  bf16_t* us = (bf16_t*)(smem + 8256);
  const int tid = otid();
  const int lane = tid & 63, w = tid >> 6;
  const float* cw = p.conv_w + (size_t)l * 3 * HYC;
  const float* cbp = p.conv_b + (size_t)l * HYC;
  __syncthreads();
  hyena_load_g(p, l, 0, c, Gs, tid);
  {
    unsigned z = 0; asm volatile("" : "+v"(z)); const uint4 z4 = make_uint4(z, z, z, z);
    if (tid < 48) *(uint4*)(us + tid * 8) = z4;
    else if (tid < 48 + 26) *(uint4*)(us + 2064 * 24 + (tid - 48) * 8) = z4;
  }
  {
    const float w0 = cw[c], w1 = cw[HYC + c], w2 = cw[2 * HYC + c], cb = cbp[c];
#pragma unroll 1
    for (int qq = tid; qq < 24 * 256; qq += NTHR) {
      const int b = qq % 24, s0 = (qq / 24) * 8;
      float v[8];
      load_conv8(p.zT + ((size_t)b * HYC + c) * SEQ, s0, w0, w1, w2, cb, v);
#pragma unroll
      for (int i = 0; i < 8; ++i) us[(s0 + i + 16) * 24 + b] = f2bf(v[i]);
    }
  }
  __syncthreads();
  f32x16 acc[8];
#pragma unroll 1
  for (int o = 0; o < 2; ++o) {
    hyena_kloop(Gs, us, w, lane, acc);
    __syncthreads();
    hyena_acc_to_us(acc, us, w, lane);
    if (o == 0) hyena_load_g(p, l, 1, c, Gs, tid);
    __syncthreads();
    const int xc = (o == 0 ? 512 : 1024) + c;
    const float xw0 = cw[xc], xw1 = cw[HYC + xc], xw2 = cw[2 * HYC + xc], xcb = cbp[xc];
#pragma unroll 1
    for (int qq = tid; qq < 24 * 256; qq += NTHR) {
      const int b = qq % 24, s0 = (qq / 24) * 8;
      float xv[8];
      load_conv8(p.zT + ((size_t)b * HYC + xc) * SEQ, s0, xw0, xw1, xw2, xcb, xv);
      if (o == 0) {
#pragma unroll
        for (int i = 0; i < 8; ++i) {
          bf16_t* e = us + (s0 + i + 16) * 24 + b;
          *e = f2bf(bf2f(*e) * xv[i]);
        }
      } else {
        float r[8];
#pragma unroll
        for (int i = 0; i < 8; ++i) r[i] = bf2f(us[(s0 + i + 16) * 24 + b]) * xv[i];
        uint4 pk; pk.x = pack2(r[0], r[1]); pk.y = pack2(r[2], r[3]); pk.z = pack2(r[4], r[5]); pk.w = pack2(r[6], r[7]);
        *(uint4*)(p.yaT + ((size_t)b * HYW + c) * SEQ + s0) = pk;
      }
    }
    __syncthreads();
  }
}

__device__ void attn_item(const Params& p, int l, int item, char* smem) {
  constexpr int KS = 72, VS = 96;
  bf16_t* Ks = (bf16_t*)smem;
  bf16_t* Vs = Ks + 384 * KS;
  const int tid = otid();
  const int lane = tid & 63, w = tid >> 6;
  const int kh = item & 1, qb = (item >> 1) & 15, b = item >> 5;
  const int kpos0 = qb * 128 - 128;
  __syncthreads();
  if (tid < 384) {
    const int r = tid, kpos = kpos0 + r;
    if (kpos >= 0 && kpos < SEQ) {
      const bf16_t* kr = p.zqkv + ((size_t)(b * SEQ + kpos)) * QKVC + 512 + kh * 64;
      float kf[64];
      float ss = 0.f;
#pragma unroll
      for (int c8 = 0; c8 < 8; ++c8) {
        uint4 v = *(const uint4*)(kr + c8 * 8);
        kf[c8 * 8 + 0] = lo2f(v.x); kf[c8 * 8 + 1] = hi2f(v.x); kf[c8 * 8 + 2] = lo2f(v.y); kf[c8 * 8 + 3] = hi2f(v.y);
        kf[c8 * 8 + 4] = lo2f(v.z); kf[c8 * 8 + 5] = hi2f(v.z); kf[c8 * 8 + 6] = lo2f(v.w); kf[c8 * 8 + 7] = hi2f(v.w);
      }
#pragma unroll
      for (int d = 0; d < 64; ++d) ss += kf[d] * kf[d];
      const float rs = rsqrtf(ss * (1.f / 64.f) + 1e-6f);
      const float* kg = p.k_gain + l * 64;
#pragma unroll
      for (int d = 0; d < 64; ++d) kf[d] = kf[d] * rs * kg[d];
      const float* rp = p.rope + (size_t)kpos * 64;
#pragma unroll
      for (int i = 0; i < 32; ++i) {
        const float cs = rp[i * 2], sn = rp[i * 2 + 1];
        const float a = kf[i], bb = kf[i + 32];
        kf[i] = a * cs - bb * sn; kf[i + 32] = bb * cs + a * sn;
      }
#pragma unroll
      for (int c8 = 0; c8 < 8; ++c8) {
        uint4 pk;
        pk.x = pack2(kf[c8 * 8 + 0], kf[c8 * 8 + 1]); pk.y = pack2(kf[c8 * 8 + 2], kf[c8 * 8 + 3]);
        pk.z = pack2(kf[c8 * 8 + 4], kf[c8 * 8 + 5]); pk.w = pack2(kf[c8 * 8 + 6], kf[c8 * 8 + 7]);
        *(uint4*)(Ks + r * KS + c8 * 8) = pk;
      }
    }
  }
#pragma unroll 1
  for (int e = tid; e < 384 * 8; e += NTHR) {
    const int r = e >> 3, c8 = e & 7, kpos = kpos0 + r;
    if (kpos >= 0 && kpos < SEQ)
      *(uint4*)(Vs + r * VS + c8 * 8) = *(const uint4*)(p.zqkv + ((size_t)(b * SEQ + kpos)) * QKVC + 640 + kh * 64 + c8 * 8);
  }
  __syncthreads();
  const int hl = w & 3, qh = w >> 2;
  const int head = kh * 4 + hl;
  const int n = lane & 31, hh = lane >> 5;
  const int Q0 = qb * 128 + 64 * qh;
  bf16x8 qf[2][4];
#pragma unroll
  for (int nt = 0; nt < 2; ++nt) {
    const int qpos = Q0 + 32 * nt + n;
    const bf16_t* qr = p.zqkv + ((size_t)(b * SEQ + qpos)) * QKVC + head * 64;
    float qv[4][8];
    float ss = 0.f;
#pragma unroll
    for (int kk = 0; kk < 4; ++kk) {
      uint4 v = *(const uint4*)(qr + 16 * kk + 8 * hh);
      qv[kk][0] = lo2f(v.x); qv[kk][1] = hi2f(v.x); qv[kk][2] = lo2f(v.y); qv[kk][3] = hi2f(v.y);
      qv[kk][4] = lo2f(v.z); qv[kk][5] = hi2f(v.z); qv[kk][6] = lo2f(v.w); qv[kk][7] = hi2f(v.w);
#pragma unroll
      for (int j = 0; j < 8; ++j) ss += qv[kk][j] * qv[kk][j];
    }
    ss += __shfl_xor(ss, 32, 64);
    const float rs = rsqrtf(ss * (1.f / 64.f) + 1e-6f) * 0.125f;
    const float* qg = p.q_gain + l * 64;
#pragma unroll
    for (int kk = 0; kk < 4; ++kk)
#pragma unroll
      for (int j = 0; j < 8; ++j) qv[kk][j] *= rs * qg[16 * kk + 8 * hh + j];
    const float* rp = p.rope + (size_t)qpos * 64;
#pragma unroll
    for (int kk = 0; kk < 2; ++kk)
#pragma unroll
      for (int j = 0; j < 8; ++j) {
        const int d = 16 * kk + 8 * hh + j;
        const float cs = rp[d * 2], sn = rp[d * 2 + 1];
        const float a = qv[kk][j], bb = qv[kk + 2][j];
        qv[kk][j] = a * cs - bb * sn; qv[kk + 2][j] = bb * cs + a * sn;
      }
#pragma unroll
    for (int kk = 0; kk < 4; ++kk)
#pragma unroll
      for (int j = 0; j < 8; ++j) qf[nt][kk][j] = (short)f2bf(qv[kk][j]);
  }
  f32x16 O[2][2];
#pragma unroll
  for (int dm = 0; dm < 2; ++dm)
#pragma unroll
    for (int nt = 0; nt < 2; ++nt)
#pragma unroll
      for (int r = 0; r < 16; ++r) O[dm][nt][r] = 0.f;
  float mrun[2], lsum[2];
  mrun[0] = mrun[1] = p.sink[l * 8 + head];
  lsum[0] = lsum[1] = (hh == 0) ? 1.f : 0.f;
  const int l16 = lane & 15, tq = l16 >> 2, tp = l16 & 3, g4 = lane >> 4;
  const bf16_t* vbase = Vs + (4 * (g4 >> 1) + tq) * VS + 16 * (g4 & 1) + 4 * tp;
#pragma unroll 1
  for (int kt = 2 * qh; kt < 2 * qh + 10; ++kt) {
    const int kp_t = kpos0 + 32 * kt;
    if (kp_t < 0 || kp_t >= SEQ) continue;
    bf16x8 kfr[4];
#pragma unroll
    for (int kk = 0; kk < 4; ++kk) kfr[kk] = *(const bf16x8*)(Ks + (32 * kt + n) * KS + 16 * kk + 8 * hh);
    bf16x8 pf[2][2];
#pragma unroll
    for (int nt = 0; nt < 2; ++nt) {
      f32x16 S;
#pragma unroll
      for (int r = 0; r < 16; ++r) S[r] = 0.f;
#pragma unroll
      for (int kk = 0; kk < 4; ++kk) S = __builtin_amdgcn_mfma_f32_32x32x16_bf16(kfr[kk], qf[nt][kk], S, 0, 0, 0);
      const int qpos = Q0 + 32 * nt + n;
      float mloc = -INFINITY;
#pragma unroll
      for (int r = 0; r < 16; ++r) {
        const int kpos = kp_t + (r & 3) + 8 * (r >> 2) + 4 * hh;
        int dd = kpos - qpos; dd = dd < 0 ? -dd : dd;
        S[r] = (dd <= 128) ? S[r] : -INFINITY;
        mloc = fmaxf(mloc, S[r]);
      }
      mloc = fmaxf(mloc, __shfl_xor(mloc, 32, 64));
      const float mnew = fmaxf(mrun[nt], mloc);
      const float corr = __expf(mrun[nt] - mnew);
      mrun[nt] = mnew;
      float psum = 0.f;
#pragma unroll
      for (int r = 0; r < 16; ++r) { S[r] = __expf(S[r] - mnew); psum += S[r]; }
      lsum[nt] = lsum[nt] * corr + psum;
#pragma unroll
      for (int dm = 0; dm < 2; ++dm)
#pragma unroll
        for (int r = 0; r < 16; ++r) O[dm][nt][r] *= corr;
#pragma unroll
      for (int s2 = 0; s2 < 2; ++s2)
#pragma unroll
        for (int j = 0; j < 8; ++j) pf[nt][s2][j] = (short)f2bf(S[8 * s2 + j]);
    }
#pragma unroll
    for (int dm = 0; dm < 2; ++dm)
#pragma unroll
      for (int s2 = 0; s2 < 2; ++s2) {
        const bf16_t* vp = vbase + (32 * kt + 16 * s2) * VS + 32 * dm;
        const s16x4 v0 = tr_read4(vp);
        const s16x4 v1 = tr_read4(vp + 8 * VS);
        bf16x8 vf;
        vf[0] = v0[0]; vf[1] = v0[1]; vf[2] = v0[2]; vf[3] = v0[3];
        vf[4] = v1[0]; vf[5] = v1[1]; vf[6] = v1[2]; vf[7] = v1[3];
#pragma unroll
        for (int nt = 0; nt < 2; ++nt) O[dm][nt] = __builtin_amdgcn_mfma_f32_32x32x16_bf16(vf, pf[nt][s2], O[dm][nt], 0, 0, 0);
      }
  }
#pragma unroll
  for (int nt = 0; nt < 2; ++nt) {
    const float ltot = lsum[nt] + __shfl_xor(lsum[nt], 32, 64);
    const float inv = 1.f / ltot;
    const int qpos = Q0 + 32 * nt + n;
    bf16_t* yo = p.yb + ((size_t)(b * SEQ + qpos)) * 512 + head * 64;
#pragma unroll
    for (int dm = 0; dm < 2; ++dm)
#pragma unroll
      for (int g = 0; g < 4; ++g) {
        uint2 o;
        o.x = pack2(O[dm][nt][4 * g + 0] * inv, O[dm][nt][4 * g + 1] * inv);
        o.y = pack2(O[dm][nt][4 * g + 2] * inv, O[dm][nt][4 * g + 3] * inv);
        *(uint2*)(yo + 32 * dm + 8 * g + 4 * hh) = o;
      }
  }
}

typedef float f32x2 __attribute__((ext_vector_type(2)));
__device__ void table_item(const Params& p, int l, int it) {
  const int tid = otid();
  const int lane = tid & 63, w = tid >> 6;
  const int which = it >> 9, r0 = (it & 511) * 32 + w * 4;
  const float* src = (which ? p.peer_v : p.peer_u) + (size_t)l * NEXP * DM;
  unsigned char* dst = which ? p.tabV8 : p.tabU8;
  float* sc = which ? p.sclV : p.sclU;
#pragma unroll 1
  for (int rr = 0; rr < 4; ++rr) {
    const int e = r0 + rr;
    float4 v[4];
    float mx = 0.f;
#pragma unroll
    for (int i = 0; i < 4; ++i) {
      v[i] = *(const float4*)(src + (size_t)e * DM + lane * 4 + 256 * i);
      mx = fmaxf(mx, fmaxf(fmaxf(fabsf(v[i].x), fabsf(v[i].y)), fmaxf(fabsf(v[i].z), fabsf(v[i].w))));
    }
#pragma unroll
    for (int m = 32; m >= 1; m >>= 1) mx = fmaxf(mx, __shfl_xor(mx, m, 64));
    const float scale = (mx > 0.f) ? 440.f / mx : 1.f;
#pragma unroll
    for (int i = 0; i < 4; ++i) {
      int pk = __builtin_amdgcn_cvt_pk_fp8_f32(v[i].x * scale, v[i].y * scale, 0, false);
      pk = __builtin_amdgcn_cvt_pk_fp8_f32(v[i].z * scale, v[i].w * scale, pk, true);
      const int x = 2 * i + (lane >> 5);
      *(int*)(dst + ((size_t)x * NEXP + e) * 128 + (lane & 31) * 4) = pk;
    }
    if (lane == 0) sc[e] = (mx > 0.f) ? mx * (1.f / 440.f) : 1.f;
  }
}

constexpr int DE_N_HY = 512, DE_N_AT = 768, DE_N_TB = 1024;
__device__ void phase_de(const Params& p, int l, char* smem) {
  for (int it = blockIdx.x; it < DE_N_HY + DE_N_AT + DE_N_TB; it += gridDim.x) {
    if (it < DE_N_HY) hyena_item(p, l, it, smem);
    else if (it < DE_N_HY + DE_N_AT) attn_item(p, l, it - DE_N_HY, smem);
    else table_item(p, l, it - DE_N_HY - DE_N_AT);
  }
}

__device__ void phase_f(const Params& p, int tile, int l, bool from_inputs, char* smem) {
  const int tid = otid();
  const int tok0 = tile * TM;
#pragma unroll 1
  for (int e = tid; e < TM * 64; e += NTHR) {
    const int r = e % TM, cg8 = e / TM;
    const int tok = tok0 + r, b = tok >> 11, sq = tok & 2047;
    const bf16_t* src = p.yaT + ((size_t)b * HYW + cg8 * 8) * SEQ + sq;
    uint4 o;
    o.x = (unsigned)src[0] | ((unsigned)src[SEQ] << 16);
    o.y = (unsigned)src[2 * SEQ] | ((unsigned)src[3 * SEQ] << 16);
    o.z = (unsigned)src[4 * SEQ] | ((unsigned)src[5 * SEQ] << 16);
    o.w = (unsigned)src[6 * SEQ] | ((unsigned)src[7 * SEQ] << 16);
    *(uint4*)(p.yatok + (size_t)tok * HYW + cg8 * 8) = o;
  }
  __syncthreads();
  const bf16_t* Ah = p.hbuf + (size_t)tok0 * DM;
  const bf16_t* Aya = p.yatok + (size_t)tok0 * HYW;
  const bf16_t* Ayb = p.yb + (size_t)tok0 * HYW;
  const bf16_t* Win = p.WinT + (size_t)l * INC * DM;
  const bf16_t* Wpa = p.WpaT + (size_t)l * DM * HYW;
  const bf16_t* Wpb = p.WpbT + (size_t)l * DM * HYW;
  float* ct = (float*)smem;
  f32x16 acc[3][1], sg[3];
  unsigned* aux = (unsigned*)(smem + 101376) + tid;
#pragma unroll 1
  for (int nc = 0; nc < 8; ++nc) {
    gemm_core2<1>(Ah, DM, Win + (size_t)(2304 + nc * 128) * DM, DM, DM, smem, acc);
#pragma unroll
    for (int mi = 0; mi < 3; ++mi)
#pragma unroll
      for (int q = 0; q < 8; ++q)
        aux[(mi * 8 + q) * 512] = pack2(__builtin_amdgcn_rcpf(1.f + __expf(-acc[mi][0][2 * q])), __builtin_amdgcn_rcpf(1.f + __expf(-acc[mi][0][2 * q + 1])));
    gemm_core2<1>(Aya, HYW, Wpa + (size_t)(nc * 128) * HYW, HYW, HYW, smem, acc);
#pragma unroll
    for (int mi = 0; mi < 3; ++mi)
#pragma unroll
      for (int q = 0; q < 8; ++q) {
        const unsigned g = aux[(mi * 8 + q) * 512];
        aux[(mi * 8 + q) * 512] = pack2(lo2f(g) * acc[mi][0][2 * q], hi2f(g) * acc[mi][0][2 * q + 1]);
      }
    gemm_core2<1>(Ah, DM, Win + (size_t)(3328 + nc * 128) * DM, DM, DM, smem, acc);
#pragma unroll
    for (int mi = 0; mi < 3; ++mi)
#pragma unroll
      for (int r = 0; r < 16; ++r) sg[mi][r] = __builtin_amdgcn_rcpf(1.f + __expf(-acc[mi][0][r]));
    gemm_core2<1>(Ayb, HYW, Wpb + (size_t)(nc * 128) * HYW, HYW, HYW, smem, acc);
#pragma unroll
    for (int mi = 0; mi < 3; ++mi)
#pragma unroll
      for (int q = 0; q < 8; ++q) {
        const unsigned g = aux[(mi * 8 + q) * 512];
        acc[mi][0][2 * q] = lo2f(g) + sg[mi][2 * q] * acc[mi][0][2 * q];
        acc[mi][0][2 * q + 1] = hi2f(g) + sg[mi][2 * q + 1] * acc[mi][0][2 * q + 1];
      }
    acc_to_lds<1>(acc, ct, 132, 0);
    lds_barrier();
    store_tile_bf16(ct, p.merged, DM, tok0, nc * 128);
  }
  __syncthreads();
  const bf16_t* Am = p.merged + (size_t)tok0 * DM;
  const bf16_t* Wo = p.WoutT + (size_t)l * DM * DM;
  f32x16 acc2[3][2];
#pragma unroll 1
  for (int nt = 0; nt < 4; ++nt) {
    gemm_core2<2>(Am, DM, Wo + (size_t)(nt * 256) * DM, DM, DM, smem, acc2);
#pragma unroll 1
    for (int half = 0; half < 2; ++half) {
      acc_to_lds<2>(acc2, ct, 132, half);
      lds_barrier();
#pragma unroll 1
      for (int it = tid; it < 192 * 32; it += NTHR) {
        const int c4 = it & 31, r = it >> 5;
        const int tok = tok0 + r, b = tok >> 11;
        const int n = nt * 256 + half * 128 + c4 * 4;
        const float4 a = *(const float4*)(ct + r * 132 + c4 * 4);
        const float4 gt = *(const float4*)(p.mod + ((size_t)l * NB + b) * 6144 + 2048 + n);
        const float* xs = from_inputs ? xrow_in(p, tok) : (p.out + (size_t)tok * DM);
        float4 xo = *(const float4*)(xs + n);
        xo.x += gt.x * a.x; xo.y += gt.y * a.y; xo.z += gt.z * a.z; xo.w += gt.w * a.w;
        *(float4*)(p.out + (size_t)tok * DM + n) = xo;
      }
      lds_barrier();
    }
  }
  __syncthreads();
}

__device__ __forceinline__ void sort16_desc(float (&v)[16]) {
#pragma unroll
  for (int k = 2; k <= 16; k <<= 1)
#pragma unroll
    for (int j = k >> 1; j >= 1; j >>= 1)
#pragma unroll
      for (int i = 0; i < 16; ++i) {
        const int l = i ^ j;
        if (l > i) {
          const float hi = fmaxf(v[i], v[l]), lo = fminf(v[i], v[l]);
          if ((i & k) == 0) { v[i] = hi; v[l] = lo; } else { v[i] = lo; v[l] = hi; }
        }
      }
}
__device__ __forceinline__ void merge16_desc(float (&top)[16], const float (&g)[16]) {
#pragma unroll
  for (int i = 0; i < 16; ++i) top[i] = fmaxf(top[i], g[15 - i]);
#pragma unroll
  for (int j = 8; j >= 1; j >>= 1)
#pragma unroll
    for (int i = 0; i < 16; ++i) {
      const int l = i ^ j;
      if (l > i) { const float hi = fmaxf(top[i], top[l]), lo = fminf(top[i], top[l]); top[i] = hi; top[l] = lo; }
    }
}
__device__ __forceinline__ void topk_insert(float (&key)[16], float kx) {
#pragma unroll
  for (int i = 0; i < 16; ++i) {
    const float hi = fmaxf(key[i], kx);
    kx = fminf(key[i], kx);
    key[i] = hi;
  }
}

__device__ void phase_g(const Params& p, int tile, int l, char* smem) {
  norm_rows(p, tile, l, 1, false, smem);
  const int tid = otid();
  const int tok0 = tile * TM;
  const bf16_t* Ah = p.hbuf + (size_t)tok0 * DM;
  const bf16_t* Wc = p.WcT + (size_t)l * 2048 * DM;
  float* sc = (float*)smem;
  f32x16 acc[3][2];
  float v1k[16], v2k[16];
#pragma unroll 1
  for (int ch = 0; ch < 16; ++ch) {
    if ((ch & 1) == 0) gemm_core2<2>(Ah, DM, Wc + (size_t)(ch * 128) * DM, DM, DM, smem, acc);
    acc_to_lds<2>(acc, sc, 129, ch & 1);
    __syncthreads();
    if (tid < TM) {
      float key[16];
      const float* row = sc + tid * 129;
#pragma unroll
      for (int i = 0; i < 16; ++i) key[i] = __uint_as_float((__float_as_uint(row[i]) & 0xFFFFFF80u) | (unsigned)i);
      sort16_desc(key);
#pragma unroll 1
      for (int j0 = 16; j0 < 128; j0 += 16) {
        float g[16];
#pragma unroll
        for (int i = 0; i < 16; ++i) g[i] = __uint_as_float((__float_as_uint(row[j0 + i]) & 0xFFFFFF80u) | (unsigned)(j0 + i));
        sort16_desc(g);
        merge16_desc(key, g);
      }
      if ((ch & 1) == 0) {
#pragma unroll
        for (int i = 0; i < 16; ++i) v1k[i] = key[i];
      } else {
#pragma unroll
        for (int i = 0; i < 16; ++i) v2k[i] = key[i];
        float top[16];
#pragma unroll
        for (int i = 0; i < 16; ++i) top[i] = -INFINITY;
#pragma unroll
        for (int i = 0; i < 16; ++i)
#pragma unroll
          for (int j = 0; j < 16; ++j)
            if ((i + 1) * (j + 1) <= 16) {
              const float s = v1k[i] + v2k[j];
              const float ck = __uint_as_float((__float_as_uint(s) & 0xFFFFFF00u) | (unsigned)(i * 16 + j));
              topk_insert(top, ck);
            }
        const float mx = top[0];
        float ex[16], sum = 0.f;
#pragma unroll
        for (int k = 0; k < 16; ++k) { ex[k] = __expf(top[k] - mx); sum += ex[k]; }
        const float inv = 1.f / sum;
        const int hh = ch >> 1;
        const size_t ob = ((size_t)(tok0 + tid) * 8 + hh) * 16;
#pragma unroll
        for (int k = 0; k < 16; ++k) {
          const unsigned code = __float_as_uint(top[k]) & 0xFFu;
          const unsigned ii = code >> 4, jj = code & 15u;
          unsigned e1 = 0, e2 = 0;
#pragma unroll
          for (int q = 0; q < 16; ++q) {
            e1 = (ii == (unsigned)q) ? (__float_as_uint(v1k[q]) & 0x7Fu) : e1;
            e2 = (jj == (unsigned)q) ? (__float_as_uint(v2k[q]) & 0x7Fu) : e2;
          }
          const unsigned ee = e1 * 128 + e2;
          p.pidx[ob + k] = (unsigned short)ee;
          p.pg[ob + k] = ex[k] * inv * p.sclV[ee];
          p.pgu[ob + k] = p.sclU[ee];
        }
      }
    }
    __syncthreads();
  }
}

__device__ __forceinline__ unsigned xcc_id() { return (unsigned)__builtin_amdgcn_s_getreg((3 << 11) | 20) & 7u; }
__device__ __forceinline__ bool next_slice_item(unsigned* cnt, int& x, int& j, int& tries, char* smem, int tid) {
  int* sh = (int*)(smem + 8192);
  while (tries < 8) {
    __syncthreads();
    if (tid == 0) *sh = (int)atomicAdd(cnt + x, 1u);
    __syncthreads();
    j = *sh;
    if (j < 32) return true;
    x = (x + 1) & 7; ++tries;
  }
  return false;
}
__device__ __forceinline__ float dpp_xor1(float v) { return __builtin_bit_cast(float, __builtin_amdgcn_update_dpp(0, __builtin_bit_cast(int, v), 0xB1, 0xF, 0xF, true)); }
__device__ __forceinline__ float dpp_xor2(float v) { return __builtin_bit_cast(float, __builtin_amdgcn_update_dpp(0, __builtin_bit_cast(int, v), 0x4E, 0xF, 0xF, true)); }
__device__ __forceinline__ float dpp_hmirror(float v) { return __builtin_bit_cast(float, __builtin_amdgcn_update_dpp(0, __builtin_bit_cast(int, v), 0x141, 0xF, 0xF, true)); }
__device__ __forceinline__ float dpp_ror8(float v) { return __builtin_bit_cast(float, __builtin_amdgcn_update_dpp(0, __builtin_bit_cast(int, v), 0x128, 0xF, 0xF, true)); }

struct I1Ctx { uint4 h0, h1, e0, e1; };
__device__ __forceinline__ void i1_load_ctx(const Params& p, int tok, int x, int g, int ch, I1Ctx& c) {
  const bf16_t* hr = p.hbuf + (size_t)tok * DM + x * 128 + ch * 16;
  c.h0 = *(const uint4*)hr; c.h1 = *(const uint4*)(hr + 8);
  const uint4* pi = (const uint4*)(p.pidx + (size_t)tok * 128 + g * 16);
  c.e0 = pi[0]; c.e1 = pi[1];
}
__device__ __forceinline__ void peer_issue_rows(const unsigned char* Tx, const uint4& e0, const uint4& e1, uint4 (&rows)[16]) {
  const unsigned ew[8] = {e0.x, e0.y, e0.z, e0.w, e1.x, e1.y, e1.z, e1.w};
#pragma unroll
  for (int rd = 0; rd < 16; ++rd) {
    const unsigned e = (ew[rd >> 1] >> (16 * (rd & 1))) & 0x3FFFu;
    rows[rd] = *(const uint4*)(Tx + (size_t)e * 128);
  }
}
__device__ __forceinline__ void i1_compute(const I1Ctx& c, const uint4 (&rows)[16], float* dst, int ch) {
  f32x2 hs[8];
  hs[0][0] = lo2f(c.h0.x); hs[0][1] = hi2f(c.h0.x); hs[1][0] = lo2f(c.h0.y); hs[1][1] = hi2f(c.h0.y);
  hs[2][0] = lo2f(c.h0.z); hs[2][1] = hi2f(c.h0.z); hs[3][0] = lo2f(c.h0.w); hs[3][1] = hi2f(c.h0.w);
  hs[4][0] = lo2f(c.h1.x); hs[4][1] = hi2f(c.h1.x); hs[5][0] = lo2f(c.h1.y); hs[5][1] = hi2f(c.h1.y);
  hs[6][0] = lo2f(c.h1.z); hs[6][1] = hi2f(c.h1.z); hs[7][0] = lo2f(c.h1.w); hs[7][1] = hi2f(c.h1.w);
  float res[16];
#pragma unroll
  for (int rd = 0; rd < 16; ++rd) {
    const unsigned wd[4] = {rows[rd].x, rows[rd].y, rows[rd].z, rows[rd].w};
    f32x2 acc2 = {0.f, 0.f};
#pragma unroll
    for (int q = 0; q < 4; ++q) {
      acc2 += __builtin_amdgcn_cvt_pk_f32_fp8((int)wd[q], false) * hs[2 * q];
      acc2 += __builtin_amdgcn_cvt_pk_f32_fp8((int)wd[q], true) * hs[2 * q + 1];
    }
    float d = acc2[0] + acc2[1];
    d += dpp_xor1(d); d += dpp_xor2(d); d += dpp_hmirror(d);
    res[rd] = d;
  }
  if (ch == 0) {
    float4* o = (float4*)dst;
    o[0] = make_float4(res[0], res[1], res[2], res[3]); o[1] = make_float4(res[4], res[5], res[6], res[7]);
    o[2] = make_float4(res[8], res[9], res[10], res[11]); o[3] = make_float4(res[12], res[13], res[14], res[15]);
  }
}

__device__ void phase_i1(const Params& p, int pass, char* smem) {
  const int tid = otid();
  const int lane = tid & 63, w = tid >> 6;
  const int g = lane >> 3, ch = lane & 7;
  int x = (int)xcc_id(), j = 0, tries = 0;
  while (next_slice_item(p.wq + pass * 8, x, j, tries, smem, tid)) {
    const unsigned char* Ux = p.tabU8 + (size_t)x * NEXP * 128 + ch * 16;
    float* ap = p.apart + (size_t)x * NTOK * 128 + g * 16;
    const int tokb = j * 1536 + w;
    I1Ctx c0, c1, c2;
    uint4 rowsA[16], rowsB[16];
    i1_load_ctx(p, tokb, x, g, ch, c0);
    i1_load_ctx(p, tokb + 8, x, g, ch, c1);
    i1_load_ctx(p, tokb + 16, x, g, ch, c2);
    peer_issue_rows(Ux, c0.e0, c0.e1, rowsA);
#pragma unroll 1
    for (int i = 0; i < 192; i += 2) {
      I1Ctx c3, c4;
      peer_issue_rows(Ux, c1.e0, c1.e1, rowsB);
      i1_load_ctx(p, tokb + 8 * min(i + 3, 191), x, g, ch, c3);
      i1_compute(c0, rowsA, ap + (size_t)(tokb + 8 * i) * 128, ch);
      peer_issue_rows(Ux, c2.e0, c2.e1, rowsA);
      i1_load_ctx(p, tokb + 8 * min(i + 4, 191), x, g, ch, c4);
      i1_compute(c1, rowsB, ap + (size_t)(tokb + 8 * (i + 1)) * 128, ch);
      c0 = c2; c1 = c3; c2 = c4;
    }
  }
}

__device__ void phase_w(const Params& p) {
  const int tid = otid();
  const size_t npair8 = (size_t)NTOK * 128 / 8;
  for (size_t q8 = (size_t)blockIdx.x * NTHR + tid; q8 < npair8; q8 += (size_t)gridDim.x * NTHR) {
    const size_t q = q8 * 8;
    float a[8];
#pragma unroll
    for (int i = 0; i < 8; ++i) a[i] = 0.f;
#pragma unroll
    for (int xx = 0; xx < 8; ++xx) {
      const float4 v0 = *(const float4*)(p.apart + (size_t)xx * NTOK * 128 + q);
      const float4 v1 = *(const float4*)(p.apart + (size_t)xx * NTOK * 128 + q + 4);
      a[0] += v0.x; a[1] += v0.y; a[2] += v0.z; a[3] += v0.w; a[4] += v1.x; a[5] += v1.y; a[6] += v1.z; a[7] += v1.w;
    }
    const float4 u0 = *(const float4*)(p.pgu + q), u1 = *(const float4*)(p.pgu + q + 4);
    const float4 g0 = *(const float4*)(p.pg + q), g1 = *(const float4*)(p.pg + q + 4);
    const float su[8] = {u0.x, u0.y, u0.z, u0.w, u1.x, u1.y, u1.z, u1.w};
    const float sg[8] = {g0.x, g0.y, g0.z, g0.w, g1.x, g1.y, g1.z, g1.w};
    float wv[8];
#pragma unroll
    for (int i = 0; i < 8; ++i) {
      const float av = a[i] * su[i];
      wv[i] = sg[i] * 0.5f * av * (1.f + erff(av * 0.70710678118654752f));
    }
    uint4 o; o.x = pack2(wv[0], wv[1]); o.y = pack2(wv[2], wv[3]); o.z = pack2(wv[4], wv[5]); o.w = pack2(wv[6], wv[7]);
    *(uint4*)(p.wbuf + q) = o;
  }
}

struct I2Ctx { uint4 e0, e1, w0, w1; };
__device__ __forceinline__ void i2_load_ctx(const Params& p, int tok, int g, I2Ctx& c) {
  const uint4* pi = (const uint4*)(p.pidx + (size_t)tok * 128 + g * 16);
  c.e0 = pi[0]; c.e1 = pi[1];
  const uint4* pw = (const uint4*)(p.wbuf + (size_t)tok * 128 + g * 16);
  c.w0 = pw[0]; c.w1 = pw[1];
}
__device__ __forceinline__ void i2_compute(const Params& p, const I2Ctx& c, const uint4 (&rows)[16], int tok, int l,
                                           int x, int g, int ch) {
  const unsigned ww[8] = {c.w0.x, c.w0.y, c.w0.z, c.w0.w, c.w1.x, c.w1.y, c.w1.z, c.w1.w};
  f32x2 acc[8];
#pragma unroll
  for (int i = 0; i < 8; ++i) acc[i] = f32x2{0.f, 0.f};
#pragma unroll
  for (int rd = 0; rd < 16; ++rd) {
    const unsigned wd[4] = {rows[rd].x, rows[rd].y, rows[rd].z, rows[rd].w};
    const float wsc = (rd & 1) ? hi2f(ww[rd >> 1]) : lo2f(ww[rd >> 1]);
    const f32x2 sw = {wsc, wsc};
#pragma unroll
    for (int q = 0; q < 4; ++q) {
      acc[2 * q] += sw * __builtin_amdgcn_cvt_pk_f32_fp8((int)wd[q], false);
      acc[2 * q + 1] += sw * __builtin_amdgcn_cvt_pk_f32_fp8((int)wd[q], true);
    }
  }
  float r[16];
#pragma unroll
  for (int i = 0; i < 8; ++i) { r[2 * i] = acc[i][0]; r[2 * i + 1] = acc[i][1]; }
#pragma unroll
  for (int i = 0; i < 16; ++i) {
    r[i] += dpp_ror8(r[i]); r[i] += __shfl_xor(r[i], 16, 64); r[i] += __shfl_xor(r[i], 32, 64);
  }
  if (g == 0) {
    const int b = tok >> 11;
    const int col = x * 128 + ch * 16;
    const float* gt = p.mod + ((size_t)l * NB + b) * 6144 + 5 * 1024 + col;
    float* xo = p.out + (size_t)tok * DM + col;
#pragma unroll
    for (int q = 0; q < 4; ++q) {
      float4 xv = *(const float4*)(xo + 4 * q);
      const float4 gv = *(const float4*)(gt + 4 * q);
      xv.x += gv.x * r[4 * q]; xv.y += gv.y * r[4 * q + 1]; xv.z += gv.z * r[4 * q + 2]; xv.w += gv.w * r[4 * q + 3];
      *(float4*)(xo + 4 * q) = xv;
    }
  }
}

__device__ void phase_i2(const Params& p, int l, int pass, char* smem) {
  const int tid = otid();
  const int lane = tid & 63, w = tid >> 6;
  const int g = lane >> 3, ch = lane & 7;
  int x = (int)xcc_id(), j = 0, tries = 0;
  while (next_slice_item(p.wq + pass * 8, x, j, tries, smem, tid)) {
    const unsigned char* Vx = p.tabV8 + (size_t)x * NEXP * 128 + ch * 16;
    const int tokb = j * 1536 + w;
    I2Ctx c0, c1, c2;
    uint4 rowsA[16], rowsB[16];
    i2_load_ctx(p, tokb, g, c0);
    i2_load_ctx(p, tokb + 8, g, c1);
    i2_load_ctx(p, tokb + 16, g, c2);
    peer_issue_rows(Vx, c0.e0, c0.e1, rowsA);
#pragma unroll 1
    for (int i = 0; i < 192; i += 2) {
      I2Ctx c3, c4;
      peer_issue_rows(Vx, c1.e0, c1.e1, rowsB);
      i2_load_ctx(p, tokb + 8 * min(i + 3, 191), g, c3);
      i2_compute(p, c0, rowsA, tokb + 8 * i, l, x, g, ch);
      peer_issue_rows(Vx, c2.e0, c2.e1, rowsA);
      i2_load_ctx(p, tokb + 8 * min(i + 4, 191), g, c4);
      i2_compute(p, c1, rowsB, tokb + 8 * (i + 1), l, x, g, ch);
      c0 = c2; c1 = c3; c2 = c4;
    }
  }
}

__device__ __forceinline__ void grid_bar(unsigned* cnt, unsigned& epoch) {
  ++epoch;
  const unsigned target = epoch * gridDim.x;
  __syncthreads();
  if (threadIdx.x == 0) {
    __builtin_amdgcn_fence(__ATOMIC_RELEASE, "agent");
    asm volatile("s_waitcnt vmcnt(0)" ::: "memory");
    __hip_atomic_fetch_add(cnt, 1u, __ATOMIC_RELAXED, __HIP_MEMORY_SCOPE_AGENT);
    while (__hip_atomic_load(cnt, __ATOMIC_RELAXED, __HIP_MEMORY_SCOPE_AGENT) < target) __builtin_amdgcn_s_sleep(1);
    __builtin_amdgcn_fence(__ATOMIC_ACQUIRE, "agent");
    asm volatile("s_waitcnt vmcnt(0)" ::: "memory");
  }
  __syncthreads();
}

__global__ void __launch_bounds__(NTHR) mega_kernel(Params p) {
  extern __shared__ __attribute__((aligned(16))) char smem[];
  cg::grid_group grid = cg::this_grid();
  unsigned epoch = 0;
  for (int rep = 0; rep < REP_P0; ++rep) phase_p0(p, smem);
  grid.sync();
  for (int l = 0; l < 2; ++l) {
    for (int rep = 0; rep < REP_C; ++rep)
    for (int tile = blockIdx.x; tile < NTILE; tile += gridDim.x) phase_c(p, tile, l, l == 0, smem);
    grid_bar(p.wq + 64, epoch);
    for (int rep = 0; rep < REP_DE; ++rep) phase_de(p, l, smem);
    grid_bar(p.wq + 64, epoch);
    for (int tile = blockIdx.x; tile < NTILE; tile += gridDim.x) {
      phase_f(p, tile, l, l == 0, smem);
      for (int rep = 0; rep < REP_G; ++rep) phase_g(p, tile, l, smem);
    }
    grid_bar(p.wq + 64, epoch);
    phase_i1(p, 2 * l, smem);
    grid_bar(p.wq + 64, epoch);
    phase_w(p);
    grid_bar(p.wq + 64, epoch);
    phase_i2(p, l, 2 * l + 1, smem);
    if (l == 0) grid_bar(p.wq + 64, epoch);
  }
}

extern "C" void kernel_launch(void* const* d_in, const int* in_sizes, int n_in, void* d_out, int out_size, void* d_ws,
                              size_t ws_size, hipStream_t stream) {
  Params p{};
  const float* const* in = (const float* const*)d_in;
  p.x_prompt = in[0]; p.x_sample = in[1]; p.c_prompt = in[2]; p.c_sample = in[3]; p.w_mod = in[4]; p.b_mod = in[5];
  p.g1 = in[6]; p.g2 = in[7]; p.w_in = in[8]; p.conv_w = in[9]; p.conv_b = in[10]; p.f_w1 = in[11]; p.f_b1 = in[12];
  p.f_freq = in[13]; p.f_w2 = in[14]; p.f_b2 = in[15]; p.f_w3 = in[16]; p.f_bias = in[17]; p.q_gain = in[18];
  p.k_gain = in[19]; p.sink = in[20]; p.w_pa = in[21]; p.w_pb = in[22]; p.w_out = in[23]; p.peer_wq = in[24];
  p.peer_k1 = in[25]; p.peer_k2 = in[26]; p.peer_u = in[27]; p.peer_v = in[28];
  p.out = (float*)d_out;
  char* ws = (char*)d_ws;
  size_t off = 0;
  auto carve = [&](size_t bytes) { char* r = ws + off; off += (bytes + 255) & ~(size_t)255; return r; };
  p.WinT = (bf16_t*)carve((size_t)2 * INC * DM * 2);
  p.WpaT = (bf16_t*)carve((size_t)2 * DM * HYW * 2);
  p.WpbT = (bf16_t*)carve((size_t)2 * DM * HYW * 2);
  p.WoutT = (bf16_t*)carve((size_t)2 * DM * DM * 2);
  p.WcT = (bf16_t*)carve((size_t)2 * 2048 * DM * 2);
  p.Gf = (bf16_t*)carve((size_t)2 * 2 * 512 * 4096 * 2);
  p.mod = (float*)carve((size_t)2 * NB * 6144 * 4);
  p.rope = (float*)carve((size_t)SEQ * 64 * 4);
  p.tabU8 = (unsigned char*)carve((size_t)NEXP * DM);
  p.tabV8 = (unsigned char*)carve((size_t)NEXP * DM);
  p.sclU = (float*)carve((size_t)NEXP * 4);
  p.sclV = (float*)carve((size_t)NEXP * 4);
  p.wq = (unsigned*)carve(1024);
  p.zT = (bf16_t*)carve((size_t)NB * HYC * SEQ * 2);
  p.yaT = (bf16_t*)carve((size_t)NTOK * HYW * 2);
  p.yb = (bf16_t*)carve((size_t)NTOK * HYW * 2);
  p.zqkv = (bf16_t*)carve((size_t)NTOK * QKVC * 2);
  p.hbuf = (bf16_t*)carve((size_t)NTOK * DM * 2);
  p.merged = p.zT;
  p.yatok = p.zT + (size_t)NTOK * DM;
  p.apart = (float*)p.zT;
  p.pidx = (unsigned short*)p.zqkv;
  p.pg = (float*)(p.zqkv + (size_t)NTOK * 128);
  p.pgu = p.pg + (size_t)NTOK * 128;
  p.wbuf = (bf16_t*)(p.pgu + (size_t)NTOK * 128);
  if (off > ws_size) fprintf(stderr, "workspace too small: need %zu have %zu\n", off, ws_size);

  static int grid_blocks = 0;
  if (!grid_blocks) {
    int dev = 0, cus = 0, per_cu = 0;
    hipGetDevice(&dev);
    hipDeviceGetAttribute(&cus, hipDeviceAttributeMultiprocessorCount, dev);
    hipFuncSetAttribute((const void*)mega_kernel, hipFuncAttributeMaxDynamicSharedMemorySize, SMEM_BYTES);
    hipOccupancyMaxActiveBlocksPerMultiprocessor(&per_cu, mega_kernel, NTHR, SMEM_BYTES);
    if (per_cu < 1) per_cu = 1;
    grid_blocks = cus * 1;
    if (grid_blocks > NTILE) grid_blocks = NTILE;
  }
  void* args[] = {&p};
  hipError_t e = hipLaunchCooperativeKernel((const void*)mega_kernel, dim3(grid_blocks), dim3(NTHR), args, SMEM_BYTES, stream);
  if (e != hipSuccess) fprintf(stderr, "cooperative launch failed: %s (grid %d)\n", hipGetErrorString(e), grid_blocks);
}
```

```cpp
#include <hip/hip_runtime.h>
#include <hip/hip_bf16.h>
#include <hip/hip_cooperative_groups.h>
#include <cstdio>
#include <cstdint>
namespace cg = cooperative_groups;

typedef unsigned short bf16_t;
using bf16x8 = __attribute__((ext_vector_type(8))) short;
using f32x16 = __attribute__((ext_vector_type(16))) float;

constexpr int DM = 1024;
constexpr int NB = 24;
constexpr int SEQ = 2048;
constexpr int NTOK = NB * SEQ;
constexpr int NBP = 16;
constexpr int INC = 4352;
constexpr int HYC = 1536;
constexpr int HYW = 512;
constexpr int QKVC = 768;
constexpr int TM = 192;
constexpr int NTILE = NTOK / TM;
constexpr int NTHR = 512;
constexpr int NEXP = 16384;
constexpr int SMEM_BYTES = 155648;
#ifndef REP_DE
#define REP_DE 1
#endif
#ifndef REP_C
#define REP_C 1
#endif
#ifndef REP_G
#define REP_G 1
#endif
#ifndef REP_I1
#define REP_I1 1
#endif
#ifndef REP_P0
#define REP_P0 1
#endif

struct Params {
  const float *x_prompt, *x_sample, *c_prompt, *c_sample, *w_mod, *b_mod, *g1, *g2, *w_in, *conv_w, *conv_b;
  const float *f_w1, *f_b1, *f_freq, *f_w2, *f_b2, *f_w3, *f_bias, *q_gain, *k_gain, *sink, *w_pa, *w_pb, *w_out;
  const float *peer_wq, *peer_k1, *peer_k2, *peer_u, *peer_v;
  float* out;
  bf16_t *WinT, *WpaT, *WpbT, *WoutT, *WcT, *Gf, *zT, *zqkv, *yaT, *yb, *hbuf, *merged, *yatok;
  unsigned char *tabU8, *tabV8;
  unsigned short* pidx;
  bf16_t* wbuf;
  float *pg, *pgu, *mod, *rope, *sclU, *sclV, *apart;
  unsigned* wq;
};

__device__ __forceinline__ float bf2f(bf16_t v) { return __uint_as_float(((unsigned)v) << 16); }
__device__ __forceinline__ bf16_t f2bf(float f) {
  unsigned u = __float_as_uint(f);
  u += 0x7FFFu + ((u >> 16) & 1u);
  return (bf16_t)(u >> 16);
}
__device__ __forceinline__ unsigned pack2(float a, float b) { return (unsigned)f2bf(a) | ((unsigned)f2bf(b) << 16); }
__device__ __forceinline__ float lo2f(unsigned u) { return __uint_as_float(u << 16); }
__device__ __forceinline__ float hi2f(unsigned u) { return __uint_as_float(u & 0xFFFF0000u); }

__device__ __forceinline__ int otid() { int t = threadIdx.x; asm volatile("" : "+v"(t)); return t; }
__device__ __forceinline__ int osgpr(int x) { asm volatile("" : "+s"(x)); return x; }
__device__ __forceinline__ void lds_barrier() { asm volatile("s_waitcnt lgkmcnt(0)\n\ts_barrier" ::: "memory"); }
__device__ __forceinline__ float wave_sum(float v) {
#pragma unroll
  for (int m = 32; m >= 1; m >>= 1) v += __shfl_xor(v, m, 64);
  return v;
}

__device__ __forceinline__ const float* xrow_in(const Params& p, int tok) {
  return (tok < NBP * SEQ) ? (p.x_prompt + (size_t)tok * DM) : (p.x_sample + (size_t)(tok - NBP * SEQ) * DM);
}
__device__ __forceinline__ const float* crow(const Params& p, int b) {
  return (b < NBP) ? (p.c_prompt + (size_t)b * DM) : (p.c_sample + (size_t)(b - NBP) * DM);
}

__device__ __forceinline__ void glds16(const bf16_t* g, char* l) {
  __builtin_amdgcn_global_load_lds((const __attribute__((address_space(1))) void*)g, (__attribute__((address_space(3))) void*)l, 16, 0, 0);
}
template <int NT>
__device__ __forceinline__ void gemm_core2(const bf16_t* __restrict__ A, int lda, const bf16_t* __restrict__ B, int ldb,
                                           int K, char* lds, f32x16 (&acc)[3][NT]) {
  constexpr int BROWS = 128 * NT;
  constexpr int STAGE = (192 + BROWS) * 128;
  const int tid = otid();
  const int lane = tid & 63, w = tid >> 6;
  const int wm = w >> 2, wn = w & 3;
#pragma unroll
  for (int i = 0; i < 3; ++i)
#pragma unroll
    for (int n = 0; n < NT; ++n)
#pragma unroll
      for (int j = 0; j < 16; ++j) acc[i][n][j] = 0.f;
  const int lr = lane >> 3, lc = lane & 7;
  const bf16_t* pa[3];
  const bf16_t* pb[2 * NT];
#pragma unroll
  for (int i = 0; i < 3; ++i) {
    const int row = (w + 8 * i) * 8 + lr;
    pa[i] = A + (size_t)row * lda + ((lc ^ ((row >> 1) & 7)) * 8);
  }
#pragma unroll
  for (int i = 0; i < 2 * NT; ++i) {
    const int row = (w + 8 * i) * 8 + lr;
    pb[i] = B + (size_t)row * ldb + ((lc ^ ((row >> 1) & 7)) * 8);
  }
  const int nk = K >> 6;
  lds_barrier();
  {
#pragma unroll
    for (int i = 0; i < 3; ++i) glds16(pa[i], lds + (w + 8 * i) * 1024);
#pragma unroll
    for (int i = 0; i < 2 * NT; ++i) glds16(pb[i], lds + 192 * 128 + (w + 8 * i) * 1024);
  }
  asm volatile("s_waitcnt vmcnt(0)" ::: "memory");
  __syncthreads();
  const int fr = lane & 31, hh = lane >> 5;
  int aoff[3], akey[3], boff[NT], bkey[NT];
#pragma unroll
  for (int mi = 0; mi < 3; ++mi) { const int r = wm * 96 + mi * 32 + fr; aoff[mi] = r * 128; akey[mi] = (r >> 1) & 7; }
#pragma unroll
  for (int ni = 0; ni < NT; ++ni) { const int r = wn * 32 * NT + ni * 32 + fr; boff[ni] = 192 * 128 + r * 128; bkey[ni] = (r >> 1) & 7; }
#pragma unroll 1
  for (int kt = 0; kt < nk; ++kt) {
    if (kt + 1 < nk) {
      char* sb = lds + ((kt + 1) & 1) * STAGE;
      const int ko = (kt + 1) << 6;
#pragma unroll
      for (int i = 0; i < 3; ++i) glds16(pa[i] + ko, sb + (w + 8 * i) * 1024);
#pragma unroll
      for (int i = 0; i < 2 * NT; ++i) glds16(pb[i] + ko, sb + 192 * 128 + (w + 8 * i) * 1024);
    }
    const char* st = lds + (kt & 1) * STAGE;
    bf16x8 afr[2][3], bfr[2][NT];
#pragma unroll
    for (int ni = 0; ni < NT; ++ni) bfr[0][ni] = *(const bf16x8*)(st + boff[ni] + ((hh ^ bkey[ni]) << 4));
#pragma unroll
    for (int mi = 0; mi < 3; ++mi) afr[0][mi] = *(const bf16x8*)(st + aoff[mi] + ((hh ^ akey[mi]) << 4));
#pragma unroll
    for (int kk = 0; kk < 4; ++kk) {
      const int cur = kk & 1, nxt = cur ^ 1;
      if (kk < 3) {
        const int kc = 2 * (kk + 1) + hh;
#pragma unroll
        for (int ni = 0; ni < NT; ++ni) bfr[nxt][ni] = *(const bf16x8*)(st + boff[ni] + ((kc ^ bkey[ni]) << 4));
#pragma unroll
        for (int mi = 0; mi < 3; ++mi) afr[nxt][mi] = *(const bf16x8*)(st + aoff[mi] + ((kc ^ akey[mi]) << 4));
      }
      __builtin_amdgcn_sched_barrier(0);
#pragma unroll
      for (int mi = 0; mi < 3; ++mi)
#pragma unroll
        for (int ni = 0; ni < NT; ++ni) acc[mi][ni] = __builtin_amdgcn_mfma_f32_32x32x16_bf16(afr[cur][mi], bfr[cur][ni], acc[mi][ni], 0, 0, 0);
      __builtin_amdgcn_sched_barrier(0);
    }
    asm volatile("s_waitcnt vmcnt(0)" ::: "memory");
    __syncthreads();
  }
}
template <int MODE>
__device__ __forceinline__ void gemm_f1(const bf16_t* __restrict__ A0, const bf16_t* __restrict__ A1, int lda,
                                        const bf16_t* __restrict__ B0, const bf16_t* __restrict__ B1, int ldb,
                                        char* lds, f32x16 (&acc)[3][2]) {
  constexpr int STAGE = (192 + 256) * 128;
  const int tid = otid();
  const int lane = tid & 63, w = tid >> 6;
  const int wm = w >> 2, wn = w & 3;
#pragma unroll
  for (int i = 0; i < 3; ++i)
#pragma unroll
    for (int n = 0; n < 2; ++n)
#pragma unroll
      for (int j = 0; j < 16; ++j) acc[i][n][j] = 0.f;
  const int lr = lane >> 3, lc = lane & 7;
  const bool hi = (w >= 4);
  int aofs[3];
  const bf16_t* pb[4];
#pragma unroll
  for (int i = 0; i < 3; ++i) {
    const int row = (w + 8 * i) * 8 + lr;
    aofs[i] = row * lda + ((lc ^ ((row >> 1) & 7)) * 8);
  }
#pragma unroll
  for (int i = 0; i < 4; ++i) {
    const int rb = (w + 8 * i) * 8 + lr;
    const int srow = i * 32 + (w & 3) * 8 + lr;
    pb[i] = (hi ? B1 : B0) + (size_t)srow * ldb + ((lc ^ ((rb >> 1) & 7)) * 8);
  }
  constexpr int NK = 16;
  auto issue = [&](int kt) {
    char* sb = lds + (kt & 1) * STAGE;
    const bf16_t* Ab = (MODE == 2 && kt >= 8) ? A1 : A0;
    const int ka = (MODE == 2) ? ((kt & 7) << 6) : (kt << 6);
#pragma unroll
    for (int i = 0; i < 3; ++i) glds16(Ab + aofs[i] + ka, sb + (w + 8 * i) * 1024);
    if (MODE == 1 || ((kt >= 8) == hi)) {
#pragma unroll
      for (int i = 0; i < 4; ++i) glds16(pb[i] + ka, sb + 192 * 128 + (w + 8 * i) * 1024);
    }
  };
  lds_barrier();
  issue(0);
  asm volatile("s_waitcnt vmcnt(0)" ::: "memory");
  __syncthreads();
  const int fr = lane & 31, hh = lane >> 5;
  int aoff[3], akey[3], boff[2], bkey[2];
#pragma unroll
  for (int mi = 0; mi < 3; ++mi) { const int r = wm * 96 + mi * 32 + fr; aoff[mi] = r * 128; akey[mi] = (r >> 1) & 7; }
#pragma unroll
  for (int ni = 0; ni < 2; ++ni) { const int r = wn * 64 + ni * 32 + fr; boff[ni] = 192 * 128 + r * 128; bkey[ni] = (r >> 1) & 7; }
#pragma unroll
  for (int hf = 0; hf < 2; ++hf) {
#pragma unroll 1
    for (int kt = hf * 8; kt < hf * 8 + 8; ++kt) {
      if (kt + 1 < NK) issue(kt + 1);
      const char* st = lds + (kt & 1) * STAGE;
#pragma unroll
      for (int kk = 0; kk < 4; ++kk) {
        const int kc = 2 * kk + hh;
        bf16x8 bfr[2];
#pragma unroll
        for (int ni = 0; ni < 2; ++ni) if (MODE == 1 || ni == hf) bfr[ni] = *(const bf16x8*)(st + boff[ni] + ((kc ^ bkey[ni]) << 4));
#pragma unroll
        for (int mi = 0; mi < 3; ++mi) {
          const bf16x8 afr = *(const bf16x8*)(st + aoff[mi] + ((kc ^ akey[mi]) << 4));
#pragma unroll
          for (int ni = 0; ni < 2; ++ni)
            if (MODE == 1 || ni == hf) acc[mi][ni] = __builtin_amdgcn_mfma_f32_32x32x16_bf16(afr, bfr[ni], acc[mi][ni], 0, 0, 0);
        }
      }
      asm volatile("s_waitcnt vmcnt(0)" ::: "memory");
      __syncthreads();
    }
  }
}

#define ACC_ROW(wm, mi, reg, lane) ((wm) * 96 + (mi) * 32 + ((reg) & 3) + 8 * ((reg) >> 2) + 4 * ((lane) >> 5))

template <int NT>
__device__ __forceinline__ void acc_to_lds(const f32x16 (&acc)[3][NT], float* ct, int LD, int half) {
  const int tid_ = otid(); const int lane = tid_ & 63, w = tid_ >> 6, wm = w >> 2, wn = w & 3;
  if (NT == 2 && (wn >> 1) != half) return;
#pragma unroll
  for (int ni = 0; ni < NT; ++ni) {
    const int n = (NT == 2 ? (wn & 1) * 64 : wn * 32) + ni * 32 + (lane & 31);
#pragma unroll
    for (int mi = 0; mi < 3; ++mi)
#pragma unroll
      for (int r = 0; r < 16; ++r) ct[ACC_ROW(wm, mi, r, lane) * LD + n] = acc[mi][ni][r];
  }
}
constexpr int LDT = 196;
template <int NT>
__device__ __forceinline__ void acc_to_lds_T(const f32x16 (&acc)[3][NT], float* ctT, int half) {
  const int tid_ = otid(); const int lane = tid_ & 63, w = tid_ >> 6, wm = w >> 2, wn = w & 3;
  if (NT == 2 && (wn >> 1) != half) return;
#pragma unroll
  for (int ni = 0; ni < NT; ++ni) {
    const int n = (NT == 2 ? (wn & 1) * 64 : wn * 32) + ni * 32 + (lane & 31);
#pragma unroll
    for (int mi = 0; mi < 3; ++mi)
#pragma unroll
      for (int g4 = 0; g4 < 4; ++g4) {
        const int r0 = wm * 96 + mi * 32 + 8 * g4 + 4 * (lane >> 5);
        float4 v; v.x = acc[mi][ni][g4 * 4 + 0]; v.y = acc[mi][ni][g4 * 4 + 1]; v.z = acc[mi][ni][g4 * 4 + 2]; v.w = acc[mi][ni][g4 * 4 + 3];
        *(float4*)(ctT + n * LDT + r0) = v;
      }
  }
}
__device__ __forceinline__ void store_tile_bf16(const float* ct, bf16_t* dst, int ldd, int tok0, int n0) {
#pragma unroll 1
  for (int it = otid(); it < 192 * 16; it += NTHR) {
    const int c8 = it & 15, r = it >> 4;
    const float4 a = *(const float4*)(ct + r * 132 + c8 * 8), b = *(const float4*)(ct + r * 132 + c8 * 8 + 4);
    uint4 o; o.x = pack2(a.x, a.y); o.y = pack2(a.z, a.w); o.z = pack2(b.x, b.y); o.w = pack2(b.z, b.w);
    *(uint4*)(dst + (size_t)(tok0 + r) * ldd + n0 + c8 * 8) = o;
  }
}

__device__ void p0_transpose_tile(const float* __restrict__ src, bf16_t* __restrict__ dst, int R, int C, int tr, int tc, char* smem) {
  float* t = (float*)smem;
  const int tid = otid();
  __syncthreads();
#pragma unroll
  for (int i = 0; i < 8; ++i) {
    int r = (tid >> 6) + 8 * i, c = tid & 63;
    t[r * 65 + c] = src[(size_t)(tr * 64 + r) * C + tc * 64 + c];
  }
  __syncthreads();
#pragma unroll
  for (int i = 0; i < 8; ++i) {
    int cc = (tid >> 6) + 8 * i, rr = tid & 63;
    dst[(size_t)(tc * 64 + cc) * R + tr * 64 + rr] = f2bf(t[rr * 65 + cc]);
  }
}

__device__ void p0_wc_item(const Params& p, int l, int ph, int kt, char* smem) {
  float* wqs = (float*)smem;
  float* ks = wqs + 64 * 129;
  const int tid = otid();
  const float* wq = p.peer_wq + (size_t)l * DM * 2048;
  const float* kk = ((ph & 1) ? p.peer_k2 : p.peer_k1) + (size_t)l * 128 * 128;
  __syncthreads();
  for (int e = tid; e < 64 * 128; e += NTHR) {
    int r = e >> 7, d = e & 127;
    wqs[r * 129 + d] = wq[(size_t)(kt * 64 + r) * 2048 + ph * 128 + d];
  }
  for (int e = tid; e < 128 * 128; e += NTHR) {
    int r = e >> 7, d = e & 127;
    ks[r * 129 + d] = kk[r * 128 + d];
  }
  __syncthreads();
  const int key = tid & 127, k0 = (tid >> 7) * 16;
  float acc[16];
#pragma unroll
  for (int i = 0; i < 16; ++i) acc[i] = 0.f;
  for (int d = 0; d < 128; ++d) {
    float kv = ks[key * 129 + d];
#pragma unroll
    for (int i = 0; i < 16; ++i) acc[i] += wqs[(k0 + i) * 129 + d] * kv;
  }
  bf16_t* dst = p.WcT + ((size_t)l * 2048 + ph * 128 + key) * DM + kt * 64 + k0;
  uint4 o0, o1;
  o0.x = pack2(acc[0], acc[1]); o0.y = pack2(acc[2], acc[3]); o0.z = pack2(acc[4], acc[5]); o0.w = pack2(acc[6], acc[7]);
  o1.x = pack2(acc[8], acc[9]); o1.y = pack2(acc[10], acc[11]); o1.z = pack2(acc[12], acc[13]); o1.w = pack2(acc[14], acc[15]);
  *(uint4*)dst = o0; *(uint4*)(dst + 8) = o1;
}

__device__ void p0_mod_item(const Params& p, int l, int cc, char* smem) {
  float* sc = (float*)smem;
  const int tid = otid();
  __syncthreads();
  for (int e = tid; e < NB * DM; e += NTHR) {
    int b = e >> 10, k = e & 1023;
    float v = crow(p, b)[k];
    sc[k * 24 + b] = v / (1.f + __expf(-v));
  }
  __syncthreads();
  const int n = cc * 512 + tid;
  float acc[24];
#pragma unroll
  for (int b = 0; b < 24; ++b) acc[b] = 0.f;
  const float* wm = p.w_mod + (size_t)l * DM * 6144 + n;
  for (int k0 = 0; k0 < DM; k0 += 8) {
    float wv[8];
#pragma unroll
    for (int j = 0; j < 8; ++j) wv[j] = wm[(size_t)(k0 + j) * 6144];
#pragma unroll
    for (int j = 0; j < 8; ++j) {
      const float4* s4 = (const float4*)(sc + (k0 + j) * 24);
#pragma unroll
      for (int q = 0; q < 6; ++q) {
        float4 s = s4[q];
        acc[q * 4 + 0] += s.x * wv[j]; acc[q * 4 + 1] += s.y * wv[j]; acc[q * 4 + 2] += s.z * wv[j]; acc[q * 4 + 3] += s.w * wv[j];
      }
    }
  }
  const float bm = p.b_mod[l * 6144 + n];
#pragma unroll
  for (int b = 0; b < 24; ++b) p.mod[((size_t)l * NB + b) * 6144 + n] = acc[b] + bm;
}

__device__ void p0_filter_item(const Params& p, int l, int tc, char* smem) {
  float* feat = (float*)smem;
  float* a1 = feat + 32 * 33;
  float* a2 = a1 + 32 * 64;
  bf16_t* stage = (bf16_t*)(a2 + 32 * 64);
  const int tid = otid();
  const int t0 = tc * 32;
  __syncthreads();
  for (int e = tid; e < 32 * 33; e += NTHR) {
    int pp = e / 33, f = e % 33;
    int ti = t0 + pp;
    float v;
    if (f == 0) v = (float)ti / (float)(SEQ - 1);
    else {
      int bi = (f - 1) & 15;
      float band = 1e-4f + (float)bi * ((15.f - 1e-4f) / 15.f);
      float wv = 2.0f * 3.14159265358979323846f * (float)ti / (float)SEQ;
      float arg = band * wv;
      v = (f <= 16) ? cosf(arg) : -sinf(arg);
    }
    feat[pp * 33 + f] = v;
  }
  __syncthreads();
  const float* w1 = p.f_w1 + l * 33 * 64; const float* b1 = p.f_b1 + l * 64; const float* fq = p.f_freq + l * 64;
  const float* w2 = p.f_w2 + l * 64 * 64; const float* b2 = p.f_b2 + l * 64;
  for (int e = tid; e < 32 * 64; e += NTHR) {
    int pp = e >> 6, j = e & 63;
    float s = b1[j];
    for (int f = 0; f < 33; ++f) s += feat[pp * 33 + f] * w1[f * 64 + j];
    a1[pp * 64 + j] = sinf(fq[j] * s);
  }
  __syncthreads();
  for (int e = tid; e < 32 * 64; e += NTHR) {
    int pp = e >> 6, j = e & 63;
    float s = b2[j];
    for (int i = 0; i < 64; ++i) s += a1[pp * 64 + i] * w2[i * 64 + j];
    a2[pp * 64 + j] = sinf(fq[j] * s);
  }
  __syncthreads();
  const float* w3 = p.f_w3 + (size_t)l * 64 * 2048;
  const float min_decay = logf(1e-2f) / 1.5f, max_decay = logf(1e-2f) / 0.3f;
  for (int q = 0; q < 4; ++q) {
    const int n = tid + 512 * q;
    const int c = n & 511;
    float wr[64];
#pragma unroll
    for (int i = 0; i < 64; ++i) wr[i] = w3[i * 2048 + n];
    const float delta = fabsf(min_decay + (max_decay - min_decay) * (float)c / 511.f);
    for (int pp = 0; pp < 32; ++pp) {
      float s = 0.f;
#pragma unroll
      for (int i = 0; i < 64; ++i) s += a2[pp * 64 + i] * wr[i];
      float tt = (float)(t0 + pp) / (float)(SEQ - 1);
      s *= __expf(-tt * delta);
      if (t0 + pp == 0 && ((n >> 9) & 1) == 0) s += p.f_bias[(l * 2 + (n >> 10)) * 512 + c];
      stage[n * 32 + pp] = f2bf(s);
    }
  }
  __syncthreads();
  for (int e = tid; e < 2048 * 32; e += NTHR) {
    int n = e >> 5, pp = e & 31;
    int o = n >> 10, d = (n >> 9) & 1, c = n & 511;
    int t = t0 + pp;
    bf16_t* g = p.Gf + ((size_t)((l * 2 + o) * 512 + c)) * 4096;
    if (d == 0) g[2048 - t] = stage[n * 32 + pp];
    else if (t >= 1) g[2048 + t] = stage[n * 32 + pp];
    if (t == 0 && d == 0) g[0] = 0;
  }
}

__device__ void p0_rope_item(const Params& p, int it) {
  int e = it * 512 + otid();
  int pos = e >> 5, i = e & 31;
  float inv = powf(10000.f, -(float)(2 * i) / 64.f);
  float ang = (float)pos * inv;
  p.rope[e * 2 + 0] = cosf(ang);
  p.rope[e * 2 + 1] = sinf(ang);
}

constexpr int P0_TR_PER_LAYER = 16 * 68 + 8 * 16 + 8 * 16 + 16 * 16;
constexpr int P0_N_TR = 2 * P0_TR_PER_LAYER;
constexpr int P0_N_WC = 2 * 16 * 16;
constexpr int P0_N_MOD = 2 * 12;
constexpr int P0_N_FILT = 2 * 64;
constexpr int P0_N_ROPE = 128;
constexpr int P0_TOTAL = P0_N_MOD + P0_N_FILT + P0_N_WC + P0_N_ROPE + P0_N_TR;

__device__ void phase_p0(const Params& p, char* smem) {
  if (blockIdx.x == 0 && threadIdx.x < 32) p.wq[threadIdx.x] = 0u;
  if (blockIdx.x == 0 && threadIdx.x == 64) p.wq[64] = 0u;
  for (int it = blockIdx.x; it < P0_TOTAL; it += gridDim.x) {
    int i = it;
    if (i < P0_N_MOD) { p0_mod_item(p, i / 12, i % 12, smem); continue; }
    i -= P0_N_MOD;
    if (i < P0_N_FILT) { p0_filter_item(p, i / 64, i % 64, smem); continue; }
    i -= P0_N_FILT;
    if (i < P0_N_WC) { p0_wc_item(p, i >> 8, (i >> 4) & 15, i & 15, smem); continue; }
    i -= P0_N_WC;
    if (i < P0_N_ROPE) { p0_rope_item(p, i); continue; }
    i -= P0_N_ROPE;
    {
      int l = i / P0_TR_PER_LAYER, j = i % P0_TR_PER_LAYER;
      if (j < 16 * 68) { p0_transpose_tile(p.w_in + (size_t)l * DM * INC, p.WinT + (size_t)l * INC * DM, DM, INC, j / 68, j % 68, smem); continue; }
      j -= 16 * 68;
      if (j < 128) { p0_transpose_tile(p.w_pa + (size_t)l * HYW * DM, p.WpaT + (size_t)l * DM * HYW, HYW, DM, j / 16, j % 16, smem); continue; }
      j -= 128;
      if (j < 128) { p0_transpose_tile(p.w_pb + (size_t)l * HYW * DM, p.WpbT + (size_t)l * DM * HYW, HYW, DM, j / 16, j % 16, smem); continue; }
      j -= 128;
      p0_transpose_tile(p.w_out + (size_t)l * DM * DM, p.WoutT + (size_t)l * DM * DM, DM, DM, j / 16, j % 16, smem);
    }
  }
}

__device__ void norm_rows(const Params& p, int tile, int l, int which, bool from_inputs, char* smem) {
  float* scl = (float*)smem;
  float* shf = scl + 2048;
  const int tid = otid(), lane = tid & 63, w = tid >> 6;
  const int tok0 = tile * TM;
  const int b0 = tok0 >> 11;
  const float* g = (which ? p.g2 : p.g1) + l * DM;
  __syncthreads();
  for (int e = tid; e < 2048; e += NTHR) {
    int bi = e >> 10, j = e & 1023;
    int b = b0 + bi; if (b > NB - 1) b = NB - 1;
    const float* m = p.mod + ((size_t)l * NB + b) * 6144 + which * 3072;
    scl[e] = g[j] * (1.f + m[1024 + j]);
    shf[e] = m[j];
  }
  __syncthreads();
  for (int r = w; r < TM; r += 8) {
    const int tok = tok0 + r;
    const int bi = (tok >> 11) - b0;
    const float* xr = from_inputs ? xrow_in(p, tok) : (p.out + (size_t)tok * DM);
    float4 v[4];
    float ss = 0.f;
#pragma unroll
    for (int i = 0; i < 4; ++i) {
      v[i] = *(const float4*)(xr + lane * 4 + 256 * i);
      ss += v[i].x * v[i].x + v[i].y * v[i].y + v[i].z * v[i].z + v[i].w * v[i].w;
    }
    ss = wave_sum(ss);
    const float rs = rsqrtf(ss * (1.f / DM) + 1e-6f);
#pragma unroll
    for (int i = 0; i < 4; ++i) {
      const int j = lane * 4 + 256 * i;
      const float4 sc4 = *(const float4*)(scl + bi * 1024 + j);
      const float4 sh4 = *(const float4*)(shf + bi * 1024 + j);
      uint2 o;
      o.x = pack2(v[i].x * rs * sc4.x + sh4.x, v[i].y * rs * sc4.y + sh4.y);
      o.y = pack2(v[i].z * rs * sc4.z + sh4.z, v[i].w * rs * sc4.w + sh4.w);
      *(uint2*)(p.hbuf + (size_t)tok * DM + j) = o;
    }
  }
  __syncthreads();
}

__device__ void phase_c(const Params& p, int tile, int l, bool from_inputs, char* smem) {
  norm_rows(p, tile, l, 0, from_inputs, smem);
  const int tid = otid();
  const int tok0 = tile * TM;
  const bf16_t* A = p.hbuf + (size_t)tok0 * DM;
  const bf16_t* W = p.WinT + (size_t)l * INC * DM;
  float* ct = (float*)smem;
  f32x16 acc[3][2];
#pragma unroll 1
  for (int nt = 0; nt < 9; ++nt) {
    gemm_core2<2>(A, DM, W + (size_t)nt * 256 * DM, DM, DM, smem, acc);
#pragma unroll 1
    for (int half = 0; half < 2; ++half) {
      const int nc = nt * 2 + half;
      if (nc < 12) {
        acc_to_lds_T<2>(acc, ct, half);
        lds_barrier();
#pragma unroll 1
        for (int it = tid; it < 128 * 24; it += NTHR) {
          const int tg = it % 24, nl = it / 24;
          const float4 a = *(const float4*)(ct + nl * LDT + tg * 8), b4 = *(const float4*)(ct + nl * LDT + tg * 8 + 4);
          uint4 o; o.x = pack2(a.x, a.y); o.y = pack2(a.z, a.w); o.z = pack2(b4.x, b4.y); o.w = pack2(b4.z, b4.w);
          const int tok = tok0 + tg * 8;
          const int b = tok >> 11, sq = tok & 2047;
          *(uint4*)(p.zT + ((size_t)b * HYC + nc * 128 + nl) * SEQ + sq) = o;
        }
      } else {
        acc_to_lds<2>(acc, ct, 132, half);
        lds_barrier();
        store_tile_bf16(ct, p.zqkv, QKVC, tok0, nc * 128 - HYC);
      }
      lds_barrier();
    }
  }
}

__device__ __forceinline__ void load_conv8(const bf16_t* __restrict__ zrow, int s0, float w0, float w1, float w2, float cb, float (&o)[8]) {
  uint4 v = *(const uint4*)(zrow + s0);
  float z[10];
  z[0] = (s0 > 0) ? bf2f(zrow[s0 - 1]) : 0.f;
  z[1] = lo2f(v.x); z[2] = hi2f(v.x); z[3] = lo2f(v.y); z[4] = hi2f(v.y);
  z[5] = lo2f(v.z); z[6] = hi2f(v.z); z[7] = lo2f(v.w); z[8] = hi2f(v.w);
  z[9] = (s0 + 8 < SEQ) ? bf2f(zrow[s0 + 8]) : 0.f;
#pragma unroll
  for (int i = 0; i < 8; ++i) o[i] = z[i] * w0 + z[i + 1] * w1 + z[i + 2] * w2 + cb;
}

struct Conv8In { uint4 v; unsigned short l, r; };
__device__ __forceinline__ void conv8_load(const bf16_t* __restrict__ zrow, int s0, Conv8In& c) {
  c.v = *(const uint4*)(zrow + s0);
  c.l = (s0 > 0) ? zrow[s0 - 1] : (unsigned short)0;
  c.r = (s0 + 8 < SEQ) ? zrow[s0 + 8] : (unsigned short)0;
}
__device__ __forceinline__ void conv8_eval(const Conv8In& c, float w0, float w1, float w2, float cb, float (&o)[8]) {
  float z[10];
  z[0] = bf2f(c.l);
  z[1] = lo2f(c.v.x); z[2] = hi2f(c.v.x); z[3] = lo2f(c.v.y); z[4] = hi2f(c.v.y);
  z[5] = lo2f(c.v.z); z[6] = hi2f(c.v.z); z[7] = lo2f(c.v.w); z[8] = hi2f(c.v.w);
  z[9] = bf2f(c.r);
#pragma unroll
  for (int i = 0; i < 8; ++i) o[i] = z[i] * w0 + z[i + 1] * w1 + z[i + 2] * w2 + cb;
}

typedef short s16x4 __attribute__((ext_vector_type(4)));
__device__ __forceinline__ s16x4 tr_read4(const bf16_t* lds_ptr) {
  return __builtin_amdgcn_ds_read_tr16_b64_v4i16((__attribute__((address_space(3))) s16x4*)(lds_ptr));
}

constexpr int HY_GS_ELEMS = 4112;
constexpr int HY_US_ROWS = 2072;
__device__ __forceinline__ void hyena_load_g(const Params& p, int l, int o, int c, bf16_t* Gs, int tid) {
  const bf16_t* g = p.Gf + ((size_t)((l * 2 + o) * 512 + c)) * 4096;
  *(uint4*)(Gs + 8 + tid * 8) = *(const uint4*)(g + tid * 8);
  if (tid == 0) { unsigned z = 0; asm volatile("" : "+v"(z)); const uint4 z4 = make_uint4(z, z, z, z); *(uint4*)Gs = z4; *(uint4*)(Gs + 4104) = z4; }
}

__device__ __forceinline__ void hyena_kloop(const bf16_t* Gs, const bf16_t* us, int rho, int lane, f32x16 (&acc)[8]) {
#pragma unroll
  for (int a = 0; a < 8; ++a)
#pragma unroll
    for (int j = 0; j < 16; ++j) acc[a][j] = 0.f;
  const int i = lane & 31, hh = lane >> 5;
  const bf16_t* ga = Gs + (2040 - 8 * i + 8 * hh) - 1792;
  const int l16 = lane & 15, q = l16 >> 2, pq = l16 & 3, g4 = lane >> 4;
  const bf16_t* ub = us + (rho + 8 * (g4 >> 1) + q) * 24 + 16 * (g4 & 1) + 4 * pq;
  bf16x8 af[2][8], bf[2];
  auto load_frags = [&](int kap, int buf) {
    const s16x4 b0 = tr_read4(ub + kap * 384);
    const s16x4 b1 = tr_read4(ub + kap * 384 + 96);
    bf[buf][0] = b0[0]; bf[buf][1] = b0[1]; bf[buf][2] = b0[2]; bf[buf][3] = b0[3];
    bf[buf][4] = b1[0]; bf[buf][5] = b1[1]; bf[buf][6] = b1[2]; bf[buf][7] = b1[3];
#pragma unroll
    for (int a = 0; a < 8; ++a) af[buf][a] = *(const bf16x8*)(ga + kap * 16 + 256 * (7 - a));
  };
  load_frags(0, 0);
#pragma unroll 1
  for (int kap = 0; kap < 128; kap += 2) {
    load_frags(kap + 1, 1);
    __builtin_amdgcn_sched_barrier(0);
#pragma unroll
    for (int a = 0; a < 8; ++a) acc[a] = __builtin_amdgcn_mfma_f32_32x32x16_bf16(af[0][a], bf[0], acc[a], 0, 0, 0);
    __builtin_amdgcn_sched_barrier(0);
    load_frags(kap + 2, 0);
    __builtin_amdgcn_sched_barrier(0);
#pragma unroll
    for (int a = 0; a < 8; ++a) acc[a] = __builtin_amdgcn_mfma_f32_32x32x16_bf16(af[1][a], bf[1], acc[a], 0, 0, 0);
    __builtin_amdgcn_sched_barrier(0);
  }
#pragma unroll
  for (int a = 0; a < 8; ++a) acc[a] = __builtin_amdgcn_mfma_f32_32x32x16_bf16(af[0][a], bf[0], acc[a], 0, 0, 0);
}

__device__ __forceinline__ void hyena_acc_to_us(const f32x16 (&acc)[8], bf16_t* us, int rho, int lane) {
  const int n = lane & 31, hh = lane >> 5;
  if (n < 24) {
#pragma unroll
    for (int a = 0; a < 8; ++a)
#pragma unroll
      for (int r = 0; r < 16; ++r) {
        const int t = 256 * a + rho + 8 * ((r & 3) + 8 * (r >> 2) + 4 * hh);
        us[(t + 16) * 24 + n] = f2bf(acc[a][r]);
      }
  }
}

__device__ void hyena_item(const Params& p, int l, int c, char* smem) {
  bf16_t* Gs = (bf16_t*)smem;
  bf16_t* us = (bf16_t*)(smem + 8256);
  const int tid = otid();
  const int lane = tid & 63, w = tid >> 6;
  const float* cw = p.conv_w + (size_t)l * 3 * HYC;
  const float* cbp = p.conv_b + (size_t)l * HYC;
  __syncthreads();
  hyena_load_g(p, l, 0, c, Gs, tid);
  {
    unsigned z = 0; asm volatile("" : "+v"(z)); const uint4 z4 = make_uint4(z, z, z, z);
    if (tid < 48) *(uint4*)(us + tid * 8) = z4;
    else if (tid < 48 + 26) *(uint4*)(us + 2064 * 24 + (tid - 48) * 8) = z4;
  }
  {
    const float w0 = cw[c], w1 = cw[HYC + c], w2 = cw[2 * HYC + c], cb = cbp[c];
#pragma unroll 1
    for (int q0 = tid; q0 < 24 * 256; q0 += 4 * NTHR) {
      Conv8In cin[4];
#pragma unroll
      for (int j = 0; j < 4; ++j) {
        const int qq = q0 + j * NTHR;
        conv8_load(p.zT + ((size_t)(qq % 24) * HYC + c) * SEQ, (qq / 24) * 8, cin[j]);
      }
#pragma unroll
      for (int j = 0; j < 4; ++j) {
        const int qq = q0 + j * NTHR;
        const int b = qq % 24, s0 = (qq / 24) * 8;
        float v[8];
        conv8_eval(cin[j], w0, w1, w2, cb, v);
#pragma unroll
        for (int i = 0; i < 8; ++i) us[(s0 + i + 16) * 24 + b] = f2bf(v[i]);
      }
    }
  }
  __syncthreads();
  f32x16 acc[8];
#pragma unroll 1
  for (int o = 0; o < 2; ++o) {
    hyena_kloop(Gs, us, w, lane, acc);
    __syncthreads();
    hyena_acc_to_us(acc, us, w, lane);
    if (o == 0) hyena_load_g(p, l, 1, c, Gs, tid);
    __syncthreads();
    const int xc = (o == 0 ? 512 : 1024) + c;
    const float xw0 = cw[xc], xw1 = cw[HYC + xc], xw2 = cw[2 * HYC + xc], xcb = cbp[xc];
#pragma unroll 1
    for (int q0 = tid; q0 < 24 * 256; q0 += 4 * NTHR) {
      Conv8In cin[4];
#pragma unroll
      for (int j = 0; j < 4; ++j) {
        const int qq = q0 + j * NTHR;
        conv8_load(p.zT + ((size_t)(qq % 24) * HYC + xc) * SEQ, (qq / 24) * 8, cin[j]);
      }
#pragma unroll
      for (int j = 0; j < 4; ++j) {
        const int qq = q0 + j * NTHR;
        const int b = qq % 24, s0 = (qq / 24) * 8;
        float xv[8];
        conv8_eval(cin[j], xw0, xw1, xw2, xcb, xv);
        if (o == 0) {
#pragma unroll
          for (int i = 0; i < 8; ++i) {
            bf16_t* e = us + (s0 + i + 16) * 24 + b;
            *e = f2bf(bf2f(*e) * xv[i]);
          }
        } else {
          float r[8];
#pragma unroll
          for (int i = 0; i < 8; ++i) r[i] = bf2f(us[(s0 + i + 16) * 24 + b]) * xv[i];
          uint4 pk; pk.x = pack2(r[0], r[1]); pk.y = pack2(r[2], r[3]); pk.z = pack2(r[4], r[5]); pk.w = pack2(r[6], r[7]);
          *(uint4*)(p.yaT + ((size_t)b * HYW + c) * SEQ + s0) = pk;
        }
      }
    }
    __syncthreads();
  }
}

__device__ void attn_item(const Params& p, int l, int item, char* smem) {
  constexpr int KS = 72, VS = 96;
  bf16_t* Ks = (bf16_t*)smem;
  bf16_t* Vs = Ks + 384 * KS;
  const int tid = otid();
  const int lane = tid & 63, w = tid >> 6;
  const int kh = item & 1, qb = (item >> 1) & 15, b = item >> 5;
  const int kpos0 = qb * 128 - 128;
  __syncthreads();
  if (tid < 384) {
    const int r = tid, kpos = kpos0 + r;
    if (kpos >= 0 && kpos < SEQ) {
      const bf16_t* kr = p.zqkv + ((size_t)(b * SEQ + kpos)) * QKVC + 512 + kh * 64;
      float kf[64];
      float ss = 0.f;
#pragma unroll
      for (int c8 = 0; c8 < 8; ++c8) {
        uint4 v = *(const uint4*)(kr + c8 * 8);
        kf[c8 * 8 + 0] = lo2f(v.x); kf[c8 * 8 + 1] = hi2f(v.x); kf[c8 * 8 + 2] = lo2f(v.y); kf[c8 * 8 + 3] = hi2f(v.y);
        kf[c8 * 8 + 4] = lo2f(v.z); kf[c8 * 8 + 5] = hi2f(v.z); kf[c8 * 8 + 6] = lo2f(v.w); kf[c8 * 8 + 7] = hi2f(v.w);
      }
#pragma unroll
      for (int d = 0; d < 64; ++d) ss += kf[d] * kf[d];
      const float rs = rsqrtf(ss * (1.f / 64.f) + 1e-6f);
      const float* kg = p.k_gain + l * 64;
#pragma unroll
      for (int d = 0; d < 64; ++d) kf[d] = kf[d] * rs * kg[d];
      const float* rp = p.rope + (size_t)kpos * 64;
#pragma unroll
      for (int i = 0; i < 32; ++i) {
        const float cs = rp[i * 2], sn = rp[i * 2 + 1];
        const float a = kf[i], bb = kf[i + 32];
        kf[i] = a * cs - bb * sn; kf[i + 32] = bb * cs + a * sn;
      }
#pragma unroll
      for (int c8 = 0; c8 < 8; ++c8) {
        uint4 pk;
        pk.x = pack2(kf[c8 * 8 + 0], kf[c8 * 8 + 1]); pk.y = pack2(kf[c8 * 8 + 2], kf[c8 * 8 + 3]);
        pk.z = pack2(kf[c8 * 8 + 4], kf[c8 * 8 + 5]); pk.w = pack2(kf[c8 * 8 + 6], kf[c8 * 8 + 7]);
        *(uint4*)(Ks + r * KS + c8 * 8) = pk;
      }
    }
  }
#pragma unroll 1
  for (int e = tid; e < 384 * 8; e += NTHR) {
    const int r = e >> 3, c8 = e & 7, kpos = kpos0 + r;
    if (kpos >= 0 && kpos < SEQ)
      *(uint4*)(Vs + r * VS + c8 * 8) = *(const uint4*)(p.zqkv + ((size_t)(b * SEQ + kpos)) * QKVC + 640 + kh * 64 + c8 * 8);
  }
  __syncthreads();
  const int hl = w & 3, qh = w >> 2;
  const int head = kh * 4 + hl;
  const int n = lane & 31, hh = lane >> 5;
  const int Q0 = qb * 128 + 64 * qh;
  bf16x8 qf[2][4];
#pragma unroll
  for (int nt = 0; nt < 2; ++nt) {
    const int qpos = Q0 + 32 * nt + n;
    const bf16_t* qr = p.zqkv + ((size_t)(b * SEQ + qpos)) * QKVC + head * 64;
    float qv[4][8];
    float ss = 0.f;
#pragma unroll
    for (int kk = 0; kk < 4; ++kk) {
      uint4 v = *(const uint4*)(qr + 16 * kk + 8 * hh);
      qv[kk][0] = lo2f(v.x); qv[kk][1] = hi2f(v.x); qv[kk][2] = lo2f(v.y); qv[kk][3] = hi2f(v.y);
      qv[kk][4] = lo2f(v.z); qv[kk][5] = hi2f(v.z); qv[kk][6] = lo2f(v.w); qv[kk][7] = hi2f(v.w);
#pragma unroll
      for (int j = 0; j < 8; ++j) ss += qv[kk][j] * qv[kk][j];
    }
    ss += __shfl_xor(ss, 32, 64);
    const float rs = rsqrtf(ss * (1.f / 64.f) + 1e-6f) * 0.125f;
    const float* qg = p.q_gain + l * 64;
#pragma unroll
    for (int kk = 0; kk < 4; ++kk)
#pragma unroll
      for (int j = 0; j < 8; ++j) qv[kk][j] *= rs * qg[16 * kk + 8 * hh + j];
    const float* rp = p.rope + (size_t)qpos * 64;
#pragma unroll
    for (int kk = 0; kk < 2; ++kk)
#pragma unroll
      for (int j = 0; j < 8; ++j) {
        const int d = 16 * kk + 8 * hh + j;
        const float cs = rp[d * 2], sn = rp[d * 2 + 1];
        const float a = qv[kk][j], bb = qv[kk + 2][j];
        qv[kk][j] = a * cs - bb * sn; qv[kk + 2][j] = bb * cs + a * sn;
      }
#pragma unroll
    for (int kk = 0; kk < 4; ++kk)
#pragma unroll
      for (int j = 0; j < 8; ++j) qf[nt][kk][j] = (short)f2bf(qv[kk][j]);
  }
  f32x16 O[2][2];
#pragma unroll
  for (int dm = 0; dm < 2; ++dm)
#pragma unroll
    for (int nt = 0; nt < 2; ++nt)
#pragma unroll
      for (int r = 0; r < 16; ++r) O[dm][nt][r] = 0.f;
  float mrun[2], lsum[2];
  mrun[0] = mrun[1] = p.sink[l * 8 + head];
  lsum[0] = lsum[1] = (hh == 0) ? 1.f : 0.f;
  const int l16 = lane & 15, tq = l16 >> 2, tp = l16 & 3, g4 = lane >> 4;
  const bf16_t* vbase = Vs + (4 * (g4 >> 1) + tq) * VS + 16 * (g4 & 1) + 4 * tp;
#pragma unroll 1
  for (int kt = 2 * qh; kt < 2 * qh + 10; ++kt) {
    const int kp_t = kpos0 + 32 * kt;
    if (kp_t < 0 || kp_t >= SEQ) continue;
    bf16x8 kfr[4];
#pragma unroll
    for (int kk = 0; kk < 4; ++kk) kfr[kk] = *(const bf16x8*)(Ks + (32 * kt + n) * KS + 16 * kk + 8 * hh);
    bf16x8 pf[2][2];
#pragma unroll
    for (int nt = 0; nt < 2; ++nt) {
      f32x16 S;
#pragma unroll
      for (int r = 0; r < 16; ++r) S[r] = 0.f;
#pragma unroll
      for (int kk = 0; kk < 4; ++kk) S = __builtin_amdgcn_mfma_f32_32x32x16_bf16(kfr[kk], qf[nt][kk], S, 0, 0, 0);
      const int qpos = Q0 + 32 * nt + n;
      float mloc = -INFINITY;
#pragma unroll
      for (int r = 0; r < 16; ++r) {
        const int kpos = kp_t + (r & 3) + 8 * (r >> 2) + 4 * hh;
        int dd = kpos - qpos; dd = dd < 0 ? -dd : dd;
        S[r] = (dd <= 128) ? S[r] : -INFINITY;
        mloc = fmaxf(mloc, S[r]);
      }
      mloc = fmaxf(mloc, __shfl_xor(mloc, 32, 64));
      const float mnew = fmaxf(mrun[nt], mloc);
      const float corr = __expf(mrun[nt] - mnew);
      mrun[nt] = mnew;
      float psum = 0.f;
#pragma unroll
      for (int r = 0; r < 16; ++r) { S[r] = __expf(S[r] - mnew); psum += S[r]; }
      lsum[nt] = lsum[nt] * corr + psum;
#pragma unroll
      for (int dm = 0; dm < 2; ++dm)
#pragma unroll
        for (int r = 0; r < 16; ++r) O[dm][nt][r] *= corr;
#pragma unroll
      for (int s2 = 0; s2 < 2; ++s2)
#pragma unroll
        for (int j = 0; j < 8; ++j) pf[nt][s2][j] = (short)f2bf(S[8 * s2 + j]);
    }
#pragma unroll
    for (int dm = 0; dm < 2; ++dm)
#pragma unroll
      for (int s2 = 0; s2 < 2; ++s2) {
        const bf16_t* vp = vbase + (32 * kt + 16 * s2) * VS + 32 * dm;
        const s16x4 v0 = tr_read4(vp);
        const s16x4 v1 = tr_read4(vp + 8 * VS);
        bf16x8 vf;
        vf[0] = v0[0]; vf[1] = v0[1]; vf[2] = v0[2]; vf[3] = v0[3];
        vf[4] = v1[0]; vf[5] = v1[1]; vf[6] = v1[2]; vf[7] = v1[3];
#pragma unroll
        for (int nt = 0; nt < 2; ++nt) O[dm][nt] = __builtin_amdgcn_mfma_f32_32x32x16_bf16(vf, pf[nt][s2], O[dm][nt], 0, 0, 0);
      }
  }
#pragma unroll
  for (int nt = 0; nt < 2; ++nt) {
    const float ltot = lsum[nt] + __shfl_xor(lsum[nt], 32, 64);
    const float inv = 1.f / ltot;
    const int qpos = Q0 + 32 * nt + n;
    bf16_t* yo = p.yb + ((size_t)(b * SEQ + qpos)) * 512 + head * 64;
#pragma unroll
    for (int dm = 0; dm < 2; ++dm)
#pragma unroll
      for (int g = 0; g < 4; ++g) {
        uint2 o;
        o.x = pack2(O[dm][nt][4 * g + 0] * inv, O[dm][nt][4 * g + 1] * inv);
        o.y = pack2(O[dm][nt][4 * g + 2] * inv, O[dm][nt][4 * g + 3] * inv);
        *(uint2*)(yo + 32 * dm + 8 * g + 4 * hh) = o;
      }
  }
}

typedef float f32x2 __attribute__((ext_vector_type(2)));
__device__ void table_item(const Params& p, int l, int it) {
  const int tid = otid();
  const int lane = tid & 63, w = tid >> 6;
  const int which = it >> 9, r0 = (it & 511) * 32 + w * 4;
  const float* src = (which ? p.peer_v : p.peer_u) + (size_t)l * NEXP * DM;
  unsigned char* dst = which ? p.tabV8 : p.tabU8;
  float* sc = which ? p.sclV : p.sclU;
  float4 v[4][4];
#pragma unroll
  for (int rr = 0; rr < 4; ++rr)
#pragma unroll
    for (int i = 0; i < 4; ++i) v[rr][i] = *(const float4*)(src + (size_t)(r0 + rr) * DM + lane * 4 + 256 * i);
#pragma unroll
  for (int rr = 0; rr < 4; ++rr) {
    const int e = r0 + rr;
    float mx = 0.f;
#pragma unroll
    for (int i = 0; i < 4; ++i)
      mx = fmaxf(mx, fmaxf(fmaxf(fabsf(v[rr][i].x), fabsf(v[rr][i].y)), fmaxf(fabsf(v[rr][i].z), fabsf(v[rr][i].w))));
#pragma unroll
    for (int m = 32; m >= 1; m >>= 1) mx = fmaxf(mx, __shfl_xor(mx, m, 64));
    const float scale = (mx > 0.f) ? 440.f / mx : 1.f;
#pragma unroll
    for (int i = 0; i < 4; ++i) {
      int pk = __builtin_amdgcn_cvt_pk_fp8_f32(v[rr][i].x * scale, v[rr][i].y * scale, 0, false);
      pk = __builtin_amdgcn_cvt_pk_fp8_f32(v[rr][i].z * scale, v[rr][i].w * scale, pk, true);
      const int x = 2 * i + (lane >> 5);
      *(int*)(dst + ((size_t)x * NEXP + e) * 128 + (lane & 31) * 4) = pk;
    }
    if (lane == 0) sc[e] = (mx > 0.f) ? mx * (1.f / 440.f) : 1.f;
  }
}

constexpr int DE_N_HY = 512, DE_N_AT = 768, DE_N_TB = 1024;
__device__ void phase_de(const Params& p, int l, char* smem) {
  for (int it = blockIdx.x; it < DE_N_HY + DE_N_AT + DE_N_TB; it += gridDim.x) {
    if (it < DE_N_HY) hyena_item(p, l, it, smem);
    else if (it < DE_N_HY + DE_N_AT) attn_item(p, l, it - DE_N_HY, smem);
    else table_item(p, l, it - DE_N_HY - DE_N_AT);
  }
}

__device__ void phase_f(const Params& p, int tile, int l, bool from_inputs, char* smem) {
  const int tid = otid();
  const int tok0 = tile * TM;
#pragma unroll 1
  for (int e = tid; e < TM * 64; e += NTHR) {
    const int r = e % TM, cg8 = e / TM;
    const int tok = tok0 + r, b = tok >> 11, sq = tok & 2047;
    const bf16_t* src = p.yaT + ((size_t)b * HYW + cg8 * 8) * SEQ + sq;
    uint4 o;
    o.x = (unsigned)src[0] | ((unsigned)src[SEQ] << 16);
    o.y = (unsigned)src[2 * SEQ] | ((unsigned)src[3 * SEQ] << 16);
    o.z = (unsigned)src[4 * SEQ] | ((unsigned)src[5 * SEQ] << 16);
    o.w = (unsigned)src[6 * SEQ] | ((unsigned)src[7 * SEQ] << 16);
    *(uint4*)(p.yatok + (size_t)tok * HYW + cg8 * 8) = o;
  }
  __syncthreads();
  const bf16_t* Ah = p.hbuf + (size_t)tok0 * DM;
  const bf16_t* Aya = p.yatok + (size_t)tok0 * HYW;
  const bf16_t* Ayb = p.yb + (size_t)tok0 * HYW;
  const bf16_t* Win = p.WinT + (size_t)l * INC * DM;
  const bf16_t* Wpa = p.WpaT + (size_t)l * DM * HYW;
  const bf16_t* Wpb = p.WpbT + (size_t)l * DM * HYW;
  float* ct = (float*)smem;
  f32x16 acc[3][2];
  unsigned sgp[3][2][8];
#pragma unroll 1
  for (int nc = 0; nc < 8; ++nc) {
    gemm_f1<1>(Ah, Ah, DM, Win + (size_t)(2304 + nc * 128) * DM, Win + (size_t)(3328 + nc * 128) * DM, DM, smem, acc);
#pragma unroll
    for (int mi = 0; mi < 3; ++mi)
#pragma unroll
      for (int ni = 0; ni < 2; ++ni)
#pragma unroll
        for (int q = 0; q < 8; ++q)
          sgp[mi][ni][q] = pack2(__builtin_amdgcn_rcpf(1.f + __expf(-acc[mi][ni][2 * q])), __builtin_amdgcn_rcpf(1.f + __expf(-acc[mi][ni][2 * q + 1])));
    gemm_f1<2>(Aya, Ayb, HYW, Wpa + (size_t)(nc * 128) * HYW, Wpb + (size_t)(nc * 128) * HYW, HYW, smem, acc);
    {
      const int tid_ = otid(); const int lane = tid_ & 63, w = tid_ >> 6, wm = w >> 2, wn = w & 3;
      const int n = wn * 32 + (lane & 31);
#pragma unroll
      for (int mi = 0; mi < 3; ++mi)
#pragma unroll
        for (int q = 0; q < 8; ++q) {
          const float m0 = lo2f(sgp[mi][0][q]) * acc[mi][0][2 * q] + lo2f(sgp[mi][1][q]) * acc[mi][1][2 * q];
          const float m1 = hi2f(sgp[mi][0][q]) * acc[mi][0][2 * q + 1] + hi2f(sgp[mi][1][q]) * acc[mi][1][2 * q + 1];
          ct[ACC_ROW(wm, mi, 2 * q, lane) * 132 + n] = m0;
          ct[ACC_ROW(wm, mi, 2 * q + 1, lane) * 132 + n] = m1;
        }
    }
    lds_barrier();
    store_tile_bf16(ct, p.merged, DM, tok0, nc * 128);
  }
  __syncthreads();
  const bf16_t* Am = p.merged + (size_t)tok0 * DM;
  const bf16_t* Wo = p.WoutT + (size_t)l * DM * DM;
  f32x16 acc2[3][2];
#pragma unroll 1
  for (int nt = 0; nt < 4; ++nt) {
    gemm_core2<2>(Am, DM, Wo + (size_t)(nt * 256) * DM, DM, DM, smem, acc2);
#pragma unroll 1
    for (int half = 0; half < 2; ++half) {
      acc_to_lds<2>(acc2, ct, 132, half);
      lds_barrier();
#pragma unroll 1
      for (int it = tid; it < 192 * 32; it += NTHR) {
        const int c4 = it & 31, r = it >> 5;
        const int tok = tok0 + r, b = tok >> 11;
        const int n = nt * 256 + half * 128 + c4 * 4;
        const float4 a = *(const float4*)(ct + r * 132 + c4 * 4);
        const float4 gt = *(const float4*)(p.mod + ((size_t)l * NB + b) * 6144 + 2048 + n);
        const float* xs = from_inputs ? xrow_in(p, tok) : (p.out + (size_t)tok * DM);
        float4 xo = *(const float4*)(xs + n);
        xo.x += gt.x * a.x; xo.y += gt.y * a.y; xo.z += gt.z * a.z; xo.w += gt.w * a.w;
        *(float4*)(p.out + (size_t)tok * DM + n) = xo;
      }
      lds_barrier();
    }
  }
  __syncthreads();
}

__device__ __forceinline__ void sort16_desc(float (&v)[16]) {
#pragma unroll
  for (int k = 2; k <= 16; k <<= 1)
#pragma unroll
    for (int j = k >> 1; j >= 1; j >>= 1)
#pragma unroll
      for (int i = 0; i < 16; ++i) {
        const int l = i ^ j;
        if (l > i) {
          const float hi = fmaxf(v[i], v[l]), lo = fminf(v[i], v[l]);
          if ((i & k) == 0) { v[i] = hi; v[l] = lo; } else { v[i] = lo; v[l] = hi; }
        }
      }
}
__device__ __forceinline__ void merge16_desc(float (&top)[16], const float (&g)[16]) {
#pragma unroll
  for (int i = 0; i < 16; ++i) top[i] = fmaxf(top[i], g[15 - i]);
#pragma unroll
  for (int j = 8; j >= 1; j >>= 1)
#pragma unroll
    for (int i = 0; i < 16; ++i) {
      const int l = i ^ j;
      if (l > i) { const float hi = fmaxf(top[i], top[l]), lo = fminf(top[i], top[l]); top[i] = hi; top[l] = lo; }
    }
}
__device__ __forceinline__ void topk_insert(float (&key)[16], float kx) {
#pragma unroll
  for (int i = 0; i < 16; ++i) {
    const float hi = fmaxf(key[i], kx);
    kx = fminf(key[i], kx);
    key[i] = hi;
  }
}

__device__ void phase_g(const Params& p, int tile, int l, char* smem) {
  norm_rows(p, tile, l, 1, false, smem);
  const int tid = otid();
  const int tok0 = tile * TM;
  const bf16_t* Ah = p.hbuf + (size_t)tok0 * DM;
  const bf16_t* Wc = p.WcT + (size_t)l * 2048 * DM;
  float* sc = (float*)smem;
  f32x16 acc[3][2];
  float v1k[16], v2k[16];
#pragma unroll 1
  for (int ch = 0; ch < 16; ++ch) {
    if ((ch & 1) == 0) gemm_core2<2>(Ah, DM, Wc + (size_t)(ch * 128) * DM, DM, DM, smem, acc);
    acc_to_lds<2>(acc, sc, 129, ch & 1);
    __syncthreads();
    if (tid < TM) {
      float key[16];
      const float* row = sc + tid * 129;
#pragma unroll
      for (int i = 0; i < 16; ++i) key[i] = __uint_as_float((__float_as_uint(row[i]) & 0xFFFFFF80u) | (unsigned)i);
      sort16_desc(key);
#pragma unroll 1
      for (int j0 = 16; j0 < 128; j0 += 16) {
        float g[16];
#pragma unroll
        for (int i = 0; i < 16; ++i) g[i] = __uint_as_float((__float_as_uint(row[j0 + i]) & 0xFFFFFF80u) | (unsigned)(j0 + i));
        sort16_desc(g);
        merge16_desc(key, g);
      }
      if ((ch & 1) == 0) {
#pragma unroll
        for (int i = 0; i < 16; ++i) v1k[i] = key[i];
      } else {
#pragma unroll
        for (int i = 0; i < 16; ++i) v2k[i] = key[i];
        float top[16];
#pragma unroll
        for (int i = 0; i < 16; ++i) top[i] = -INFINITY;
#pragma unroll
        for (int i = 0; i < 16; ++i)
#pragma unroll
          for (int j = 0; j < 16; ++j)
            if ((i + 1) * (j + 1) <= 16) {
              const float s = v1k[i] + v2k[j];
              const float ck = __uint_as_float((__float_as_uint(s) & 0xFFFFFF00u) | (unsigned)(i * 16 + j));
              topk_insert(top, ck);
            }
        const float mx = top[0];
        float ex[16], sum = 0.f;
#pragma unroll
        for (int k = 0; k < 16; ++k) { ex[k] = __expf(top[k] - mx); sum += ex[k]; }
        const float inv = 1.f / sum;
        const int hh = ch >> 1;
        const size_t ob = ((size_t)(tok0 + tid) * 8 + hh) * 16;
#pragma unroll
        for (int k = 0; k < 16; ++k) {
          const unsigned code = __float_as_uint(top[k]) & 0xFFu;
          const unsigned ii = code >> 4, jj = code & 15u;
          unsigned e1 = 0, e2 = 0;
#pragma unroll
          for (int q = 0; q < 16; ++q) {
            e1 = (ii == (unsigned)q) ? (__float_as_uint(v1k[q]) & 0x7Fu) : e1;
            e2 = (jj == (unsigned)q) ? (__float_as_uint(v2k[q]) & 0x7Fu) : e2;
          }
          const unsigned ee = e1 * 128 + e2;
          p.pidx[ob + k] = (unsigned short)ee;
          p.pg[ob + k] = ex[k] * inv * p.sclV[ee];
          p.pgu[ob + k] = p.sclU[ee];
        }
      }
    }
    __syncthreads();
  }
}

__device__ __forceinline__ unsigned xcc_id() { return (unsigned)__builtin_amdgcn_s_getreg((3 << 11) | 20) & 7u; }
__device__ __forceinline__ bool next_slice_item(unsigned* cnt, int& x, int& j, int& tries, char* smem, int tid) {
  int* sh = (int*)(smem + 8192);
  while (tries < 8) {
    __syncthreads();
    if (tid == 0) *sh = (int)atomicAdd(cnt + x, 1u);
    __syncthreads();
    j = *sh;
    if (j < 32) return true;
    x = (x + 1) & 7; ++tries;
  }
  return false;
}
__device__ __forceinline__ float dpp_xor1(float v) { return __builtin_bit_cast(float, __builtin_amdgcn_update_dpp(0, __builtin_bit_cast(int, v), 0xB1, 0xF, 0xF, true)); }
__device__ __forceinline__ float dpp_xor2(float v) { return __builtin_bit_cast(float, __builtin_amdgcn_update_dpp(0, __builtin_bit_cast(int, v), 0x4E, 0xF, 0xF, true)); }
__device__ __forceinline__ float dpp_hmirror(float v) { return __builtin_bit_cast(float, __builtin_amdgcn_update_dpp(0, __builtin_bit_cast(int, v), 0x141, 0xF, 0xF, true)); }
__device__ __forceinline__ float dpp_ror8(float v) { return __builtin_bit_cast(float, __builtin_amdgcn_update_dpp(0, __builtin_bit_cast(int, v), 0x128, 0xF, 0xF, true)); }

struct I1Ctx { uint4 h0, h1, e0, e1; };
__device__ __forceinline__ void i1_load_ctx(const Params& p, int tok, int x, int g, int ch, I1Ctx& c) {
  const bf16_t* hr = p.hbuf + (size_t)tok * DM + x * 128 + ch * 16;
  c.h0 = *(const uint4*)hr; c.h1 = *(const uint4*)(hr + 8);
  const uint4* pi = (const uint4*)(p.pidx + (size_t)tok * 128 + g * 16);
  c.e0 = pi[0]; c.e1 = pi[1];
}
__device__ __forceinline__ void peer_issue_rows(const unsigned char* Tx, const uint4& e0, const uint4& e1, uint4 (&rows)[16]) {
  const unsigned ew[8] = {e0.x, e0.y, e0.z, e0.w, e1.x, e1.y, e1.z, e1.w};
#pragma unroll
  for (int rd = 0; rd < 16; ++rd) {
    const unsigned e = (ew[rd >> 1] >> (16 * (rd & 1))) & 0x3FFFu;
    rows[rd] = *(const uint4*)(Tx + (size_t)e * 128);
  }
}
__device__ __forceinline__ void i1_compute(const I1Ctx& c, const uint4 (&rows)[16], float* dst, int ch) {
  f32x2 hs[8];
  hs[0][0] = lo2f(c.h0.x); hs[0][1] = hi2f(c.h0.x); hs[1][0] = lo2f(c.h0.y); hs[1][1] = hi2f(c.h0.y);
  hs[2][0] = lo2f(c.h0.z); hs[2][1] = hi2f(c.h0.z); hs[3][0] = lo2f(c.h0.w); hs[3][1] = hi2f(c.h0.w);
  hs[4][0] = lo2f(c.h1.x); hs[4][1] = hi2f(c.h1.x); hs[5][0] = lo2f(c.h1.y); hs[5][1] = hi2f(c.h1.y);
  hs[6][0] = lo2f(c.h1.z); hs[6][1] = hi2f(c.h1.z); hs[7][0] = lo2f(c.h1.w); hs[7][1] = hi2f(c.h1.w);
  float res[16];
#pragma unroll
  for (int rd = 0; rd < 16; ++rd) {
    const unsigned wd[4] = {rows[rd].x, rows[rd].y, rows[rd].z, rows[rd].w};
    f32x2 acc2 = {0.f, 0.f};
#pragma unroll
    for (int q = 0; q < 4; ++q) {
      acc2 += __builtin_amdgcn_cvt_pk_f32_fp8((int)wd[q], false) * hs[2 * q];
      acc2 += __builtin_amdgcn_cvt_pk_f32_fp8((int)wd[q], true) * hs[2 * q + 1];
    }
    float d = acc2[0] + acc2[1];
    d += dpp_xor1(d); d += dpp_xor2(d); d += dpp_hmirror(d);
    res[rd] = d;
  }
  if (ch == 0) {
    float4* o = (float4*)dst;
    o[0] = make_float4(res[0], res[1], res[2], res[3]); o[1] = make_float4(res[4], res[5], res[6], res[7]);
    o[2] = make_float4(res[8], res[9], res[10], res[11]); o[3] = make_float4(res[12], res[13], res[14], res[15]);
  }
}

__device__ void phase_i1(const Params& p, int pass, char* smem) {
  const int tid = otid();
  const int lane = tid & 63, w = tid >> 6;
  const int g = lane >> 3, ch = lane & 7;
  int x = (int)xcc_id(), j = 0, tries = 0;
  while (next_slice_item(p.wq + pass * 8, x, j, tries, smem, tid)) {
    const unsigned char* Ux = p.tabU8 + (size_t)x * NEXP * 128 + ch * 16;
    float* ap = p.apart + (size_t)x * NTOK * 128 + g * 16;
    const int tokb = j * 1536 + w;
    I1Ctx c0, c1, c2;
    uint4 rowsA[16], rowsB[16];
    i1_load_ctx(p, tokb, x, g, ch, c0);
    i1_load_ctx(p, tokb + 8, x, g, ch, c1);
    i1_load_ctx(p, tokb + 16, x, g, ch, c2);
    peer_issue_rows(Ux, c0.e0, c0.e1, rowsA);
#pragma unroll 1
    for (int i = 0; i < 192; i += 2) {
      I1Ctx c3, c4;
      peer_issue_rows(Ux, c1.e0, c1.e1, rowsB);
      i1_load_ctx(p, tokb + 8 * min(i + 3, 191), x, g, ch, c3);
      i1_compute(c0, rowsA, ap + (size_t)(tokb + 8 * i) * 128, ch);
      peer_issue_rows(Ux, c2.e0, c2.e1, rowsA);
      i1_load_ctx(p, tokb + 8 * min(i + 4, 191), x, g, ch, c4);
      i1_compute(c1, rowsB, ap + (size_t)(tokb + 8 * (i + 1)) * 128, ch);
      c0 = c2; c1 = c3; c2 = c4;
    }
  }
}

__device__ void phase_w(const Params& p) {
  const int tid = otid();
  const size_t npair8 = (size_t)NTOK * 128 / 8;
  for (size_t q8 = (size_t)blockIdx.x * NTHR + tid; q8 < npair8; q8 += (size_t)gridDim.x * NTHR) {
    const size_t q = q8 * 8;
    float a[8];
#pragma unroll
    for (int i = 0; i < 8; ++i) a[i] = 0.f;
#pragma unroll
    for (int xx = 0; xx < 8; ++xx) {
      const float4 v0 = *(const float4*)(p.apart + (size_t)xx * NTOK * 128 + q);
      const float4 v1 = *(const float4*)(p.apart + (size_t)xx * NTOK * 128 + q + 4);
      a[0] += v0.x; a[1] += v0.y; a[2] += v0.z; a[3] += v0.w; a[4] += v1.x; a[5] += v1.y; a[6] += v1.z; a[7] += v1.w;
    }
    const float4 u0 = *(const float4*)(p.pgu + q), u1 = *(const float4*)(p.pgu + q + 4);
    const float4 g0 = *(const float4*)(p.pg + q), g1 = *(const float4*)(p.pg + q + 4);
    const float su[8] = {u0.x, u0.y, u0.z, u0.w, u1.x, u1.y, u1.z, u1.w};
    const float sg[8] = {g0.x, g0.y, g0.z, g0.w, g1.x, g1.y, g1.z, g1.w};
    float wv[8];
#pragma unroll
    for (int i = 0; i < 8; ++i) {
      const float av = a[i] * su[i];
      wv[i] = sg[i] * 0.5f * av * (1.f + erff(av * 0.70710678118654752f));
    }
    uint4 o; o.x = pack2(wv[0], wv[1]); o.y = pack2(wv[2], wv[3]); o.z = pack2(wv[4], wv[5]); o.w = pack2(wv[6], wv[7]);
    *(uint4*)(p.wbuf + q) = o;
  }
}

struct I2Ctx { uint4 e0, e1, w0, w1; };
__device__ __forceinline__ void i2_load_ctx(const Params& p, int tok, int g, I2Ctx& c) {
  const uint4* pi = (const uint4*)(p.pidx + (size_t)tok * 128 + g * 16);
  c.e0 = pi[0]; c.e1 = pi[1];
  const uint4* pw = (const uint4*)(p.wbuf + (size_t)tok * 128 + g * 16);
  c.w0 = pw[0]; c.w1 = pw[1];
}
__device__ __forceinline__ void i2_compute(const Params& p, const I2Ctx& c, const uint4 (&rows)[16], int tok, int l,
                                           int x, int g, int ch) {
  const unsigned ww[8] = {c.w0.x, c.w0.y, c.w0.z, c.w0.w, c.w1.x, c.w1.y, c.w1.z, c.w1.w};
  f32x2 acc[8];
#pragma unroll
  for (int i = 0; i < 8; ++i) acc[i] = f32x2{0.f, 0.f};
#pragma unroll
  for (int rd = 0; rd < 16; ++rd) {
    const unsigned wd[4] = {rows[rd].x, rows[rd].y, rows[rd].z, rows[rd].w};
    const float wsc = (rd & 1) ? hi2f(ww[rd >> 1]) : lo2f(ww[rd >> 1]);
    const f32x2 sw = {wsc, wsc};
#pragma unroll
    for (int q = 0; q < 4; ++q) {
      acc[2 * q] += sw * __builtin_amdgcn_cvt_pk_f32_fp8((int)wd[q], false);
      acc[2 * q + 1] += sw * __builtin_amdgcn_cvt_pk_f32_fp8((int)wd[q], true);
    }
  }
  float r[16];
#pragma unroll
  for (int i = 0; i < 8; ++i) { r[2 * i] = acc[i][0]; r[2 * i + 1] = acc[i][1]; }
#pragma unroll
  for (int i = 0; i < 16; ++i) {
    r[i] += dpp_ror8(r[i]); r[i] += __shfl_xor(r[i], 16, 64); r[i] += __shfl_xor(r[i], 32, 64);
  }
  if (g == 0) {
    const int b = tok >> 11;
    const int col = x * 128 + ch * 16;
    const float* gt = p.mod + ((size_t)l * NB + b) * 6144 + 5 * 1024 + col;
    float* xo = p.out + (size_t)tok * DM + col;
#pragma unroll
    for (int q = 0; q < 4; ++q) {
      float4 xv = *(const float4*)(xo + 4 * q);
      const float4 gv = *(const float4*)(gt + 4 * q);
      xv.x += gv.x * r[4 * q]; xv.y += gv.y * r[4 * q + 1]; xv.z += gv.z * r[4 * q + 2]; xv.w += gv.w * r[4 * q + 3];
      *(float4*)(xo + 4 * q) = xv;
    }
  }
}

__device__ void phase_i2(const Params& p, int l, int pass, char* smem) {
  const int tid = otid();
  const int lane = tid & 63, w = tid >> 6;
  const int g = lane >> 3, ch = lane & 7;
  int x = (int)xcc_id(), j = 0, tries = 0;
  while (next_slice_item(p.wq + pass * 8, x, j, tries, smem, tid)) {
    const unsigned char* Vx = p.tabV8 + (size_t)x * NEXP * 128 + ch * 16;
    const int tokb = j * 1536 + w;
    I2Ctx c0, c1, c2;
    uint4 rowsA[16], rowsB[16];
    i2_load_ctx(p, tokb, g, c0);
    i2_load_ctx(p, tokb + 8, g, c1);
    i2_load_ctx(p, tokb + 16, g, c2);
    peer_issue_rows(Vx, c0.e0, c0.e1, rowsA);
#pragma unroll 1
    for (int i = 0; i < 192; i += 2) {
      I2Ctx c3, c4;
      peer_issue_rows(Vx, c1.e0, c1.e1, rowsB);
      i2_load_ctx(p, tokb + 8 * min(i + 3, 191), g, c3);
      i2_compute(p, c0, rowsA, tokb + 8 * i, l, x, g, ch);
      peer_issue_rows(Vx, c2.e0, c2.e1, rowsA);
      i2_load_ctx(p, tokb + 8 * min(i + 4, 191), g, c4);
      i2_compute(p, c1, rowsB, tokb + 8 * (i + 1), l, x, g, ch);
      c0 = c2; c1 = c3; c2 = c4;
    }
  }
}

__device__ __forceinline__ void grid_bar(unsigned* cnt, unsigned& epoch) {
  ++epoch;
  const unsigned target = epoch * gridDim.x;
  __syncthreads();
  if (threadIdx.x == 0) {
    __builtin_amdgcn_fence(__ATOMIC_RELEASE, "agent");
    asm volatile("s_waitcnt vmcnt(0)" ::: "memory");
    __hip_atomic_fetch_add(cnt, 1u, __ATOMIC_RELAXED, __HIP_MEMORY_SCOPE_AGENT);
    while (__hip_atomic_load(cnt, __ATOMIC_RELAXED, __HIP_MEMORY_SCOPE_AGENT) < target) __builtin_amdgcn_s_sleep(1);
    __builtin_amdgcn_fence(__ATOMIC_ACQUIRE, "agent");
    asm volatile("s_waitcnt vmcnt(0)" ::: "memory");
  }
  __syncthreads();
}

__global__ void __launch_bounds__(NTHR) mega_kernel(Params p) {
  extern __shared__ __attribute__((aligned(16))) char smem[];
  cg::grid_group grid = cg::this_grid();
  unsigned epoch = 0;
  for (int rep = 0; rep < REP_P0; ++rep) phase_p0(p, smem);
  grid.sync();
  for (int l = 0; l < 2; ++l) {
    for (int rep = 0; rep < REP_C; ++rep)
    for (int tile = blockIdx.x; tile < NTILE; tile += gridDim.x) phase_c(p, tile, l, l == 0, smem);
    grid_bar(p.wq + 64, epoch);
    for (int rep = 0; rep < REP_DE; ++rep) phase_de(p, l, smem);
    grid_bar(p.wq + 64, epoch);
    for (int tile = blockIdx.x; tile < NTILE; tile += gridDim.x) {
      phase_f(p, tile, l, l == 0, smem);
      for (int rep = 0; rep < REP_G; ++rep) phase_g(p, tile, l, smem);
    }
    grid_bar(p.wq + 64, epoch);
    phase_i1(p, 2 * l, smem);
    grid_bar(p.wq + 64, epoch);
    phase_w(p);
    grid_bar(p.wq + 64, epoch);
    phase_i2(p, l, 2 * l + 1, smem);
    if (l == 0) grid_bar(p.wq + 64, epoch);
  }
}

extern "C" void kernel_launch(void* const* d_in, const int* in_sizes, int n_in, void* d_out, int out_size, void* d_ws,
                              size_t ws_size, hipStream_t stream) {
  Params p{};
  const float* const* in = (const float* const*)d_in;
  p.x_prompt = in[0]; p.x_sample = in[1]; p.c_prompt = in[2]; p.c_sample = in[3]; p.w_mod = in[4]; p.b_mod = in[5];
  p.g1 = in[6]; p.g2 = in[7]; p.w_in = in[8]; p.conv_w = in[9]; p.conv_b = in[10]; p.f_w1 = in[11]; p.f_b1 = in[12];
  p.f_freq = in[13]; p.f_w2 = in[14]; p.f_b2 = in[15]; p.f_w3 = in[16]; p.f_bias = in[17]; p.q_gain = in[18];
  p.k_gain = in[19]; p.sink = in[20]; p.w_pa = in[21]; p.w_pb = in[22]; p.w_out = in[23]; p.peer_wq = in[24];
  p.peer_k1 = in[25]; p.peer_k2 = in[26]; p.peer_u = in[27]; p.peer_v = in[28];
  p.out = (float*)d_out;
  char* ws = (char*)d_ws;
  size_t off = 0;
  auto carve = [&](size_t bytes) { char* r = ws + off; off += (bytes + 255) & ~(size_t)255; return r; };
  p.WinT = (bf16_t*)carve((size_t)2 * INC * DM * 2);
  p.WpaT = (bf16_t*)carve((size_t)2 * DM * HYW * 2);
  p.WpbT = (bf16_t*)carve((size_t)2 * DM * HYW * 2);
  p.WoutT = (bf16_t*)carve((size_t)2 * DM * DM * 2);
  p.WcT = (bf16_t*)carve((size_t)2 * 2048 * DM * 2);
  p.Gf = (bf16_t*)carve((size_t)2 * 2 * 512 * 4096 * 2);
  p.mod = (float*)carve((size_t)2 * NB * 6144 * 4);
  p.rope = (float*)carve((size_t)SEQ * 64 * 4);
  p.tabU8 = (unsigned char*)carve((size_t)NEXP * DM);
  p.tabV8 = (unsigned char*)carve((size_t)NEXP * DM);
  p.sclU = (float*)carve((size_t)NEXP * 4);
  p.sclV = (float*)carve((size_t)NEXP * 4);
  p.wq = (unsigned*)carve(1024);
  p.zT = (bf16_t*)carve((size_t)NB * HYC * SEQ * 2);
  p.yaT = (bf16_t*)carve((size_t)NTOK * HYW * 2);
  p.yb = (bf16_t*)carve((size_t)NTOK * HYW * 2);
  p.zqkv = (bf16_t*)carve((size_t)NTOK * QKVC * 2);
  p.hbuf = (bf16_t*)carve((size_t)NTOK * DM * 2);
  p.merged = p.zT;
  p.yatok = p.zT + (size_t)NTOK * DM;
  p.apart = (float*)p.zT;
  p.pidx = (unsigned short*)p.zqkv;
  p.pg = (float*)(p.zqkv + (size_t)NTOK * 128);
  p.pgu = p.pg + (size_t)NTOK * 128;
  p.wbuf = (bf16_t*)(p.pgu + (size_t)NTOK * 128);
  if (off > ws_size) fprintf(stderr, "workspace too small: need %zu have %zu\n", off, ws_size);

  static int grid_blocks = 0;
  if (!grid_blocks) {
    int dev = 0, cus = 0, per_cu = 0;
    hipGetDevice(&dev);
    hipDeviceGetAttribute(&cus, hipDeviceAttributeMultiprocessorCount, dev);
    hipFuncSetAttribute((const void*)mega_kernel, hipFuncAttributeMaxDynamicSharedMemorySize, SMEM_BYTES);
    hipOccupancyMaxActiveBlocksPerMultiprocessor(&per_cu, mega_kernel, NTHR, SMEM_BYTES);
    if (per_cu < 1) per_cu = 1;
    grid_blocks = cus * 1;
    if (grid_blocks > NTILE) grid_blocks = NTILE;
  }
  void* args[] = {&p};
  hipError_t e = hipLaunchCooperativeKernel((const void*)mega_kernel, dim3(grid_blocks), dim3(NTHR), args, SMEM_BYTES, stream);
  if (e != hipSuccess) fprintf(stderr, "cooperative launch failed: %s (grid %d)\n", hipGetErrorString(e), grid_blocks);
}
```

```cpp
#include <hip/hip_runtime.h>
#include <hip/hip_bf16.h>
#include <hip/hip_cooperative_groups.h>
#include <cstdio>
#include <cstdint>
namespace cg = cooperative_groups;

typedef unsigned short bf16_t;
using bf16x8 = __attribute__((ext_vector_type(8))) short;
using f32x16 = __attribute__((ext_vector_type(16))) float;

constexpr int DM = 1024;
constexpr int NB = 24;
constexpr int SEQ = 2048;
constexpr int NTOK = NB * SEQ;
constexpr int NBP = 16;
constexpr int INC = 4352;
constexpr int HYC = 1536;
constexpr int HYW = 512;
constexpr int QKVC = 768;
constexpr int TM = 192;
constexpr int NTILE = NTOK / TM;
constexpr int NTHR = 512;
constexpr int NEXP = 16384;
constexpr int SMEM_BYTES = 155648;
constexpr int I_TOK = 384;
constexpr int I_NJ = NTOK / I_TOK;
constexpr int I_TW = I_TOK / 8;
#ifndef REP_DE
#define REP_DE 1
#endif
#ifndef REP_C
#define REP_C 1
#endif
#ifndef REP_G
#define REP_G 1
#endif
#ifndef REP_I1
#define REP_I1 1
#endif
#ifndef REP_P0
#define REP_P0 1
#endif

struct Params {
  const float *x_prompt, *x_sample, *c_prompt, *c_sample, *w_mod, *b_mod, *g1, *g2, *w_in, *conv_w, *conv_b;
  const float *f_w1, *f_b1, *f_freq, *f_w2, *f_b2, *f_w3, *f_bias, *q_gain, *k_gain, *sink, *w_pa, *w_pb, *w_out;
  const float *peer_wq, *peer_k1, *peer_k2, *peer_u, *peer_v;
  float* out;
  bf16_t *WinT, *WpaT, *WpbT, *WoutT, *WcT, *Gf, *zT, *zqkv, *yaT, *yb, *hbuf, *merged, *yatok;
  unsigned char *tabU8, *tabV8;
  unsigned short* pidx;
  bf16_t* wbuf;
  float *pg, *pgu, *mod, *rope, *sclU, *sclV, *apart;
  unsigned* wq;
};

__device__ __forceinline__ float bf2f(bf16_t v) { return __uint_as_float(((unsigned)v) << 16); }
__device__ __forceinline__ bf16_t f2bf(float f) {
  unsigned u = __float_as_uint(f);
  u += 0x7FFFu + ((u >> 16) & 1u);
  return (bf16_t)(u >> 16);
}
__device__ __forceinline__ unsigned pack2(float a, float b) { return (unsigned)f2bf(a) | ((unsigned)f2bf(b) << 16); }
__device__ __forceinline__ float lo2f(unsigned u) { return __uint_as_float(u << 16); }
__device__ __forceinline__ float hi2f(unsigned u) { return __uint_as_float(u & 0xFFFF0000u); }

__device__ __forceinline__ int otid() { int t = threadIdx.x; asm volatile("" : "+v"(t)); return t; }
__device__ __forceinline__ int osgpr(int x) { asm volatile("" : "+s"(x)); return x; }
__device__ __forceinline__ void lds_barrier() { asm volatile("s_waitcnt lgkmcnt(0)\n\ts_barrier" ::: "memory"); }
__device__ __forceinline__ float wave_sum(float v) {
#pragma unroll
  for (int m = 32; m >= 1; m >>= 1) v += __shfl_xor(v, m, 64);
  return v;
}

__device__ __forceinline__ const float* xrow_in(const Params& p, int tok) {
  return (tok < NBP * SEQ) ? (p.x_prompt + (size_t)tok * DM) : (p.x_sample + (size_t)(tok - NBP * SEQ) * DM);
}
__device__ __forceinline__ const float* crow(const Params& p, int b) {
  return (b < NBP) ? (p.c_prompt + (size_t)b * DM) : (p.c_sample + (size_t)(b - NBP) * DM);
}

__device__ __forceinline__ void glds16(const bf16_t* g, char* l) {
  __builtin_amdgcn_global_load_lds((const __attribute__((address_space(1))) void*)g, (__attribute__((address_space(3))) void*)l, 16, 0, 0);
}
template <int NT>
__device__ __forceinline__ void gemm_core2(const bf16_t* __restrict__ A, int lda, const bf16_t* __restrict__ B, int ldb,
                                           int K, char* lds, f32x16 (&acc)[3][NT]) {
  constexpr int BROWS = 128 * NT;
  constexpr int STAGE = (192 + BROWS) * 128;
  const int tid = otid();
  const int lane = tid & 63, w = tid >> 6;
  const int wm = w >> 2, wn = w & 3;
#pragma unroll
  for (int i = 0; i < 3; ++i)
#pragma unroll
    for (int n = 0; n < NT; ++n)
#pragma unroll
      for (int j = 0; j < 16; ++j) acc[i][n][j] = 0.f;
  const int lr = lane >> 3, lc = lane & 7;
  const bf16_t* pa[3];
  const bf16_t* pb[2 * NT];
#pragma unroll
  for (int i = 0; i < 3; ++i) {
    const int row = (w + 8 * i) * 8 + lr;
    pa[i] = A + (size_t)row * lda + ((lc ^ ((row >> 1) & 7)) * 8);
  }
#pragma unroll
  for (int i = 0; i < 2 * NT; ++i) {
    const int row = (w + 8 * i) * 8 + lr;
    pb[i] = B + (size_t)row * ldb + ((lc ^ ((row >> 1) & 7)) * 8);
  }
  const int nk = K >> 6;
  lds_barrier();
  {
#pragma unroll
    for (int i = 0; i < 3; ++i) glds16(pa[i], lds + (w + 8 * i) * 1024);
#pragma unroll
    for (int i = 0; i < 2 * NT; ++i) glds16(pb[i], lds + 192 * 128 + (w + 8 * i) * 1024);
  }
  asm volatile("s_waitcnt vmcnt(0)" ::: "memory");
  __syncthreads();
  const int fr = lane & 31, hh = lane >> 5;
  int aoff[3], akey[3], boff[NT], bkey[NT];
#pragma unroll
  for (int mi = 0; mi < 3; ++mi) { const int r = wm * 96 + mi * 32 + fr; aoff[mi] = r * 128; akey[mi] = (r >> 1) & 7; }
#pragma unroll
  for (int ni = 0; ni < NT; ++ni) { const int r = wn * 32 * NT + ni * 32 + fr; boff[ni] = 192 * 128 + r * 128; bkey[ni] = (r >> 1) & 7; }
#pragma unroll 1
  for (int kt = 0; kt < nk; ++kt) {
    if (kt + 1 < nk) {
      char* sb = lds + ((kt + 1) & 1) * STAGE;
      const int ko = (kt + 1) << 6;
#pragma unroll
      for (int i = 0; i < 3; ++i) glds16(pa[i] + ko, sb + (w + 8 * i) * 1024);
#pragma unroll
      for (int i = 0; i < 2 * NT; ++i) glds16(pb[i] + ko, sb + 192 * 128 + (w + 8 * i) * 1024);
    }
    const char* st = lds + (kt & 1) * STAGE;
    bf16x8 afr[2][3], bfr[2][NT];
#pragma unroll
    for (int ni = 0; ni < NT; ++ni) bfr[0][ni] = *(const bf16x8*)(st + boff[ni] + ((hh ^ bkey[ni]) << 4));
#pragma unroll
    for (int mi = 0; mi < 3; ++mi) afr[0][mi] = *(const bf16x8*)(st + aoff[mi] + ((hh ^ akey[mi]) << 4));
#pragma unroll
    for (int kk = 0; kk < 4; ++kk) {
      const int cur = kk & 1, nxt = cur ^ 1;
      if (kk < 3) {
        const int kc = 2 * (kk + 1) + hh;
#pragma unroll
        for (int ni = 0; ni < NT; ++ni) bfr[nxt][ni] = *(const bf16x8*)(st + boff[ni] + ((kc ^ bkey[ni]) << 4));
#pragma unroll
        for (int mi = 0; mi < 3; ++mi) afr[nxt][mi] = *(const bf16x8*)(st + aoff[mi] + ((kc ^ akey[mi]) << 4));
      }
      __builtin_amdgcn_sched_barrier(0);
#pragma unroll
      for (int mi = 0; mi < 3; ++mi)
#pragma unroll
        for (int ni = 0; ni < NT; ++ni) acc[mi][ni] = __builtin_amdgcn_mfma_f32_32x32x16_bf16(afr[cur][mi], bfr[cur][ni], acc[mi][ni], 0, 0, 0);
      __builtin_amdgcn_sched_barrier(0);
    }
    asm volatile("s_waitcnt vmcnt(0)" ::: "memory");
    __syncthreads();
  }
}
template <int MODE>
__device__ __forceinline__ void gemm_f1(const bf16_t* __restrict__ A0, const bf16_t* __restrict__ A1, int lda,
                                        const bf16_t* __restrict__ B0, const bf16_t* __restrict__ B1, int ldb,
                                        char* lds, f32x16 (&acc)[3][2]) {
  constexpr int STAGE = (192 + 256) * 128;
  const int tid = otid();
  const int lane = tid & 63, w = tid >> 6;
  const int wm = w >> 2, wn = w & 3;
#pragma unroll
  for (int i = 0; i < 3; ++i)
#pragma unroll
    for (int n = 0; n < 2; ++n)
#pragma unroll
      for (int j = 0; j < 16; ++j) acc[i][n][j] = 0.f;
  const int lr = lane >> 3, lc = lane & 7;
  const bool hi = (w >= 4);
  int aofs[3];
  const bf16_t* pb[4];
#pragma unroll
  for (int i = 0; i < 3; ++i) {
    const int row = (w + 8 * i) * 8 + lr;
    aofs[i] = row * lda + ((lc ^ ((row >> 1) & 7)) * 8);
  }
#pragma unroll
  for (int i = 0; i < 4; ++i) {
    const int rb = (w + 8 * i) * 8 + lr;
    const int srow = i * 32 + (w & 3) * 8 + lr;
    pb[i] = (hi ? B1 : B0) + (size_t)srow * ldb + ((lc ^ ((rb >> 1) & 7)) * 8);
  }
  constexpr int NK = 16;
  auto issue = [&](int kt) {
    char* sb = lds + (kt & 1) * STAGE;
    const bf16_t* Ab = (MODE == 2 && kt >= 8) ? A1 : A0;
    const int ka = (MODE == 2) ? ((kt & 7) << 6) : (kt << 6);
#pragma unroll
    for (int i = 0; i < 3; ++i) glds16(Ab + aofs[i] + ka, sb + (w + 8 * i) * 1024);
    if (MODE == 1 || ((kt >= 8) == hi)) {
#pragma unroll
      for (int i = 0; i < 4; ++i) glds16(pb[i] + ka, sb + 192 * 128 + (w + 8 * i) * 1024);
    }
  };
  lds_barrier();
  issue(0);
  asm volatile("s_waitcnt vmcnt(0)" ::: "memory");
  __syncthreads();
  const int fr = lane & 31, hh = lane >> 5;
  int aoff[3], akey[3], boff[2], bkey[2];
#pragma unroll
  for (int mi = 0; mi < 3; ++mi) { const int r = wm * 96 + mi * 32 + fr; aoff[mi] = r * 128; akey[mi] = (r >> 1) & 7; }
#pragma unroll
  for (int ni = 0; ni < 2; ++ni) { const int r = wn * 64 + ni * 32 + fr; boff[ni] = 192 * 128 + r * 128; bkey[ni] = (r >> 1) & 7; }
#pragma unroll
  for (int hf = 0; hf < 2; ++hf) {
#pragma unroll 1
    for (int kt = hf * 8; kt < hf * 8 + 8; ++kt) {
      if (kt + 1 < NK) issue(kt + 1);
      const char* st = lds + (kt & 1) * STAGE;
#pragma unroll
      for (int kk = 0; kk < 4; ++kk) {
        const int kc = 2 * kk + hh;
        bf16x8 bfr[2];
#pragma unroll
        for (int ni = 0; ni < 2; ++ni) if (MODE == 1 || ni == hf) bfr[ni] = *(const bf16x8*)(st + boff[ni] + ((kc ^ bkey[ni]) << 4));
#pragma unroll
        for (int mi = 0; mi < 3; ++mi) {
          const bf16x8 afr = *(const bf16x8*)(st + aoff[mi] + ((kc ^ akey[mi]) << 4));
#pragma unroll
          for (int ni = 0; ni < 2; ++ni)
            if (MODE == 1 || ni == hf) acc[mi][ni] = __builtin_amdgcn_mfma_f32_32x32x16_bf16(afr, bfr[ni], acc[mi][ni], 0, 0, 0);
        }
      }
      asm volatile("s_waitcnt vmcnt(0)" ::: "memory");
      __syncthreads();
    }
  }
}

#define ACC_ROW(wm, mi, reg, lane) ((wm) * 96 + (mi) * 32 + ((reg) & 3) + 8 * ((reg) >> 2) + 4 * ((lane) >> 5))

template <int NT>
__device__ __forceinline__ void acc_to_lds(const f32x16 (&acc)[3][NT], float* ct, int LD, int half) {
  const int tid_ = otid(); const int lane = tid_ & 63, w = tid_ >> 6, wm = w >> 2, wn = w & 3;
  if (NT == 2 && (wn >> 1) != half) return;
#pragma unroll
  for (int ni = 0; ni < NT; ++ni) {
    const int n = (NT == 2 ? (wn & 1) * 64 : wn * 32) + ni * 32 + (lane & 31);
#pragma unroll
    for (int mi = 0; mi < 3; ++mi)
#pragma unroll
      for (int r = 0; r < 16; ++r) ct[ACC_ROW(wm, mi, r, lane) * LD + n] = acc[mi][ni][r];
  }
}
constexpr int LDT = 196;
template <int NT>
__device__ __forceinline__ void acc_to_lds_T(const f32x16 (&acc)[3][NT], float* ctT, int half) {
  const int tid_ = otid(); const int lane = tid_ & 63, w = tid_ >> 6, wm = w >> 2, wn = w & 3;
  if (NT == 2 && (wn >> 1) != half) return;
#pragma unroll
  for (int ni = 0; ni < NT; ++ni) {
    const int n = (NT == 2 ? (wn & 1) * 64 : wn * 32) + ni * 32 + (lane & 31);
#pragma unroll
    for (int mi = 0; mi < 3; ++mi)
#pragma unroll
      for (int g4 = 0; g4 < 4; ++g4) {
        const int r0 = wm * 96 + mi * 32 + 8 * g4 + 4 * (lane >> 5);
        float4 v; v.x = acc[mi][ni][g4 * 4 + 0]; v.y = acc[mi][ni][g4 * 4 + 1]; v.z = acc[mi][ni][g4 * 4 + 2]; v.w = acc[mi][ni][g4 * 4 + 3];
        *(float4*)(ctT + n * LDT + r0) = v;
      }
  }
}
__device__ __forceinline__ void store_tile_bf16(const float* ct, bf16_t* dst, int ldd, int tok0, int n0) {
#pragma unroll 1
  for (int it = otid(); it < 192 * 16; it += NTHR) {
    const int c8 = it & 15, r = it >> 4;
    const float4 a = *(const float4*)(ct + r * 132 + c8 * 8), b = *(const float4*)(ct + r * 132 + c8 * 8 + 4);
    uint4 o; o.x = pack2(a.x, a.y); o.y = pack2(a.z, a.w); o.z = pack2(b.x, b.y); o.w = pack2(b.z, b.w);
    *(uint4*)(dst + (size_t)(tok0 + r) * ldd + n0 + c8 * 8) = o;
  }
}

__device__ void p0_transpose_tile(const float* __restrict__ src, bf16_t* __restrict__ dst, int R, int C, int tr, int tc, char* smem) {
  float* t = (float*)smem;
  const int tid = otid();
  __syncthreads();
#pragma unroll
  for (int i = 0; i < 8; ++i) {
    int r = (tid >> 6) + 8 * i, c = tid & 63;
    t[r * 65 + c] = src[(size_t)(tr * 64 + r) * C + tc * 64 + c];
  }
  __syncthreads();
#pragma unroll
  for (int i = 0; i < 8; ++i) {
    int cc = (tid >> 6) + 8 * i, rr = tid & 63;
    dst[(size_t)(tc * 64 + cc) * R + tr * 64 + rr] = f2bf(t[rr * 65 + cc]);
  }
}

__device__ void p0_wc_item(const Params& p, int l, int ph, int kt, char* smem) {
  float* wqs = (float*)smem;
  float* ks = wqs + 64 * 129;
  const int tid = otid();
  const float* wq = p.peer_wq + (size_t)l * DM * 2048;
  const float* kk = ((ph & 1) ? p.peer_k2 : p.peer_k1) + (size_t)l * 128 * 128;
  __syncthreads();
  for (int e = tid; e < 64 * 128; e += NTHR) {
    int r = e >> 7, d = e & 127;
    wqs[r * 129 + d] = wq[(size_t)(kt * 64 + r) * 2048 + ph * 128 + d];
  }
  for (int e = tid; e < 128 * 128; e += NTHR) {
    int r = e >> 7, d = e & 127;
    ks[r * 129 + d] = kk[r * 128 + d];
  }
  __syncthreads();
  const int key = tid & 127, k0 = (tid >> 7) * 16;
  float acc[16];
#pragma unroll
  for (int i = 0; i < 16; ++i) acc[i] = 0.f;
  for (int d = 0; d < 128; ++d) {
    float kv = ks[key * 129 + d];
#pragma unroll
    for (int i = 0; i < 16; ++i) acc[i] += wqs[(k0 + i) * 129 + d] * kv;
  }
  bf16_t* dst = p.WcT + ((size_t)l * 2048 + ph * 128 + key) * DM + kt * 64 + k0;
  uint4 o0, o1;
  o0.x = pack2(acc[0], acc[1]); o0.y = pack2(acc[2], acc[3]); o0.z = pack2(acc[4], acc[5]); o0.w = pack2(acc[6], acc[7]);
  o1.x = pack2(acc[8], acc[9]); o1.y = pack2(acc[10], acc[11]); o1.z = pack2(acc[12], acc[13]); o1.w = pack2(acc[14], acc[15]);
  *(uint4*)dst = o0; *(uint4*)(dst + 8) = o1;
}

__device__ void p0_mod_item(const Params& p, int l, int cc, char* smem) {
  float* sc = (float*)smem;
  float* red = sc + 1024 * 24;
  const int tid = otid();
  __syncthreads();
  for (int e = tid; e < NB * DM; e += NTHR) {
    int b = e >> 10, k = e & 1023;
    float v = crow(p, b)[k];
    sc[k * 24 + b] = v / (1.f + __expf(-v));
  }
  __syncthreads();
  const int col = tid & 63, kg = tid >> 6;
  const int n = cc * 64 + col;
  float acc[24];
#pragma unroll
  for (int b = 0; b < 24; ++b) acc[b] = 0.f;
  const float* wm = p.w_mod + (size_t)l * DM * 6144 + n;
#pragma unroll 1
  for (int k0 = kg * 128; k0 < kg * 128 + 128; k0 += 8) {
    float wv[8];
#pragma unroll
    for (int j = 0; j < 8; ++j) wv[j] = wm[(size_t)(k0 + j) * 6144];
#pragma unroll
    for (int j = 0; j < 8; ++j) {
      const float4* s4 = (const float4*)(sc + (k0 + j) * 24);
#pragma unroll
      for (int q = 0; q < 6; ++q) {
        float4 sv = s4[q];
        acc[q * 4 + 0] += sv.x * wv[j]; acc[q * 4 + 1] += sv.y * wv[j]; acc[q * 4 + 2] += sv.z * wv[j]; acc[q * 4 + 3] += sv.w * wv[j];
      }
    }
  }
#pragma unroll
  for (int b = 0; b < 24; ++b) red[(kg * 24 + b) * 64 + col] = acc[b];
  __syncthreads();
  for (int e = tid; e < 24 * 64; e += NTHR) {
    const int b = e >> 6, c2 = e & 63;
    float sum = p.b_mod[l * 6144 + cc * 64 + c2];
#pragma unroll
    for (int g = 0; g < 8; ++g) sum += red[(g * 24 + b) * 64 + c2];
    p.mod[((size_t)l * NB + b) * 6144 + cc * 64 + c2] = sum;
  }
}

__device__ void p0_filter_item(const Params& p, int l, int tc, char* smem) {
  float* feat = (float*)smem;
  float* a1 = feat + 32 * 33;
  float* a2 = a1 + 32 * 64;
  bf16_t* stage = (bf16_t*)(a2 + 32 * 64);
  const int tid = otid();
  const int t0 = tc * 32;
  __syncthreads();
  for (int e = tid; e < 32 * 33; e += NTHR) {
    int pp = e / 33, f = e % 33;
    int ti = t0 + pp;
    float v;
    if (f == 0) v = (float)ti / (float)(SEQ - 1);
    else {
      int bi = (f - 1) & 15;
      float band = 1e-4f + (float)bi * ((15.f - 1e-4f) / 15.f);
      float wv = 2.0f * 3.14159265358979323846f * (float)ti / (float)SEQ;
      float arg = band * wv;
      v = (f <= 16) ? cosf(arg) : -sinf(arg);
    }
    feat[pp * 33 + f] = v;
  }
  __syncthreads();
  const float* w1 = p.f_w1 + l * 33 * 64; const float* b1 = p.f_b1 + l * 64; const float* fq = p.f_freq + l * 64;
  const float* w2 = p.f_w2 + l * 64 * 64; const float* b2 = p.f_b2 + l * 64;
  for (int e = tid; e < 32 * 64; e += NTHR) {
    int pp = e >> 6, j = e & 63;
    float s = b1[j];
    for (int f = 0; f < 33; ++f) s += feat[pp * 33 + f] * w1[f * 64 + j];
    a1[pp * 64 + j] = sinf(fq[j] * s);
  }
  __syncthreads();
  for (int e = tid; e < 32 * 64; e += NTHR) {
    int pp = e >> 6, j = e & 63;
    float s = b2[j];
    for (int i = 0; i < 64; ++i) s += a1[pp * 64 + i] * w2[i * 64 + j];
    a2[pp * 64 + j] = sinf(fq[j] * s);
  }
  __syncthreads();
  const float* w3 = p.f_w3 + (size_t)l * 64 * 2048;
  const float min_decay = logf(1e-2f) / 1.5f, max_decay = logf(1e-2f) / 0.3f;
  for (int q = 0; q < 4; ++q) {
    const int n = tid + 512 * q;
    const int c = n & 511;
    float wr[64];
#pragma unroll
    for (int i = 0; i < 64; ++i) wr[i] = w3[i * 2048 + n];
    const float delta = fabsf(min_decay + (max_decay - min_decay) * (float)c / 511.f);
    for (int pp = 0; pp < 32; ++pp) {
      float s = 0.f;
#pragma unroll
      for (int i = 0; i < 64; ++i) s += a2[pp * 64 + i] * wr[i];
      float tt = (float)(t0 + pp) / (float)(SEQ - 1);
      s *= __expf(-tt * delta);
      if (t0 + pp == 0 && ((n >> 9) & 1) == 0) s += p.f_bias[(l * 2 + (n >> 10)) * 512 + c];
      stage[n * 32 + pp] = f2bf(s);
    }
  }
  __syncthreads();
  for (int e = tid; e < 2048 * 32; e += NTHR) {
    int n = e >> 5, pp = e & 31;
    int o = n >> 10, d = (n >> 9) & 1, c = n & 511;
    int t = t0 + pp;
    bf16_t* g = p.Gf + ((size_t)((l * 2 + o) * 512 + c)) * 4096;
    if (d == 0) g[2048 - t] = stage[n * 32 + pp];
    else if (t >= 1) g[2048 + t] = stage[n * 32 + pp];
    if (t == 0 && d == 0) g[0] = 0;
  }
}

__device__ void p0_rope_item(const Params& p, int it) {
  int e = it * 512 + otid();
  int pos = e >> 5, i = e & 31;
  float inv = powf(10000.f, -(float)(2 * i) / 64.f);
  float ang = (float)pos * inv;
  p.rope[e * 2 + 0] = cosf(ang);
  p.rope[e * 2 + 1] = sinf(ang);
}

constexpr int P0_TR_PER_LAYER = 16 * 68 + 8 * 16 + 8 * 16 + 16 * 16;
constexpr int P0_N_TR = 2 * P0_TR_PER_LAYER;
constexpr int P0_N_WC = 2 * 16 * 16;
constexpr int P0_N_MOD = 2 * 96;
constexpr int P0_N_FILT = 2 * 64;
constexpr int P0_N_ROPE = 128;
constexpr int P0_TOTAL = P0_N_MOD + P0_N_FILT + P0_N_WC + P0_N_ROPE + P0_N_TR;

__device__ void phase_p0(const Params& p, char* smem) {
  if (blockIdx.x == 0 && threadIdx.x < 32) p.wq[threadIdx.x] = 0u;
  if (blockIdx.x == 0 && threadIdx.x == 64) p.wq[64] = 0u;
  for (int it = blockIdx.x; it < P0_TOTAL; it += gridDim.x) {
    int i = it;
    if (i < P0_N_MOD) { p0_mod_item(p, i / 96, i % 96, smem); continue; }
    i -= P0_N_MOD;
    if (i < P0_N_FILT) { p0_filter_item(p, i / 64, i % 64, smem); continue; }
    i -= P0_N_FILT;
    if (i < P0_N_WC) { p0_wc_item(p, i >> 8, (i >> 4) & 15, i & 15, smem); continue; }
    i -= P0_N_WC;
    if (i < P0_N_ROPE) { p0_rope_item(p, i); continue; }
    i -= P0_N_ROPE;
    {
      int l = i / P0_TR_PER_LAYER, j = i % P0_TR_PER_LAYER;
      if (j < 16 * 68) { p0_transpose_tile(p.w_in + (size_t)l * DM * INC, p.WinT + (size_t)l * INC * DM, DM, INC, j / 68, j % 68, smem); continue; }
      j -= 16 * 68;
      if (j < 128) { p0_transpose_tile(p.w_pa + (size_t)l * HYW * DM, p.WpaT + (size_t)l * DM * HYW, HYW, DM, j / 16, j % 16, smem); continue; }
      j -= 128;
      if (j < 128) { p0_transpose_tile(p.w_pb + (size_t)l * HYW * DM, p.WpbT + (size_t)l * DM * HYW, HYW, DM, j / 16, j % 16, smem); continue; }
      j -= 128;
      p0_transpose_tile(p.w_out + (size_t)l * DM * DM, p.WoutT + (size_t)l * DM * DM, DM, DM, j / 16, j % 16, smem);
    }
  }
}

__device__ void norm_rows(const Params& p, int tile, int l, int which, bool from_inputs, char* smem) {
  float* scl = (float*)smem;
  float* shf = scl + 2048;
  const int tid = otid(), lane = tid & 63, w = tid >> 6;
  const int tok0 = tile * TM;
  const int b0 = tok0 >> 11;
  const float* g = (which ? p.g2 : p.g1) + l * DM;
  __syncthreads();
  for (int e = tid; e < 2048; e += NTHR) {
    int bi = e >> 10, j = e & 1023;
    int b = b0 + bi; if (b > NB - 1) b = NB - 1;
    const float* m = p.mod + ((size_t)l * NB + b) * 6144 + which * 3072;
    scl[e] = g[j] * (1.f + m[1024 + j]);
    shf[e] = m[j];
  }
  __syncthreads();
  for (int r = w; r < TM; r += 8) {
    const int tok = tok0 + r;
    const int bi = (tok >> 11) - b0;
    const float* xr = from_inputs ? xrow_in(p, tok) : (p.out + (size_t)tok * DM);
    float4 v[4];
    float ss = 0.f;
#pragma unroll
    for (int i = 0; i < 4; ++i) {
      v[i] = *(const float4*)(xr + lane * 4 + 256 * i);
      ss += v[i].x * v[i].x + v[i].y * v[i].y + v[i].z * v[i].z + v[i].w * v[i].w;
    }
    ss = wave_sum(ss);
    const float rs = rsqrtf(ss * (1.f / DM) + 1e-6f);
#pragma unroll
    for (int i = 0; i < 4; ++i) {
      const int j = lane * 4 + 256 * i;
      const float4 sc4 = *(const float4*)(scl + bi * 1024 + j);
      const float4 sh4 = *(const float4*)(shf + bi * 1024 + j);
      uint2 o;
      o.x = pack2(v[i].x * rs * sc4.x + sh4.x, v[i].y * rs * sc4.y + sh4.y);
      o.y = pack2(v[i].z * rs * sc4.z + sh4.z, v[i].w * rs * sc4.w + sh4.w);
      *(uint2*)(p.hbuf + (size_t)tok * DM + j) = o;
    }
  }
  __syncthreads();
}

__device__ void phase_c(const Params& p, int tile, int l, bool from_inputs, char* smem) {
  norm_rows(p, tile, l, 0, from_inputs, smem);
  const int tid = otid();
  const int tok0 = tile * TM;
  const bf16_t* A = p.hbuf + (size_t)tok0 * DM;
  const bf16_t* W = p.WinT + (size_t)l * INC * DM;
  float* ct = (float*)smem;
  f32x16 acc[3][2];
#pragma unroll 1
  for (int nt = 0; nt < 9; ++nt) {
    gemm_core2<2>(A, DM, W + (size_t)nt * 256 * DM, DM, DM, smem, acc);
#pragma unroll 1
    for (int half = 0; half < 2; ++half) {
      const int nc = nt * 2 + half;
      if (nc < 12) {
        acc_to_lds_T<2>(acc, ct, half);
        lds_barrier();
#pragma unroll 1
        for (int it = tid; it < 128 * 24; it += NTHR) {
          const int tg = it % 24, nl = it / 24;
          const float4 a = *(const float4*)(ct + nl * LDT + tg * 8), b4 = *(const float4*)(ct + nl * LDT + tg * 8 + 4);
          uint4 o; o.x = pack2(a.x, a.y); o.y = pack2(a.z, a.w); o.z = pack2(b4.x, b4.y); o.w = pack2(b4.z, b4.w);
          const int tok = tok0 + tg * 8;
          const int b = tok >> 11, sq = tok & 2047;
          *(uint4*)(p.zT + ((size_t)b * HYC + nc * 128 + nl) * SEQ + sq) = o;
        }
      } else {
        acc_to_lds<2>(acc, ct, 132, half);
        lds_barrier();
        store_tile_bf16(ct, p.zqkv, QKVC, tok0, nc * 128 - HYC);
      }
      lds_barrier();
    }
  }
}

__device__ __forceinline__ void load_conv8(const bf16_t* __restrict__ zrow, int s0, float w0, float w1, float w2, float cb, float (&o)[8]) {
  uint4 v = *(const uint4*)(zrow + s0);
  float z[10];
  z[0] = (s0 > 0) ? bf2f(zrow[s0 - 1]) : 0.f;
  z[1] = lo2f(v.x); z[2] = hi2f(v.x); z[3] = lo2f(v.y); z[4] = hi2f(v.y);
  z[5] = lo2f(v.z); z[6] = hi2f(v.z); z[7] = lo2f(v.w); z[8] = hi2f(v.w);
  z[9] = (s0 + 8 < SEQ) ? bf2f(zrow[s0 + 8]) : 0.f;
#pragma unroll
  for (int i = 0; i < 8; ++i) o[i] = z[i] * w0 + z[i + 1] * w1 + z[i + 2] * w2 + cb;
}

struct Conv8In { uint4 v; unsigned short l, r; };
__device__ __forceinline__ void conv8_load(const bf16_t* __restrict__ zrow, int s0, Conv8In& c) {
  c.v = *(const uint4*)(zrow + s0);
  c.l = (s0 > 0) ? zrow[s0 - 1] : (unsigned short)0;
  c.r = (s0 + 8 < SEQ) ? zrow[s0 + 8] : (unsigned short)0;
}
__device__ __forceinline__ void conv8_eval(const Conv8In& c, float w0, float w1, float w2, float cb, float (&o)[8]) {
  float z[10];
  z[0] = bf2f(c.l);
  z[1] = lo2f(c.v.x); z[2] = hi2f(c.v.x); z[3] = lo2f(c.v.y); z[4] = hi2f(c.v.y);
  z[5] = lo2f(c.v.z); z[6] = hi2f(c.v.z); z[7] = lo2f(c.v.w); z[8] = hi2f(c.v.w);
  z[9] = bf2f(c.r);
#pragma unroll
  for (int i = 0; i < 8; ++i) o[i] = z[i] * w0 + z[i + 1] * w1 + z[i + 2] * w2 + cb;
}

typedef short s16x4 __attribute__((ext_vector_type(4)));
__device__ __forceinline__ s16x4 tr_read4(const bf16_t* lds_ptr) {
  return __builtin_amdgcn_ds_read_tr16_b64_v4i16((__attribute__((address_space(3))) s16x4*)(lds_ptr));
}

constexpr int HY_GS_ELEMS = 4112;
constexpr int HY_US_ROWS = 2072;
__device__ __forceinline__ void hyena_load_g(const Params& p, int l, int o, int c, bf16_t* Gs, int tid) {
  const bf16_t* g = p.Gf + ((size_t)((l * 2 + o) * 512 + c)) * 4096;
  *(uint4*)(Gs + 8 + tid * 8) = *(const uint4*)(g + tid * 8);
  if (tid == 0) { unsigned z = 0; asm volatile("" : "+v"(z)); const uint4 z4 = make_uint4(z, z, z, z); *(uint4*)Gs = z4; *(uint4*)(Gs + 4104) = z4; }
}

__device__ __forceinline__ void hyena_kloop(const bf16_t* Gs, const bf16_t* us, int rho, int lane, f32x16 (&acc)[8]) {
#pragma unroll
  for (int a = 0; a < 8; ++a)
#pragma unroll
    for (int j = 0; j < 16; ++j) acc[a][j] = 0.f;
  const int i = lane & 31, hh = lane >> 5;
  const bf16_t* ga = Gs + (2040 - 8 * i + 8 * hh) - 1792;
  const int l16 = lane & 15, q = l16 >> 2, pq = l16 & 3, g4 = lane >> 4;
  const bf16_t* ub = us + (rho + 8 * (g4 >> 1) + q) * 24 + 16 * (g4 & 1) + 4 * pq;
#pragma unroll 1
  for (int kap = 0; kap < 129; ++kap) {
    const s16x4 b0 = tr_read4(ub + kap * 384);
    const s16x4 b1 = tr_read4(ub + kap * 384 + 96);
    bf16x8 bfrag;
    bfrag[0] = b0[0]; bfrag[1] = b0[1]; bfrag[2] = b0[2]; bfrag[3] = b0[3];
    bfrag[4] = b1[0]; bfrag[5] = b1[1]; bfrag[6] = b1[2]; bfrag[7] = b1[3];
#pragma unroll
    for (int a = 0; a < 8; ++a) {
      const bf16x8 af = *(const bf16x8*)(ga + kap * 16 + 256 * (7 - a));
      acc[a] = __builtin_amdgcn_mfma_f32_32x32x16_bf16(af, bfrag, acc[a], 0, 0, 0);
    }
  }
}

__device__ __forceinline__ void hyena_acc_to_us(const f32x16 (&acc)[8], bf16_t* us, int rho, int lane) {
  const int n = lane & 31, hh = lane >> 5;
  if (n < 24) {
#pragma unroll
    for (int a = 0; a < 8; ++a)
#pragma unroll
      for (int r = 0; r < 16; ++r) {
        const int t = 256 * a + rho + 8 * ((r & 3) + 8 * (r >> 2) + 4 * hh);
        us[(t + 16) * 24 + n] = f2bf(acc[a][r]);
      }
  }
}

__device__ void hyena_item(const Params& p, int l, int c, char* smem) {
  bf16_t* Gs = (bf16_t*)smem;
  bf16_t* us = (bf16_t*)(smem + 8256);
  const int tid = otid();
  const int lane = tid & 63, w = tid >> 6;
  const float* cw = p.conv_w + (size_t)l * 3 * HYC;
  const float* cbp = p.conv_b + (size_t)l * HYC;
  __syncthreads();
  hyena_load_g(p, l, 0, c, Gs, tid);
  {
    unsigned z = 0; asm volatile("" : "+v"(z)); const uint4 z4 = make_uint4(z, z, z, z);
    if (tid < 48) *(uint4*)(us + tid * 8) = z4;
    else if (tid < 48 + 26) *(uint4*)(us + 2064 * 24 + (tid - 48) * 8) = z4;
  }
  {
    const float w0 = cw[c], w1 = cw[HYC + c], w2 = cw[2 * HYC + c], cb = cbp[c];
#pragma unroll 1
    for (int q0 = tid; q0 < 24 * 256; q0 += 4 * NTHR) {
      Conv8In cin[4];
#pragma unroll
      for (int j = 0; j < 4; ++j) {
        const int qq = q0 + j * NTHR;
        conv8_load(p.zT + ((size_t)(qq % 24) * HYC + c) * SEQ, (qq / 24) * 8, cin[j]);
      }
#pragma unroll
      for (int j = 0; j < 4; ++j) {
        const int qq = q0 + j * NTHR;
        const int b = qq % 24, s0 = (qq / 24) * 8;
        float v[8];
        conv8_eval(cin[j], w0, w1, w2, cb, v);
#pragma unroll
        for (int i = 0; i < 8; ++i) us[(s0 + i + 16) * 24 + b] = f2bf(v[i]);
      }
    }
  }
  __syncthreads();
  f32x16 acc[8];
#pragma unroll 1
  for (int o = 0; o < 2; ++o) {
    hyena_kloop(Gs, us, w, lane, acc);
    __syncthreads();
    hyena_acc_to_us(acc, us, w, lane);
    if (o == 0) hyena_load_g(p, l, 1, c, Gs, tid);
    __syncthreads();
    const int xc = (o == 0 ? 512 : 1024) + c;
    const float xw0 = cw[xc], xw1 = cw[HYC + xc], xw2 = cw[2 * HYC + xc], xcb = cbp[xc];
#pragma unroll 1
    for (int q0 = tid; q0 < 24 * 256; q0 += 4 * NTHR) {
      Conv8In cin[4];
#pragma unroll
      for (int j = 0; j < 4; ++j) {
        const int qq = q0 + j * NTHR;
        conv8_load(p.zT + ((size_t)(qq % 24) * HYC + xc) * SEQ, (qq / 24) * 8, cin[j]);
      }
#pragma unroll
      for (int j = 0; j < 4; ++j) {
        const int qq = q0 + j * NTHR;
        const int b = qq % 24, s0 = (qq / 24) * 8;
        float xv[8];
        conv8_eval(cin[j], xw0, xw1, xw2, xcb, xv);
        if (o == 0) {
#pragma unroll
          for (int i = 0; i < 8; ++i) {
            bf16_t* e = us + (s0 + i + 16) * 24 + b;
            *e = f2bf(bf2f(*e) * xv[i]);
          }
        } else {
          float r[8];
#pragma unroll
          for (int i = 0; i < 8; ++i) r[i] = bf2f(us[(s0 + i + 16) * 24 + b]) * xv[i];
          uint4 pk; pk.x = pack2(r[0], r[1]); pk.y = pack2(r[2], r[3]); pk.z = pack2(r[4], r[5]); pk.w = pack2(r[6], r[7]);
          *(uint4*)(p.yaT + ((size_t)b * HYW + c) * SEQ + s0) = pk;
        }
      }
    }
    __syncthreads();
  }
}

__device__ void attn_item(const Params& p, int l, int item, char* smem) {
  constexpr int KS = 72, VS = 96;
  bf16_t* Ks = (bf16_t*)smem;
  bf16_t* Vs = Ks + 384 * KS;
  const int tid = otid();
  const int lane = tid & 63, w = tid >> 6;
  const int kh = item & 1, qb = (item >> 1) & 15, b = item >> 5;
  const int kpos0 = qb * 128 - 128;
  __syncthreads();
  if (tid < 384) {
    const int r = tid, kpos = kpos0 + r;
    if (kpos >= 0 && kpos < SEQ) {
      const bf16_t* kr = p.zqkv + ((size_t)(b * SEQ + kpos)) * QKVC + 512 + kh * 64;
      float kf[64];
      float ss = 0.f;
#pragma unroll
      for (int c8 = 0; c8 < 8; ++c8) {
        uint4 v = *(const uint4*)(kr + c8 * 8);
        kf[c8 * 8 + 0] = lo2f(v.x); kf[c8 * 8 + 1] = hi2f(v.x); kf[c8 * 8 + 2] = lo2f(v.y); kf[c8 * 8 + 3] = hi2f(v.y);
        kf[c8 * 8 + 4] = lo2f(v.z); kf[c8 * 8 + 5] = hi2f(v.z); kf[c8 * 8 + 6] = lo2f(v.w); kf[c8 * 8 + 7] = hi2f(v.w);
      }
#pragma unroll
      for (int d = 0; d < 64; ++d) ss += kf[d] * kf[d];
      const float rs = rsqrtf(ss * (1.f / 64.f) + 1e-6f);
      const float* kg = p.k_gain + l * 64;
#pragma unroll
      for (int d = 0; d < 64; ++d) kf[d] = kf[d] * rs * kg[d];
      const float* rp = p.rope + (size_t)kpos * 64;
#pragma unroll
      for (int i = 0; i < 32; ++i) {
        const float cs = rp[i * 2], sn = rp[i * 2 + 1];
        const float a = kf[i], bb = kf[i + 32];
        kf[i] = a * cs - bb * sn; kf[i + 32] = bb * cs + a * sn;
      }
#pragma unroll
      for (int c8 = 0; c8 < 8; ++c8) {
        uint4 pk;
        pk.x = pack2(kf[c8 * 8 + 0], kf[c8 * 8 + 1]); pk.y = pack2(kf[c8 * 8 + 2], kf[c8 * 8 + 3]);
        pk.z = pack2(kf[c8 * 8 + 4], kf[c8 * 8 + 5]); pk.w = pack2(kf[c8 * 8 + 6], kf[c8 * 8 + 7]);
        *(uint4*)(Ks + r * KS + c8 * 8) = pk;
      }
    }
  }
#pragma unroll 1
  for (int e = tid; e < 384 * 8; e += NTHR) {
    const int r = e >> 3, c8 = e & 7, kpos = kpos0 + r;
    if (kpos >= 0 && kpos < SEQ)
      *(uint4*)(Vs + r * VS + c8 * 8) = *(const uint4*)(p.zqkv + ((size_t)(b * SEQ + kpos)) * QKVC + 640 + kh * 64 + c8 * 8);
  }
  __syncthreads();
  const int hl = w & 3, qh = w >> 2;
  const int head = kh * 4 + hl;
  const int n = lane & 31, hh = lane >> 5;
  const int Q0 = qb * 128 + 64 * qh;
  bf16x8 qf[2][4];
#pragma unroll
  for (int nt = 0; nt < 2; ++nt) {
    const int qpos = Q0 + 32 * nt + n;
    const bf16_t* qr = p.zqkv + ((size_t)(b * SEQ + qpos)) * QKVC + head * 64;
    float qv[4][8];
    float ss = 0.f;
#pragma unroll
    for (int kk = 0; kk < 4; ++kk) {
      uint4 v = *(const uint4*)(qr + 16 * kk + 8 * hh);
      qv[kk][0] = lo2f(v.x); qv[kk][1] = hi2f(v.x); qv[kk][2] = lo2f(v.y); qv[kk][3] = hi2f(v.y);
      qv[kk][4] = lo2f(v.z); qv[kk][5] = hi2f(v.z); qv[kk][6] = lo2f(v.w); qv[kk][7] = hi2f(v.w);
#pragma unroll
      for (int j = 0; j < 8; ++j) ss += qv[kk][j] * qv[kk][j];
    }
    ss += __shfl_xor(ss, 32, 64);
    const float rs = rsqrtf(ss * (1.f / 64.f) + 1e-6f) * 0.125f;
    const float* qg = p.q_gain + l * 64;
#pragma unroll
    for (int kk = 0; kk < 4; ++kk)
#pragma unroll
      for (int j = 0; j < 8; ++j) qv[kk][j] *= rs * qg[16 * kk + 8 * hh + j];
    const float* rp = p.rope + (size_t)qpos * 64;
#pragma unroll
    for (int kk = 0; kk < 2; ++kk)
#pragma unroll
      for (int j = 0; j < 8; ++j) {
        const int d = 16 * kk + 8 * hh + j;
        const float cs = rp[d * 2], sn = rp[d * 2 + 1];
        const float a = qv[kk][j], bb = qv[kk + 2][j];
        qv[kk][j] = a * cs - bb * sn; qv[kk + 2][j] = bb * cs + a * sn;
      }
#pragma unroll
    for (int kk = 0; kk < 4; ++kk)
#pragma unroll
      for (int j = 0; j < 8; ++j) qf[nt][kk][j] = (short)f2bf(qv[kk][j]);
  }
  f32x16 O[2][2];
#pragma unroll
  for (int dm = 0; dm < 2; ++dm)
#pragma unroll
    for (int nt = 0; nt < 2; ++nt)
#pragma unroll
      for (int r = 0; r < 16; ++r) O[dm][nt][r] = 0.f;
  float mrun[2], lsum[2];
  mrun[0] = mrun[1] = p.sink[l * 8 + head];
  lsum[0] = lsum[1] = (hh == 0) ? 1.f : 0.f;
  const int l16 = lane & 15, tq = l16 >> 2, tp = l16 & 3, g4 = lane >> 4;
  const bf16_t* vbase = Vs + (4 * (g4 >> 1) + tq) * VS + 16 * (g4 & 1) + 4 * tp;
#pragma unroll 1
  for (int kt = 2 * qh; kt < 2 * qh + 10; ++kt) {
    const int kp_t = kpos0 + 32 * kt;
    if (kp_t < 0 || kp_t >= SEQ) continue;
    bf16x8 kfr[4];
#pragma unroll
    for (int kk = 0; kk < 4; ++kk) kfr[kk] = *(const bf16x8*)(Ks + (32 * kt + n) * KS + 16 * kk + 8 * hh);
    bf16x8 pf[2][2];
#pragma unroll
    for (int nt = 0; nt < 2; ++nt) {
      f32x16 S;
#pragma unroll
      for (int r = 0; r < 16; ++r) S[r] = 0.f;
#pragma unroll
      for (int kk = 0; kk < 4; ++kk) S = __builtin_amdgcn_mfma_f32_32x32x16_bf16(kfr[kk], qf[nt][kk], S, 0, 0, 0);
      const int qpos = Q0 + 32 * nt + n;
      float mloc = -INFINITY;
#pragma unroll
      for (int r = 0; r < 16; ++r) {
        const int kpos = kp_t + (r & 3) + 8 * (r >> 2) + 4 * hh;
        int dd = kpos - qpos; dd = dd < 0 ? -dd : dd;
        S[r] = (dd <= 128) ? S[r] : -INFINITY;
        mloc = fmaxf(mloc, S[r]);
      }
      mloc = fmaxf(mloc, __shfl_xor(mloc, 32, 64));
      const float mnew = fmaxf(mrun[nt], mloc);
      const float corr = __expf(mrun[nt] - mnew);
      mrun[nt] = mnew;
      float psum = 0.f;
#pragma unroll
      for (int r = 0; r < 16; ++r) { S[r] = __expf(S[r] - mnew); psum += S[r]; }
      lsum[nt] = lsum[nt] * corr + psum;
#pragma unroll
      for (int dm = 0; dm < 2; ++dm)
#pragma unroll
        for (int r = 0; r < 16; ++r) O[dm][nt][r] *= corr;
#pragma unroll
      for (int s2 = 0; s2 < 2; ++s2)
#pragma unroll
        for (int j = 0; j < 8; ++j) pf[nt][s2][j] = (short)f2bf(S[8 * s2 + j]);
    }
#pragma unroll
    for (int dm = 0; dm < 2; ++dm)
#pragma unroll
      for (int s2 = 0; s2 < 2; ++s2) {
        const bf16_t* vp = vbase + (32 * kt + 16 * s2) * VS + 32 * dm;
        const s16x4 v0 = tr_read4(vp);
        const s16x4 v1 = tr_read4(vp + 8 * VS);
        bf16x8 vf;
        vf[0] = v0[0]; vf[1] = v0[1]; vf[2] = v0[2]; vf[3] = v0[3];
        vf[4] = v1[0]; vf[5] = v1[1]; vf[6] = v1[2]; vf[7] = v1[3];
#pragma unroll
        for (int nt = 0; nt < 2; ++nt) O[dm][nt] = __builtin_amdgcn_mfma_f32_32x32x16_bf16(vf, pf[nt][s2], O[dm][nt], 0, 0, 0);
      }
  }
#pragma unroll
  for (int nt = 0; nt < 2; ++nt) {
    const float ltot = lsum[nt] + __shfl_xor(lsum[nt], 32, 64);
    const float inv = 1.f / ltot;
    const int qpos = Q0 + 32 * nt + n;
    bf16_t* yo = p.yb + ((size_t)(b * SEQ + qpos)) * 512 + head * 64;
#pragma unroll
    for (int dm = 0; dm < 2; ++dm)
#pragma unroll
      for (int g = 0; g < 4; ++g) {
        uint2 o;
        o.x = pack2(O[dm][nt][4 * g + 0] * inv, O[dm][nt][4 * g + 1] * inv);
        o.y = pack2(O[dm][nt][4 * g + 2] * inv, O[dm][nt][4 * g + 3] * inv);
        *(uint2*)(yo + 32 * dm + 8 * g + 4 * hh) = o;
      }
  }
}

typedef float f32x2 __attribute__((ext_vector_type(2)));
__device__ void table_item(const Params& p, int l, int it) {
  const int tid = otid();
  const int lane = tid & 63, w = tid >> 6;
  const int which = it >> 9, r0 = (it & 511) * 32 + w * 4;
  const float* src = (which ? p.peer_v : p.peer_u) + (size_t)l * NEXP * DM;
  unsigned char* dst = which ? p.tabV8 : p.tabU8;
  float* sc = which ? p.sclV : p.sclU;
  float4 v[4][4];
#pragma unroll
  for (int rr = 0; rr < 4; ++rr)
#pragma unroll
    for (int i = 0; i < 4; ++i) v[rr][i] = *(const float4*)(src + (size_t)(r0 + rr) * DM + lane * 4 + 256 * i);
#pragma unroll
  for (int rr = 0; rr < 4; ++rr) {
    const int e = r0 + rr;
    float mx = 0.f;
#pragma unroll
    for (int i = 0; i < 4; ++i)
      mx = fmaxf(mx, fmaxf(fmaxf(fabsf(v[rr][i].x), fabsf(v[rr][i].y)), fmaxf(fabsf(v[rr][i].z), fabsf(v[rr][i].w))));
#pragma unroll
    for (int m = 32; m >= 1; m >>= 1) mx = fmaxf(mx, __shfl_xor(mx, m, 64));
    const float scale = (mx > 0.f) ? 440.f / mx : 1.f;
#pragma unroll
    for (int i = 0; i < 4; ++i) {
      int pk = __builtin_amdgcn_cvt_pk_fp8_f32(v[rr][i].x * scale, v[rr][i].y * scale, 0, false);
      pk = __builtin_amdgcn_cvt_pk_fp8_f32(v[rr][i].z * scale, v[rr][i].w * scale, pk, true);
      const int x = 2 * i + (lane >> 5);
      *(int*)(dst + ((size_t)x * NEXP + e) * 128 + (lane & 31) * 4) = pk;
    }
    if (lane == 0) sc[e] = (mx > 0.f) ? mx * (1.f / 440.f) : 1.f;
  }
}

constexpr int DE_N_HY = 512, DE_N_AT = 768, DE_N_TB = 1024;
__device__ void phase_de(const Params& p, int l, char* smem) {
  for (int it = blockIdx.x; it < DE_N_HY + DE_N_AT + DE_N_TB; it += gridDim.x) {
    if (it < DE_N_HY) hyena_item(p, l, it, smem);
    else if (it < DE_N_HY + DE_N_AT) attn_item(p, l, it - DE_N_HY, smem);
    else table_item(p, l, it - DE_N_HY - DE_N_AT);
  }
}

__device__ void phase_f(const Params& p, int tile, int l, bool from_inputs, char* smem) {
  const int tid = otid();
  const int tok0 = tile * TM;
#pragma unroll 1
  for (int e = tid; e < TM * 64; e += NTHR) {
    const int r = e % TM, cg8 = e / TM;
    const int tok = tok0 + r, b = tok >> 11, sq = tok & 2047;
    const bf16_t* src = p.yaT + ((size_t)b * HYW + cg8 * 8) * SEQ + sq;
    uint4 o;
    o.x = (unsigned)src[0] | ((unsigned)src[SEQ] << 16);
    o.y = (unsigned)src[2 * SEQ] | ((unsigned)src[3 * SEQ] << 16);
    o.z = (unsigned)src[4 * SEQ] | ((unsigned)src[5 * SEQ] << 16);
    o.w = (unsigned)src[6 * SEQ] | ((unsigned)src[7 * SEQ] << 16);
    *(uint4*)(p.yatok + (size_t)tok * HYW + cg8 * 8) = o;
  }
  __syncthreads();
  const bf16_t* Ah = p.hbuf + (size_t)tok0 * DM;
  const bf16_t* Aya = p.yatok + (size_t)tok0 * HYW;
  const bf16_t* Ayb = p.yb + (size_t)tok0 * HYW;
  const bf16_t* Win = p.WinT + (size_t)l * INC * DM;
  const bf16_t* Wpa = p.WpaT + (size_t)l * DM * HYW;
  const bf16_t* Wpb = p.WpbT + (size_t)l * DM * HYW;
  float* ct = (float*)smem;
  f32x16 acc[3][2];
  unsigned sgp[3][2][8];
#pragma unroll 1
  for (int nc = 0; nc < 8; ++nc) {
    gemm_f1<1>(Ah, Ah, DM, Win + (size_t)(2304 + nc * 128) * DM, Win + (size_t)(3328 + nc * 128) * DM, DM, smem, acc);
#pragma unroll
    for (int mi = 0; mi < 3; ++mi)
#pragma unroll
      for (int ni = 0; ni < 2; ++ni)
#pragma unroll
        for (int q = 0; q < 8; ++q)
          sgp[mi][ni][q] = pack2(__builtin_amdgcn_rcpf(1.f + __expf(-acc[mi][ni][2 * q])), __builtin_amdgcn_rcpf(1.f + __expf(-acc[mi][ni][2 * q + 1])));
    gemm_f1<2>(Aya, Ayb, HYW, Wpa + (size_t)(nc * 128) * HYW, Wpb + (size_t)(nc * 128) * HYW, HYW, smem, acc);
    {
      const int tid_ = otid(); const int lane = tid_ & 63, w = tid_ >> 6, wm = w >> 2, wn = w & 3;
      const int n = wn * 32 + (lane & 31);
#pragma unroll
      for (int mi = 0; mi < 3; ++mi)
#pragma unroll
        for (int q = 0; q < 8; ++q) {
          const float m0 = lo2f(sgp[mi][0][q]) * acc[mi][0][2 * q] + lo2f(sgp[mi][1][q]) * acc[mi][1][2 * q];
          const float m1 = hi2f(sgp[mi][0][q]) * acc[mi][0][2 * q + 1] + hi2f(sgp[mi][1][q]) * acc[mi][1][2 * q + 1];
          ct[ACC_ROW(wm, mi, 2 * q, lane) * 132 + n] = m0;
          ct[ACC_ROW(wm, mi, 2 * q + 1, lane) * 132 + n] = m1;
        }
    }
    lds_barrier();
    store_tile_bf16(ct, p.merged, DM, tok0, nc * 128);
  }
  __syncthreads();
  const bf16_t* Am = p.merged + (size_t)tok0 * DM;
  const bf16_t* Wo = p.WoutT + (size_t)l * DM * DM;
  f32x16 acc2[3][2];
#pragma unroll 1
  for (int nt = 0; nt < 4; ++nt) {
    gemm_core2<2>(Am, DM, Wo + (size_t)(nt * 256) * DM, DM, DM, smem, acc2);
#pragma unroll 1
    for (int half = 0; half < 2; ++half) {
      acc_to_lds<2>(acc2, ct, 132, half);
      lds_barrier();
#pragma unroll 1
      for (int it = tid; it < 192 * 32; it += NTHR) {
        const int c4 = it & 31, r = it >> 5;
        const int tok = tok0 + r, b = tok >> 11;
        const int n = nt * 256 + half * 128 + c4 * 4;
        const float4 a = *(const float4*)(ct + r * 132 + c4 * 4);
        const float4 gt = *(const float4*)(p.mod + ((size_t)l * NB + b) * 6144 + 2048 + n);
        const float* xs = from_inputs ? xrow_in(p, tok) : (p.out + (size_t)tok * DM);
        float4 xo = *(const float4*)(xs + n);
        xo.x += gt.x * a.x; xo.y += gt.y * a.y; xo.z += gt.z * a.z; xo.w += gt.w * a.w;
        *(float4*)(p.out + (size_t)tok * DM + n) = xo;
      }
      lds_barrier();
    }
  }
  __syncthreads();
}

__device__ __forceinline__ void sort16_desc(float (&v)[16]) {
#pragma unroll
  for (int k = 2; k <= 16; k <<= 1)
#pragma unroll
    for (int j = k >> 1; j >= 1; j >>= 1)
#pragma unroll
      for (int i = 0; i < 16; ++i) {
        const int l = i ^ j;
        if (l > i) {
          const float hi = fmaxf(v[i], v[l]), lo = fminf(v[i], v[l]);
          if ((i & k) == 0) { v[i] = hi; v[l] = lo; } else { v[i] = lo; v[l] = hi; }
        }
      }
}
__device__ __forceinline__ void merge16_desc(float (&top)[16], const float (&g)[16]) {
#pragma unroll
  for (int i = 0; i < 16; ++i) top[i] = fmaxf(top[i], g[15 - i]);
#pragma unroll
  for (int j = 8; j >= 1; j >>= 1)
#pragma unroll
    for (int i = 0; i < 16; ++i) {
      const int l = i ^ j;
      if (l > i) { const float hi = fmaxf(top[i], top[l]), lo = fminf(top[i], top[l]); top[i] = hi; top[l] = lo; }
    }
}
__device__ __forceinline__ void topk_insert(float (&key)[16], float kx) {
#pragma unroll
  for (int i = 0; i < 16; ++i) {
    const float hi = fmaxf(key[i], kx);
    kx = fminf(key[i], kx);
    key[i] = hi;
  }
}

__device__ void phase_g(const Params& p, int tile, int l, char* smem) {
  norm_rows(p, tile, l, 1, false, smem);
  const int tid = otid();
  const int tok0 = tile * TM;
  const bf16_t* Ah = p.hbuf + (size_t)tok0 * DM;
  const bf16_t* Wc = p.WcT + (size_t)l * 2048 * DM;
  float* sc = (float*)smem;
  f32x16 acc[3][2];
  float v1k[16], v2k[16];
#pragma unroll
  for (int i = 0; i < 16; ++i) { v1k[i] = 0.f; v2k[i] = 0.f; }
#pragma unroll 1
  for (int ch = 0; ch < 16; ++ch) {
    if ((ch & 1) == 0) gemm_core2<2>(Ah, DM, Wc + (size_t)(ch * 128) * DM, DM, DM, smem, acc);
    acc_to_lds<2>(acc, sc, 129, ch & 1);
    __syncthreads();
    if (tid < TM) {
      float key[16];
      const float* row = sc + tid * 129;
#pragma unroll
      for (int i = 0; i < 16; ++i) key[i] = __uint_as_float((__float_as_uint(row[i]) & 0xFFFFFF80u) | (unsigned)i);
      sort16_desc(key);
#pragma unroll 1
      for (int j0 = 16; j0 < 128; j0 += 16) {
        float g[16];
#pragma unroll
        for (int i = 0; i < 16; ++i) g[i] = __uint_as_float((__float_as_uint(row[j0 + i]) & 0xFFFFFF80u) | (unsigned)(j0 + i));
        sort16_desc(g);
        merge16_desc(key, g);
      }
      if ((ch & 1) == 0) {
#pragma unroll
        for (int i = 0; i < 16; ++i) v1k[i] = key[i];
      } else {
#pragma unroll
        for (int i = 0; i < 16; ++i) v2k[i] = key[i];
        float top[16];
#pragma unroll
        for (int i = 0; i < 16; ++i) top[i] = -INFINITY;
#pragma unroll
        for (int i = 0; i < 16; ++i)
#pragma unroll
          for (int j = 0; j < 16; ++j)
            if ((i + 1) * (j + 1) <= 16) {
              const float s = v1k[i] + v2k[j];
              const float ck = __uint_as_float((__float_as_uint(s) & 0xFFFFFF00u) | (unsigned)(i * 16 + j));
              topk_insert(top, ck);
            }
        const float mx = top[0];
        float ex[16], sum = 0.f;
#pragma unroll
        for (int k = 0; k < 16; ++k) { ex[k] = __expf(top[k] - mx); sum += ex[k]; }
        const float inv = 1.f / sum;
        const int hh = ch >> 1;
        const size_t ob = ((size_t)(tok0 + tid) * 8 + hh) * 16;
#pragma unroll
        for (int k = 0; k < 16; ++k) {
          const unsigned code = __float_as_uint(top[k]) & 0xFFu;
          const unsigned ii = code >> 4, jj = code & 15u;
          unsigned e1 = 0, e2 = 0;
#pragma unroll
          for (int q = 0; q < 16; ++q) {
            e1 = (ii == (unsigned)q) ? (__float_as_uint(v1k[q]) & 0x7Fu) : e1;
            e2 = (jj == (unsigned)q) ? (__float_as_uint(v2k[q]) & 0x7Fu) : e2;
          }
          const unsigned ee = e1 * 128 + e2;
          p.pidx[ob + k] = (unsigned short)ee;
          p.pg[ob + k] = ex[k] * inv * p.sclV[ee];
          p.pgu[ob + k] = p.sclU[ee];
        }
      }
    }
    __syncthreads();
  }
}

__device__ __forceinline__ unsigned xcc_id() { return (unsigned)__builtin_amdgcn_s_getreg((3 << 11) | 20) & 7u; }
__device__ __forceinline__ bool next_slice_item(unsigned* cnt, int& x, int& j, int& tries, char* smem, int tid) {
  int* sh = (int*)(smem + 8192);
  while (tries < 8) {
    __syncthreads();
    if (tid == 0) *sh = (int)atomicAdd(cnt + x, 1u);
    __syncthreads();
    j = *sh;
    if (j < I_NJ) return true;
    x = (x + 1) & 7; ++tries;
  }
  return false;
}
__device__ __forceinline__ float dpp_xor1(float v) { return __builtin_bit_cast(float, __builtin_amdgcn_update_dpp(0, __builtin_bit_cast(int, v), 0xB1, 0xF, 0xF, true)); }
__device__ __forceinline__ float dpp_xor2(float v) { return __builtin_bit_cast(float, __builtin_amdgcn_update_dpp(0, __builtin_bit_cast(int, v), 0x4E, 0xF, 0xF, true)); }
__device__ __forceinline__ float dpp_hmirror(float v) { return __builtin_bit_cast(float, __builtin_amdgcn_update_dpp(0, __builtin_bit_cast(int, v), 0x141, 0xF, 0xF, true)); }
__device__ __forceinline__ float dpp_ror8(float v) { return __builtin_bit_cast(float, __builtin_amdgcn_update_dpp(0, __builtin_bit_cast(int, v), 0x128, 0xF, 0xF, true)); }

struct I1Ctx { uint4 h0, h1, e0, e1; };
__device__ __forceinline__ void i1_load_ctx(const Params& p, int tok, int x, int g, int ch, I1Ctx& c) {
  const bf16_t* hr = p.hbuf + (size_t)tok * DM + x * 128 + ch * 16;
  c.h0 = *(const uint4*)hr; c.h1 = *(const uint4*)(hr + 8);
  const uint4* pi = (const uint4*)(p.pidx + (size_t)tok * 128 + g * 16);
  c.e0 = pi[0]; c.e1 = pi[1];
}
__device__ __forceinline__ void peer_issue_rows(const unsigned char* Tslice, unsigned lane_off, const uint4& e0, const uint4& e1, uint4 (&rows)[16]) {
  const unsigned ew[8] = {e0.x, e0.y, e0.z, e0.w, e1.x, e1.y, e1.z, e1.w};
#pragma unroll
  for (int rd = 0; rd < 16; ++rd) {
    const unsigned e = (ew[rd >> 1] >> (16 * (rd & 1))) & 0x3FFFu;
    rows[rd] = *(const uint4*)(Tslice + (e * 128u + lane_off));
  }
}
typedef _Float16 f16x2 __attribute__((ext_vector_type(2)));
__device__ __forceinline__ f16x2 bf2_to_h2(unsigned u) {
  f16x2 r; r[0] = (_Float16)lo2f(u); r[1] = (_Float16)hi2f(u); return r;
}
__device__ __forceinline__ void i1_compute(const I1Ctx& c, const uint4 (&rows)[16], float* dst, int ch) {
  f16x2 hs[8];
  hs[0] = bf2_to_h2(c.h0.x); hs[1] = bf2_to_h2(c.h0.y); hs[2] = bf2_to_h2(c.h0.z); hs[3] = bf2_to_h2(c.h0.w);
  hs[4] = bf2_to_h2(c.h1.x); hs[5] = bf2_to_h2(c.h1.y); hs[6] = bf2_to_h2(c.h1.z); hs[7] = bf2_to_h2(c.h1.w);
  float res[16];
#pragma unroll
  for (int rd = 0; rd < 16; ++rd) {
    const unsigned wd[4] = {rows[rd].x, rows[rd].y, rows[rd].z, rows[rd].w};
    float d0 = 0.f, d1 = 0.f;
#pragma unroll
    for (int q = 0; q < 4; ++q) {
      d0 = __builtin_amdgcn_fdot2(__builtin_amdgcn_cvt_scalef32_pk_f16_fp8((int)wd[q], 1.0f, false), hs[2 * q], d0, false);
      d1 = __builtin_amdgcn_fdot2(__builtin_amdgcn_cvt_scalef32_pk_f16_fp8((int)wd[q], 1.0f, true), hs[2 * q + 1], d1, false);
    }
    float d = d0 + d1;
    d += dpp_xor1(d); d += dpp_xor2(d); d += dpp_hmirror(d);
    res[rd] = d;
  }
  if (ch == 0) {
    float4* o = (float4*)dst;
    o[0] = make_float4(res[0], res[1], res[2], res[3]); o[1] = make_float4(res[4], res[5], res[6], res[7]);
    o[2] = make_float4(res[8], res[9], res[10], res[11]); o[3] = make_float4(res[12], res[13], res[14], res[15]);
  }
}

__device__ void phase_i1(const Params& p, int pass, char* smem) {
  const int tid = otid();
  const int lane = tid & 63, w = tid >> 6;
  const int g = lane >> 3, ch = lane & 7;
  int x = (int)xcc_id(), j = 0, tries = 0;
  while (next_slice_item(p.wq + pass * 8, x, j, tries, smem, tid)) {
    const unsigned char* Ux = p.tabU8 + (size_t)x * NEXP * 128;
    const unsigned loff = ch * 16;
    float* ap = p.apart + (size_t)x * NTOK * 128 + g * 16;
    const int tokb = j * I_TOK + w;
    I1Ctx c0, c1, c2;
    uint4 rowsA[16], rowsB[16];
    i1_load_ctx(p, tokb, x, g, ch, c0);
    i1_load_ctx(p, tokb + 8, x, g, ch, c1);
    i1_load_ctx(p, tokb + 16, x, g, ch, c2);
    peer_issue_rows(Ux, loff, c0.e0, c0.e1, rowsA);
#pragma unroll 1
    for (int i = 0; i < I_TW; i += 2) {
      I1Ctx c3, c4;
      peer_issue_rows(Ux, loff, c1.e0, c1.e1, rowsB);
      i1_load_ctx(p, tokb + 8 * min(i + 3, I_TW - 1), x, g, ch, c3);
      i1_compute(c0, rowsA, ap + (size_t)(tokb + 8 * i) * 128, ch);
      peer_issue_rows(Ux, loff, c2.e0, c2.e1, rowsA);
      i1_load_ctx(p, tokb + 8 * min(i + 4, I_TW - 1), x, g, ch, c4);
      i1_compute(c1, rowsB, ap + (size_t)(tokb + 8 * (i + 1)) * 128, ch);
      c0 = c2; c1 = c3; c2 = c4;
    }
  }
}

__device__ void phase_w(const Params& p) {
  const int tid = otid();
  const size_t npair8 = (size_t)NTOK * 128 / 8;
  for (size_t q8 = (size_t)blockIdx.x * NTHR + tid; q8 < npair8; q8 += (size_t)gridDim.x * NTHR) {
    const size_t q = q8 * 8;
    float a[8];
#pragma unroll
    for (int i = 0; i < 8; ++i) a[i] = 0.f;
#pragma unroll
    for (int xx = 0; xx < 8; ++xx) {
      const float4 v0 = *(const float4*)(p.apart + (size_t)xx * NTOK * 128 + q);
      const float4 v1 = *(const float4*)(p.apart + (size_t)xx * NTOK * 128 + q + 4);
      a[0] += v0.x; a[1] += v0.y; a[2] += v0.z; a[3] += v0.w; a[4] += v1.x; a[5] += v1.y; a[6] += v1.z; a[7] += v1.w;
    }
    const float4 u0 = *(const float4*)(p.pgu + q), u1 = *(const float4*)(p.pgu + q + 4);
    const float4 g0 = *(const float4*)(p.pg + q), g1 = *(const float4*)(p.pg + q + 4);
    const float su[8] = {u0.x, u0.y, u0.z, u0.w, u1.x, u1.y, u1.z, u1.w};
    const float sg[8] = {g0.x, g0.y, g0.z, g0.w, g1.x, g1.y, g1.z, g1.w};
    float wv[8];
#pragma unroll
    for (int i = 0; i < 8; ++i) {
      const float av = a[i] * su[i];
      wv[i] = sg[i] * 0.5f * av * (1.f + erff(av * 0.70710678118654752f));
    }
    uint4 o; o.x = pack2(wv[0], wv[1]); o.y = pack2(wv[2], wv[3]); o.z = pack2(wv[4], wv[5]); o.w = pack2(wv[6], wv[7]);
    *(uint4*)(p.wbuf + q) = o;
  }
}

struct I2Ctx { uint4 e0, e1; };
struct I2XG { uint4 w0, w1; float2 xv, gt; };
__device__ __forceinline__ void i2_load_ctx(const Params& p, int tok, int l, int x, int g, int ch, I2Ctx& c) {
  const unsigned off = (unsigned)tok * 256u + (unsigned)g * 32u;
  const uint4* pi = (const uint4*)((const char*)p.pidx + off);
  c.e0 = pi[0]; c.e1 = pi[1];
}
__device__ __forceinline__ void i2_load_xg(const Params& p, int tok, int l, int x, int g, int ch, I2XG& c) {
  const unsigned off = (unsigned)tok * 256u + (unsigned)g * 32u;
  const uint4* pw = (const uint4*)((const char*)p.wbuf + off);
  c.w0 = pw[0]; c.w1 = pw[1];
  const unsigned col = (unsigned)(x * 128 + ch * 16 + 2 * g);
  c.xv = *(const float2*)((const char*)p.out + ((unsigned)tok * 4096u + col * 4u));
  c.gt = *(const float2*)((const char*)p.mod + ((unsigned)(l * NB + (tok >> 11)) * 24576u + 20480u + col * 4u));
}
__device__ __forceinline__ void i2_compute(const Params& p, const I2XG& xg, const uint4 (&rows)[16], int tok, int x, int g, int ch) {
  const unsigned ww[8] = {xg.w0.x, xg.w0.y, xg.w0.z, xg.w0.w, xg.w1.x, xg.w1.y, xg.w1.z, xg.w1.w};
  f32x2 acc[8];
#pragma unroll
  for (int i = 0; i < 8; ++i) acc[i] = f32x2{0.f, 0.f};
#pragma unroll
  for (int rd = 0; rd < 16; ++rd) {
    const unsigned wd[4] = {rows[rd].x, rows[rd].y, rows[rd].z, rows[rd].w};
    const float wsc = (rd & 1) ? hi2f(ww[rd >> 1]) : lo2f(ww[rd >> 1]);
    const f32x2 sw = {wsc, wsc};
#pragma unroll
    for (int q = 0; q < 4; ++q) {
      acc[2 * q] += sw * __builtin_amdgcn_cvt_pk_f32_fp8((int)wd[q], false);
      acc[2 * q + 1] += sw * __builtin_amdgcn_cvt_pk_f32_fp8((int)wd[q], true);
    }
  }
  float r[16];
#pragma unroll
  for (int i = 0; i < 8; ++i) { r[2 * i] = acc[i][0]; r[2 * i + 1] = acc[i][1]; }
  const bool b2 = (g & 4) != 0, b1 = (g & 2) != 0, b0 = (g & 1) != 0;
  float r8[8];
#pragma unroll
  for (int i = 0; i < 8; ++i) {
    const float snd = b2 ? r[i] : r[i + 8];
    const float kp = b2 ? r[i + 8] : r[i];
    r8[i] = kp + __shfl_xor(snd, 32, 64);
  }
  float r4[4];
#pragma unroll
  for (int i = 0; i < 4; ++i) {
    const float snd = b1 ? r8[i] : r8[i + 4];
    const float kp = b1 ? r8[i + 4] : r8[i];
    r4[i] = kp + __shfl_xor(snd, 16, 64);
  }
  float r2[2];
#pragma unroll
  for (int i = 0; i < 2; ++i) {
    const float snd = b0 ? r4[i] : r4[i + 2];
    const float kp = b0 ? r4[i + 2] : r4[i];
    r2[i] = kp + dpp_ror8(snd);
  }
  float2 o;
  o.x = xg.xv.x + xg.gt.x * r2[0];
  o.y = xg.xv.y + xg.gt.y * r2[1];
  *(float2*)((char*)p.out + ((unsigned)tok * 4096u + (unsigned)(x * 128 + ch * 16 + 2 * g) * 4u)) = o;
}

__device__ void phase_i2(const Params& p, int l, int pass, char* smem) {
  const int tid = otid();
  const int lane = tid & 63, w = tid >> 6;
  const int g = lane >> 3, ch = lane & 7;
  int x = (int)xcc_id(), j = 0, tries = 0;
  while (next_slice_item(p.wq + pass * 8, x, j, tries, smem, tid)) {
    const unsigned char* Vx = p.tabV8 + (size_t)x * NEXP * 128;
    const unsigned loff = ch * 16;
    const int tokb = j * I_TOK + w;
    I2Ctx c0, c1;
    I2XG xa, xb;
    uint4 rowsA[16], rowsB[16];
    i2_load_ctx(p, tokb, l, x, g, ch, c0);
    i2_load_ctx(p, tokb + 8, l, x, g, ch, c1);
    peer_issue_rows(Vx, loff, c0.e0, c0.e1, rowsA);
    i2_load_xg(p, tokb, l, x, g, ch, xa);
    i2_load_ctx(p, tokb + 8 * min(2, I_TW - 1), l, x, g, ch, c0);
#pragma unroll 1
    for (int i = 0; i < I_TW; i += 2) {
      __builtin_amdgcn_sched_barrier(0);
      peer_issue_rows(Vx, loff, c1.e0, c1.e1, rowsB);
      i2_load_xg(p, tokb + 8 * (i + 1), l, x, g, ch, xb);
      i2_load_ctx(p, tokb + 8 * min(i + 3, I_TW - 1), l, x, g, ch, c1);
      __builtin_amdgcn_sched_barrier(0);
      i2_compute(p, xa, rowsA, tokb + 8 * i, x, g, ch);
      __builtin_amdgcn_sched_barrier(0);
      peer_issue_rows(Vx, loff, c0.e0, c0.e1, rowsA);
      i2_load_xg(p, tokb + 8 * min(i + 2, I_TW - 1), l, x, g, ch, xa);
      i2_load_ctx(p, tokb + 8 * min(i + 4, I_TW - 1), l, x, g, ch, c0);
      __builtin_amdgcn_sched_barrier(0);
      i2_compute(p, xb, rowsB, tokb + 8 * (i + 1), x, g, ch);
      __builtin_amdgcn_sched_barrier(0);
    }
  }
}

__device__ __forceinline__ void grid_bar(unsigned* cnt, unsigned& epoch) {
  ++epoch;
  const unsigned target = epoch * gridDim.x;
  __syncthreads();
  if (threadIdx.x == 0) {
    __builtin_amdgcn_fence(__ATOMIC_RELEASE, "agent");
    asm volatile("s_waitcnt vmcnt(0)" ::: "memory");
    __hip_atomic_fetch_add(cnt, 1u, __ATOMIC_RELAXED, __HIP_MEMORY_SCOPE_AGENT);
    while (__hip_atomic_load(cnt, __ATOMIC_RELAXED, __HIP_MEMORY_SCOPE_AGENT) < target) __builtin_amdgcn_s_sleep(1);
    __builtin_amdgcn_fence(__ATOMIC_ACQUIRE, "agent");
    asm volatile("s_waitcnt vmcnt(0)" ::: "memory");
  }
  __syncthreads();
}

__global__ void __launch_bounds__(NTHR) mega_kernel(Params p) {
  extern __shared__ __attribute__((aligned(16))) char smem[];
  cg::grid_group grid = cg::this_grid();
  unsigned epoch = 0;
  for (int rep = 0; rep < REP_P0; ++rep) phase_p0(p, smem);
  grid.sync();
  for (int l = 0; l < 2; ++l) {
    for (int rep = 0; rep < REP_C; ++rep)
    for (int tile = blockIdx.x; tile < NTILE; tile += gridDim.x) phase_c(p, tile, l, l == 0, smem);
    grid_bar(p.wq + 64, epoch);
    for (int rep = 0; rep < REP_DE; ++rep) phase_de(p, l, smem);
    grid_bar(p.wq + 64, epoch);
    for (int tile = blockIdx.x; tile < NTILE; tile += gridDim.x) {
      phase_f(p, tile, l, l == 0, smem);
      for (int rep = 0; rep < REP_G; ++rep) phase_g(p, tile, l, smem);
    }
    grid_bar(p.wq + 64, epoch);
    phase_i1(p, 2 * l, smem);
    grid_bar(p.wq + 64, epoch);
    phase_w(p);
    grid_bar(p.wq + 64, epoch);
    phase_i2(p, l, 2 * l + 1, smem);
    if (l == 0) grid_bar(p.wq + 64, epoch);
  }
}

extern "C" void kernel_launch(void* const* d_in, const int* in_sizes, int n_in, void* d_out, int out_size, void* d_ws,
                              size_t ws_size, hipStream_t stream) {
  Params p{};
  const float* const* in = (const float* const*)d_in;
  p.x_prompt = in[0]; p.x_sample = in[1]; p.c_prompt = in[2]; p.c_sample = in[3]; p.w_mod = in[4]; p.b_mod = in[5];
  p.g1 = in[6]; p.g2 = in[7]; p.w_in = in[8]; p.conv_w = in[9]; p.conv_b = in[10]; p.f_w1 = in[11]; p.f_b1 = in[12];
  p.f_freq = in[13]; p.f_w2 = in[14]; p.f_b2 = in[15]; p.f_w3 = in[16]; p.f_bias = in[17]; p.q_gain = in[18];
  p.k_gain = in[19]; p.sink = in[20]; p.w_pa = in[21]; p.w_pb = in[22]; p.w_out = in[23]; p.peer_wq = in[24];
  p.peer_k1 = in[25]; p.peer_k2 = in[26]; p.peer_u = in[27]; p.peer_v = in[28];
  p.out = (float*)d_out;
  char* ws = (char*)d_ws;
  size_t off = 0;
  auto carve = [&](size_t bytes) { char* r = ws + off; off += (bytes + 255) & ~(size_t)255; return r; };
  p.WinT = (bf16_t*)carve((size_t)2 * INC * DM * 2);
  p.WpaT = (bf16_t*)carve((size_t)2 * DM * HYW * 2);
  p.WpbT = (bf16_t*)carve((size_t)2 * DM * HYW * 2);
  p.WoutT = (bf16_t*)carve((size_t)2 * DM * DM * 2);
  p.WcT = (bf16_t*)carve((size_t)2 * 2048 * DM * 2);
  p.Gf = (bf16_t*)carve((size_t)2 * 2 * 512 * 4096 * 2);
  p.mod = (float*)carve((size_t)2 * NB * 6144 * 4);
  p.rope = (float*)carve((size_t)SEQ * 64 * 4);
  p.tabU8 = (unsigned char*)carve((size_t)NEXP * DM);
  p.tabV8 = (unsigned char*)carve((size_t)NEXP * DM);
  p.sclU = (float*)carve((size_t)NEXP * 4);
  p.sclV = (float*)carve((size_t)NEXP * 4);
  p.wq = (unsigned*)carve(1024);
  p.zT = (bf16_t*)carve((size_t)NB * HYC * SEQ * 2);
  p.yaT = (bf16_t*)carve((size_t)NTOK * HYW * 2);
  p.yb = (bf16_t*)carve((size_t)NTOK * HYW * 2);
  p.zqkv = (bf16_t*)carve((size_t)NTOK * QKVC * 2);
  p.hbuf = (bf16_t*)carve((size_t)NTOK * DM * 2);
  p.merged = p.zT;
  p.yatok = p.zT + (size_t)NTOK * DM;
  p.apart = (float*)p.zT;
  p.pidx = (unsigned short*)p.zqkv;
  p.pg = (float*)(p.zqkv + (size_t)NTOK * 128);
  p.pgu = p.pg + (size_t)NTOK * 128;
  p.wbuf = (bf16_t*)(p.pgu + (size_t)NTOK * 128);
  if (off > ws_size) fprintf(stderr, "workspace too small: need %zu have %zu\n", off, ws_size);

  static int grid_blocks = 0;
  if (!grid_blocks) {
    int dev = 0, cus = 0, per_cu = 0;
    hipGetDevice(&dev);
    hipDeviceGetAttribute(&cus, hipDeviceAttributeMultiprocessorCount, dev);
    hipFuncSetAttribute((const void*)mega_kernel, hipFuncAttributeMaxDynamicSharedMemorySize, SMEM_BYTES);
    hipOccupancyMaxActiveBlocksPerMultiprocessor(&per_cu, mega_kernel, NTHR, SMEM_BYTES);
    if (per_cu < 1) per_cu = 1;
    grid_blocks = cus * 1;
    if (grid_blocks > NTILE) grid_blocks = NTILE;
  }
  void* args[] = {&p};
  hipError_t e = hipLaunchCooperativeKernel((const void*)mega_kernel, dim3(grid_blocks), dim3(NTHR), args, SMEM_BYTES, stream);
  if (e != hipSuccess) fprintf(stderr, "cooperative launch failed: %s (grid %d)\n", hipGetErrorString(e), grid_blocks);
}
```

```cpp
#include <hip/hip_runtime.h>
#include <hip/hip_bf16.h>
#include <hip/hip_cooperative_groups.h>
#include <cstdio>
#include <cstdint>
namespace cg = cooperative_groups;

typedef unsigned short bf16_t;
using bf16x8 = __attribute__((ext_vector_type(8))) short;
using f32x16 = __attribute__((ext_vector_type(16))) float;

constexpr int DM = 1024;
constexpr int NB = 24;
constexpr int SEQ = 2048;
constexpr int NTOK = NB * SEQ;
constexpr int NBP = 16;
constexpr int INC = 4352;
constexpr int HYC = 1536;
constexpr int HYW = 512;
constexpr int QKVC = 768;
constexpr int TM = 192;
constexpr int NTILE = NTOK / TM;
constexpr int NTHR = 512;
constexpr int NEXP = 16384;
constexpr int SMEM_BYTES = 155648;
constexpr int I_TOK = 384;
constexpr int I_NJ = NTOK / I_TOK;
constexpr int I_TW = I_TOK / 8;
#ifndef REP_DE
#define REP_DE 1
#endif
#ifndef REP_C
#define REP_C 1
#endif
#ifndef REP_G
#define REP_G 1
#endif
#ifndef REP_I1
#define REP_I1 1
#endif
#ifndef REP_P0
#define REP_P0 1
#endif

struct Params {
  const float *x_prompt, *x_sample, *c_prompt, *c_sample, *w_mod, *b_mod, *g1, *g2, *w_in, *conv_w, *conv_b;
  const float *f_w1, *f_b1, *f_freq, *f_w2, *f_b2, *f_w3, *f_bias, *q_gain, *k_gain, *sink, *w_pa, *w_pb, *w_out;
  const float *peer_wq, *peer_k1, *peer_k2, *peer_u, *peer_v;
  float* out;
  bf16_t *WinT, *WpaT, *WpbT, *WoutT, *WcT, *Gf, *zT, *zqkv, *yaT, *yb, *hbuf, *merged, *yatok;
  unsigned char *tabU8, *tabV8;
  unsigned short* pidx;
  bf16_t* wbuf;
  float *pg, *pgu, *mod, *rope, *sclU, *sclV, *apart;
  unsigned* wq;
};

__device__ __forceinline__ float bf2f(bf16_t v) { return __uint_as_float(((unsigned)v) << 16); }
__device__ __forceinline__ bf16_t f2bf(float f) {
  unsigned u = __float_as_uint(f);
  u += 0x7FFFu + ((u >> 16) & 1u);
  return (bf16_t)(u >> 16);
}
__device__ __forceinline__ unsigned pack2(float a, float b) { return (unsigned)f2bf(a) | ((unsigned)f2bf(b) << 16); }
__device__ __forceinline__ float lo2f(unsigned u) { return __uint_as_float(u << 16); }
__device__ __forceinline__ float hi2f(unsigned u) { return __uint_as_float(u & 0xFFFF0000u); }

__device__ __forceinline__ int otid() { int t = threadIdx.x; asm volatile("" : "+v"(t)); return t; }
__device__ __forceinline__ int osgpr(int x) { asm volatile("" : "+s"(x)); return x; }
__device__ __forceinline__ void lds_barrier() { asm volatile("s_waitcnt lgkmcnt(0)\n\ts_barrier" ::: "memory"); }
__device__ __forceinline__ float wave_sum(float v) {
#pragma unroll
  for (int m = 32; m >= 1; m >>= 1) v += __shfl_xor(v, m, 64);
  return v;
}

__device__ __forceinline__ const float* xrow_in(const Params& p, int tok) {
  return (tok < NBP * SEQ) ? (p.x_prompt + (size_t)tok * DM) : (p.x_sample + (size_t)(tok - NBP * SEQ) * DM);
}
__device__ __forceinline__ const float* crow(const Params& p, int b) {
  return (b < NBP) ? (p.c_prompt + (size_t)b * DM) : (p.c_sample + (size_t)(b - NBP) * DM);
}

__device__ __forceinline__ void glds16(const bf16_t* g, char* l) {
  __builtin_amdgcn_global_load_lds((const __attribute__((address_space(1))) void*)g, (__attribute__((address_space(3))) void*)l, 16, 0, 0);
}
template <int NT>
__device__ __forceinline__ void gemm_core2(const bf16_t* __restrict__ A, int lda, const bf16_t* __restrict__ B, int ldb,
                                           int K, char* lds, f32x16 (&acc)[3][NT]) {
  constexpr int BROWS = 128 * NT;
  constexpr int STAGE = (192 + BROWS) * 128;
  const int tid = otid();
  const int lane = tid & 63, w = tid >> 6;
  const int wm = w >> 2, wn = w & 3;
#pragma unroll
  for (int i = 0; i < 3; ++i)
#pragma unroll
    for (int n = 0; n < NT; ++n)
#pragma unroll
      for (int j = 0; j < 16; ++j) acc[i][n][j] = 0.f;
  const int lr = lane >> 3, lc = lane & 7;
  const bf16_t* pa[3];
  const bf16_t* pb[2 * NT];
#pragma unroll
  for (int i = 0; i < 3; ++i) {
    const int row = (w + 8 * i) * 8 + lr;
    pa[i] = A + (size_t)row * lda + ((lc ^ ((row >> 1) & 7)) * 8);
  }
#pragma unroll
  for (int i = 0; i < 2 * NT; ++i) {
    const int row = (w + 8 * i) * 8 + lr;
    pb[i] = B + (size_t)row * ldb + ((lc ^ ((row >> 1) & 7)) * 8);
  }
  const int nk = K >> 6;
  lds_barrier();
  {
#pragma unroll
    for (int i = 0; i < 3; ++i) glds16(pa[i], lds + (w + 8 * i) * 1024);
#pragma unroll
    for (int i = 0; i < 2 * NT; ++i) glds16(pb[i], lds + 192 * 128 + (w + 8 * i) * 1024);
  }
  asm volatile("s_waitcnt vmcnt(0)" ::: "memory");
  __syncthreads();
  const int fr = lane & 31, hh = lane >> 5;
  int aoff[3], akey[3], boff[NT], bkey[NT];
#pragma unroll
  for (int mi = 0; mi < 3; ++mi) { const int r = wm * 96 + mi * 32 + fr; aoff[mi] = r * 128; akey[mi] = (r >> 1) & 7; }
#pragma unroll
  for (int ni = 0; ni < NT; ++ni) { const int r = wn * 32 * NT + ni * 32 + fr; boff[ni] = 192 * 128 + r * 128; bkey[ni] = (r >> 1) & 7; }
#pragma unroll 1
  for (int kt = 0; kt < nk; ++kt) {
    if (kt + 1 < nk) {
      char* sb = lds + ((kt + 1) & 1) * STAGE;
      const int ko = (kt + 1) << 6;
#pragma unroll
      for (int i = 0; i < 3; ++i) glds16(pa[i] + ko, sb + (w + 8 * i) * 1024);
#pragma unroll
      for (int i = 0; i < 2 * NT; ++i) glds16(pb[i] + ko, sb + 192 * 128 + (w + 8 * i) * 1024);
    }
    const char* st = lds + (kt & 1) * STAGE;
    bf16x8 afr[2][3], bfr[2][NT];
#pragma unroll
    for (int ni = 0; ni < NT; ++ni) bfr[0][ni] = *(const bf16x8*)(st + boff[ni] + ((hh ^ bkey[ni]) << 4));
#pragma unroll
    for (int mi = 0; mi < 3; ++mi) afr[0][mi] = *(const bf16x8*)(st + aoff[mi] + ((hh ^ akey[mi]) << 4));
#pragma unroll
    for (int kk = 0; kk < 4; ++kk) {
      const int cur = kk & 1, nxt = cur ^ 1;
      if (kk < 3) {
        const int kc = 2 * (kk + 1) + hh;
#pragma unroll
        for (int ni = 0; ni < NT; ++ni) bfr[nxt][ni] = *(const bf16x8*)(st + boff[ni] + ((kc ^ bkey[ni]) << 4));
#pragma unroll
        for (int mi = 0; mi < 3; ++mi) afr[nxt][mi] = *(const bf16x8*)(st + aoff[mi] + ((kc ^ akey[mi]) << 4));
      }
      __builtin_amdgcn_sched_barrier(0);
#pragma unroll
      for (int mi = 0; mi < 3; ++mi)
#pragma unroll
        for (int ni = 0; ni < NT; ++ni) acc[mi][ni] = __builtin_amdgcn_mfma_f32_32x32x16_bf16(afr[cur][mi], bfr[cur][ni], acc[mi][ni], 0, 0, 0);
      __builtin_amdgcn_sched_barrier(0);
    }
    asm volatile("s_waitcnt vmcnt(0)" ::: "memory");
    __syncthreads();
  }
}
template <int MODE>
__device__ __forceinline__ void gemm_f1(const bf16_t* __restrict__ A0, const bf16_t* __restrict__ A1, int lda,
                                        const bf16_t* __restrict__ B0, const bf16_t* __restrict__ B1, int ldb,
                                        char* lds, f32x16 (&acc)[3][2]) {
  constexpr int STAGE = (192 + 256) * 128;
  const int tid = otid();
  const int lane = tid & 63, w = tid >> 6;
  const int wm = w >> 2, wn = w & 3;
#pragma unroll
  for (int i = 0; i < 3; ++i)
#pragma unroll
    for (int n = 0; n < 2; ++n)
#pragma unroll
      for (int j = 0; j < 16; ++j) acc[i][n][j] = 0.f;
  const int lr = lane >> 3, lc = lane & 7;
  const bool hi = (w >= 4);
  int aofs[3];
  const bf16_t* pb[4];
#pragma unroll
  for (int i = 0; i < 3; ++i) {
    const int row = (w + 8 * i) * 8 + lr;
    aofs[i] = row * lda + ((lc ^ ((row >> 1) & 7)) * 8);
  }
#pragma unroll
  for (int i = 0; i < 4; ++i) {
    const int rb = (w + 8 * i) * 8 + lr;
    const int srow = i * 32 + (w & 3) * 8 + lr;
    pb[i] = (hi ? B1 : B0) + (size_t)srow * ldb + ((lc ^ ((rb >> 1) & 7)) * 8);
  }
  constexpr int NK = 16;
  auto issue = [&](int kt) {
    char* sb = lds + (kt & 1) * STAGE;
    const bf16_t* Ab = (MODE == 2 && kt >= 8) ? A1 : A0;
    const int ka = (MODE == 2) ? ((kt & 7) << 6) : (kt << 6);
#pragma unroll
    for (int i = 0; i < 3; ++i) glds16(Ab + aofs[i] + ka, sb + (w + 8 * i) * 1024);
    if (MODE == 1 || ((kt >= 8) == hi)) {
#pragma unroll
      for (int i = 0; i < 4; ++i) glds16(pb[i] + ka, sb + 192 * 128 + (w + 8 * i) * 1024);
    }
  };
  lds_barrier();
  issue(0);
  asm volatile("s_waitcnt vmcnt(0)" ::: "memory");
  __syncthreads();
  const int fr = lane & 31, hh = lane >> 5;
  int aoff[3], akey[3], boff[2], bkey[2];
#pragma unroll
  for (int mi = 0; mi < 3; ++mi) { const int r = wm * 96 + mi * 32 + fr; aoff[mi] = r * 128; akey[mi] = (r >> 1) & 7; }
#pragma unroll
  for (int ni = 0; ni < 2; ++ni) { const int r = wn * 64 + ni * 32 + fr; boff[ni] = 192 * 128 + r * 128; bkey[ni] = (r >> 1) & 7; }
#pragma unroll
  for (int hf = 0; hf < 2; ++hf) {
#pragma unroll 1
    for (int kt = hf * 8; kt < hf * 8 + 8; ++kt) {
      if (kt + 1 < NK) issue(kt + 1);
      const char* st = lds + (kt & 1) * STAGE;
#pragma unroll
      for (int kk = 0; kk < 4; ++kk) {
        const int kc = 2 * kk + hh;
        bf16x8 bfr[2];
#pragma unroll
        for (int ni = 0; ni < 2; ++ni) if (MODE == 1 || ni == hf) bfr[ni] = *(const bf16x8*)(st + boff[ni] + ((kc ^ bkey[ni]) << 4));
#pragma unroll
        for (int mi = 0; mi < 3; ++mi) {
          const bf16x8 afr = *(const bf16x8*)(st + aoff[mi] + ((kc ^ akey[mi]) << 4));
#pragma unroll
          for (int ni = 0; ni < 2; ++ni)
            if (MODE == 1 || ni == hf) acc[mi][ni] = __builtin_amdgcn_mfma_f32_32x32x16_bf16(afr, bfr[ni], acc[mi][ni], 0, 0, 0);
        }
      }
      asm volatile("s_waitcnt vmcnt(0)" ::: "memory");
      __syncthreads();
    }
  }
}

#define ACC_ROW(wm, mi, reg, lane) ((wm) * 96 + (mi) * 32 + ((reg) & 3) + 8 * ((reg) >> 2) + 4 * ((lane) >> 5))

template <int NT>
__device__ __forceinline__ void acc_to_lds(const f32x16 (&acc)[3][NT], float* ct, int LD, int half) {
  const int tid_ = otid(); const int lane = tid_ & 63, w = tid_ >> 6, wm = w >> 2, wn = w & 3;
  if (NT == 2 && (wn >> 1) != half) return;
#pragma unroll
  for (int ni = 0; ni < NT; ++ni) {
    const int n = (NT == 2 ? (wn & 1) * 64 : wn * 32) + ni * 32 + (lane & 31);
#pragma unroll
    for (int mi = 0; mi < 3; ++mi)
#pragma unroll
      for (int r = 0; r < 16; ++r) ct[ACC_ROW(wm, mi, r, lane) * LD + n] = acc[mi][ni][r];
  }
}
constexpr int LDT = 196;
template <int NT>
__device__ __forceinline__ void acc_to_lds_T(const f32x16 (&acc)[3][NT], float* ctT, int half) {
  const int tid_ = otid(); const int lane = tid_ & 63, w = tid_ >> 6, wm = w >> 2, wn = w & 3;
  if (NT == 2 && (wn >> 1) != half) return;
#pragma unroll
  for (int ni = 0; ni < NT; ++ni) {
    const int n = (NT == 2 ? (wn & 1) * 64 : wn * 32) + ni * 32 + (lane & 31);
#pragma unroll
    for (int mi = 0; mi < 3; ++mi)
#pragma unroll
      for (int g4 = 0; g4 < 4; ++g4) {
        const int r0 = wm * 96 + mi * 32 + 8 * g4 + 4 * (lane >> 5);
        float4 v; v.x = acc[mi][ni][g4 * 4 + 0]; v.y = acc[mi][ni][g4 * 4 + 1]; v.z = acc[mi][ni][g4 * 4 + 2]; v.w = acc[mi][ni][g4 * 4 + 3];
        *(float4*)(ctT + n * LDT + r0) = v;
      }
  }
}
__device__ __forceinline__ void store_tile_bf16(const float* ct, bf16_t* dst, int ldd, int tok0, int n0) {
#pragma unroll 1
  for (int it = otid(); it < 192 * 16; it += NTHR) {
    const int c8 = it & 15, r = it >> 4;
    const float4 a = *(const float4*)(ct + r * 132 + c8 * 8), b = *(const float4*)(ct + r * 132 + c8 * 8 + 4);
    uint4 o; o.x = pack2(a.x, a.y); o.y = pack2(a.z, a.w); o.z = pack2(b.x, b.y); o.w = pack2(b.z, b.w);
    *(uint4*)(dst + (size_t)(tok0 + r) * ldd + n0 + c8 * 8) = o;
  }
}

__device__ void p0_transpose_tile(const float* __restrict__ src, bf16_t* __restrict__ dst, int R, int C, int tr, int tc, char* smem) {
  float* t = (float*)smem;
  const int tid = otid();
  __syncthreads();
#pragma unroll
  for (int i = 0; i < 8; ++i) {
    int r = (tid >> 6) + 8 * i, c = tid & 63;
    t[r * 65 + c] = src[(size_t)(tr * 64 + r) * C + tc * 64 + c];
  }
  __syncthreads();
#pragma unroll
  for (int i = 0; i < 8; ++i) {
    int cc = (tid >> 6) + 8 * i, rr = tid & 63;
    dst[(size_t)(tc * 64 + cc) * R + tr * 64 + rr] = f2bf(t[rr * 65 + cc]);
  }
}

__device__ void p0_wc_item(const Params& p, int l, int ph, int kt, char* smem) {
  float* wqs = (float*)smem;
  float* ks = wqs + 64 * 129;
  const int tid = otid();
  const float* wq = p.peer_wq + (size_t)l * DM * 2048;
  const float* kk = ((ph & 1) ? p.peer_k2 : p.peer_k1) + (size_t)l * 128 * 128;
  __syncthreads();
  for (int e = tid; e < 64 * 128; e += NTHR) {
    int r = e >> 7, d = e & 127;
    wqs[r * 129 + d] = wq[(size_t)(kt * 64 + r) * 2048 + ph * 128 + d];
  }
  for (int e = tid; e < 128 * 128; e += NTHR) {
    int r = e >> 7, d = e & 127;
    ks[r * 129 + d] = kk[r * 128 + d];
  }
  __syncthreads();
  const int key = tid & 127, k0 = (tid >> 7) * 16;
  float acc[16];
#pragma unroll
  for (int i = 0; i < 16; ++i) acc[i] = 0.f;
  for (int d = 0; d < 128; ++d) {
    float kv = ks[key * 129 + d];
#pragma unroll
    for (int i = 0; i < 16; ++i) acc[i] += wqs[(k0 + i) * 129 + d] * kv;
  }
  bf16_t* dst = p.WcT + ((size_t)l * 2048 + ph * 128 + key) * DM + kt * 64 + k0;
  uint4 o0, o1;
  o0.x = pack2(acc[0], acc[1]); o0.y = pack2(acc[2], acc[3]); o0.z = pack2(acc[4], acc[5]); o0.w = pack2(acc[6], acc[7]);
  o1.x = pack2(acc[8], acc[9]); o1.y = pack2(acc[10], acc[11]); o1.z = pack2(acc[12], acc[13]); o1.w = pack2(acc[14], acc[15]);
  *(uint4*)dst = o0; *(uint4*)(dst + 8) = o1;
}

__device__ void p0_mod_item(const Params& p, int l, int cc, char* smem) {
  float* sc = (float*)smem;
  float* red = sc + 1024 * 24;
  const int tid = otid();
  __syncthreads();
  for (int e = tid; e < NB * DM; e += NTHR) {
    int b = e >> 10, k = e & 1023;
    float v = crow(p, b)[k];
    sc[k * 24 + b] = v / (1.f + __expf(-v));
  }
  __syncthreads();
  const int col = tid & 63, kg = tid >> 6;
  const int n = cc * 64 + col;
  float acc[24];
#pragma unroll
  for (int b = 0; b < 24; ++b) acc[b] = 0.f;
  const float* wm = p.w_mod + (size_t)l * DM * 6144 + n;
#pragma unroll 1
  for (int k0 = kg * 128; k0 < kg * 128 + 128; k0 += 8) {
    float wv[8];
#pragma unroll
    for (int j = 0; j < 8; ++j) wv[j] = wm[(size_t)(k0 + j) * 6144];
#pragma unroll
    for (int j = 0; j < 8; ++j) {
      const float4* s4 = (const float4*)(sc + (k0 + j) * 24);
#pragma unroll
      for (int q = 0; q < 6; ++q) {
        float4 sv = s4[q];
        acc[q * 4 + 0] += sv.x * wv[j]; acc[q * 4 + 1] += sv.y * wv[j]; acc[q * 4 + 2] += sv.z * wv[j]; acc[q * 4 + 3] += sv.w * wv[j];
      }
    }
  }
#pragma unroll
  for (int b = 0; b < 24; ++b) red[(kg * 24 + b) * 64 + col] = acc[b];
  __syncthreads();
  for (int e = tid; e < 24 * 64; e += NTHR) {
    const int b = e >> 6, c2 = e & 63;
    float sum = p.b_mod[l * 6144 + cc * 64 + c2];
#pragma unroll
    for (int g = 0; g < 8; ++g) sum += red[(g * 24 + b) * 64 + c2];
    p.mod[((size_t)l * NB + b) * 6144 + cc * 64 + c2] = sum;
  }
}

__device__ void p0_filter_item(const Params& p, int l, int tc, char* smem) {
  float* feat = (float*)smem;
  float* a1 = feat + 32 * 33;
  float* a2 = a1 + 32 * 64;
  bf16_t* stage = (bf16_t*)(a2 + 32 * 64);
  const int tid = otid();
  const int t0 = tc * 32;
  __syncthreads();
  for (int e = tid; e < 32 * 33; e += NTHR) {
    int pp = e / 33, f = e % 33;
    int ti = t0 + pp;
    float v;
    if (f == 0) v = (float)ti / (float)(SEQ - 1);
    else {
      int bi = (f - 1) & 15;
      float band = 1e-4f + (float)bi * ((15.f - 1e-4f) / 15.f);
      float wv = 2.0f * 3.14159265358979323846f * (float)ti / (float)SEQ;
      float arg = band * wv;
      v = (f <= 16) ? cosf(arg) : -sinf(arg);
    }
    feat[pp * 33 + f] = v;
  }
  __syncthreads();
  const float* w1 = p.f_w1 + l * 33 * 64; const float* b1 = p.f_b1 + l * 64; const float* fq = p.f_freq + l * 64;
  const float* w2 = p.f_w2 + l * 64 * 64; const float* b2 = p.f_b2 + l * 64;
  for (int e = tid; e < 32 * 64; e += NTHR) {
    int pp = e >> 6, j = e & 63;
    float s = b1[j];
    for (int f = 0; f < 33; ++f) s += feat[pp * 33 + f] * w1[f * 64 + j];
    a1[pp * 64 + j] = sinf(fq[j] * s);
  }
  __syncthreads();
  for (int e = tid; e < 32 * 64; e += NTHR) {
    int pp = e >> 6, j = e & 63;
    float s = b2[j];
    for (int i = 0; i < 64; ++i) s += a1[pp * 64 + i] * w2[i * 64 + j];
    a2[pp * 64 + j] = sinf(fq[j] * s);
  }
  __syncthreads();
  const float* w3 = p.f_w3 + (size_t)l * 64 * 2048;
  const float min_decay = logf(1e-2f) / 1.5f, max_decay = logf(1e-2f) / 0.3f;
  for (int q = 0; q < 4; ++q) {
    const int n = tid + 512 * q;
    const int c = n & 511;
    float wr[64];
#pragma unroll
    for (int i = 0; i < 64; ++i) wr[i] = w3[i * 2048 + n];
    const float delta = fabsf(min_decay + (max_decay - min_decay) * (float)c / 511.f);
    for (int pp = 0; pp < 32; ++pp) {
      float s = 0.f;
#pragma unroll
      for (int i = 0; i < 64; ++i) s += a2[pp * 64 + i] * wr[i];
      float tt = (float)(t0 + pp) / (float)(SEQ - 1);
      s *= __expf(-tt * delta);
      if (t0 + pp == 0 && ((n >> 9) & 1) == 0) s += p.f_bias[(l * 2 + (n >> 10)) * 512 + c];
      stage[n * 32 + pp] = f2bf(s);
    }
  }
  __syncthreads();
  for (int e = tid; e < 2048 * 32; e += NTHR) {
    int n = e >> 5, pp = e & 31;
    int o = n >> 10, d = (n >> 9) & 1, c = n & 511;
    int t = t0 + pp;
    bf16_t* g = p.Gf + ((size_t)((l * 2 + o) * 512 + c)) * 4096;
    if (d == 0) g[2048 - t] = stage[n * 32 + pp];
    else if (t >= 1) g[2048 + t] = stage[n * 32 + pp];
    if (t == 0 && d == 0) g[0] = 0;
  }
}

__device__ void p0_rope_item(const Params& p, int it) {
  int e = it * 512 + otid();
  int pos = e >> 5, i = e & 31;
  float inv = powf(10000.f, -(float)(2 * i) / 64.f);
  float ang = (float)pos * inv;
  p.rope[e * 2 + 0] = cosf(ang);
  p.rope[e * 2 + 1] = sinf(ang);
}

__device__ __forceinline__ int next_item(unsigned* cnt, char* smem) {
  int* sh = (int*)(smem + SMEM_BYTES - 16);
  __syncthreads();
  if (threadIdx.x == 0) *sh = (int)atomicAdd(cnt, 1u);
  __syncthreads();
  return *sh;
}

constexpr int P0_N_MOD = 2 * 96;
constexpr int P0_N_FILT = 2 * 64;
constexpr int P0_N_ROPE = 128;
constexpr int P0_N_WIN = 16 * 68;
constexpr int P0A_TOTAL = P0_N_FILT + P0_N_MOD + P0_N_ROPE + P0_N_WIN;
constexpr int P0_N_WC = 2 * 16 * 16;
constexpr int P0_N_SMALL = 8 * 16 + 8 * 16 + 16 * 16;
constexpr int P0B_TOTAL = P0_N_WC + P0_N_WIN + 2 * P0_N_SMALL;

__device__ __forceinline__ void p0_win_tile(const Params& p, int l, int j, char* smem) {
  p0_transpose_tile(p.w_in + (size_t)l * DM * INC, p.WinT + (size_t)l * INC * DM, DM, INC, j / 68, j % 68, smem);
}
__device__ void p0a_item(const Params& p, int i, char* smem) {
  if (i < P0_N_FILT) { p0_filter_item(p, i / 64, i % 64, smem); return; }
  i -= P0_N_FILT;
  if (i < P0_N_MOD) { p0_mod_item(p, i / 96, i % 96, smem); return; }
  i -= P0_N_MOD;
  if (i < P0_N_ROPE) { p0_rope_item(p, i); return; }
  i -= P0_N_ROPE;
  p0_win_tile(p, 0, i, smem);
}
__device__ void p0b_item(const Params& p, int i, char* smem) {
  if (i < P0_N_WC) { p0_wc_item(p, i >> 8, (i >> 4) & 15, i & 15, smem); return; }
  i -= P0_N_WC;
  if (i < P0_N_WIN) { p0_win_tile(p, 1, i, smem); return; }
  i -= P0_N_WIN;
  const int l = i / P0_N_SMALL; int j = i % P0_N_SMALL;
  if (j < 128) { p0_transpose_tile(p.w_pa + (size_t)l * HYW * DM, p.WpaT + (size_t)l * DM * HYW, HYW, DM, j / 16, j % 16, smem); return; }
  j -= 128;
  if (j < 128) { p0_transpose_tile(p.w_pb + (size_t)l * HYW * DM, p.WpbT + (size_t)l * DM * HYW, HYW, DM, j / 16, j % 16, smem); return; }
  j -= 128;
  p0_transpose_tile(p.w_out + (size_t)l * DM * DM, p.WoutT + (size_t)l * DM * DM, DM, DM, j / 16, j % 16, smem);
}
__device__ void phase_p0(const Params& p, char* smem) {
  for (int it = next_item(p.wq + 96, smem); it < P0A_TOTAL; it = next_item(p.wq + 96, smem)) p0a_item(p, it, smem);
}

__device__ void norm_rows(const Params& p, int tile, int l, int which, bool from_inputs, char* smem) {
  float* scl = (float*)smem;
  float* shf = scl + 2048;
  const int tid = otid(), lane = tid & 63, w = tid >> 6;
  const int tok0 = tile * TM;
  const int b0 = tok0 >> 11;
  const float* g = (which ? p.g2 : p.g1) + l * DM;
  __syncthreads();
  for (int e = tid; e < 2048; e += NTHR) {
    int bi = e >> 10, j = e & 1023;
    int b = b0 + bi; if (b > NB - 1) b = NB - 1;
    const float* m = p.mod + ((size_t)l * NB + b) * 6144 + which * 3072;
    scl[e] = g[j] * (1.f + m[1024 + j]);
    shf[e] = m[j];
  }
  __syncthreads();
#pragma unroll 1
  for (int r0 = w; r0 < TM; r0 += 32) {
    float4 v[4][4];
#pragma unroll
    for (int q = 0; q < 4; ++q) {
      const int tok = tok0 + r0 + 8 * q;
      const float* xr = from_inputs ? xrow_in(p, tok) : (p.out + (size_t)tok * DM);
#pragma unroll
      for (int i = 0; i < 4; ++i) v[q][i] = *(const float4*)(xr + lane * 4 + 256 * i);
    }
#pragma unroll
    for (int q = 0; q < 4; ++q) {
      const int tok = tok0 + r0 + 8 * q;
      const int bi = (tok >> 11) - b0;
      float ss = 0.f;
#pragma unroll
      for (int i = 0; i < 4; ++i) ss += v[q][i].x * v[q][i].x + v[q][i].y * v[q][i].y + v[q][i].z * v[q][i].z + v[q][i].w * v[q][i].w;
      ss = wave_sum(ss);
      const float rs = rsqrtf(ss * (1.f / DM) + 1e-6f);
#pragma unroll
      for (int i = 0; i < 4; ++i) {
        const int j = lane * 4 + 256 * i;
        const float4 sc4 = *(const float4*)(scl + bi * 1024 + j);
        const float4 sh4 = *(const float4*)(shf + bi * 1024 + j);
        uint2 o;
        o.x = pack2(v[q][i].x * rs * sc4.x + sh4.x, v[q][i].y * rs * sc4.y + sh4.y);
        o.y = pack2(v[q][i].z * rs * sc4.z + sh4.z, v[q][i].w * rs * sc4.w + sh4.w);
        *(uint2*)(p.hbuf + (size_t)tok * DM + j) = o;
      }
    }
  }
  __syncthreads();
}

__device__ void phase_c(const Params& p, int tile, int l, bool from_inputs, char* smem) {
  norm_rows(p, tile, l, 0, from_inputs, smem);
  const int tid = otid();
  const int tok0 = tile * TM;
  const bf16_t* A = p.hbuf + (size_t)tok0 * DM;
  const bf16_t* W = p.WinT + (size_t)l * INC * DM;
  float* ct = (float*)smem;
  f32x16 acc[3][2];
#pragma unroll 1
  for (int nt = 0; nt < 9; ++nt) {
    gemm_core2<2>(A, DM, W + (size_t)nt * 256 * DM, DM, DM, smem, acc);
#pragma unroll 1
    for (int half = 0; half < 2; ++half) {
      const int nc = nt * 2 + half;
      if (nc < 12) {
        acc_to_lds_T<2>(acc, ct, half);
        lds_barrier();
#pragma unroll 1
        for (int it = tid; it < 128 * 24; it += NTHR) {
          const int tg = it % 24, nl = it / 24;
          const float4 a = *(const float4*)(ct + nl * LDT + tg * 8), b4 = *(const float4*)(ct + nl * LDT + tg * 8 + 4);
          uint4 o; o.x = pack2(a.x, a.y); o.y = pack2(a.z, a.w); o.z = pack2(b4.x, b4.y); o.w = pack2(b4.z, b4.w);
          const int tok = tok0 + tg * 8;
          const int b = tok >> 11, sq = tok & 2047;
          *(uint4*)(p.zT + ((size_t)b * HYC + nc * 128 + nl) * SEQ + sq) = o;
        }
      } else {
        acc_to_lds<2>(acc, ct, 132, half);
        lds_barrier();
        store_tile_bf16(ct, p.zqkv, QKVC, tok0, nc * 128 - HYC);
      }
      lds_barrier();
    }
  }
}

__device__ __forceinline__ void load_conv8(const bf16_t* __restrict__ zrow, int s0, float w0, float w1, float w2, float cb, float (&o)[8]) {
  uint4 v = *(const uint4*)(zrow + s0);
  float z[10];
  z[0] = (s0 > 0) ? bf2f(zrow[s0 - 1]) : 0.f;
  z[1] = lo2f(v.x); z[2] = hi2f(v.x); z[3] = lo2f(v.y); z[4] = hi2f(v.y);
  z[5] = lo2f(v.z); z[6] = hi2f(v.z); z[7] = lo2f(v.w); z[8] = hi2f(v.w);
  z[9] = (s0 + 8 < SEQ) ? bf2f(zrow[s0 + 8]) : 0.f;
#pragma unroll
  for (int i = 0; i < 8; ++i) o[i] = z[i] * w0 + z[i + 1] * w1 + z[i + 2] * w2 + cb;
}

struct Conv8In { uint4 v; unsigned short l, r; };
__device__ __forceinline__ void conv8_load(const bf16_t* __restrict__ zrow, int s0, Conv8In& c) {
  c.v = *(const uint4*)(zrow + s0);
  c.l = (s0 > 0) ? zrow[s0 - 1] : (unsigned short)0;
  c.r = (s0 + 8 < SEQ) ? zrow[s0 + 8] : (unsigned short)0;
}
__device__ __forceinline__ void conv8_eval(const Conv8In& c, float w0, float w1, float w2, float cb, float (&o)[8]) {
  float z[10];
  z[0] = bf2f(c.l);
  z[1] = lo2f(c.v.x); z[2] = hi2f(c.v.x); z[3] = lo2f(c.v.y); z[4] = hi2f(c.v.y);
  z[5] = lo2f(c.v.z); z[6] = hi2f(c.v.z); z[7] = lo2f(c.v.w); z[8] = hi2f(c.v.w);
  z[9] = bf2f(c.r);
#pragma unroll
  for (int i = 0; i < 8; ++i) o[i] = z[i] * w0 + z[i + 1] * w1 + z[i + 2] * w2 + cb;
}

typedef short s16x4 __attribute__((ext_vector_type(4)));
__device__ __forceinline__ s16x4 tr_read4(const bf16_t* lds_ptr) {
  return __builtin_amdgcn_ds_read_tr16_b64_v4i16((__attribute__((address_space(3))) s16x4*)(lds_ptr));
}

constexpr int HY_GS_ELEMS = 4112;
constexpr int HY_US_ROWS = 2072;
__device__ __forceinline__ void hyena_load_g(const Params& p, int l, int o, int c, bf16_t* Gs, int tid) {
  const bf16_t* g = p.Gf + ((size_t)((l * 2 + o) * 512 + c)) * 4096;
  *(uint4*)(Gs + 8 + tid * 8) = *(const uint4*)(g + tid * 8);
  if (tid == 0) { unsigned z = 0; asm volatile("" : "+v"(z)); const uint4 z4 = make_uint4(z, z, z, z); *(uint4*)Gs = z4; *(uint4*)(Gs + 4104) = z4; }
}

__device__ __forceinline__ void hyena_kloop(const bf16_t* Gs, const bf16_t* us, int rho, int lane, f32x16 (&acc)[8]) {
#pragma unroll
  for (int a = 0; a < 8; ++a)
#pragma unroll
    for (int j = 0; j < 16; ++j) acc[a][j] = 0.f;
  const int i = lane & 31, hh = lane >> 5;
  const bf16_t* ga = Gs + (2040 - 8 * i + 8 * hh) - 1792;
  const int l16 = lane & 15, q = l16 >> 2, pq = l16 & 3, g4 = lane >> 4;
  const bf16_t* ub = us + (rho + 8 * (g4 >> 1) + q) * 24 + 16 * (g4 & 1) + 4 * pq;
#pragma unroll 1
  for (int kap = 0; kap < 129; ++kap) {
    const s16x4 b0 = tr_read4(ub + kap * 384);
    const s16x4 b1 = tr_read4(ub + kap * 384 + 96);
    bf16x8 bfrag;
    bfrag[0] = b0[0]; bfrag[1] = b0[1]; bfrag[2] = b0[2]; bfrag[3] = b0[3];
    bfrag[4] = b1[0]; bfrag[5] = b1[1]; bfrag[6] = b1[2]; bfrag[7] = b1[3];
#pragma unroll
    for (int a = 0; a < 8; ++a) {
      const bf16x8 af = *(const bf16x8*)(ga + kap * 16 + 256 * (7 - a));
      acc[a] = __builtin_amdgcn_mfma_f32_32x32x16_bf16(af, bfrag, acc[a], 0, 0, 0);
    }
  }
}

__device__ __forceinline__ void hyena_acc_to_us(const f32x16 (&acc)[8], bf16_t* us, int rho, int lane) {
  const int n = lane & 31, hh = lane >> 5;
  if (n < 24) {
#pragma unroll
    for (int a = 0; a < 8; ++a)
#pragma unroll
      for (int r = 0; r < 16; ++r) {
        const int t = 256 * a + rho + 8 * ((r & 3) + 8 * (r >> 2) + 4 * hh);
        us[(t + 16) * 24 + n] = f2bf(acc[a][r]);
      }
  }
}

__device__ void hyena_item(const Params& p, int l, int c, char* smem) {
  bf16_t* Gs = (bf16_t*)smem;
  bf16_t* us = (bf16_t*)(smem + 8256);
  const int tid = otid();
  const int lane = tid & 63, w = tid >> 6;
  const float* cw = p.conv_w + (size_t)l * 3 * HYC;
  const float* cbp = p.conv_b + (size_t)l * HYC;
  __syncthreads();
  hyena_load_g(p, l, 0, c, Gs, tid);
  {
    unsigned z = 0; asm volatile("" : "+v"(z)); const uint4 z4 = make_uint4(z, z, z, z);
    if (tid < 48) *(uint4*)(us + tid * 8) = z4;
    else if (tid < 48 + 26) *(uint4*)(us + 2064 * 24 + (tid - 48) * 8) = z4;
  }
  {
    const float w0 = cw[c], w1 = cw[HYC + c], w2 = cw[2 * HYC + c], cb = cbp[c];
#pragma unroll 1
    for (int q0 = tid; q0 < 24 * 256; q0 += 4 * NTHR) {
      Conv8In cin[4];
#pragma unroll
      for (int j = 0; j < 4; ++j) {
        const int qq = q0 + j * NTHR;
        conv8_load(p.zT + ((size_t)(qq % 24) * HYC + c) * SEQ, (qq / 24) * 8, cin[j]);
      }
#pragma unroll
      for (int j = 0; j < 4; ++j) {
        const int qq = q0 + j * NTHR;
        const int b = qq % 24, s0 = (qq / 24) * 8;
        float v[8];
        conv8_eval(cin[j], w0, w1, w2, cb, v);
#pragma unroll
        for (int i = 0; i < 8; ++i) us[(s0 + i + 16) * 24 + b] = f2bf(v[i]);
      }
    }
  }
  __syncthreads();
  f32x16 acc[8];
#pragma unroll 1
  for (int o = 0; o < 2; ++o) {
    hyena_kloop(Gs, us, w, lane, acc);
    __syncthreads();
    hyena_acc_to_us(acc, us, w, lane);
    if (o == 0) hyena_load_g(p, l, 1, c, Gs, tid);
    __syncthreads();
    const int xc = (o == 0 ? 512 : 1024) + c;
    const float xw0 = cw[xc], xw1 = cw[HYC + xc], xw2 = cw[2 * HYC + xc], xcb = cbp[xc];
#pragma unroll 1
    for (int q0 = tid; q0 < 24 * 256; q0 += 4 * NTHR) {
      Conv8In cin[4];
#pragma unroll
      for (int j = 0; j < 4; ++j) {
        const int qq = q0 + j * NTHR;
        conv8_load(p.zT + ((size_t)(qq % 24) * HYC + xc) * SEQ, (qq / 24) * 8, cin[j]);
      }
#pragma unroll
      for (int j = 0; j < 4; ++j) {
        const int qq = q0 + j * NTHR;
        const int b = qq % 24, s0 = (qq / 24) * 8;
        float xv[8];
        conv8_eval(cin[j], xw0, xw1, xw2, xcb, xv);
        if (o == 0) {
#pragma unroll
          for (int i = 0; i < 8; ++i) {
            bf16_t* e = us + (s0 + i + 16) * 24 + b;
            *e = f2bf(bf2f(*e) * xv[i]);
          }
        } else {
          float r[8];
#pragma unroll
          for (int i = 0; i < 8; ++i) r[i] = bf2f(us[(s0 + i + 16) * 24 + b]) * xv[i];
          uint4 pk; pk.x = pack2(r[0], r[1]); pk.y = pack2(r[2], r[3]); pk.z = pack2(r[4], r[5]); pk.w = pack2(r[6], r[7]);
          *(uint4*)(p.yaT + ((size_t)b * HYW + c) * SEQ + s0) = pk;
        }
      }
    }
    __syncthreads();
  }
}

__device__ void attn_item(const Params& p, int l, int item, char* smem) {
  constexpr int KS = 72, VS = 96;
  bf16_t* Ks = (bf16_t*)smem;
  bf16_t* Vs = Ks + 384 * KS;
  const int tid = otid();
  const int lane = tid & 63, w = tid >> 6;
  const int kh = item & 1, qb = (item >> 1) & 15, b = item >> 5;
  const int kpos0 = qb * 128 - 128;
  __syncthreads();
  if (tid < 384) {
    const int r = tid, kpos = kpos0 + r;
    if (kpos >= 0 && kpos < SEQ) {
      const bf16_t* kr = p.zqkv + ((size_t)(b * SEQ + kpos)) * QKVC + 512 + kh * 64;
      float kf[64];
      float ss = 0.f;
#pragma unroll
      for (int c8 = 0; c8 < 8; ++c8) {
        uint4 v = *(const uint4*)(kr + c8 * 8);
        kf[c8 * 8 + 0] = lo2f(v.x); kf[c8 * 8 + 1] = hi2f(v.x); kf[c8 * 8 + 2] = lo2f(v.y); kf[c8 * 8 + 3] = hi2f(v.y);
        kf[c8 * 8 + 4] = lo2f(v.z); kf[c8 * 8 + 5] = hi2f(v.z); kf[c8 * 8 + 6] = lo2f(v.w); kf[c8 * 8 + 7] = hi2f(v.w);
      }
#pragma unroll
      for (int d = 0; d < 64; ++d) ss += kf[d] * kf[d];
      const float rs = rsqrtf(ss * (1.f / 64.f) + 1e-6f);
      const float* kg = p.k_gain + l * 64;
#pragma unroll
      for (int d = 0; d < 64; ++d) kf[d] = kf[d] * rs * kg[d];
      const float* rp = p.rope + (size_t)kpos * 64;
#pragma unroll
      for (int i = 0; i < 32; ++i) {
        const float cs = rp[i * 2], sn = rp[i * 2 + 1];
        const float a = kf[i], bb = kf[i + 32];
        kf[i] = a * cs - bb * sn; kf[i + 32] = bb * cs + a * sn;
      }
#pragma unroll
      for (int c8 = 0; c8 < 8; ++c8) {
        uint4 pk;
        pk.x = pack2(kf[c8 * 8 + 0], kf[c8 * 8 + 1]); pk.y = pack2(kf[c8 * 8 + 2], kf[c8 * 8 + 3]);
        pk.z = pack2(kf[c8 * 8 + 4], kf[c8 * 8 + 5]); pk.w = pack2(kf[c8 * 8 + 6], kf[c8 * 8 + 7]);
        *(uint4*)(Ks + r * KS + c8 * 8) = pk;
      }
    }
  }
#pragma unroll 1
  for (int e = tid; e < 384 * 8; e += NTHR) {
    const int r = e >> 3, c8 = e & 7, kpos = kpos0 + r;
    if (kpos >= 0 && kpos < SEQ)
      *(uint4*)(Vs + r * VS + c8 * 8) = *(const uint4*)(p.zqkv + ((size_t)(b * SEQ + kpos)) * QKVC + 640 + kh * 64 + c8 * 8);
  }
  __syncthreads();
  const int hl = w & 3, qh = w >> 2;
  const int head = kh * 4 + hl;
  const int n = lane & 31, hh = lane >> 5;
  const int Q0 = qb * 128 + 64 * qh;
  bf16x8 qf[2][4];
#pragma unroll
  for (int nt = 0; nt < 2; ++nt) {
    const int qpos = Q0 + 32 * nt + n;
    const bf16_t* qr = p.zqkv + ((size_t)(b * SEQ + qpos)) * QKVC + head * 64;
    float qv[4][8];
    float ss = 0.f;
#pragma unroll
    for (int kk = 0; kk < 4; ++kk) {
      uint4 v = *(const uint4*)(qr + 16 * kk + 8 * hh);
      qv[kk][0] = lo2f(v.x); qv[kk][1] = hi2f(v.x); qv[kk][2] = lo2f(v.y); qv[kk][3] = hi2f(v.y);
      qv[kk][4] = lo2f(v.z); qv[kk][5] = hi2f(v.z); qv[kk][6] = lo2f(v.w); qv[kk][7] = hi2f(v.w);
#pragma unroll
      for (int j = 0; j < 8; ++j) ss += qv[kk][j] * qv[kk][j];
    }
    ss += __shfl_xor(ss, 32, 64);
    const float rs = rsqrtf(ss * (1.f / 64.f) + 1e-6f) * 0.125f;
    const float* qg = p.q_gain + l * 64;
#pragma unroll
    for (int kk = 0; kk < 4; ++kk)
#pragma unroll
      for (int j = 0; j < 8; ++j) qv[kk][j] *= rs * qg[16 * kk + 8 * hh + j];
    const float* rp = p.rope + (size_t)qpos * 64;
#pragma unroll
    for (int kk = 0; kk < 2; ++kk)
#pragma unroll
      for (int j = 0; j < 8; ++j) {
        const int d = 16 * kk + 8 * hh + j;
        const float cs = rp[d * 2], sn = rp[d * 2 + 1];
        const float a = qv[kk][j], bb = qv[kk + 2][j];
        qv[kk][j] = a * cs - bb * sn; qv[kk + 2][j] = bb * cs + a * sn;
      }
#pragma unroll
    for (int kk = 0; kk < 4; ++kk)
#pragma unroll
      for (int j = 0; j < 8; ++j) qf[nt][kk][j] = (short)f2bf(qv[kk][j]);
  }
  f32x16 O[2][2];
#pragma unroll
  for (int dm = 0; dm < 2; ++dm)
#pragma unroll
    for (int nt = 0; nt < 2; ++nt)
#pragma unroll
      for (int r = 0; r < 16; ++r) O[dm][nt][r] = 0.f;
  float mrun[2], lsum[2];
  mrun[0] = mrun[1] = p.sink[l * 8 + head];
  lsum[0] = lsum[1] = (hh == 0) ? 1.f : 0.f;
  const int l16 = lane & 15, tq = l16 >> 2, tp = l16 & 3, g4 = lane >> 4;
  const bf16_t* vbase = Vs + (4 * (g4 >> 1) + tq) * VS + 16 * (g4 & 1) + 4 * tp;
#pragma unroll 1
  for (int kt = 2 * qh; kt < 2 * qh + 10; ++kt) {
    const int kp_t = kpos0 + 32 * kt;
    if (kp_t < 0 || kp_t >= SEQ) continue;
    bf16x8 kfr[4];
#pragma unroll
    for (int kk = 0; kk < 4; ++kk) kfr[kk] = *(const bf16x8*)(Ks + (32 * kt + n) * KS + 16 * kk + 8 * hh);
    bf16x8 pf[2][2];
#pragma unroll
    for (int nt = 0; nt < 2; ++nt) {
      f32x16 S;
#pragma unroll
      for (int r = 0; r < 16; ++r) S[r] = 0.f;
#pragma unroll
      for (int kk = 0; kk < 4; ++kk) S = __builtin_amdgcn_mfma_f32_32x32x16_bf16(kfr[kk], qf[nt][kk], S, 0, 0, 0);
      const int qpos = Q0 + 32 * nt + n;
      float mloc = -INFINITY;
#pragma unroll
      for (int r = 0; r < 16; ++r) {
        const int kpos = kp_t + (r & 3) + 8 * (r >> 2) + 4 * hh;
        int dd = kpos - qpos; dd = dd < 0 ? -dd : dd;
        S[r] = (dd <= 128) ? S[r] : -INFINITY;
        mloc = fmaxf(mloc, S[r]);
      }
      mloc = fmaxf(mloc, __shfl_xor(mloc, 32, 64));
      const float mnew = fmaxf(mrun[nt], mloc);
      const float corr = __expf(mrun[nt] - mnew);
      mrun[nt] = mnew;
      float psum = 0.f;
#pragma unroll
      for (int r = 0; r < 16; ++r) { S[r] = __expf(S[r] - mnew); psum += S[r]; }
      lsum[nt] = lsum[nt] * corr + psum;
#pragma unroll
      for (int dm = 0; dm < 2; ++dm)
#pragma unroll
        for (int r = 0; r < 16; ++r) O[dm][nt][r] *= corr;
#pragma unroll
      for (int s2 = 0; s2 < 2; ++s2)
#pragma unroll
        for (int j = 0; j < 8; ++j) pf[nt][s2][j] = (short)f2bf(S[8 * s2 + j]);
    }
#pragma unroll
    for (int dm = 0; dm < 2; ++dm)
#pragma unroll
      for (int s2 = 0; s2 < 2; ++s2) {
        const bf16_t* vp = vbase + (32 * kt + 16 * s2) * VS + 32 * dm;
        const s16x4 v0 = tr_read4(vp);
        const s16x4 v1 = tr_read4(vp + 8 * VS);
        bf16x8 vf;
        vf[0] = v0[0]; vf[1] = v0[1]; vf[2] = v0[2]; vf[3] = v0[3];
        vf[4] = v1[0]; vf[5] = v1[1]; vf[6] = v1[2]; vf[7] = v1[3];
#pragma unroll
        for (int nt = 0; nt < 2; ++nt) O[dm][nt] = __builtin_amdgcn_mfma_f32_32x32x16_bf16(vf, pf[nt][s2], O[dm][nt], 0, 0, 0);
      }
  }
#pragma unroll
  for (int nt = 0; nt < 2; ++nt) {
    const float ltot = lsum[nt] + __shfl_xor(lsum[nt], 32, 64);
    const float inv = 1.f / ltot;
    const int qpos = Q0 + 32 * nt + n;
    bf16_t* yo = p.yb + ((size_t)(b * SEQ + qpos)) * 512 + head * 64;
#pragma unroll
    for (int dm = 0; dm < 2; ++dm)
#pragma unroll
      for (int g = 0; g < 4; ++g) {
        uint2 o;
        o.x = pack2(O[dm][nt][4 * g + 0] * inv, O[dm][nt][4 * g + 1] * inv);
        o.y = pack2(O[dm][nt][4 * g + 2] * inv, O[dm][nt][4 * g + 3] * inv);
        *(uint2*)(yo + 32 * dm + 8 * g + 4 * hh) = o;
      }
  }
}

typedef float f32x2 __attribute__((ext_vector_type(2)));
__device__ void table_item(const Params& p, int l, int it) {
  const int tid = otid();
  const int lane = tid & 63, w = tid >> 6;
  const int which = it >> 9, r0 = (it & 511) * 32 + w * 4;
  const float* src = (which ? p.peer_v : p.peer_u) + (size_t)l * NEXP * DM;
  unsigned char* dst = which ? p.tabV8 : p.tabU8;
  float* sc = which ? p.sclV : p.sclU;
  float4 v[4][4];
#pragma unroll
  for (int rr = 0; rr < 4; ++rr)
#pragma unroll
    for (int i = 0; i < 4; ++i) v[rr][i] = *(const float4*)(src + (size_t)(r0 + rr) * DM + lane * 4 + 256 * i);
#pragma unroll
  for (int rr = 0; rr < 4; ++rr) {
    const int e = r0 + rr;
    float mx = 0.f;
#pragma unroll
    for (int i = 0; i < 4; ++i)
      mx = fmaxf(mx, fmaxf(fmaxf(fabsf(v[rr][i].x), fabsf(v[rr][i].y)), fmaxf(fabsf(v[rr][i].z), fabsf(v[rr][i].w))));
#pragma unroll
    for (int m = 32; m >= 1; m >>= 1) mx = fmaxf(mx, __shfl_xor(mx, m, 64));
    const float scale = (mx > 0.f) ? 440.f / mx : 1.f;
#pragma unroll
    for (int i = 0; i < 4; ++i) {
      int pk = __builtin_amdgcn_cvt_pk_fp8_f32(v[rr][i].x * scale, v[rr][i].y * scale, 0, false);
      pk = __builtin_amdgcn_cvt_pk_fp8_f32(v[rr][i].z * scale, v[rr][i].w * scale, pk, true);
      const int x = 2 * i + (lane >> 5);
      *(int*)(dst + ((size_t)x * NEXP + e) * 128 + (lane & 31) * 4) = pk;
    }
    if (lane == 0) sc[e] = (mx > 0.f) ? mx * (1.f / 440.f) : 1.f;
  }
}

constexpr int DE_N_HY = 512, DE_N_AT = 768, DE_N_TB = 1024;
__device__ void phase_de(const Params& p, int l, char* smem) {
  const int total = DE_N_HY + DE_N_AT + DE_N_TB + (l == 0 ? P0B_TOTAL : 0);
  for (int it = next_item(p.wq + 100 + l, smem); it < total; it = next_item(p.wq + 100 + l, smem)) {
    if (it < DE_N_HY) hyena_item(p, l, it, smem);
    else if (it < DE_N_HY + DE_N_AT) attn_item(p, l, it - DE_N_HY, smem);
    else if (it < DE_N_HY + DE_N_AT + DE_N_TB) table_item(p, l, it - DE_N_HY - DE_N_AT);
    else p0b_item(p, it - DE_N_HY - DE_N_AT - DE_N_TB, smem);
  }
}

__device__ void phase_f(const Params& p, int tile, int l, bool from_inputs, char* smem) {
  const int tid = otid();
  const int tok0 = tile * TM;
#pragma unroll 4
  for (int e = tid; e < TM * 64; e += NTHR) {
    const int r = e % TM, cg8 = e / TM;
    const int tok = tok0 + r, b = tok >> 11, sq = tok & 2047;
    const bf16_t* src = p.yaT + ((size_t)b * HYW + cg8 * 8) * SEQ + sq;
    uint4 o;
    o.x = (unsigned)src[0] | ((unsigned)src[SEQ] << 16);
    o.y = (unsigned)src[2 * SEQ] | ((unsigned)src[3 * SEQ] << 16);
    o.z = (unsigned)src[4 * SEQ] | ((unsigned)src[5 * SEQ] << 16);
    o.w = (unsigned)src[6 * SEQ] | ((unsigned)src[7 * SEQ] << 16);
    *(uint4*)(p.yatok + (size_t)tok * HYW + cg8 * 8) = o;
  }
  __syncthreads();
  const bf16_t* Ah = p.hbuf + (size_t)tok0 * DM;
  const bf16_t* Aya = p.yatok + (size_t)tok0 * HYW;
  const bf16_t* Ayb = p.yb + (size_t)tok0 * HYW;
  const bf16_t* Win = p.WinT + (size_t)l * INC * DM;
  const bf16_t* Wpa = p.WpaT + (size_t)l * DM * HYW;
  const bf16_t* Wpb = p.WpbT + (size_t)l * DM * HYW;
  float* ct = (float*)smem;
  f32x16 acc[3][2];
  unsigned sgp[3][2][8];
#pragma unroll 1
  for (int nc = 0; nc < 8; ++nc) {
    gemm_f1<1>(Ah, Ah, DM, Win + (size_t)(2304 + nc * 128) * DM, Win + (size_t)(3328 + nc * 128) * DM, DM, smem, acc);
#pragma unroll
    for (int mi = 0; mi < 3; ++mi)
#pragma unroll
      for (int ni = 0; ni < 2; ++ni)
#pragma unroll
        for (int q = 0; q < 8; ++q)
          sgp[mi][ni][q] = pack2(__builtin_amdgcn_rcpf(1.f + __expf(-acc[mi][ni][2 * q])), __builtin_amdgcn_rcpf(1.f + __expf(-acc[mi][ni][2 * q + 1])));
    gemm_f1<2>(Aya, Ayb, HYW, Wpa + (size_t)(nc * 128) * HYW, Wpb + (size_t)(nc * 128) * HYW, HYW, smem, acc);
    {
      const int tid_ = otid(); const int lane = tid_ & 63, w = tid_ >> 6, wm = w >> 2, wn = w & 3;
      const int n = wn * 32 + (lane & 31);
#pragma unroll
      for (int mi = 0; mi < 3; ++mi)
#pragma unroll
        for (int q = 0; q < 8; ++q) {
          const float m0 = lo2f(sgp[mi][0][q]) * acc[mi][0][2 * q] + lo2f(sgp[mi][1][q]) * acc[mi][1][2 * q];
          const float m1 = hi2f(sgp[mi][0][q]) * acc[mi][0][2 * q + 1] + hi2f(sgp[mi][1][q]) * acc[mi][1][2 * q + 1];
          ct[ACC_ROW(wm, mi, 2 * q, lane) * 132 + n] = m0;
          ct[ACC_ROW(wm, mi, 2 * q + 1, lane) * 132 + n] = m1;
        }
    }
    lds_barrier();
    store_tile_bf16(ct, p.merged, DM, tok0, nc * 128);
  }
  __syncthreads();
  const bf16_t* Am = p.merged + (size_t)tok0 * DM;
  const bf16_t* Wo = p.WoutT + (size_t)l * DM * DM;
  f32x16 acc2[3][2];
#pragma unroll 1
  for (int nt = 0; nt < 4; ++nt) {
    gemm_core2<2>(Am, DM, Wo + (size_t)(nt * 256) * DM, DM, DM, smem, acc2);
#pragma unroll 1
    for (int half = 0; half < 2; ++half) {
      acc_to_lds<2>(acc2, ct, 132, half);
      lds_barrier();
#pragma unroll 4
      for (int it = tid; it < 192 * 32; it += NTHR) {
        const int c4 = it & 31, r = it >> 5;
        const int tok = tok0 + r, b = tok >> 11;
        const int n = nt * 256 + half * 128 + c4 * 4;
        const float4 a = *(const float4*)(ct + r * 132 + c4 * 4);
        const float4 gt = *(const float4*)(p.mod + ((size_t)l * NB + b) * 6144 + 2048 + n);
        const float* xs = from_inputs ? xrow_in(p, tok) : (p.out + (size_t)tok * DM);
        float4 xo = *(const float4*)(xs + n);
        xo.x += gt.x * a.x; xo.y += gt.y * a.y; xo.z += gt.z * a.z; xo.w += gt.w * a.w;
        *(float4*)(p.out + (size_t)tok * DM + n) = xo;
      }
      lds_barrier();
    }
  }
  __syncthreads();
}

__device__ __forceinline__ void sort16_desc(float (&v)[16]) {
#pragma unroll
  for (int k = 2; k <= 16; k <<= 1)
#pragma unroll
    for (int j = k >> 1; j >= 1; j >>= 1)
#pragma unroll
      for (int i = 0; i < 16; ++i) {
        const int l = i ^ j;
        if (l > i) {
          const float hi = fmaxf(v[i], v[l]), lo = fminf(v[i], v[l]);
          if ((i & k) == 0) { v[i] = hi; v[l] = lo; } else { v[i] = lo; v[l] = hi; }
        }
      }
}
__device__ __forceinline__ void merge16_desc(float (&top)[16], const float (&g)[16]) {
#pragma unroll
  for (int i = 0; i < 16; ++i) top[i] = fmaxf(top[i], g[15 - i]);
#pragma unroll
  for (int j = 8; j >= 1; j >>= 1)
#pragma unroll
    for (int i = 0; i < 16; ++i) {
      const int l = i ^ j;
      if (l > i) { const float hi = fmaxf(top[i], top[l]), lo = fminf(top[i], top[l]); top[i] = hi; top[l] = lo; }
    }
}
__device__ __forceinline__ void topk_insert(float (&key)[16], float kx) {
#pragma unroll
  for (int i = 0; i < 16; ++i) {
    const float hi = fmaxf(key[i], kx);
    kx = fminf(key[i], kx);
    key[i] = hi;
  }
}

__device__ void phase_g(const Params& p, int tile, int l, char* smem) {
  norm_rows(p, tile, l, 1, false, smem);
  const int tid = otid();
  const int tok0 = tile * TM;
  const bf16_t* Ah = p.hbuf + (size_t)tok0 * DM;
  const bf16_t* Wc = p.WcT + (size_t)l * 2048 * DM;
  float* sc = (float*)smem;
  f32x16 acc[3][2];
  float v1k[16], v2k[16];
#pragma unroll
  for (int i = 0; i < 16; ++i) { v1k[i] = 0.f; v2k[i] = 0.f; }
#pragma unroll 1
  for (int ch = 0; ch < 16; ++ch) {
    if ((ch & 1) == 0) gemm_core2<2>(Ah, DM, Wc + (size_t)(ch * 128) * DM, DM, DM, smem, acc);
    acc_to_lds<2>(acc, sc, 129, ch & 1);
    __syncthreads();
    if (tid < TM) {
      float key[16];
      const float* row = sc + tid * 129;
#pragma unroll
      for (int i = 0; i < 16; ++i) key[i] = __uint_as_float((__float_as_uint(row[i]) & 0xFFFFFF80u) | (unsigned)i);
      sort16_desc(key);
#pragma unroll 1
      for (int j0 = 16; j0 < 128; j0 += 16) {
        float g[16];
#pragma unroll
        for (int i = 0; i < 16; ++i) g[i] = __uint_as_float((__float_as_uint(row[j0 + i]) & 0xFFFFFF80u) | (unsigned)(j0 + i));
        sort16_desc(g);
        merge16_desc(key, g);
      }
      if ((ch & 1) == 0) {
#pragma unroll
        for (int i = 0; i < 16; ++i) v1k[i] = key[i];
      } else {
#pragma unroll
        for (int i = 0; i < 16; ++i) v2k[i] = key[i];
        float top[16];
#pragma unroll
        for (int i = 0; i < 16; ++i) top[i] = -INFINITY;
#pragma unroll
        for (int i = 0; i < 16; ++i)
#pragma unroll
          for (int j = 0; j < 16; ++j)
            if ((i + 1) * (j + 1) <= 16) {
              const float s = v1k[i] + v2k[j];
              const float ck = __uint_as_float((__float_as_uint(s) & 0xFFFFFF00u) | (unsigned)(i * 16 + j));
              topk_insert(top, ck);
            }
        const float mx = top[0];
        float ex[16], sum = 0.f;
#pragma unroll
        for (int k = 0; k < 16; ++k) { ex[k] = __expf(top[k] - mx); sum += ex[k]; }
        const float inv = 1.f / sum;
        const int hh = ch >> 1;
        const size_t ob = ((size_t)(tok0 + tid) * 8 + hh) * 16;
#pragma unroll
        for (int k = 0; k < 16; ++k) {
          const unsigned code = __float_as_uint(top[k]) & 0xFFu;
          const unsigned ii = code >> 4, jj = code & 15u;
          unsigned e1 = 0, e2 = 0;
#pragma unroll
          for (int q = 0; q < 16; ++q) {
            e1 = (ii == (unsigned)q) ? (__float_as_uint(v1k[q]) & 0x7Fu) : e1;
            e2 = (jj == (unsigned)q) ? (__float_as_uint(v2k[q]) & 0x7Fu) : e2;
          }
          const unsigned ee = e1 * 128 + e2;
          p.pidx[ob + k] = (unsigned short)ee;
          p.pg[ob + k] = ex[k] * inv * p.sclV[ee];
          p.pgu[ob + k] = p.sclU[ee];
        }
      }
    }
    __syncthreads();
  }
}

__device__ __forceinline__ unsigned xcc_id() { return (unsigned)__builtin_amdgcn_s_getreg((3 << 11) | 20) & 7u; }
__device__ __forceinline__ bool next_slice_item(unsigned* cnt, int& x, int& j, int& tries, char* smem, int tid) {
  int* sh = (int*)(smem + 8192);
  while (tries < 8) {
    __syncthreads();
    if (tid == 0) *sh = (int)atomicAdd(cnt + x, 1u);
    __syncthreads();
    j = *sh;
    if (j < I_NJ) return true;
    x = (x + 1) & 7; ++tries;
  }
  return false;
}
__device__ __forceinline__ float dpp_xor1(float v) { return __builtin_bit_cast(float, __builtin_amdgcn_update_dpp(0, __builtin_bit_cast(int, v), 0xB1, 0xF, 0xF, true)); }
__device__ __forceinline__ float dpp_xor2(float v) { return __builtin_bit_cast(float, __builtin_amdgcn_update_dpp(0, __builtin_bit_cast(int, v), 0x4E, 0xF, 0xF, true)); }
__device__ __forceinline__ float dpp_hmirror(float v) { return __builtin_bit_cast(float, __builtin_amdgcn_update_dpp(0, __builtin_bit_cast(int, v), 0x141, 0xF, 0xF, true)); }
__device__ __forceinline__ float dpp_ror8(float v) { return __builtin_bit_cast(float, __builtin_amdgcn_update_dpp(0, __builtin_bit_cast(int, v), 0x128, 0xF, 0xF, true)); }

struct I1Ctx { uint4 h0, h1, e0, e1; };
__device__ __forceinline__ void i1_load_ctx(const Params& p, int tok, int x, int g, int ch, I1Ctx& c) {
  const bf16_t* hr = p.hbuf + (size_t)tok * DM + x * 128 + ch * 16;
  c.h0 = *(const uint4*)hr; c.h1 = *(const uint4*)(hr + 8);
  const uint4* pi = (const uint4*)(p.pidx + (size_t)tok * 128 + g * 16);
  c.e0 = pi[0]; c.e1 = pi[1];
}
__device__ __forceinline__ void peer_issue_rows(const unsigned char* Tslice, unsigned lane_off, const uint4& e0, const uint4& e1, uint4 (&rows)[16]) {
  const unsigned ew[8] = {e0.x, e0.y, e0.z, e0.w, e1.x, e1.y, e1.z, e1.w};
#pragma unroll
  for (int rd = 0; rd < 16; ++rd) {
    const unsigned e = (ew[rd >> 1] >> (16 * (rd & 1))) & 0x3FFFu;
    rows[rd] = *(const uint4*)(Tslice + (e * 128u + lane_off));
  }
}
typedef _Float16 f16x2 __attribute__((ext_vector_type(2)));
__device__ __forceinline__ f16x2 bf2_to_h2(unsigned u) {
  f16x2 r; r[0] = (_Float16)lo2f(u); r[1] = (_Float16)hi2f(u); return r;
}
__device__ __forceinline__ void i1_compute(const I1Ctx& c, const uint4 (&rows)[16], float* dst, int ch) {
  f16x2 hs[8];
  hs[0] = bf2_to_h2(c.h0.x); hs[1] = bf2_to_h2(c.h0.y); hs[2] = bf2_to_h2(c.h0.z); hs[3] = bf2_to_h2(c.h0.w);
  hs[4] = bf2_to_h2(c.h1.x); hs[5] = bf2_to_h2(c.h1.y); hs[6] = bf2_to_h2(c.h1.z); hs[7] = bf2_to_h2(c.h1.w);
  float res[16];
#pragma unroll
  for (int rd = 0; rd < 16; ++rd) {
    const unsigned wd[4] = {rows[rd].x, rows[rd].y, rows[rd].z, rows[rd].w};
    float d0 = 0.f, d1 = 0.f;
#pragma unroll
    for (int q = 0; q < 4; ++q) {
      d0 = __builtin_amdgcn_fdot2(__builtin_amdgcn_cvt_scalef32_pk_f16_fp8((int)wd[q], 1.0f, false), hs[2 * q], d0, false);
      d1 = __builtin_amdgcn_fdot2(__builtin_amdgcn_cvt_scalef32_pk_f16_fp8((int)wd[q], 1.0f, true), hs[2 * q + 1], d1, false);
    }
    float d = d0 + d1;
    d += dpp_xor1(d); d += dpp_xor2(d); d += dpp_hmirror(d);
    res[rd] = d;
  }
  if (ch == 0) {
    float4* o = (float4*)dst;
    o[0] = make_float4(res[0], res[1], res[2], res[3]); o[1] = make_float4(res[4], res[5], res[6], res[7]);
    o[2] = make_float4(res[8], res[9], res[10], res[11]); o[3] = make_float4(res[12], res[13], res[14], res[15]);
  }
}

__device__ void phase_i1(const Params& p, int pass, char* smem) {
  const int tid = otid();
  const int lane = tid & 63, w = tid >> 6;
  const int g = lane >> 3, ch = lane & 7;
  int x = (int)xcc_id(), j = 0, tries = 0;
  while (next_slice_item(p.wq + pass * 8, x, j, tries, smem, tid)) {
    const unsigned char* Ux = p.tabU8 + (size_t)x * NEXP * 128;
    const unsigned loff = ch * 16;
    float* ap = p.apart + (size_t)x * NTOK * 128 + g * 16;
    const int tokb = j * I_TOK + w;
    I1Ctx c0, c1, c2;
    uint4 rowsA[16], rowsB[16];
    i1_load_ctx(p, tokb, x, g, ch, c0);
    i1_load_ctx(p, tokb + 8, x, g, ch, c1);
    i1_load_ctx(p, tokb + 16, x, g, ch, c2);
    peer_issue_rows(Ux, loff, c0.e0, c0.e1, rowsA);
#pragma unroll 1
    for (int i = 0; i < I_TW; i += 2) {
      I1Ctx c3, c4;
      peer_issue_rows(Ux, loff, c1.e0, c1.e1, rowsB);
      i1_load_ctx(p, tokb + 8 * min(i + 3, I_TW - 1), x, g, ch, c3);
      i1_compute(c0, rowsA, ap + (size_t)(tokb + 8 * i) * 128, ch);
      peer_issue_rows(Ux, loff, c2.e0, c2.e1, rowsA);
      i1_load_ctx(p, tokb + 8 * min(i + 4, I_TW - 1), x, g, ch, c4);
      i1_compute(c1, rowsB, ap + (size_t)(tokb + 8 * (i + 1)) * 128, ch);
      c0 = c2; c1 = c3; c2 = c4;
    }
  }
}

__device__ void phase_w(const Params& p) {
  const int tid = otid();
  const size_t npair8 = (size_t)NTOK * 128 / 8;
  for (size_t q8 = (size_t)blockIdx.x * NTHR + tid; q8 < npair8; q8 += (size_t)gridDim.x * NTHR) {
    const size_t q = q8 * 8;
    float a[8];
#pragma unroll
    for (int i = 0; i < 8; ++i) a[i] = 0.f;
#pragma unroll
    for (int xx = 0; xx < 8; ++xx) {
      const float4 v0 = *(const float4*)(p.apart + (size_t)xx * NTOK * 128 + q);
      const float4 v1 = *(const float4*)(p.apart + (size_t)xx * NTOK * 128 + q + 4);
      a[0] += v0.x; a[1] += v0.y; a[2] += v0.z; a[3] += v0.w; a[4] += v1.x; a[5] += v1.y; a[6] += v1.z; a[7] += v1.w;
    }
    const float4 u0 = *(const float4*)(p.pgu + q), u1 = *(const float4*)(p.pgu + q + 4);
    const float4 g0 = *(const float4*)(p.pg + q), g1 = *(const float4*)(p.pg + q + 4);
    const float su[8] = {u0.x, u0.y, u0.z, u0.w, u1.x, u1.y, u1.z, u1.w};
    const float sg[8] = {g0.x, g0.y, g0.z, g0.w, g1.x, g1.y, g1.z, g1.w};
    float wv[8];
#pragma unroll
    for (int i = 0; i < 8; ++i) {
      const float av = a[i] * su[i];
      wv[i] = sg[i] * 0.5f * av * (1.f + erff(av * 0.70710678118654752f));
    }
    uint4 o; o.x = pack2(wv[0], wv[1]); o.y = pack2(wv[2], wv[3]); o.z = pack2(wv[4], wv[5]); o.w = pack2(wv[6], wv[7]);
    *(uint4*)(p.wbuf + q) = o;
  }
}

struct I2Ctx { uint4 e0, e1; };
struct I2XG { uint4 w0, w1; float2 xv, gt; };
__device__ __forceinline__ void i2_load_ctx(const Params& p, int tok, int l, int x, int g, int ch, I2Ctx& c) {
  const unsigned off = (unsigned)tok * 256u + (unsigned)g * 32u;
  const uint4* pi = (const uint4*)((const char*)p.pidx + off);
  c.e0 = pi[0]; c.e1 = pi[1];
}
__device__ __forceinline__ void i2_load_xg(const Params& p, int tok, int l, int x, int g, int ch, I2XG& c) {
  const unsigned off = (unsigned)tok * 256u + (unsigned)g * 32u;
  const uint4* pw = (const uint4*)((const char*)p.wbuf + off);
  c.w0 = pw[0]; c.w1 = pw[1];
  const unsigned col = (unsigned)(x * 128 + ch * 16 + 2 * g);
  c.xv = *(const float2*)((const char*)p.out + ((unsigned)tok * 4096u + col * 4u));
  c.gt = *(const float2*)((const char*)p.mod + ((unsigned)(l * NB + (tok >> 11)) * 24576u + 20480u + col * 4u));
}
__device__ __forceinline__ void i2_compute(const Params& p, const I2XG& xg, const uint4 (&rows)[16], int tok, int x, int g, int ch) {
  const unsigned ww[8] = {xg.w0.x, xg.w0.y, xg.w0.z, xg.w0.w, xg.w1.x, xg.w1.y, xg.w1.z, xg.w1.w};
  f32x2 acc[8];
#pragma unroll
  for (int i = 0; i < 8; ++i) acc[i] = f32x2{0.f, 0.f};
#pragma unroll
  for (int rd = 0; rd < 16; ++rd) {
    const unsigned wd[4] = {rows[rd].x, rows[rd].y, rows[rd].z, rows[rd].w};
    const float wsc = (rd & 1) ? hi2f(ww[rd >> 1]) : lo2f(ww[rd >> 1]);
    const f32x2 sw = {wsc, wsc};
#pragma unroll
    for (int q = 0; q < 4; ++q) {
      acc[2 * q] += sw * __builtin_amdgcn_cvt_pk_f32_fp8((int)wd[q], false);
      acc[2 * q + 1] += sw * __builtin_amdgcn_cvt_pk_f32_fp8((int)wd[q], true);
    }
  }
  float r[16];
#pragma unroll
  for (int i = 0; i < 8; ++i) { r[2 * i] = acc[i][0]; r[2 * i + 1] = acc[i][1]; }
  const bool b2 = (g & 4) != 0, b1 = (g & 2) != 0, b0 = (g & 1) != 0;
  float r8[8];
#pragma unroll
  for (int i = 0; i < 8; ++i) {
    const float snd = b2 ? r[i] : r[i + 8];
    const float kp = b2 ? r[i + 8] : r[i];
    r8[i] = kp + __shfl_xor(snd, 32, 64);
  }
  float r4[4];
#pragma unroll
  for (int i = 0; i < 4; ++i) {
    const float snd = b1 ? r8[i] : r8[i + 4];
    const float kp = b1 ? r8[i + 4] : r8[i];
    r4[i] = kp + __shfl_xor(snd, 16, 64);
  }
  float r2[2];
#pragma unroll
  for (int i = 0; i < 2; ++i) {
    const float snd = b0 ? r4[i] : r4[i + 2];
    const float kp = b0 ? r4[i + 2] : r4[i];
    r2[i] = kp + dpp_ror8(snd);
  }
  float2 o;
  o.x = xg.xv.x + xg.gt.x * r2[0];
  o.y = xg.xv.y + xg.gt.y * r2[1];
  *(float2*)((char*)p.out + ((unsigned)tok * 4096u + (unsigned)(x * 128 + ch * 16 + 2 * g) * 4u)) = o;
}

__device__ void phase_i2(const Params& p, int l, int pass, char* smem) {
  const int tid = otid();
  const int lane = tid & 63, w = tid >> 6;
  const int g = lane >> 3, ch = lane & 7;
  int x = (int)xcc_id(), j = 0, tries = 0;
  while (next_slice_item(p.wq + pass * 8, x, j, tries, smem, tid)) {
    const unsigned char* Vx = p.tabV8 + (size_t)x * NEXP * 128;
    const unsigned loff = ch * 16;
    const int tokb = j * I_TOK + w;
    I2Ctx c0, c1;
    I2XG xa, xb;
    uint4 rowsA[16], rowsB[16];
    i2_load_ctx(p, tokb, l, x, g, ch, c0);
    i2_load_ctx(p, tokb + 8, l, x, g, ch, c1);
    peer_issue_rows(Vx, loff, c0.e0, c0.e1, rowsA);
    i2_load_xg(p, tokb, l, x, g, ch, xa);
    i2_load_ctx(p, tokb + 8 * min(2, I_TW - 1), l, x, g, ch, c0);
#pragma unroll 1
    for (int i = 0; i < I_TW; i += 2) {
      __builtin_amdgcn_sched_barrier(0);
      peer_issue_rows(Vx, loff, c1.e0, c1.e1, rowsB);
      i2_load_xg(p, tokb + 8 * (i + 1), l, x, g, ch, xb);
      i2_load_ctx(p, tokb + 8 * min(i + 3, I_TW - 1), l, x, g, ch, c1);
      __builtin_amdgcn_sched_barrier(0);
      i2_compute(p, xa, rowsA, tokb + 8 * i, x, g, ch);
      __builtin_amdgcn_sched_barrier(0);
      peer_issue_rows(Vx, loff, c0.e0, c0.e1, rowsA);
      i2_load_xg(p, tokb + 8 * min(i + 2, I_TW - 1), l, x, g, ch, xa);
      i2_load_ctx(p, tokb + 8 * min(i + 4, I_TW - 1), l, x, g, ch, c0);
      __builtin_amdgcn_sched_barrier(0);
      i2_compute(p, xb, rowsB, tokb + 8 * (i + 1), x, g, ch);
      __builtin_amdgcn_sched_barrier(0);
    }
  }
}

__device__ __forceinline__ void grid_bar(unsigned* cnt, unsigned& epoch) {
  ++epoch;
  const unsigned target = epoch * gridDim.x;
  __syncthreads();
  if (threadIdx.x == 0) {
    __builtin_amdgcn_fence(__ATOMIC_RELEASE, "agent");
    asm volatile("s_waitcnt vmcnt(0)" ::: "memory");
    __hip_atomic_fetch_add(cnt, 1u, __ATOMIC_RELAXED, __HIP_MEMORY_SCOPE_AGENT);
    while (__hip_atomic_load(cnt, __ATOMIC_RELAXED, __HIP_MEMORY_SCOPE_AGENT) < target) __builtin_amdgcn_s_sleep(1);
    __builtin_amdgcn_fence(__ATOMIC_ACQUIRE, "agent");
    asm volatile("s_waitcnt vmcnt(0)" ::: "memory");
  }
  __syncthreads();
}

__global__ void __launch_bounds__(NTHR) mega_kernel(Params p) {
  extern __shared__ __attribute__((aligned(16))) char smem[];
  cg::grid_group grid = cg::this_grid();
  unsigned epoch = 0;
  for (int rep = 0; rep < REP_P0; ++rep) phase_p0(p, smem);
  grid.sync();
  for (int l = 0; l < 2; ++l) {
    for (int rep = 0; rep < REP_C; ++rep)
    for (int tile = blockIdx.x; tile < NTILE; tile += gridDim.x) phase_c(p, tile, l, l == 0, smem);
    grid_bar(p.wq + 64, epoch);
    for (int rep = 0; rep < REP_DE; ++rep) phase_de(p, l, smem);
    grid_bar(p.wq + 64, epoch);
    for (int tile = blockIdx.x; tile < NTILE; tile += gridDim.x) {
      phase_f(p, tile, l, l == 0, smem);
      for (int rep = 0; rep < REP_G; ++rep) phase_g(p, tile, l, smem);
    }
    grid_bar(p.wq + 64, epoch);
    phase_i1(p, 2 * l, smem);
    grid_bar(p.wq + 64, epoch);
    phase_w(p);
    grid_bar(p.wq + 64, epoch);
    phase_i2(p, l, 2 * l + 1, smem);
    if (l == 0) grid_bar(p.wq + 64, epoch);
  }
}

extern "C" void kernel_launch(void* const* d_in, const int* in_sizes, int n_in, void* d_out, int out_size, void* d_ws,
                              size_t ws_size, hipStream_t stream) {
  Params p{};
  const float* const* in = (const float* const*)d_in;
  p.x_prompt = in[0]; p.x_sample = in[1]; p.c_prompt = in[2]; p.c_sample = in[3]; p.w_mod = in[4]; p.b_mod = in[5];
  p.g1 = in[6]; p.g2 = in[7]; p.w_in = in[8]; p.conv_w = in[9]; p.conv_b = in[10]; p.f_w1 = in[11]; p.f_b1 = in[12];
  p.f_freq = in[13]; p.f_w2 = in[14]; p.f_b2 = in[15]; p.f_w3 = in[16]; p.f_bias = in[17]; p.q_gain = in[18];
  p.k_gain = in[19]; p.sink = in[20]; p.w_pa = in[21]; p.w_pb = in[22]; p.w_out = in[23]; p.peer_wq = in[24];
  p.peer_k1 = in[25]; p.peer_k2 = in[26]; p.peer_u = in[27]; p.peer_v = in[28];
  p.out = (float*)d_out;
  char* ws = (char*)d_ws;
  size_t off = 0;
  auto carve = [&](size_t bytes) { char* r = ws + off; off += (bytes + 255) & ~(size_t)255; return r; };
  p.WinT = (bf16_t*)carve((size_t)2 * INC * DM * 2);
  p.WpaT = (bf16_t*)carve((size_t)2 * DM * HYW * 2);
  p.WpbT = (bf16_t*)carve((size_t)2 * DM * HYW * 2);
  p.WoutT = (bf16_t*)carve((size_t)2 * DM * DM * 2);
  p.WcT = (bf16_t*)carve((size_t)2 * 2048 * DM * 2);
  p.Gf = (bf16_t*)carve((size_t)2 * 2 * 512 * 4096 * 2);
  p.mod = (float*)carve((size_t)2 * NB * 6144 * 4);
  p.rope = (float*)carve((size_t)SEQ * 64 * 4);
  p.tabU8 = (unsigned char*)carve((size_t)NEXP * DM);
  p.tabV8 = (unsigned char*)carve((size_t)NEXP * DM);
  p.sclU = (float*)carve((size_t)NEXP * 4);
  p.sclV = (float*)carve((size_t)NEXP * 4);
  p.wq = (unsigned*)carve(1024);
  p.zT = (bf16_t*)carve((size_t)NB * HYC * SEQ * 2);
  p.yaT = (bf16_t*)carve((size_t)NTOK * HYW * 2);
  p.yb = (bf16_t*)carve((size_t)NTOK * HYW * 2);
  p.zqkv = (bf16_t*)carve((size_t)NTOK * QKVC * 2);
  p.hbuf = (bf16_t*)carve((size_t)NTOK * DM * 2);
  p.merged = p.zT;
  p.yatok = p.zT + (size_t)NTOK * DM;
  p.apart = (float*)p.zT;
  p.pidx = (unsigned short*)p.zqkv;
  p.pg = (float*)(p.zqkv + (size_t)NTOK * 128);
  p.pgu = p.pg + (size_t)NTOK * 128;
  p.wbuf = (bf16_t*)(p.pgu + (size_t)NTOK * 128);
  if (off > ws_size) fprintf(stderr, "workspace too small: need %zu have %zu\n", off, ws_size);

  static int grid_blocks = 0;
  if (!grid_blocks) {
    int dev = 0, cus = 0, per_cu = 0;
    hipGetDevice(&dev);
    hipDeviceGetAttribute(&cus, hipDeviceAttributeMultiprocessorCount, dev);
    hipFuncSetAttribute((const void*)mega_kernel, hipFuncAttributeMaxDynamicSharedMemorySize, SMEM_BYTES);
    hipOccupancyMaxActiveBlocksPerMultiprocessor(&per_cu, mega_kernel, NTHR, SMEM_BYTES);
    if (per_cu < 1) per_cu = 1;
    grid_blocks = cus * 1;
    if (grid_blocks > NTILE) grid_blocks = NTILE;
  }
  hipMemsetAsync(p.wq, 0, 1024, stream);
  void* args[] = {&p};
  hipError_t e = hipLaunchCooperativeKernel((const void*)mega_kernel, dim3(grid_blocks), dim3(NTHR), args, SMEM_BYTES, stream);
  if (e != hipSuccess) fprintf(stderr, "cooperative launch failed: %s (grid %d)\n", hipGetErrorString(e), grid_blocks);
}
```

```cpp
#include <hip/hip_runtime.h>
#include <hip/hip_bf16.h>
#include <hip/hip_cooperative_groups.h>
#include <cstdio>
#include <cstdint>
namespace cg = cooperative_groups;

typedef unsigned short bf16_t;
using bf16x8 = __attribute__((ext_vector_type(8))) short;
using f32x16 = __attribute__((ext_vector_type(16))) float;

constexpr int DM = 1024;
constexpr int NB = 24;
constexpr int SEQ = 2048;
constexpr int NTOK = NB * SEQ;
constexpr int NBP = 16;
constexpr int INC = 4352;
constexpr int HYC = 1536;
constexpr int HYW = 512;
constexpr int QKVC = 768;
constexpr int TM = 192;
constexpr int NTILE = NTOK / TM;
constexpr int NTHR = 512;
constexpr int NEXP = 16384;
constexpr int SMEM_BYTES = 155648;
constexpr int I_TOK = 384;
constexpr int I_NJ = NTOK / I_TOK;
constexpr int I_TW = I_TOK / 8;
#ifndef REP_DE
#define REP_DE 1
#endif
#ifndef REP_C
#define REP_C 1
#endif
#ifndef REP_G
#define REP_G 1
#endif
#ifndef REP_I1
#define REP_I1 1
#endif
#ifndef REP_P0
#define REP_P0 1
#endif

struct Params {
  const float *x_prompt, *x_sample, *c_prompt, *c_sample, *w_mod, *b_mod, *g1, *g2, *w_in, *conv_w, *conv_b;
  const float *f_w1, *f_b1, *f_freq, *f_w2, *f_b2, *f_w3, *f_bias, *q_gain, *k_gain, *sink, *w_pa, *w_pb, *w_out;
  const float *peer_wq, *peer_k1, *peer_k2, *peer_u, *peer_v;
  float* out;
  bf16_t *WinT, *WpaT, *WpbT, *WoutT, *WcT, *Gf, *zT, *zqkv, *yaT, *yb, *hbuf, *merged, *yatok;
  unsigned char *tabU8, *tabV8;
  unsigned short* pidx;
  bf16_t* wbuf;
  float *pg, *pgu, *mod, *rope, *sclU, *sclV;
  bf16_t* apart;
  unsigned* wq;
};

__device__ __forceinline__ float bf2f(bf16_t v) { return __uint_as_float(((unsigned)v) << 16); }
__device__ __forceinline__ bf16_t f2bf(float f) {
  unsigned u = __float_as_uint(f);
  u += 0x7FFFu + ((u >> 16) & 1u);
  return (bf16_t)(u >> 16);
}
__device__ __forceinline__ unsigned pack2(float a, float b) { return (unsigned)f2bf(a) | ((unsigned)f2bf(b) << 16); }
__device__ __forceinline__ float lo2f(unsigned u) { return __uint_as_float(u << 16); }
__device__ __forceinline__ float hi2f(unsigned u) { return __uint_as_float(u & 0xFFFF0000u); }

__device__ __forceinline__ int otid() { int t = threadIdx.x; asm volatile("" : "+v"(t)); return t; }
__device__ __forceinline__ int osgpr(int x) { asm volatile("" : "+s"(x)); return x; }
__device__ __forceinline__ void lds_barrier() { asm volatile("s_waitcnt lgkmcnt(0)\n\ts_barrier" ::: "memory"); }
__device__ __forceinline__ float wave_sum(float v) {
#pragma unroll
  for (int m = 32; m >= 1; m >>= 1) v += __shfl_xor(v, m, 64);
  return v;
}

__device__ __forceinline__ const float* xrow_in(const Params& p, int tok) {
  return (tok < NBP * SEQ) ? (p.x_prompt + (size_t)tok * DM) : (p.x_sample + (size_t)(tok - NBP * SEQ) * DM);
}
__device__ __forceinline__ const float* crow(const Params& p, int b) {
  return (b < NBP) ? (p.c_prompt + (size_t)b * DM) : (p.c_sample + (size_t)(b - NBP) * DM);
}

__device__ __forceinline__ void glds16(const bf16_t* g, char* l) {
  __builtin_amdgcn_global_load_lds((const __attribute__((address_space(1))) void*)g, (__attribute__((address_space(3))) void*)l, 16, 0, 0);
}
template <int NT>
__device__ __forceinline__ void gemm_core2(const bf16_t* __restrict__ A, int lda, const bf16_t* __restrict__ B, int ldb,
                                           int K, char* lds, f32x16 (&acc)[3][NT]) {
  constexpr int BROWS = 128 * NT;
  constexpr int STAGE = (192 + BROWS) * 128;
  const int tid = otid();
  const int lane = tid & 63, w = tid >> 6;
  const int wm = w >> 2, wn = w & 3;
#pragma unroll
  for (int i = 0; i < 3; ++i)
#pragma unroll
    for (int n = 0; n < NT; ++n)
#pragma unroll
      for (int j = 0; j < 16; ++j) acc[i][n][j] = 0.f;
  const int lr = lane >> 3, lc = lane & 7;
  const bf16_t* pa[3];
  const bf16_t* pb[2 * NT];
#pragma unroll
  for (int i = 0; i < 3; ++i) {
    const int row = (w + 8 * i) * 8 + lr;
    pa[i] = A + (size_t)row * lda + ((lc ^ ((row >> 1) & 7)) * 8);
  }
#pragma unroll
  for (int i = 0; i < 2 * NT; ++i) {
    const int row = (w + 8 * i) * 8 + lr;
    pb[i] = B + (size_t)row * ldb + ((lc ^ ((row >> 1) & 7)) * 8);
  }
  const int nk = K >> 6;
  lds_barrier();
  {
#pragma unroll
    for (int i = 0; i < 3; ++i) glds16(pa[i], lds + (w + 8 * i) * 1024);
#pragma unroll
    for (int i = 0; i < 2 * NT; ++i) glds16(pb[i], lds + 192 * 128 + (w + 8 * i) * 1024);
  }
  asm volatile("s_waitcnt vmcnt(0)" ::: "memory");
  __syncthreads();
  const int fr = lane & 31, hh = lane >> 5;
  int aoff[3], akey[3], boff[NT], bkey[NT];
#pragma unroll
  for (int mi = 0; mi < 3; ++mi) { const int r = wm * 96 + mi * 32 + fr; aoff[mi] = r * 128; akey[mi] = (r >> 1) & 7; }
#pragma unroll
  for (int ni = 0; ni < NT; ++ni) { const int r = wn * 32 * NT + ni * 32 + fr; boff[ni] = 192 * 128 + r * 128; bkey[ni] = (r >> 1) & 7; }
#pragma unroll 1
  for (int kt = 0; kt < nk; ++kt) {
    if (kt + 1 < nk) {
      char* sb = lds + ((kt + 1) & 1) * STAGE;
      const int ko = (kt + 1) << 6;
#pragma unroll
      for (int i = 0; i < 3; ++i) glds16(pa[i] + ko, sb + (w + 8 * i) * 1024);
#pragma unroll
      for (int i = 0; i < 2 * NT; ++i) glds16(pb[i] + ko, sb + 192 * 128 + (w + 8 * i) * 1024);
    }
    const char* st = lds + (kt & 1) * STAGE;
    bf16x8 afr[2][3], bfr[2][NT];
#pragma unroll
    for (int ni = 0; ni < NT; ++ni) bfr[0][ni] = *(const bf16x8*)(st + boff[ni] + ((hh ^ bkey[ni]) << 4));
#pragma unroll
    for (int mi = 0; mi < 3; ++mi) afr[0][mi] = *(const bf16x8*)(st + aoff[mi] + ((hh ^ akey[mi]) << 4));
#pragma unroll
    for (int kk = 0; kk < 4; ++kk) {
      const int cur = kk & 1, nxt = cur ^ 1;
      if (kk < 3) {
        const int kc = 2 * (kk + 1) + hh;
#pragma unroll
        for (int ni = 0; ni < NT; ++ni) bfr[nxt][ni] = *(const bf16x8*)(st + boff[ni] + ((kc ^ bkey[ni]) << 4));
#pragma unroll
        for (int mi = 0; mi < 3; ++mi) afr[nxt][mi] = *(const bf16x8*)(st + aoff[mi] + ((kc ^ akey[mi]) << 4));
      }
      __builtin_amdgcn_sched_barrier(0);
#pragma unroll
      for (int mi = 0; mi < 3; ++mi)
#pragma unroll
        for (int ni = 0; ni < NT; ++ni) acc[mi][ni] = __builtin_amdgcn_mfma_f32_32x32x16_bf16(afr[cur][mi], bfr[cur][ni], acc[mi][ni], 0, 0, 0);
      __builtin_amdgcn_sched_barrier(0);
    }
    asm volatile("s_waitcnt vmcnt(0)" ::: "memory");
    __syncthreads();
  }
}
template <int MODE>
__device__ __forceinline__ void gemm_f1(const bf16_t* __restrict__ A0, const bf16_t* __restrict__ A1, int lda,
                                        const bf16_t* __restrict__ B0, const bf16_t* __restrict__ B1, int ldb,
                                        char* lds, f32x16 (&acc)[3][2]) {
  constexpr int STAGE = (192 + 256) * 128;
  const int tid = otid();
  const int lane = tid & 63, w = tid >> 6;
  const int wm = w >> 2, wn = w & 3;
#pragma unroll
  for (int i = 0; i < 3; ++i)
#pragma unroll
    for (int n = 0; n < 2; ++n)
#pragma unroll
      for (int j = 0; j < 16; ++j) acc[i][n][j] = 0.f;
  const int lr = lane >> 3, lc = lane & 7;
  const bool hi = (w >= 4);
  int aofs[3];
  const bf16_t* pb[4];
#pragma unroll
  for (int i = 0; i < 3; ++i) {
    const int row = (w + 8 * i) * 8 + lr;
    aofs[i] = row * lda + ((lc ^ ((row >> 1) & 7)) * 8);
  }
#pragma unroll
  for (int i = 0; i < 4; ++i) {
    const int rb = (w + 8 * i) * 8 + lr;
    const int srow = i * 32 + (w & 3) * 8 + lr;
    pb[i] = (hi ? B1 : B0) + (size_t)srow * ldb + ((lc ^ ((rb >> 1) & 7)) * 8);
  }
  constexpr int NK = 16;
  auto issue = [&](int kt) {
    char* sb = lds + (kt & 1) * STAGE;
    const bf16_t* Ab = (MODE == 2 && kt >= 8) ? A1 : A0;
    const int ka = (MODE == 2) ? ((kt & 7) << 6) : (kt << 6);
#pragma unroll
    for (int i = 0; i < 3; ++i) glds16(Ab + aofs[i] + ka, sb + (w + 8 * i) * 1024);
    if (MODE == 1 || ((kt >= 8) == hi)) {
#pragma unroll
      for (int i = 0; i < 4; ++i) glds16(pb[i] + ka, sb + 192 * 128 + (w + 8 * i) * 1024);
    }
  };
  lds_barrier();
  issue(0);
  asm volatile("s_waitcnt vmcnt(0)" ::: "memory");
  __syncthreads();
  const int fr = lane & 31, hh = lane >> 5;
  int aoff[3], akey[3], boff[2], bkey[2];
#pragma unroll
  for (int mi = 0; mi < 3; ++mi) { const int r = wm * 96 + mi * 32 + fr; aoff[mi] = r * 128; akey[mi] = (r >> 1) & 7; }
#pragma unroll
  for (int ni = 0; ni < 2; ++ni) { const int r = wn * 64 + ni * 32 + fr; boff[ni] = 192 * 128 + r * 128; bkey[ni] = (r >> 1) & 7; }
#pragma unroll
  for (int hf = 0; hf < 2; ++hf) {
#pragma unroll 1
    for (int kt = hf * 8; kt < hf * 8 + 8; ++kt) {
      if (kt + 1 < NK) issue(kt + 1);
      const char* st = lds + (kt & 1) * STAGE;
#pragma unroll
      for (int kk = 0; kk < 4; ++kk) {
        const int kc = 2 * kk + hh;
        bf16x8 bfr[2];
#pragma unroll
        for (int ni = 0; ni < 2; ++ni) if (MODE == 1 || ni == hf) bfr[ni] = *(const bf16x8*)(st + boff[ni] + ((kc ^ bkey[ni]) << 4));
#pragma unroll
        for (int mi = 0; mi < 3; ++mi) {
          const bf16x8 afr = *(const bf16x8*)(st + aoff[mi] + ((kc ^ akey[mi]) << 4));
#pragma unroll
          for (int ni = 0; ni < 2; ++ni)
            if (MODE == 1 || ni == hf) acc[mi][ni] = __builtin_amdgcn_mfma_f32_32x32x16_bf16(afr, bfr[ni], acc[mi][ni], 0, 0, 0);
        }
      }
      asm volatile("s_waitcnt vmcnt(0)" ::: "memory");
      __syncthreads();
    }
  }
}

#define ACC_ROW(wm, mi, reg, lane) ((wm) * 96 + (mi) * 32 + ((reg) & 3) + 8 * ((reg) >> 2) + 4 * ((lane) >> 5))

template <int NT>
__device__ __forceinline__ void acc_to_lds(const f32x16 (&acc)[3][NT], float* ct, int LD, int half) {
  const int tid_ = otid(); const int lane = tid_ & 63, w = tid_ >> 6, wm = w >> 2, wn = w & 3;
  if (NT == 2 && (wn >> 1) != half) return;
#pragma unroll
  for (int ni = 0; ni < NT; ++ni) {
    const int n = (NT == 2 ? (wn & 1) * 64 : wn * 32) + ni * 32 + (lane & 31);
#pragma unroll
    for (int mi = 0; mi < 3; ++mi)
#pragma unroll
      for (int r = 0; r < 16; ++r) ct[ACC_ROW(wm, mi, r, lane) * LD + n] = acc[mi][ni][r];
  }
}
constexpr int LDT = 196;
template <int NT>
__device__ __forceinline__ void acc_to_lds_T(const f32x16 (&acc)[3][NT], float* ctT, int half) {
  const int tid_ = otid(); const int lane = tid_ & 63, w = tid_ >> 6, wm = w >> 2, wn = w & 3;
  if (NT == 2 && (wn >> 1) != half) return;
#pragma unroll
  for (int ni = 0; ni < NT; ++ni) {
    const int n = (NT == 2 ? (wn & 1) * 64 : wn * 32) + ni * 32 + (lane & 31);
#pragma unroll
    for (int mi = 0; mi < 3; ++mi)
#pragma unroll
      for (int g4 = 0; g4 < 4; ++g4) {
        const int r0 = wm * 96 + mi * 32 + 8 * g4 + 4 * (lane >> 5);
        float4 v; v.x = acc[mi][ni][g4 * 4 + 0]; v.y = acc[mi][ni][g4 * 4 + 1]; v.z = acc[mi][ni][g4 * 4 + 2]; v.w = acc[mi][ni][g4 * 4 + 3];
        *(float4*)(ctT + n * LDT + r0) = v;
      }
  }
}
__device__ __forceinline__ void store_tile_bf16(const float* ct, bf16_t* dst, int ldd, int tok0, int n0) {
#pragma unroll 1
  for (int it = otid(); it < 192 * 16; it += NTHR) {
    const int c8 = it & 15, r = it >> 4;
    const float4 a = *(const float4*)(ct + r * 132 + c8 * 8), b = *(const float4*)(ct + r * 132 + c8 * 8 + 4);
    uint4 o; o.x = pack2(a.x, a.y); o.y = pack2(a.z, a.w); o.z = pack2(b.x, b.y); o.w = pack2(b.z, b.w);
    *(uint4*)(dst + (size_t)(tok0 + r) * ldd + n0 + c8 * 8) = o;
  }
}

__device__ void p0_transpose_tile(const float* __restrict__ src, bf16_t* __restrict__ dst, int R, int C, int tr, int tc, char* smem) {
  float* t = (float*)smem;
  const int tid = otid();
  __syncthreads();
#pragma unroll
  for (int i = 0; i < 8; ++i) {
    int r = (tid >> 6) + 8 * i, c = tid & 63;
    t[r * 65 + c] = src[(size_t)(tr * 64 + r) * C + tc * 64 + c];
  }
  __syncthreads();
#pragma unroll
  for (int i = 0; i < 8; ++i) {
    int cc = (tid >> 6) + 8 * i, rr = tid & 63;
    dst[(size_t)(tc * 64 + cc) * R + tr * 64 + rr] = f2bf(t[rr * 65 + cc]);
  }
}

__device__ void p0_wc_item(const Params& p, int l, int ph, int kt, char* smem) {
  float* wqs = (float*)smem;
  float* ks = wqs + 64 * 129;
  const int tid = otid();
  const float* wq = p.peer_wq + (size_t)l * DM * 2048;
  const float* kk = ((ph & 1) ? p.peer_k2 : p.peer_k1) + (size_t)l * 128 * 128;
  __syncthreads();
  for (int e = tid; e < 64 * 128; e += NTHR) {
    int r = e >> 7, d = e & 127;
    wqs[r * 129 + d] = wq[(size_t)(kt * 64 + r) * 2048 + ph * 128 + d];
  }
  for (int e = tid; e < 128 * 128; e += NTHR) {
    int r = e >> 7, d = e & 127;
    ks[r * 129 + d] = kk[r * 128 + d];
  }
  __syncthreads();
  const int key = tid & 127, k0 = (tid >> 7) * 16;
  float acc[16];
#pragma unroll
  for (int i = 0; i < 16; ++i) acc[i] = 0.f;
  for (int d = 0; d < 128; ++d) {
    float kv = ks[key * 129 + d];
#pragma unroll
    for (int i = 0; i < 16; ++i) acc[i] += wqs[(k0 + i) * 129 + d] * kv;
  }
  bf16_t* dst = p.WcT + ((size_t)l * 2048 + ph * 128 + key) * DM + kt * 64 + k0;
  uint4 o0, o1;
  o0.x = pack2(acc[0], acc[1]); o0.y = pack2(acc[2], acc[3]); o0.z = pack2(acc[4], acc[5]); o0.w = pack2(acc[6], acc[7]);
  o1.x = pack2(acc[8], acc[9]); o1.y = pack2(acc[10], acc[11]); o1.z = pack2(acc[12], acc[13]); o1.w = pack2(acc[14], acc[15]);
  *(uint4*)dst = o0; *(uint4*)(dst + 8) = o1;
}

__device__ void p0_mod_item(const Params& p, int l, int cc, char* smem) {
  float* sc = (float*)smem;
  float* red = sc + 1024 * 24;
  const int tid = otid();
  __syncthreads();
  for (int e = tid; e < NB * DM; e += NTHR) {
    int b = e >> 10, k = e & 1023;
    float v = crow(p, b)[k];
    sc[k * 24 + b] = v / (1.f + __expf(-v));
  }
  __syncthreads();
  const int col = tid & 63, kg = tid >> 6;
  const int n = cc * 64 + col;
  float acc[24];
#pragma unroll
  for (int b = 0; b < 24; ++b) acc[b] = 0.f;
  const float* wm = p.w_mod + (size_t)l * DM * 6144 + n;
#pragma unroll 1
  for (int k0 = kg * 128; k0 < kg * 128 + 128; k0 += 8) {
    float wv[8];
#pragma unroll
    for (int j = 0; j < 8; ++j) wv[j] = wm[(size_t)(k0 + j) * 6144];
#pragma unroll
    for (int j = 0; j < 8; ++j) {
      const float4* s4 = (const float4*)(sc + (k0 + j) * 24);
#pragma unroll
      for (int q = 0; q < 6; ++q) {
        float4 sv = s4[q];
        acc[q * 4 + 0] += sv.x * wv[j]; acc[q * 4 + 1] += sv.y * wv[j]; acc[q * 4 + 2] += sv.z * wv[j]; acc[q * 4 + 3] += sv.w * wv[j];
      }
    }
  }
#pragma unroll
  for (int b = 0; b < 24; ++b) red[(kg * 24 + b) * 64 + col] = acc[b];
  __syncthreads();
  for (int e = tid; e < 24 * 64; e += NTHR) {
    const int b = e >> 6, c2 = e & 63;
    float sum = p.b_mod[l * 6144 + cc * 64 + c2];
#pragma unroll
    for (int g = 0; g < 8; ++g) sum += red[(g * 24 + b) * 64 + c2];
    p.mod[((size_t)l * NB + b) * 6144 + cc * 64 + c2] = sum;
  }
}

__device__ void p0_filter_item(const Params& p, int l, int tc, char* smem) {
  float* feat = (float*)smem;
  float* a1 = feat + 32 * 33;
  float* a2 = a1 + 32 * 64;
  bf16_t* stage = (bf16_t*)(a2 + 32 * 64);
  const int tid = otid();
  const int t0 = tc * 32;
  __syncthreads();
  for (int e = tid; e < 32 * 33; e += NTHR) {
    int pp = e / 33, f = e % 33;
    int ti = t0 + pp;
    float v;
    if (f == 0) v = (float)ti / (float)(SEQ - 1);
    else {
      int bi = (f - 1) & 15;
      float band = 1e-4f + (float)bi * ((15.f - 1e-4f) / 15.f);
      float wv = 2.0f * 3.14159265358979323846f * (float)ti / (float)SEQ;
      float arg = band * wv;
      v = (f <= 16) ? cosf(arg) : -sinf(arg);
    }
    feat[pp * 33 + f] = v;
  }
  __syncthreads();
  const float* w1 = p.f_w1 + l * 33 * 64; const float* b1 = p.f_b1 + l * 64; const float* fq = p.f_freq + l * 64;
  const float* w2 = p.f_w2 + l * 64 * 64; const float* b2 = p.f_b2 + l * 64;
  for (int e = tid; e < 32 * 64; e += NTHR) {
    int pp = e >> 6, j = e & 63;
    float s = b1[j];
    for (int f = 0; f < 33; ++f) s += feat[pp * 33 + f] * w1[f * 64 + j];
    a1[pp * 64 + j] = sinf(fq[j] * s);
  }
  __syncthreads();
  for (int e = tid; e < 32 * 64; e += NTHR) {
    int pp = e >> 6, j = e & 63;
    float s = b2[j];
    for (int i = 0; i < 64; ++i) s += a1[pp * 64 + i] * w2[i * 64 + j];
    a2[pp * 64 + j] = sinf(fq[j] * s);
  }
  __syncthreads();
  const float* w3 = p.f_w3 + (size_t)l * 64 * 2048;
  const float min_decay = logf(1e-2f) / 1.5f, max_decay = logf(1e-2f) / 0.3f;
  for (int q = 0; q < 4; ++q) {
    const int n = tid + 512 * q;
    const int c = n & 511;
    float wr[64];
#pragma unroll
    for (int i = 0; i < 64; ++i) wr[i] = w3[i * 2048 + n];
    const float delta = fabsf(min_decay + (max_decay - min_decay) * (float)c / 511.f);
    for (int pp = 0; pp < 32; ++pp) {
      float s = 0.f;
#pragma unroll
      for (int i = 0; i < 64; ++i) s += a2[pp * 64 + i] * wr[i];
      float tt = (float)(t0 + pp) / (float)(SEQ - 1);
      s *= __expf(-tt * delta);
      if (t0 + pp == 0 && ((n >> 9) & 1) == 0) s += p.f_bias[(l * 2 + (n >> 10)) * 512 + c];
      stage[n * 32 + pp] = f2bf(s);
    }
  }
  __syncthreads();
  for (int e = tid; e < 2048 * 32; e += NTHR) {
    int n = e >> 5, pp = e & 31;
    int o = n >> 10, d = (n >> 9) & 1, c = n & 511;
    int t = t0 + pp;
    bf16_t* g = p.Gf + ((size_t)((l * 2 + o) * 512 + c)) * 4096;
    if (d == 0) g[2048 - t] = stage[n * 32 + pp];
    else if (t >= 1) g[2048 + t] = stage[n * 32 + pp];
    if (t == 0 && d == 0) g[0] = 0;
  }
}

__device__ void p0_rope_item(const Params& p, int it) {
  int e = it * 512 + otid();
  int pos = e >> 5, i = e & 31;
  float inv = powf(10000.f, -(float)(2 * i) / 64.f);
  float ang = (float)pos * inv;
  p.rope[e * 2 + 0] = cosf(ang);
  p.rope[e * 2 + 1] = sinf(ang);
}

__device__ __forceinline__ int next_item(unsigned* cnt, char* smem) {
  int* sh = (int*)(smem + SMEM_BYTES - 16);
  __syncthreads();
  if (threadIdx.x == 0) *sh = (int)atomicAdd(cnt, 1u);
  __syncthreads();
  return *sh;
}

constexpr int P0_N_MOD = 2 * 96;
constexpr int P0_N_FILT = 2 * 64;
constexpr int P0_N_ROPE = 128;
constexpr int P0_N_WIN = 16 * 68;
constexpr int P0A_TOTAL = P0_N_FILT + P0_N_MOD + P0_N_ROPE + P0_N_WIN;
constexpr int P0_N_WC = 2 * 16 * 16;
constexpr int P0_N_SMALL = 8 * 16 + 8 * 16 + 16 * 16;
constexpr int P0B_TOTAL = P0_N_WC + P0_N_WIN + 2 * P0_N_SMALL;

__device__ __forceinline__ void p0_win_tile(const Params& p, int l, int j, char* smem) {
  p0_transpose_tile(p.w_in + (size_t)l * DM * INC, p.WinT + (size_t)l * INC * DM, DM, INC, j / 68, j % 68, smem);
}
__device__ void p0a_item(const Params& p, int i, char* smem) {
  if (i < P0_N_FILT) { p0_filter_item(p, i / 64, i % 64, smem); return; }
  i -= P0_N_FILT;
  if (i < P0_N_MOD) { p0_mod_item(p, i / 96, i % 96, smem); return; }
  i -= P0_N_MOD;
  if (i < P0_N_ROPE) { p0_rope_item(p, i); return; }
  i -= P0_N_ROPE;
  p0_win_tile(p, 0, i, smem);
}
__device__ void p0b_item(const Params& p, int i, char* smem) {
  if (i < P0_N_WC) { p0_wc_item(p, i >> 8, (i >> 4) & 15, i & 15, smem); return; }
  i -= P0_N_WC;
  if (i < P0_N_WIN) { p0_win_tile(p, 1, i, smem); return; }
  i -= P0_N_WIN;
  const int l = i / P0_N_SMALL; int j = i % P0_N_SMALL;
  if (j < 128) { p0_transpose_tile(p.w_pa + (size_t)l * HYW * DM, p.WpaT + (size_t)l * DM * HYW, HYW, DM, j / 16, j % 16, smem); return; }
  j -= 128;
  if (j < 128) { p0_transpose_tile(p.w_pb + (size_t)l * HYW * DM, p.WpbT + (size_t)l * DM * HYW, HYW, DM, j / 16, j % 16, smem); return; }
  j -= 128;
  p0_transpose_tile(p.w_out + (size_t)l * DM * DM, p.WoutT + (size_t)l * DM * DM, DM, DM, j / 16, j % 16, smem);
}
__device__ void phase_p0(const Params& p, char* smem) {
  for (int it = next_item(p.wq + 96, smem); it < P0A_TOTAL; it = next_item(p.wq + 96, smem)) p0a_item(p, it, smem);
}

__device__ void norm_rows(const Params& p, int tile, int l, int which, bool from_inputs, char* smem) {
  float* scl = (float*)smem;
  float* shf = scl + 2048;
  const int tid = otid(), lane = tid & 63, w = tid >> 6;
  const int tok0 = tile * TM;
  const int b0 = tok0 >> 11;
  const float* g = (which ? p.g2 : p.g1) + l * DM;
  __syncthreads();
  for (int e = tid; e < 2048; e += NTHR) {
    int bi = e >> 10, j = e & 1023;
    int b = b0 + bi; if (b > NB - 1) b = NB - 1;
    const float* m = p.mod + ((size_t)l * NB + b) * 6144 + which * 3072;
    scl[e] = g[j] * (1.f + m[1024 + j]);
    shf[e] = m[j];
  }
  __syncthreads();
#pragma unroll 1
  for (int r0 = w; r0 < TM; r0 += 32) {
    float4 v[4][4];
#pragma unroll
    for (int q = 0; q < 4; ++q) {
      const int tok = tok0 + r0 + 8 * q;
      const float* xr = from_inputs ? xrow_in(p, tok) : (p.out + (size_t)tok * DM);
#pragma unroll
      for (int i = 0; i < 4; ++i) v[q][i] = *(const float4*)(xr + lane * 4 + 256 * i);
    }
#pragma unroll
    for (int q = 0; q < 4; ++q) {
      const int tok = tok0 + r0 + 8 * q;
      const int bi = (tok >> 11) - b0;
      float ss = 0.f;
#pragma unroll
      for (int i = 0; i < 4; ++i) ss += v[q][i].x * v[q][i].x + v[q][i].y * v[q][i].y + v[q][i].z * v[q][i].z + v[q][i].w * v[q][i].w;
      ss = wave_sum(ss);
      const float rs = rsqrtf(ss * (1.f / DM) + 1e-6f);
#pragma unroll
      for (int i = 0; i < 4; ++i) {
        const int j = lane * 4 + 256 * i;
        const float4 sc4 = *(const float4*)(scl + bi * 1024 + j);
        const float4 sh4 = *(const float4*)(shf + bi * 1024 + j);
        uint2 o;
        o.x = pack2(v[q][i].x * rs * sc4.x + sh4.x, v[q][i].y * rs * sc4.y + sh4.y);
        o.y = pack2(v[q][i].z * rs * sc4.z + sh4.z, v[q][i].w * rs * sc4.w + sh4.w);
        *(uint2*)(p.hbuf + (size_t)tok * DM + j) = o;
      }
    }
  }
  __syncthreads();
}

__device__ void phase_c(const Params& p, int tile, int l, bool from_inputs, char* smem) {
  norm_rows(p, tile, l, 0, from_inputs, smem);
  const int tid = otid();
  const int tok0 = tile * TM;
  const bf16_t* A = p.hbuf + (size_t)tok0 * DM;
  const bf16_t* W = p.WinT + (size_t)l * INC * DM;
  float* ct = (float*)smem;
  f32x16 acc[3][2];
#pragma unroll 1
  for (int nt = 0; nt < 9; ++nt) {
    gemm_core2<2>(A, DM, W + (size_t)nt * 256 * DM, DM, DM, smem, acc);
#pragma unroll 1
    for (int half = 0; half < 2; ++half) {
      const int nc = nt * 2 + half;
      if (nc < 12) {
        acc_to_lds_T<2>(acc, ct, half);
        lds_barrier();
#pragma unroll 1
        for (int it = tid; it < 128 * 24; it += NTHR) {
          const int tg = it % 24, nl = it / 24;
          const float4 a = *(const float4*)(ct + nl * LDT + tg * 8), b4 = *(const float4*)(ct + nl * LDT + tg * 8 + 4);
          uint4 o; o.x = pack2(a.x, a.y); o.y = pack2(a.z, a.w); o.z = pack2(b4.x, b4.y); o.w = pack2(b4.z, b4.w);
          const int tok = tok0 + tg * 8;
          const int b = tok >> 11, sq = tok & 2047;
          *(uint4*)(p.zT + ((size_t)b * HYC + nc * 128 + nl) * SEQ + sq) = o;
        }
      } else {
        acc_to_lds<2>(acc, ct, 132, half);
        lds_barrier();
        store_tile_bf16(ct, p.zqkv, QKVC, tok0, nc * 128 - HYC);
      }
      lds_barrier();
    }
  }
}

__device__ __forceinline__ void load_conv8(const bf16_t* __restrict__ zrow, int s0, float w0, float w1, float w2, float cb, float (&o)[8]) {
  uint4 v = *(const uint4*)(zrow + s0);
  float z[10];
  z[0] = (s0 > 0) ? bf2f(zrow[s0 - 1]) : 0.f;
  z[1] = lo2f(v.x); z[2] = hi2f(v.x); z[3] = lo2f(v.y); z[4] = hi2f(v.y);
  z[5] = lo2f(v.z); z[6] = hi2f(v.z); z[7] = lo2f(v.w); z[8] = hi2f(v.w);
  z[9] = (s0 + 8 < SEQ) ? bf2f(zrow[s0 + 8]) : 0.f;
#pragma unroll
  for (int i = 0; i < 8; ++i) o[i] = z[i] * w0 + z[i + 1] * w1 + z[i + 2] * w2 + cb;
}

struct Conv8In { uint4 v; unsigned short l, r; };
__device__ __forceinline__ void conv8_load(const bf16_t* __restrict__ zrow, int s0, Conv8In& c) {
  c.v = *(const uint4*)(zrow + s0);
  c.l = (s0 > 0) ? zrow[s0 - 1] : (unsigned short)0;
  c.r = (s0 + 8 < SEQ) ? zrow[s0 + 8] : (unsigned short)0;
}
__device__ __forceinline__ void conv8_eval(const Conv8In& c, float w0, float w1, float w2, float cb, float (&o)[8]) {
  float z[10];
  z[0] = bf2f(c.l);
  z[1] = lo2f(c.v.x); z[2] = hi2f(c.v.x); z[3] = lo2f(c.v.y); z[4] = hi2f(c.v.y);
  z[5] = lo2f(c.v.z); z[6] = hi2f(c.v.z); z[7] = lo2f(c.v.w); z[8] = hi2f(c.v.w);
  z[9] = bf2f(c.r);
#pragma unroll
  for (int i = 0; i < 8; ++i) o[i] = z[i] * w0 + z[i + 1] * w1 + z[i + 2] * w2 + cb;
}

typedef short s16x4 __attribute__((ext_vector_type(4)));
__device__ __forceinline__ s16x4 tr_read4(const bf16_t* lds_ptr) {
  return __builtin_amdgcn_ds_read_tr16_b64_v4i16((__attribute__((address_space(3))) s16x4*)(lds_ptr));
}

constexpr int HY_GS_ELEMS = 4112;
constexpr int HY_US_ROWS = 2072;
__device__ __forceinline__ void hyena_load_g(const Params& p, int l, int o, int c, bf16_t* Gs, int tid) {
  const bf16_t* g = p.Gf + ((size_t)((l * 2 + o) * 512 + c)) * 4096;
  *(uint4*)(Gs + 8 + tid * 8) = *(const uint4*)(g + tid * 8);
  if (tid == 0) { unsigned z = 0; asm volatile("" : "+v"(z)); const uint4 z4 = make_uint4(z, z, z, z); *(uint4*)Gs = z4; *(uint4*)(Gs + 4104) = z4; }
}

__device__ __forceinline__ void hyena_kloop(const bf16_t* Gs, const bf16_t* us, int rho, int lane, f32x16 (&acc)[8]) {
#pragma unroll
  for (int a = 0; a < 8; ++a)
#pragma unroll
    for (int j = 0; j < 16; ++j) acc[a][j] = 0.f;
  const int i = lane & 31, hh = lane >> 5;
  const bf16_t* ga = Gs + (2040 - 8 * i + 8 * hh) - 1792;
  const int l16 = lane & 15, q = l16 >> 2, pq = l16 & 3, g4 = lane >> 4;
  const bf16_t* ub = us + (rho + 8 * (g4 >> 1) + q) * 24 + 16 * (g4 & 1) + 4 * pq;
#pragma unroll 1
  for (int kap = 0; kap < 129; ++kap) {
    const s16x4 b0 = tr_read4(ub + kap * 384);
    const s16x4 b1 = tr_read4(ub + kap * 384 + 96);
    bf16x8 bfrag;
    bfrag[0] = b0[0]; bfrag[1] = b0[1]; bfrag[2] = b0[2]; bfrag[3] = b0[3];
    bfrag[4] = b1[0]; bfrag[5] = b1[1]; bfrag[6] = b1[2]; bfrag[7] = b1[3];
#pragma unroll
    for (int a = 0; a < 8; ++a) {
      const bf16x8 af = *(const bf16x8*)(ga + kap * 16 + 256 * (7 - a));
      acc[a] = __builtin_amdgcn_mfma_f32_32x32x16_bf16(af, bfrag, acc[a], 0, 0, 0);
    }
  }
}

__device__ __forceinline__ void hyena_acc_to_us(const f32x16 (&acc)[8], bf16_t* us, int rho, int lane) {
  const int n = lane & 31, hh = lane >> 5;
  if (n < 24) {
#pragma unroll
    for (int a = 0; a < 8; ++a)
#pragma unroll
      for (int r = 0; r < 16; ++r) {
        const int t = 256 * a + rho + 8 * ((r & 3) + 8 * (r >> 2) + 4 * hh);
        us[(t + 16) * 24 + n] = f2bf(acc[a][r]);
      }
  }
}

__device__ void hyena_item(const Params& p, int l, int c, char* smem) {
  bf16_t* Gs = (bf16_t*)smem;
  bf16_t* us = (bf16_t*)(smem + 8256);
  const int tid = otid();
  const int lane = tid & 63, w = tid >> 6;
  const float* cw = p.conv_w + (size_t)l * 3 * HYC;
  const float* cbp = p.conv_b + (size_t)l * HYC;
  __syncthreads();
  hyena_load_g(p, l, 0, c, Gs, tid);
  {
    unsigned z = 0; asm volatile("" : "+v"(z)); const uint4 z4 = make_uint4(z, z, z, z);
    if (tid < 48) *(uint4*)(us + tid * 8) = z4;
    else if (tid < 48 + 26) *(uint4*)(us + 2064 * 24 + (tid - 48) * 8) = z4;
  }
  {
    const float w0 = cw[c], w1 = cw[HYC + c], w2 = cw[2 * HYC + c], cb = cbp[c];
#pragma unroll 1
    for (int q0 = tid; q0 < 24 * 256; q0 += 4 * NTHR) {
      Conv8In cin[4];
#pragma unroll
      for (int j = 0; j < 4; ++j) {
        const int qq = q0 + j * NTHR;
        conv8_load(p.zT + ((size_t)(qq % 24) * HYC + c) * SEQ, (qq / 24) * 8, cin[j]);
      }
#pragma unroll
      for (int j = 0; j < 4; ++j) {
        const int qq = q0 + j * NTHR;
        const int b = qq % 24, s0 = (qq / 24) * 8;
        float v[8];
        conv8_eval(cin[j], w0, w1, w2, cb, v);
#pragma unroll
        for (int i = 0; i < 8; ++i) us[(s0 + i + 16) * 24 + b] = f2bf(v[i]);
      }
    }
  }
  __syncthreads();
  f32x16 acc[8];
#pragma unroll 1
  for (int o = 0; o < 2; ++o) {
    hyena_kloop(Gs, us, w, lane, acc);
    __syncthreads();
    hyena_acc_to_us(acc, us, w, lane);
    if (o == 0) hyena_load_g(p, l, 1, c, Gs, tid);
    __syncthreads();
    const int xc = (o == 0 ? 512 : 1024) + c;
    const float xw0 = cw[xc], xw1 = cw[HYC + xc], xw2 = cw[2 * HYC + xc], xcb = cbp[xc];
#pragma unroll 1
    for (int q0 = tid; q0 < 24 * 256; q0 += 4 * NTHR) {
      Conv8In cin[4];
#pragma unroll
      for (int j = 0; j < 4; ++j) {
        const int qq = q0 + j * NTHR;
        conv8_load(p.zT + ((size_t)(qq % 24) * HYC + xc) * SEQ, (qq / 24) * 8, cin[j]);
      }
#pragma unroll
      for (int j = 0; j < 4; ++j) {
        const int qq = q0 + j * NTHR;
        const int b = qq % 24, s0 = (qq / 24) * 8;
        float xv[8];
        conv8_eval(cin[j], xw0, xw1, xw2, xcb, xv);
        if (o == 0) {
#pragma unroll
          for (int i = 0; i < 8; ++i) {
            bf16_t* e = us + (s0 + i + 16) * 24 + b;
            *e = f2bf(bf2f(*e) * xv[i]);
          }
        } else {
          float r[8];
#pragma unroll
          for (int i = 0; i < 8; ++i) r[i] = bf2f(us[(s0 + i + 16) * 24 + b]) * xv[i];
          uint4 pk; pk.x = pack2(r[0], r[1]); pk.y = pack2(r[2], r[3]); pk.z = pack2(r[4], r[5]); pk.w = pack2(r[6], r[7]);
          *(uint4*)(p.yaT + ((size_t)b * HYW + c) * SEQ + s0) = pk;
        }
      }
    }
    __syncthreads();
  }
}

__device__ void attn_item(const Params& p, int l, int item, char* smem) {
  constexpr int KS = 72, VS = 96;
  bf16_t* Ks = (bf16_t*)smem;
  bf16_t* Vs = Ks + 384 * KS;
  const int tid = otid();
  const int lane = tid & 63, w = tid >> 6;
  const int kh = item & 1, qb = (item >> 1) & 15, b = item >> 5;
  const int kpos0 = qb * 128 - 128;
  __syncthreads();
  if (tid < 384) {
    const int r = tid, kpos = kpos0 + r;
    if (kpos >= 0 && kpos < SEQ) {
      const bf16_t* kr = p.zqkv + ((size_t)(b * SEQ + kpos)) * QKVC + 512 + kh * 64;
      float kf[64];
      float ss = 0.f;
#pragma unroll
      for (int c8 = 0; c8 < 8; ++c8) {
        uint4 v = *(const uint4*)(kr + c8 * 8);
        kf[c8 * 8 + 0] = lo2f(v.x); kf[c8 * 8 + 1] = hi2f(v.x); kf[c8 * 8 + 2] = lo2f(v.y); kf[c8 * 8 + 3] = hi2f(v.y);
        kf[c8 * 8 + 4] = lo2f(v.z); kf[c8 * 8 + 5] = hi2f(v.z); kf[c8 * 8 + 6] = lo2f(v.w); kf[c8 * 8 + 7] = hi2f(v.w);
      }
#pragma unroll
      for (int d = 0; d < 64; ++d) ss += kf[d] * kf[d];
      const float rs = rsqrtf(ss * (1.f / 64.f) + 1e-6f);
      const float* kg = p.k_gain + l * 64;
#pragma unroll
      for (int d = 0; d < 64; ++d) kf[d] = kf[d] * rs * kg[d];
      const float* rp = p.rope + (size_t)kpos * 64;
#pragma unroll
      for (int i = 0; i < 32; ++i) {
        const float cs = rp[i * 2], sn = rp[i * 2 + 1];
        const float a = kf[i], bb = kf[i + 32];
        kf[i] = a * cs - bb * sn; kf[i + 32] = bb * cs + a * sn;
      }
#pragma unroll
      for (int c8 = 0; c8 < 8; ++c8) {
        uint4 pk;
        pk.x = pack2(kf[c8 * 8 + 0], kf[c8 * 8 + 1]); pk.y = pack2(kf[c8 * 8 + 2], kf[c8 * 8 + 3]);
        pk.z = pack2(kf[c8 * 8 + 4], kf[c8 * 8 + 5]); pk.w = pack2(kf[c8 * 8 + 6], kf[c8 * 8 + 7]);
        *(uint4*)(Ks + r * KS + c8 * 8) = pk;
      }
    }
  }
#pragma unroll 1
  for (int e = tid; e < 384 * 8; e += NTHR) {
    const int r = e >> 3, c8 = e & 7, kpos = kpos0 + r;
    if (kpos >= 0 && kpos < SEQ)
      *(uint4*)(Vs + r * VS + c8 * 8) = *(const uint4*)(p.zqkv + ((size_t)(b * SEQ + kpos)) * QKVC + 640 + kh * 64 + c8 * 8);
  }
  __syncthreads();
  const int hl = w & 3, qh = w >> 2;
  const int head = kh * 4 + hl;
  const int n = lane & 31, hh = lane >> 5;
  const int Q0 = qb * 128 + 64 * qh;
  bf16x8 qf[2][4];
#pragma unroll
  for (int nt = 0; nt < 2; ++nt) {
    const int qpos = Q0 + 32 * nt + n;
    const bf16_t* qr = p.zqkv + ((size_t)(b * SEQ + qpos)) * QKVC + head * 64;
    float qv[4][8];
    float ss = 0.f;
#pragma unroll
    for (int kk = 0; kk < 4; ++kk) {
      uint4 v = *(const uint4*)(qr + 16 * kk + 8 * hh);
      qv[kk][0] = lo2f(v.x); qv[kk][1] = hi2f(v.x); qv[kk][2] = lo2f(v.y); qv[kk][3] = hi2f(v.y);
      qv[kk][4] = lo2f(v.z); qv[kk][5] = hi2f(v.z); qv[kk][6] = lo2f(v.w); qv[kk][7] = hi2f(v.w);
#pragma unroll
      for (int j = 0; j < 8; ++j) ss += qv[kk][j] * qv[kk][j];
    }
    ss += __shfl_xor(ss, 32, 64);
    const float rs = rsqrtf(ss * (1.f / 64.f) + 1e-6f) * 0.125f;
    const float* qg = p.q_gain + l * 64;
#pragma unroll
    for (int kk = 0; kk < 4; ++kk)
#pragma unroll
      for (int j = 0; j < 8; ++j) qv[kk][j] *= rs * qg[16 * kk + 8 * hh + j];
    const float* rp = p.rope + (size_t)qpos * 64;
#pragma unroll
    for (int kk = 0; kk < 2; ++kk)
#pragma unroll
      for (int j = 0; j < 8; ++j) {
        const int d = 16 * kk + 8 * hh + j;
        const float cs = rp[d * 2], sn = rp[d * 2 + 1];
        const float a = qv[kk][j], bb = qv[kk + 2][j];
        qv[kk][j] = a * cs - bb * sn; qv[kk + 2][j] = bb * cs + a * sn;
      }
#pragma unroll
    for (int kk = 0; kk < 4; ++kk)
#pragma unroll
      for (int j = 0; j < 8; ++j) qf[nt][kk][j] = (short)f2bf(qv[kk][j]);
  }
  f32x16 O[2][2];
#pragma unroll
  for (int dm = 0; dm < 2; ++dm)
#pragma unroll
    for (int nt = 0; nt < 2; ++nt)
#pragma unroll
      for (int r = 0; r < 16; ++r) O[dm][nt][r] = 0.f;
  float mrun[2], lsum[2];
  mrun[0] = mrun[1] = p.sink[l * 8 + head];
  lsum[0] = lsum[1] = (hh == 0) ? 1.f : 0.f;
  const int l16 = lane & 15, tq = l16 >> 2, tp = l16 & 3, g4 = lane >> 4;
  const bf16_t* vbase = Vs + (4 * (g4 >> 1) + tq) * VS + 16 * (g4 & 1) + 4 * tp;
#pragma unroll 1
  for (int kt = 2 * qh; kt < 2 * qh + 10; ++kt) {
    const int kp_t = kpos0 + 32 * kt;
    if (kp_t < 0 || kp_t >= SEQ) continue;
    bf16x8 kfr[4];
#pragma unroll
    for (int kk = 0; kk < 4; ++kk) kfr[kk] = *(const bf16x8*)(Ks + (32 * kt + n) * KS + 16 * kk + 8 * hh);
    bf16x8 pf[2][2];
#pragma unroll
    for (int nt = 0; nt < 2; ++nt) {
      f32x16 S;
#pragma unroll
      for (int r = 0; r < 16; ++r) S[r] = 0.f;
#pragma unroll
      for (int kk = 0; kk < 4; ++kk) S = __builtin_amdgcn_mfma_f32_32x32x16_bf16(kfr[kk], qf[nt][kk], S, 0, 0, 0);
      const int qpos = Q0 + 32 * nt + n;
      float mloc = -INFINITY;
#pragma unroll
      for (int r = 0; r < 16; ++r) {
        const int kpos = kp_t + (r & 3) + 8 * (r >> 2) + 4 * hh;
        int dd = kpos - qpos; dd = dd < 0 ? -dd : dd;
        S[r] = (dd <= 128) ? S[r] : -INFINITY;
        mloc = fmaxf(mloc, S[r]);
      }
      mloc = fmaxf(mloc, __shfl_xor(mloc, 32, 64));
      const float mnew = fmaxf(mrun[nt], mloc);
      const float corr = __expf(mrun[nt] - mnew);
      mrun[nt] = mnew;
      float psum = 0.f;
#pragma unroll
      for (int r = 0; r < 16; ++r) { S[r] = __expf(S[r] - mnew); psum += S[r]; }
      lsum[nt] = lsum[nt] * corr + psum;
#pragma unroll
      for (int dm = 0; dm < 2; ++dm)
#pragma unroll
        for (int r = 0; r < 16; ++r) O[dm][nt][r] *= corr;
#pragma unroll
      for (int s2 = 0; s2 < 2; ++s2)
#pragma unroll
        for (int j = 0; j < 8; ++j) pf[nt][s2][j] = (short)f2bf(S[8 * s2 + j]);
    }
#pragma unroll
    for (int dm = 0; dm < 2; ++dm)
#pragma unroll
      for (int s2 = 0; s2 < 2; ++s2) {
        const bf16_t* vp = vbase + (32 * kt + 16 * s2) * VS + 32 * dm;
        const s16x4 v0 = tr_read4(vp);
        const s16x4 v1 = tr_read4(vp + 8 * VS);
        bf16x8 vf;
        vf[0] = v0[0]; vf[1] = v0[1]; vf[2] = v0[2]; vf[3] = v0[3];
        vf[4] = v1[0]; vf[5] = v1[1]; vf[6] = v1[2]; vf[7] = v1[3];
#pragma unroll
        for (int nt = 0; nt < 2; ++nt) O[dm][nt] = __builtin_amdgcn_mfma_f32_32x32x16_bf16(vf, pf[nt][s2], O[dm][nt], 0, 0, 0);
      }
  }
#pragma unroll
  for (int nt = 0; nt < 2; ++nt) {
    const float ltot = lsum[nt] + __shfl_xor(lsum[nt], 32, 64);
    const float inv = 1.f / ltot;
    const int qpos = Q0 + 32 * nt + n;
    bf16_t* yo = p.yb + ((size_t)(b * SEQ + qpos)) * 512 + head * 64;
#pragma unroll
    for (int dm = 0; dm < 2; ++dm)
#pragma unroll
      for (int g = 0; g < 4; ++g) {
        uint2 o;
        o.x = pack2(O[dm][nt][4 * g + 0] * inv, O[dm][nt][4 * g + 1] * inv);
        o.y = pack2(O[dm][nt][4 * g + 2] * inv, O[dm][nt][4 * g + 3] * inv);
        *(uint2*)(yo + 32 * dm + 8 * g + 4 * hh) = o;
      }
  }
}

typedef float f32x2 __attribute__((ext_vector_type(2)));
__device__ void table_item(const Params& p, int l, int it) {
  const int tid = otid();
  const int lane = tid & 63, w = tid >> 6;
  const int which = it >> 9, r0 = (it & 511) * 32 + w * 4;
  const float* src = (which ? p.peer_v : p.peer_u) + (size_t)l * NEXP * DM;
  unsigned char* dst = which ? p.tabV8 : p.tabU8;
  float* sc = which ? p.sclV : p.sclU;
  float4 v[4][4];
#pragma unroll
  for (int rr = 0; rr < 4; ++rr)
#pragma unroll
    for (int i = 0; i < 4; ++i) v[rr][i] = *(const float4*)(src + (size_t)(r0 + rr) * DM + lane * 4 + 256 * i);
#pragma unroll
  for (int rr = 0; rr < 4; ++rr) {
    const int e = r0 + rr;
    float mx = 0.f;
#pragma unroll
    for (int i = 0; i < 4; ++i)
      mx = fmaxf(mx, fmaxf(fmaxf(fabsf(v[rr][i].x), fabsf(v[rr][i].y)), fmaxf(fabsf(v[rr][i].z), fabsf(v[rr][i].w))));
#pragma unroll
    for (int m = 32; m >= 1; m >>= 1) mx = fmaxf(mx, __shfl_xor(mx, m, 64));
    const float scale = (mx > 0.f) ? 440.f / mx : 1.f;
#pragma unroll
    for (int i = 0; i < 4; ++i) {
      int pk = __builtin_amdgcn_cvt_pk_fp8_f32(v[rr][i].x * scale, v[rr][i].y * scale, 0, false);
      pk = __builtin_amdgcn_cvt_pk_fp8_f32(v[rr][i].z * scale, v[rr][i].w * scale, pk, true);
      const int x = 2 * i + (lane >> 5);
      *(int*)(dst + ((size_t)x * NEXP + e) * 128 + (lane & 31) * 4) = pk;
    }
    if (lane == 0) sc[e] = (mx > 0.f) ? mx * (1.f / 440.f) : 1.f;
  }
}

constexpr int DE_N_HY = 512, DE_N_AT = 768, DE_N_TB = 1024;
__device__ void phase_de(const Params& p, int l, char* smem) {
  const int total = DE_N_HY + DE_N_AT + DE_N_TB + (l == 0 ? P0B_TOTAL : 0);
  for (int it = next_item(p.wq + 100 + l, smem); it < total; it = next_item(p.wq + 100 + l, smem)) {
    if (it < DE_N_HY) hyena_item(p, l, it, smem);
    else if (it < DE_N_HY + DE_N_AT) attn_item(p, l, it - DE_N_HY, smem);
    else if (it < DE_N_HY + DE_N_AT + DE_N_TB) table_item(p, l, it - DE_N_HY - DE_N_AT);
    else p0b_item(p, it - DE_N_HY - DE_N_AT - DE_N_TB, smem);
  }
}

__device__ void phase_f(const Params& p, int tile, int l, bool from_inputs, char* smem) {
  const int tid = otid();
  const int tok0 = tile * TM;
#pragma unroll 4
  for (int e = tid; e < TM * 64; e += NTHR) {
    const int r = e % TM, cg8 = e / TM;
    const int tok = tok0 + r, b = tok >> 11, sq = tok & 2047;
    const bf16_t* src = p.yaT + ((size_t)b * HYW + cg8 * 8) * SEQ + sq;
    uint4 o;
    o.x = (unsigned)src[0] | ((unsigned)src[SEQ] << 16);
    o.y = (unsigned)src[2 * SEQ] | ((unsigned)src[3 * SEQ] << 16);
    o.z = (unsigned)src[4 * SEQ] | ((unsigned)src[5 * SEQ] << 16);
    o.w = (unsigned)src[6 * SEQ] | ((unsigned)src[7 * SEQ] << 16);
    *(uint4*)(p.yatok + (size_t)tok * HYW + cg8 * 8) = o;
  }
  __syncthreads();
  const bf16_t* Ah = p.hbuf + (size_t)tok0 * DM;
  const bf16_t* Aya = p.yatok + (size_t)tok0 * HYW;
  const bf16_t* Ayb = p.yb + (size_t)tok0 * HYW;
  const bf16_t* Win = p.WinT + (size_t)l * INC * DM;
  const bf16_t* Wpa = p.WpaT + (size_t)l * DM * HYW;
  const bf16_t* Wpb = p.WpbT + (size_t)l * DM * HYW;
  float* ct = (float*)smem;
  f32x16 acc[3][2];
  unsigned sgp[3][2][8];
#pragma unroll 1
  for (int nc = 0; nc < 8; ++nc) {
    gemm_f1<1>(Ah, Ah, DM, Win + (size_t)(2304 + nc * 128) * DM, Win + (size_t)(3328 + nc * 128) * DM, DM, smem, acc);
#pragma unroll
    for (int mi = 0; mi < 3; ++mi)
#pragma unroll
      for (int ni = 0; ni < 2; ++ni)
#pragma unroll
        for (int q = 0; q < 8; ++q)
          sgp[mi][ni][q] = pack2(__builtin_amdgcn_rcpf(1.f + __expf(-acc[mi][ni][2 * q])), __builtin_amdgcn_rcpf(1.f + __expf(-acc[mi][ni][2 * q + 1])));
    gemm_f1<2>(Aya, Ayb, HYW, Wpa + (size_t)(nc * 128) * HYW, Wpb + (size_t)(nc * 128) * HYW, HYW, smem, acc);
    {
      const int tid_ = otid(); const int lane = tid_ & 63, w = tid_ >> 6, wm = w >> 2, wn = w & 3;
      const int n = wn * 32 + (lane & 31);
#pragma unroll
      for (int mi = 0; mi < 3; ++mi)
#pragma unroll
        for (int q = 0; q < 8; ++q) {
          const float m0 = lo2f(sgp[mi][0][q]) * acc[mi][0][2 * q] + lo2f(sgp[mi][1][q]) * acc[mi][1][2 * q];
          const float m1 = hi2f(sgp[mi][0][q]) * acc[mi][0][2 * q + 1] + hi2f(sgp[mi][1][q]) * acc[mi][1][2 * q + 1];
          ct[ACC_ROW(wm, mi, 2 * q, lane) * 132 + n] = m0;
          ct[ACC_ROW(wm, mi, 2 * q + 1, lane) * 132 + n] = m1;
        }
    }
    lds_barrier();
    store_tile_bf16(ct, p.merged, DM, tok0, nc * 128);
  }
  __syncthreads();
  const bf16_t* Am = p.merged + (size_t)tok0 * DM;
  const bf16_t* Wo = p.WoutT + (size_t)l * DM * DM;
  f32x16 acc2[3][2];
#pragma unroll 1
  for (int nt = 0; nt < 4; ++nt) {
    gemm_core2<2>(Am, DM, Wo + (size_t)(nt * 256) * DM, DM, DM, smem, acc2);
#pragma unroll 1
    for (int half = 0; half < 2; ++half) {
      acc_to_lds<2>(acc2, ct, 132, half);
      lds_barrier();
#pragma unroll 4
      for (int it = tid; it < 192 * 32; it += NTHR) {
        const int c4 = it & 31, r = it >> 5;
        const int tok = tok0 + r, b = tok >> 11;
        const int n = nt * 256 + half * 128 + c4 * 4;
        const float4 a = *(const float4*)(ct + r * 132 + c4 * 4);
        const float4 gt = *(const float4*)(p.mod + ((size_t)l * NB + b) * 6144 + 2048 + n);
        const float* xs = from_inputs ? xrow_in(p, tok) : (p.out + (size_t)tok * DM);
        float4 xo = *(const float4*)(xs + n);
        xo.x += gt.x * a.x; xo.y += gt.y * a.y; xo.z += gt.z * a.z; xo.w += gt.w * a.w;
        *(float4*)(p.out + (size_t)tok * DM + n) = xo;
      }
      lds_barrier();
    }
  }
  __syncthreads();
}

__device__ __forceinline__ void sort16_desc(float (&v)[16]) {
#pragma unroll
  for (int k = 2; k <= 16; k <<= 1)
#pragma unroll
    for (int j = k >> 1; j >= 1; j >>= 1)
#pragma unroll
      for (int i = 0; i < 16; ++i) {
        const int l = i ^ j;
        if (l > i) {
          const float hi = fmaxf(v[i], v[l]), lo = fminf(v[i], v[l]);
          if ((i & k) == 0) { v[i] = hi; v[l] = lo; } else { v[i] = lo; v[l] = hi; }
        }
      }
}
__device__ __forceinline__ void merge16_desc(float (&top)[16], const float (&g)[16]) {
#pragma unroll
  for (int i = 0; i < 16; ++i) top[i] = fmaxf(top[i], g[15 - i]);
#pragma unroll
  for (int j = 8; j >= 1; j >>= 1)
#pragma unroll
    for (int i = 0; i < 16; ++i) {
      const int l = i ^ j;
      if (l > i) { const float hi = fmaxf(top[i], top[l]), lo = fminf(top[i], top[l]); top[i] = hi; top[l] = lo; }
    }
}
__device__ __forceinline__ void topk_insert(float (&key)[16], float kx) {
#pragma unroll
  for (int i = 0; i < 16; ++i) {
    const float hi = fmaxf(key[i], kx);
    kx = fminf(key[i], kx);
    key[i] = hi;
  }
}

__device__ void phase_g(const Params& p, int tile, int l, char* smem) {
  norm_rows(p, tile, l, 1, false, smem);
  const int tid = otid();
  const int tok0 = tile * TM;
  const bf16_t* Ah = p.hbuf + (size_t)tok0 * DM;
  const bf16_t* Wc = p.WcT + (size_t)l * 2048 * DM;
  float* sc = (float*)smem;
  f32x16 acc[3][2];
  float v1k[16], v2k[16];
#pragma unroll
  for (int i = 0; i < 16; ++i) { v1k[i] = 0.f; v2k[i] = 0.f; }
#pragma unroll 1
  for (int ch = 0; ch < 16; ++ch) {
    if ((ch & 1) == 0) gemm_core2<2>(Ah, DM, Wc + (size_t)(ch * 128) * DM, DM, DM, smem, acc);
    acc_to_lds<2>(acc, sc, 129, ch & 1);
    __syncthreads();
    float key[16];
    const int ttok = tid % TM, part = tid / TM;
    float* xch = (float*)(smem + 100352);
    if (tid < 2 * TM) {
      const float* row = sc + ttok * 129 + part * 64;
#pragma unroll
      for (int i = 0; i < 16; ++i) key[i] = __uint_as_float((__float_as_uint(row[i]) & 0xFFFFFF80u) | (unsigned)(part * 64 + i));
      sort16_desc(key);
#pragma unroll 1
      for (int j0 = 16; j0 < 64; j0 += 16) {
        float g[16];
#pragma unroll
        for (int i = 0; i < 16; ++i) g[i] = __uint_as_float((__float_as_uint(row[j0 + i]) & 0xFFFFFF80u) | (unsigned)(part * 64 + j0 + i));
        sort16_desc(g);
        merge16_desc(key, g);
      }
      if (part == 1) {
#pragma unroll
        for (int i = 0; i < 16; ++i) xch[ttok * 17 + i] = key[i];
      }
    }
    __syncthreads();
    if (tid < TM) {
      {
        float g[16];
#pragma unroll
        for (int i = 0; i < 16; ++i) g[i] = xch[tid * 17 + i];
        merge16_desc(key, g);
      }
      if ((ch & 1) == 0) {
#pragma unroll
        for (int i = 0; i < 16; ++i) v1k[i] = key[i];
      } else {
#pragma unroll
        for (int i = 0; i < 16; ++i) v2k[i] = key[i];
        float top[16], grp[16];
        {
          constexpr int CI[64] = {0,0,0,0,0,0,0,0,0,0,0,0,0,0,0,0, 1,1,1,1,1,1,1,1, 2,2,2,2,2, 3,3,3,3, 4,4,4, 5,5, 6,6, 7,7, 8,9,10,11,12,13,14,15, 0,0,0,0,0,0,0,0,0,0,0,0,0,0};
          constexpr int CJ[64] = {0,1,2,3,4,5,6,7,8,9,10,11,12,13,14,15, 0,1,2,3,4,5,6,7, 0,1,2,3,4, 0,1,2,3, 0,1,2, 0,1, 0,1, 0,1, 0,0,0,0,0,0,0,0, 0,0,0,0,0,0,0,0,0,0,0,0,0,0};
#pragma unroll
          for (int gq = 0; gq < 4; ++gq) {
#pragma unroll
            for (int i = 0; i < 16; ++i) {
              const int c = gq * 16 + i;
              if (c < 50) {
                const float sv = v1k[CI[c]] + v2k[CJ[c]];
                grp[i] = __uint_as_float((__float_as_uint(sv) & 0xFFFFFF00u) | (unsigned)(CI[c] * 16 + CJ[c]));
              } else grp[i] = -INFINITY;
            }
            sort16_desc(grp);
            if (gq == 0) {
#pragma unroll
              for (int i = 0; i < 16; ++i) top[i] = grp[i];
            } else merge16_desc(top, grp);
          }
        }
        const float mx = top[0];
        float ex[16], sum = 0.f;
#pragma unroll
        for (int k = 0; k < 16; ++k) { ex[k] = __expf(top[k] - mx); sum += ex[k]; }
        const float inv = 1.f / sum;
        const int hh = ch >> 1;
        const size_t ob = ((size_t)(tok0 + tid) * 8 + hh) * 16;
        unsigned char* ltab = (unsigned char*)(smem + 114688) + tid * 32;
#pragma unroll
        for (int q = 0; q < 4; ++q) {
          unsigned w1 = 0, w2 = 0;
#pragma unroll
          for (int b4 = 0; b4 < 4; ++b4) {
            w1 |= (__float_as_uint(v1k[4 * q + b4]) & 0x7Fu) << (8 * b4);
            w2 |= (__float_as_uint(v2k[4 * q + b4]) & 0x7Fu) << (8 * b4);
          }
          *(unsigned*)(ltab + 4 * q) = w1;
          *(unsigned*)(ltab + 16 + 4 * q) = w2;
        }
        unsigned ee[16];
#pragma unroll
        for (int k = 0; k < 16; ++k) {
          const unsigned code = __float_as_uint(top[k]) & 0xFFu;
          ee[k] = (unsigned)ltab[code >> 4] * 128u + (unsigned)ltab[16 + (code & 15u)];
        }
        uint4 i0, i1;
        i0.x = ee[0] | (ee[1] << 16); i0.y = ee[2] | (ee[3] << 16); i0.z = ee[4] | (ee[5] << 16); i0.w = ee[6] | (ee[7] << 16);
        i1.x = ee[8] | (ee[9] << 16); i1.y = ee[10] | (ee[11] << 16); i1.z = ee[12] | (ee[13] << 16); i1.w = ee[14] | (ee[15] << 16);
        *(uint4*)(p.pidx + ob) = i0; *(uint4*)(p.pidx + ob + 8) = i1;
#pragma unroll
        for (int q = 0; q < 4; ++q)
          *(float4*)(p.pg + ob + 4 * q) = make_float4(ex[4 * q] * inv, ex[4 * q + 1] * inv, ex[4 * q + 2] * inv, ex[4 * q + 3] * inv);
      }
    }
    __syncthreads();
  }
}

__device__ __forceinline__ unsigned xcc_id() { return (unsigned)__builtin_amdgcn_s_getreg((3 << 11) | 20) & 7u; }
__device__ __forceinline__ bool next_slice_item(unsigned* cnt, int& x, int& j, int& tries, char* smem, int tid) {
  int* sh = (int*)(smem + 8192);
  while (tries < 8) {
    __syncthreads();
    if (tid == 0) *sh = (int)atomicAdd(cnt + x, 1u);
    __syncthreads();
    j = *sh;
    if (j < I_NJ) return true;
    x = (x + 1) & 7; ++tries;
  }
  return false;
}
__device__ __forceinline__ float dpp_xor1(float v) { return __builtin_bit_cast(float, __builtin_amdgcn_update_dpp(0, __builtin_bit_cast(int, v), 0xB1, 0xF, 0xF, true)); }
__device__ __forceinline__ float dpp_xor2(float v) { return __builtin_bit_cast(float, __builtin_amdgcn_update_dpp(0, __builtin_bit_cast(int, v), 0x4E, 0xF, 0xF, true)); }
__device__ __forceinline__ float dpp_hmirror(float v) { return __builtin_bit_cast(float, __builtin_amdgcn_update_dpp(0, __builtin_bit_cast(int, v), 0x141, 0xF, 0xF, true)); }
__device__ __forceinline__ float dpp_ror8(float v) { return __builtin_bit_cast(float, __builtin_amdgcn_update_dpp(0, __builtin_bit_cast(int, v), 0x128, 0xF, 0xF, true)); }

struct I1Ctx { uint4 h0, h1, e0, e1; };
__device__ __forceinline__ void i1_load_ctx(const Params& p, int tok, int x, int g, int ch, I1Ctx& c) {
  const bf16_t* hr = p.hbuf + (size_t)tok * DM + x * 128 + ch * 16;
  c.h0 = *(const uint4*)hr; c.h1 = *(const uint4*)(hr + 8);
  const uint4* pi = (const uint4*)(p.pidx + (size_t)tok * 128 + g * 16);
  c.e0 = pi[0]; c.e1 = pi[1];
}
__device__ __forceinline__ void peer_issue_rows(const unsigned char* Tslice, unsigned lane_off, const uint4& e0, const uint4& e1, uint4 (&rows)[16]) {
  const unsigned ew[8] = {e0.x, e0.y, e0.z, e0.w, e1.x, e1.y, e1.z, e1.w};
#pragma unroll
  for (int rd = 0; rd < 16; ++rd) {
    const unsigned e = (ew[rd >> 1] >> (16 * (rd & 1))) & 0x3FFFu;
    rows[rd] = *(const uint4*)(Tslice + (e * 128u + lane_off));
  }
}
typedef _Float16 f16x2 __attribute__((ext_vector_type(2)));
__device__ __forceinline__ f16x2 bf2_to_h2(unsigned u) {
  f16x2 r; r[0] = (_Float16)lo2f(u); r[1] = (_Float16)hi2f(u); return r;
}
__device__ __forceinline__ void i1_compute(const I1Ctx& c, const uint4 (&rows)[16], bf16_t* dst, int ch) {
  f16x2 hs[8];
  hs[0] = bf2_to_h2(c.h0.x); hs[1] = bf2_to_h2(c.h0.y); hs[2] = bf2_to_h2(c.h0.z); hs[3] = bf2_to_h2(c.h0.w);
  hs[4] = bf2_to_h2(c.h1.x); hs[5] = bf2_to_h2(c.h1.y); hs[6] = bf2_to_h2(c.h1.z); hs[7] = bf2_to_h2(c.h1.w);
  float res[16];
#pragma unroll
  for (int rd = 0; rd < 16; ++rd) {
    const unsigned wd[4] = {rows[rd].x, rows[rd].y, rows[rd].z, rows[rd].w};
    float d0 = 0.f, d1 = 0.f;
#pragma unroll
    for (int q = 0; q < 4; ++q) {
      d0 = __builtin_amdgcn_fdot2(__builtin_amdgcn_cvt_scalef32_pk_f16_fp8((int)wd[q], 1.0f, false), hs[2 * q], d0, false);
      d1 = __builtin_amdgcn_fdot2(__builtin_amdgcn_cvt_scalef32_pk_f16_fp8((int)wd[q], 1.0f, true), hs[2 * q + 1], d1, false);
    }
    float d = d0 + d1;
    d += dpp_xor1(d); d += dpp_xor2(d); d += dpp_hmirror(d);
    res[rd] = d;
  }
  if (ch == 0) {
    uint4 o0, o1;
    o0.x = pack2(res[0], res[1]); o0.y = pack2(res[2], res[3]); o0.z = pack2(res[4], res[5]); o0.w = pack2(res[6], res[7]);
    o1.x = pack2(res[8], res[9]); o1.y = pack2(res[10], res[11]); o1.z = pack2(res[12], res[13]); o1.w = pack2(res[14], res[15]);
    *(uint4*)dst = o0; *(uint4*)(dst + 8) = o1;
  }
}

__device__ void phase_i1(const Params& p, int pass, char* smem) {
  const int tid = otid();
  const int lane = tid & 63, w = tid >> 6;
  const int g = lane >> 3, ch = lane & 7;
  int x = (int)xcc_id(), j = 0, tries = 0;
  while (next_slice_item(p.wq + pass * 8, x, j, tries, smem, tid)) {
    const unsigned char* Ux = p.tabU8 + (size_t)x * NEXP * 128;
    const unsigned loff = ch * 16;
    bf16_t* ap = p.apart + (size_t)x * NTOK * 128 + g * 16;
    const int tokb = j * I_TOK + w;
    I1Ctx c0, c1, c2;
    uint4 rowsA[16], rowsB[16];
    i1_load_ctx(p, tokb, x, g, ch, c0);
    i1_load_ctx(p, tokb + 8, x, g, ch, c1);
    i1_load_ctx(p, tokb + 16, x, g, ch, c2);
    peer_issue_rows(Ux, loff, c0.e0, c0.e1, rowsA);
#pragma unroll 1
    for (int i = 0; i < I_TW; i += 2) {
      I1Ctx c3, c4;
      peer_issue_rows(Ux, loff, c1.e0, c1.e1, rowsB);
      i1_load_ctx(p, tokb + 8 * min(i + 3, I_TW - 1), x, g, ch, c3);
      i1_compute(c0, rowsA, ap + (size_t)(tokb + 8 * i) * 128, ch);
      peer_issue_rows(Ux, loff, c2.e0, c2.e1, rowsA);
      i1_load_ctx(p, tokb + 8 * min(i + 4, I_TW - 1), x, g, ch, c4);
      i1_compute(c1, rowsB, ap + (size_t)(tokb + 8 * (i + 1)) * 128, ch);
      c0 = c2; c1 = c3; c2 = c4;
    }
  }
}

__device__ void phase_w(const Params& p) {
  const int tid = otid();
  const size_t npair8 = (size_t)NTOK * 128 / 8;
  for (size_t q8 = (size_t)blockIdx.x * NTHR + tid; q8 < npair8; q8 += (size_t)gridDim.x * NTHR) {
    const size_t q = q8 * 8;
    float a[8];
#pragma unroll
    for (int i = 0; i < 8; ++i) a[i] = 0.f;
#pragma unroll
    for (int xx = 0; xx < 8; ++xx) {
      const uint4 v = *(const uint4*)(p.apart + (size_t)xx * NTOK * 128 + q);
      a[0] += lo2f(v.x); a[1] += hi2f(v.x); a[2] += lo2f(v.y); a[3] += hi2f(v.y);
      a[4] += lo2f(v.z); a[5] += hi2f(v.z); a[6] += lo2f(v.w); a[7] += hi2f(v.w);
    }
    const float4 g0 = *(const float4*)(p.pg + q), g1 = *(const float4*)(p.pg + q + 4);
    const uint4 ev = *(const uint4*)(p.pidx + q);
    const unsigned ew[4] = {ev.x, ev.y, ev.z, ev.w};
    float su[8], sg[8];
    const float gg[8] = {g0.x, g0.y, g0.z, g0.w, g1.x, g1.y, g1.z, g1.w};
#pragma unroll
    for (int i = 0; i < 8; ++i) {
      const unsigned e = (ew[i >> 1] >> (16 * (i & 1))) & 0x3FFFu;
      su[i] = p.sclU[e];
      sg[i] = gg[i] * p.sclV[e];
    }
    float wv[8];
#pragma unroll
    for (int i = 0; i < 8; ++i) {
      const float av = a[i] * su[i];
      wv[i] = sg[i] * 0.5f * av * (1.f + erff(av * 0.70710678118654752f));
    }
    uint4 o; o.x = pack2(wv[0], wv[1]); o.y = pack2(wv[2], wv[3]); o.z = pack2(wv[4], wv[5]); o.w = pack2(wv[6], wv[7]);
    *(uint4*)(p.wbuf + q) = o;
  }
}

struct I2Ctx { uint4 e0, e1; };
struct I2XG { uint4 w0, w1; float2 xv, gt; };
__device__ __forceinline__ void i2_load_ctx(const Params& p, int tok, int l, int x, int g, int ch, I2Ctx& c) {
  const unsigned off = (unsigned)tok * 256u + (unsigned)g * 32u;
  const uint4* pi = (const uint4*)((const char*)p.pidx + off);
  c.e0 = pi[0]; c.e1 = pi[1];
}
__device__ __forceinline__ void i2_load_xg(const Params& p, int tok, int l, int x, int g, int ch, I2XG& c) {
  const unsigned off = (unsigned)tok * 256u + (unsigned)g * 32u;
  const uint4* pw = (const uint4*)((const char*)p.wbuf + off);
  c.w0 = pw[0]; c.w1 = pw[1];
  const unsigned col = (unsigned)(x * 128 + ch * 16 + 2 * g);
  c.xv = *(const float2*)((const char*)p.out + ((unsigned)tok * 4096u + col * 4u));
  c.gt = *(const float2*)((const char*)p.mod + ((unsigned)(l * NB + (tok >> 11)) * 24576u + 20480u + col * 4u));
}
__device__ __forceinline__ void i2_compute(const Params& p, const I2XG& xg, const uint4 (&rows)[16], int tok, int x, int g, int ch) {
  const unsigned ww[8] = {xg.w0.x, xg.w0.y, xg.w0.z, xg.w0.w, xg.w1.x, xg.w1.y, xg.w1.z, xg.w1.w};
  f32x2 acc[8];
#pragma unroll
  for (int i = 0; i < 8; ++i) acc[i] = f32x2{0.f, 0.f};
#pragma unroll
  for (int rd = 0; rd < 16; ++rd) {
    const unsigned wd[4] = {rows[rd].x, rows[rd].y, rows[rd].z, rows[rd].w};
    const float wsc = (rd & 1) ? hi2f(ww[rd >> 1]) : lo2f(ww[rd >> 1]);
    const f32x2 sw = {wsc, wsc};
#pragma unroll
    for (int q = 0; q < 4; ++q) {
      acc[2 * q] += sw * __builtin_amdgcn_cvt_pk_f32_fp8((int)wd[q], false);
      acc[2 * q + 1] += sw * __builtin_amdgcn_cvt_pk_f32_fp8((int)wd[q], true);
    }
  }
  float r[16];
#pragma unroll
  for (int i = 0; i < 8; ++i) { r[2 * i] = acc[i][0]; r[2 * i + 1] = acc[i][1]; }
  const bool b2 = (g & 4) != 0, b1 = (g & 2) != 0, b0 = (g & 1) != 0;
  float r8[8];
#pragma unroll
  for (int i = 0; i < 8; ++i) {
    const float snd = b2 ? r[i] : r[i + 8];
    const float kp = b2 ? r[i + 8] : r[i];
    r8[i] = kp + __shfl_xor(snd, 32, 64);
  }
  float r4[4];
#pragma unroll
  for (int i = 0; i < 4; ++i) {
    const float snd = b1 ? r8[i] : r8[i + 4];
    const float kp = b1 ? r8[i + 4] : r8[i];
    r4[i] = kp + __shfl_xor(snd, 16, 64);
  }
  float r2[2];
#pragma unroll
  for (int i = 0; i < 2; ++i) {
    const float snd = b0 ? r4[i] : r4[i + 2];
    const float kp = b0 ? r4[i + 2] : r4[i];
    r2[i] = kp + dpp_ror8(snd);
  }
  float2 o;
  o.x = xg.xv.x + xg.gt.x * r2[0];
  o.y = xg.xv.y + xg.gt.y * r2[1];
  *(float2*)((char*)p.out + ((unsigned)tok * 4096u + (unsigned)(x * 128 + ch * 16 + 2 * g) * 4u)) = o;
}

__device__ void phase_i2(const Params& p, int l, int pass, char* smem) {
  const int tid = otid();
  const int lane = tid & 63, w = tid >> 6;
  const int g = lane >> 3, ch = lane & 7;
  int x = (int)xcc_id(), j = 0, tries = 0;
  while (next_slice_item(p.wq + pass * 8, x, j, tries, smem, tid)) {
    const unsigned char* Vx = p.tabV8 + (size_t)x * NEXP * 128;
    const unsigned loff = ch * 16;
    const int tokb = j * I_TOK + w;
    I2Ctx c0, c1;
    I2XG xa, xb;
    uint4 rowsA[16], rowsB[16];
    i2_load_ctx(p, tokb, l, x, g, ch, c0);
    i2_load_ctx(p, tokb + 8, l, x, g, ch, c1);
    peer_issue_rows(Vx, loff, c0.e0, c0.e1, rowsA);
    i2_load_xg(p, tokb, l, x, g, ch, xa);
    i2_load_ctx(p, tokb + 8 * min(2, I_TW - 1), l, x, g, ch, c0);
#pragma unroll 1
    for (int i = 0; i < I_TW; i += 2) {
      __builtin_amdgcn_sched_barrier(0);
      peer_issue_rows(Vx, loff, c1.e0, c1.e1, rowsB);
      i2_load_xg(p, tokb + 8 * (i + 1), l, x, g, ch, xb);
      i2_load_ctx(p, tokb + 8 * min(i + 3, I_TW - 1), l, x, g, ch, c1);
      __builtin_amdgcn_sched_barrier(0);
      i2_compute(p, xa, rowsA, tokb + 8 * i, x, g, ch);
      __builtin_amdgcn_sched_barrier(0);
      peer_issue_rows(Vx, loff, c0.e0, c0.e1, rowsA);
      i2_load_xg(p, tokb + 8 * min(i + 2, I_TW - 1), l, x, g, ch, xa);
      i2_load_ctx(p, tokb + 8 * min(i + 4, I_TW - 1), l, x, g, ch, c0);
      __builtin_amdgcn_sched_barrier(0);
      i2_compute(p, xb, rowsB, tokb + 8 * (i + 1), x, g, ch);
      __builtin_amdgcn_sched_barrier(0);
    }
  }
}

__device__ __forceinline__ void grid_bar(unsigned* cnt, unsigned& epoch) {
  ++epoch;
  const unsigned target = epoch * gridDim.x;
  __syncthreads();
  if (threadIdx.x == 0) {
    __builtin_amdgcn_fence(__ATOMIC_RELEASE, "agent");
    asm volatile("s_waitcnt vmcnt(0)" ::: "memory");
    __hip_atomic_fetch_add(cnt, 1u, __ATOMIC_RELAXED, __HIP_MEMORY_SCOPE_AGENT);
    while (__hip_atomic_load(cnt, __ATOMIC_RELAXED, __HIP_MEMORY_SCOPE_AGENT) < target) __builtin_amdgcn_s_sleep(1);
    __builtin_amdgcn_fence(__ATOMIC_ACQUIRE, "agent");
    asm volatile("s_waitcnt vmcnt(0)" ::: "memory");
  }
  __syncthreads();
}

__global__ void __launch_bounds__(NTHR) mega_kernel(Params p) {
  extern __shared__ __attribute__((aligned(16))) char smem[];
  cg::grid_group grid = cg::this_grid();
  unsigned epoch = 0;
  for (int rep = 0; rep < REP_P0; ++rep) phase_p0(p, smem);
  grid.sync();
  for (int l = 0; l < 2; ++l) {
    for (int rep = 0; rep < REP_C; ++rep)
    for (int tile = blockIdx.x; tile < NTILE; tile += gridDim.x) phase_c(p, tile, l, l == 0, smem);
    grid_bar(p.wq + 64, epoch);
    for (int rep = 0; rep < REP_DE; ++rep) phase_de(p, l, smem);
    grid_bar(p.wq + 64, epoch);
    for (int tile = blockIdx.x; tile < NTILE; tile += gridDim.x) {
      phase_f(p, tile, l, l == 0, smem);
      for (int rep = 0; rep < REP_G; ++rep) phase_g(p, tile, l, smem);
    }
    grid_bar(p.wq + 64, epoch);
    phase_i1(p, 2 * l, smem);
    grid_bar(p.wq + 64, epoch);
    phase_w(p);
    grid_bar(p.wq + 64, epoch);
    phase_i2(p, l, 2 * l + 1, smem);
    if (l == 0) grid_bar(p.wq + 64, epoch);
  }
}

extern "C" void kernel_launch(void* const* d_in, const int* in_sizes, int n_in, void* d_out, int out_size, void* d_ws,
                              size_t ws_size, hipStream_t stream) {
  Params p{};
  const float* const* in = (const float* const*)d_in;
  p.x_prompt = in[0]; p.x_sample = in[1]; p.c_prompt = in[2]; p.c_sample = in[3]; p.w_mod = in[4]; p.b_mod = in[5];
  p.g1 = in[6]; p.g2 = in[7]; p.w_in = in[8]; p.conv_w = in[9]; p.conv_b = in[10]; p.f_w1 = in[11]; p.f_b1 = in[12];
  p.f_freq = in[13]; p.f_w2 = in[14]; p.f_b2 = in[15]; p.f_w3 = in[16]; p.f_bias = in[17]; p.q_gain = in[18];
  p.k_gain = in[19]; p.sink = in[20]; p.w_pa = in[21]; p.w_pb = in[22]; p.w_out = in[23]; p.peer_wq = in[24];
  p.peer_k1 = in[25]; p.peer_k2 = in[26]; p.peer_u = in[27]; p.peer_v = in[28];
  p.out = (float*)d_out;
  char* ws = (char*)d_ws;
  size_t off = 0;
  auto carve = [&](size_t bytes) { char* r = ws + off; off += (bytes + 255) & ~(size_t)255; return r; };
  p.WinT = (bf16_t*)carve((size_t)2 * INC * DM * 2);
  p.WpaT = (bf16_t*)carve((size_t)2 * DM * HYW * 2);
  p.WpbT = (bf16_t*)carve((size_t)2 * DM * HYW * 2);
  p.WoutT = (bf16_t*)carve((size_t)2 * DM * DM * 2);
  p.WcT = (bf16_t*)carve((size_t)2 * 2048 * DM * 2);
  p.Gf = (bf16_t*)carve((size_t)2 * 2 * 512 * 4096 * 2);
  p.mod = (float*)carve((size_t)2 * NB * 6144 * 4);
  p.rope = (float*)carve((size_t)SEQ * 64 * 4);
  p.tabU8 = (unsigned char*)carve((size_t)NEXP * DM);
  p.tabV8 = (unsigned char*)carve((size_t)NEXP * DM);
  p.sclU = (float*)carve((size_t)NEXP * 4);
  p.sclV = (float*)carve((size_t)NEXP * 4);
  p.wq = (unsigned*)carve(1024);
  p.zT = (bf16_t*)carve((size_t)NB * HYC * SEQ * 2);
  p.yaT = (bf16_t*)carve((size_t)NTOK * HYW * 2);
  p.yb = (bf16_t*)carve((size_t)NTOK * HYW * 2);
  p.zqkv = (bf16_t*)carve((size_t)NTOK * QKVC * 2);
  p.hbuf = (bf16_t*)carve((size_t)NTOK * DM * 2);
  p.merged = p.zT;
  p.yatok = p.zT + (size_t)NTOK * DM;
  p.apart = p.zT;
  p.pidx = (unsigned short*)p.zqkv;
  p.pg = (float*)(p.zqkv + (size_t)NTOK * 128);
  p.pgu = p.pg + (size_t)NTOK * 128;
  p.wbuf = (bf16_t*)(p.pgu + (size_t)NTOK * 128);
  if (off > ws_size) fprintf(stderr, "workspace too small: need %zu have %zu\n", off, ws_size);

  static int grid_blocks = 0;
  if (!grid_blocks) {
    int dev = 0, cus = 0, per_cu = 0;
    hipGetDevice(&dev);
    hipDeviceGetAttribute(&cus, hipDeviceAttributeMultiprocessorCount, dev);
    hipFuncSetAttribute((const void*)mega_kernel, hipFuncAttributeMaxDynamicSharedMemorySize, SMEM_BYTES);
    hipOccupancyMaxActiveBlocksPerMultiprocessor(&per_cu, mega_kernel, NTHR, SMEM_BYTES);
    if (per_cu < 1) per_cu = 1;
    grid_blocks = cus * 1;
    if (grid_blocks > NTILE) grid_blocks = NTILE;
  }
  hipMemsetAsync(p.wq, 0, 1024, stream);
  void* args[] = {&p};
  hipError_t e = hipLaunchCooperativeKernel((const void*)mega_kernel, dim3(grid_blocks), dim3(NTHR), args, SMEM_BYTES, stream);
  if (e != hipSuccess) fprintf(stderr, "cooperative launch failed: %s (grid %d)\n", hipGetErrorString(e), grid_blocks);
}
```

```cpp
#include <hip/hip_runtime.h>
#include <hip/hip_bf16.h>
#include <hip/hip_cooperative_groups.h>
#include <cstdio>
#include <cstdint>
namespace cg = cooperative_groups;

typedef unsigned short bf16_t;
using bf16x8 = __attribute__((ext_vector_type(8))) short;
using f32x16 = __attribute__((ext_vector_type(16))) float;

constexpr int DM = 1024;
constexpr int NB = 24;
constexpr int SEQ = 2048;
constexpr int NTOK = NB * SEQ;
constexpr int NBP = 16;
constexpr int INC = 4352;
constexpr int HYC = 1536;
constexpr int HYW = 512;
constexpr int QKVC = 768;
constexpr int TM = 192;
constexpr int NTILE = NTOK / TM;
constexpr int NTHR = 512;
constexpr int NEXP = 16384;
constexpr int SMEM_BYTES = 155648;
constexpr int I_TOK = 384;
constexpr int I_NJ = NTOK / I_TOK;
constexpr int I_TW = I_TOK / 8;
#ifndef REP_DE
#define REP_DE 1
#endif
#ifndef REP_C
#define REP_C 1
#endif
#ifndef REP_G
#define REP_G 1
#endif
#ifndef REP_I1
#define REP_I1 1
#endif
#ifndef REP_P0
#define REP_P0 1
#endif

struct Params {
  const float *x_prompt, *x_sample, *c_prompt, *c_sample, *w_mod, *b_mod, *g1, *g2, *w_in, *conv_w, *conv_b;
  const float *f_w1, *f_b1, *f_freq, *f_w2, *f_b2, *f_w3, *f_bias, *q_gain, *k_gain, *sink, *w_pa, *w_pb, *w_out;
  const float *peer_wq, *peer_k1, *peer_k2, *peer_u, *peer_v;
  float* out;
  bf16_t *WinT, *WpaT, *WpbT, *WoutT, *WcT, *Gf, *zT, *zqkv, *yaT, *yb, *hbuf, *merged, *yatok;
  unsigned char *tabU8, *tabV8;
  unsigned short* pidx;
  bf16_t* wbuf;
  float *pg, *pgu, *mod, *rope, *sclU, *sclV;
  bf16_t* apart;
  unsigned* wq;
};

__device__ __forceinline__ float bf2f(bf16_t v) { return __uint_as_float(((unsigned)v) << 16); }
__device__ __forceinline__ bf16_t f2bf(float f) {
  unsigned u = __float_as_uint(f);
  u += 0x7FFFu + ((u >> 16) & 1u);
  return (bf16_t)(u >> 16);
}
__device__ __forceinline__ unsigned pack2(float a, float b) { return (unsigned)f2bf(a) | ((unsigned)f2bf(b) << 16); }
__device__ __forceinline__ float lo2f(unsigned u) { return __uint_as_float(u << 16); }
__device__ __forceinline__ float hi2f(unsigned u) { return __uint_as_float(u & 0xFFFF0000u); }

__device__ __forceinline__ int otid() { int t = threadIdx.x; asm volatile("" : "+v"(t)); return t; }
__device__ __forceinline__ int osgpr(int x) { asm volatile("" : "+s"(x)); return x; }
__device__ __forceinline__ void lds_barrier() { asm volatile("s_waitcnt lgkmcnt(0)\n\ts_barrier" ::: "memory"); }
__device__ __forceinline__ float wave_sum(float v) {
#pragma unroll
  for (int m = 32; m >= 1; m >>= 1) v += __shfl_xor(v, m, 64);
  return v;
}

__device__ __forceinline__ const float* xrow_in(const Params& p, int tok) {
  return (tok < NBP * SEQ) ? (p.x_prompt + (size_t)tok * DM) : (p.x_sample + (size_t)(tok - NBP * SEQ) * DM);
}
__device__ __forceinline__ const float* crow(const Params& p, int b) {
  return (b < NBP) ? (p.c_prompt + (size_t)b * DM) : (p.c_sample + (size_t)(b - NBP) * DM);
}

__device__ __forceinline__ void glds16(const bf16_t* g, char* l) {
  __builtin_amdgcn_global_load_lds((const __attribute__((address_space(1))) void*)g, (__attribute__((address_space(3))) void*)l, 16, 0, 0);
}
template <int NT>
__device__ __forceinline__ void gemm_core2(const bf16_t* __restrict__ A, int lda, const bf16_t* __restrict__ B, int ldb,
                                           int K, char* lds, f32x16 (&acc)[3][NT]) {
  constexpr int BROWS = 128 * NT;
  constexpr int STAGE = (192 + BROWS) * 128;
  const int tid = otid();
  const int lane = tid & 63, w = tid >> 6;
  const int wm = w >> 2, wn = w & 3;
#pragma unroll
  for (int i = 0; i < 3; ++i)
#pragma unroll
    for (int n = 0; n < NT; ++n)
#pragma unroll
      for (int j = 0; j < 16; ++j) acc[i][n][j] = 0.f;
  const int lr = lane >> 3, lc = lane & 7;
  const bf16_t* pa[3];
  const bf16_t* pb[2 * NT];
#pragma unroll
  for (int i = 0; i < 3; ++i) {
    const int row = (w + 8 * i) * 8 + lr;
    pa[i] = A + (size_t)row * lda + ((lc ^ ((row >> 1) & 7)) * 8);
  }
#pragma unroll
  for (int i = 0; i < 2 * NT; ++i) {
    const int row = (w + 8 * i) * 8 + lr;
    pb[i] = B + (size_t)row * ldb + ((lc ^ ((row >> 1) & 7)) * 8);
  }
  const int nk = K >> 6;
  lds_barrier();
  {
#pragma unroll
    for (int i = 0; i < 3; ++i) glds16(pa[i], lds + (w + 8 * i) * 1024);
#pragma unroll
    for (int i = 0; i < 2 * NT; ++i) glds16(pb[i], lds + 192 * 128 + (w + 8 * i) * 1024);
  }
  asm volatile("s_waitcnt vmcnt(0)" ::: "memory");
  __syncthreads();
  const int fr = lane & 31, hh = lane >> 5;
  int aoff[3], akey[3], boff[NT], bkey[NT];
#pragma unroll
  for (int mi = 0; mi < 3; ++mi) { const int r = wm * 96 + mi * 32 + fr; aoff[mi] = r * 128; akey[mi] = (r >> 1) & 7; }
#pragma unroll
  for (int ni = 0; ni < NT; ++ni) { const int r = wn * 32 * NT + ni * 32 + fr; boff[ni] = 192 * 128 + r * 128; bkey[ni] = (r >> 1) & 7; }
#pragma unroll 1
  for (int kt = 0; kt < nk; ++kt) {
    if (kt + 1 < nk) {
      char* sb = lds + ((kt + 1) & 1) * STAGE;
      const int ko = (kt + 1) << 6;
#pragma unroll
      for (int i = 0; i < 3; ++i) glds16(pa[i] + ko, sb + (w + 8 * i) * 1024);
#pragma unroll
      for (int i = 0; i < 2 * NT; ++i) glds16(pb[i] + ko, sb + 192 * 128 + (w + 8 * i) * 1024);
    }
    const char* st = lds + (kt & 1) * STAGE;
    bf16x8 afr[2][3], bfr[2][NT];
#pragma unroll
    for (int ni = 0; ni < NT; ++ni) bfr[0][ni] = *(const bf16x8*)(st + boff[ni] + ((hh ^ bkey[ni]) << 4));
#pragma unroll
    for (int mi = 0; mi < 3; ++mi) afr[0][mi] = *(const bf16x8*)(st + aoff[mi] + ((hh ^ akey[mi]) << 4));
#pragma unroll
    for (int kk = 0; kk < 4; ++kk) {
      const int cur = kk & 1, nxt = cur ^ 1;
      if (kk < 3) {
        const int kc = 2 * (kk + 1) + hh;
#pragma unroll
        for (int ni = 0; ni < NT; ++ni) bfr[nxt][ni] = *(const bf16x8*)(st + boff[ni] + ((kc ^ bkey[ni]) << 4));
#pragma unroll
        for (int mi = 0; mi < 3; ++mi) afr[nxt][mi] = *(const bf16x8*)(st + aoff[mi] + ((kc ^ akey[mi]) << 4));
      }
      __builtin_amdgcn_sched_barrier(0);
#pragma unroll
      for (int mi = 0; mi < 3; ++mi)
#pragma unroll
        for (int ni = 0; ni < NT; ++ni) acc[mi][ni] = __builtin_amdgcn_mfma_f32_32x32x16_bf16(afr[cur][mi], bfr[cur][ni], acc[mi][ni], 0, 0, 0);
      __builtin_amdgcn_sched_barrier(0);
    }
    asm volatile("s_waitcnt vmcnt(0)" ::: "memory");
    __syncthreads();
  }
}
typedef short s16x4 __attribute__((ext_vector_type(4)));
__device__ __forceinline__ s16x4 tr_read4(const bf16_t* lds_ptr) {
  return __builtin_amdgcn_ds_read_tr16_b64_v4i16((__attribute__((address_space(3))) s16x4*)(lds_ptr));
}

template <int MODE>
__device__ __forceinline__ void gemm_f1(const bf16_t* __restrict__ A0, const bf16_t* __restrict__ A1, int lda,
                                        const bf16_t* __restrict__ B0, const bf16_t* __restrict__ B1, int ldb,
                                        char* lds, f32x16 (&acc)[3][2], int tok0 = 0) {
  constexpr int STAGE = (192 + 256) * 128;
  const int tid = otid();
  const int lane = tid & 63, w = tid >> 6;
  const int wm = w >> 2, wn = w & 3;
#pragma unroll
  for (int i = 0; i < 3; ++i)
#pragma unroll
    for (int n = 0; n < 2; ++n)
#pragma unroll
      for (int j = 0; j < 16; ++j) acc[i][n][j] = 0.f;
  const int lr = lane >> 3, lc = lane & 7;
  const bool hi = (w >= 4);
  int aofs[3];
  const bf16_t* pb[4];
#pragma unroll
  for (int i = 0; i < 3; ++i) {
    const int row = (w + 8 * i) * 8 + lr;
    aofs[i] = row * lda + ((lc ^ ((row >> 1) & 7)) * 8);
  }
#pragma unroll
  for (int i = 0; i < 4; ++i) {
    const int rb = (w + 8 * i) * 8 + lr;
    const int srow = i * 32 + (w & 3) * 8 + lr;
    pb[i] = (hi ? B1 : B0) + (size_t)srow * ldb + ((lc ^ ((rb >> 1) & 7)) * 8);
  }
  constexpr int NK = 16;
  int tofs[3];
  if (MODE == 2) {
#pragma unroll
    for (int i = 0; i < 3; ++i) {
      const int q = (w + 8 * i) * 64 + lane;
      const int k = q / 24, pos = q - k * 24;
      const int cch = pos ^ (((k >> 1) & 1) << 2);
      const int tok = tok0 + cch * 8;
      tofs[i] = (((tok >> 11) * HYW + k) * SEQ) + (tok & 2047);
    }
  }
  auto issue = [&](int kt) {
    char* sb = lds + (kt & 1) * STAGE;
    const int ka = (MODE == 2) ? ((kt & 7) << 6) : (kt << 6);
    if (MODE == 2 && kt < 8) {
#pragma unroll
      for (int i = 0; i < 3; ++i) glds16(A0 + tofs[i] + (size_t)ka * SEQ, sb + (w + 8 * i) * 1024);
    } else {
      const bf16_t* Ab = (MODE == 2) ? A1 : A0;
#pragma unroll
      for (int i = 0; i < 3; ++i) glds16(Ab + aofs[i] + ka, sb + (w + 8 * i) * 1024);
    }
    if (MODE == 1 || ((kt >= 8) == hi)) {
#pragma unroll
      for (int i = 0; i < 4; ++i) glds16(pb[i] + ka, sb + 192 * 128 + (w + 8 * i) * 1024);
    }
  };
  lds_barrier();
  issue(0);
  asm volatile("s_waitcnt vmcnt(0)" ::: "memory");
  __syncthreads();
  const int fr = lane & 31, hh = lane >> 5;
  int aoff[3], akey[3], boff[2], bkey[2];
#pragma unroll
  for (int mi = 0; mi < 3; ++mi) { const int r = wm * 96 + mi * 32 + fr; aoff[mi] = r * 128; akey[mi] = (r >> 1) & 7; }
#pragma unroll
  for (int ni = 0; ni < 2; ++ni) { const int r = wn * 64 + ni * 32 + fr; boff[ni] = 192 * 128 + r * 128; bkey[ni] = (r >> 1) & 7; }
  int toff[3];
  if (MODE == 2) {
    const int g4 = lane >> 4, tq = (lane & 15) >> 2, tp = lane & 3;
    const int fk = ((tq >> 1) & 1) << 2;
#pragma unroll
    for (int mi = 0; mi < 3; ++mi) {
      const int chunk = wm * 12 + mi * 4 + 2 * (g4 & 1) + (tp >> 1);
      toff[mi] = (8 * (g4 >> 1) + tq) * 384 + ((chunk ^ fk) << 4) + (tp & 1) * 8;
    }
  }
#pragma unroll
  for (int hf = 0; hf < 2; ++hf) {
#pragma unroll 1
    for (int kt = hf * 8; kt < hf * 8 + 8; ++kt) {
      if (kt + 1 < NK) issue(kt + 1);
      const char* st = lds + (kt & 1) * STAGE;
#pragma unroll
      for (int kk = 0; kk < 4; ++kk) {
        const int kc = 2 * kk + hh;
        bf16x8 bfr[2];
#pragma unroll
        for (int ni = 0; ni < 2; ++ni) if (MODE == 1 || ni == hf) bfr[ni] = *(const bf16x8*)(st + boff[ni] + ((kc ^ bkey[ni]) << 4));
#pragma unroll
        for (int mi = 0; mi < 3; ++mi) {
          bf16x8 afr;
          if (MODE == 2 && hf == 0) {
            const s16x4 t0 = tr_read4((const bf16_t*)(st + toff[mi] + kk * 6144));
            const s16x4 t1 = tr_read4((const bf16_t*)(st + toff[mi] + kk * 6144 + 1536));
            afr[0] = t0[0]; afr[1] = t0[1]; afr[2] = t0[2]; afr[3] = t0[3];
            afr[4] = t1[0]; afr[5] = t1[1]; afr[6] = t1[2]; afr[7] = t1[3];
          } else {
            afr = *(const bf16x8*)(st + aoff[mi] + ((kc ^ akey[mi]) << 4));
          }
#pragma unroll
          for (int ni = 0; ni < 2; ++ni)
            if (MODE == 1 || ni == hf) acc[mi][ni] = __builtin_amdgcn_mfma_f32_32x32x16_bf16(afr, bfr[ni], acc[mi][ni], 0, 0, 0);
        }
      }
      asm volatile("s_waitcnt vmcnt(0)" ::: "memory");
      __syncthreads();
    }
  }
}

#define ACC_ROW(wm, mi, reg, lane) ((wm) * 96 + (mi) * 32 + ((reg) & 3) + 8 * ((reg) >> 2) + 4 * ((lane) >> 5))

template <int NT>
__device__ __forceinline__ void acc_to_lds(const f32x16 (&acc)[3][NT], float* ct, int LD, int half) {
  const int tid_ = otid(); const int lane = tid_ & 63, w = tid_ >> 6, wm = w >> 2, wn = w & 3;
  if (NT == 2 && (wn >> 1) != half) return;
#pragma unroll
  for (int ni = 0; ni < NT; ++ni) {
    const int n = (NT == 2 ? (wn & 1) * 64 : wn * 32) + ni * 32 + (lane & 31);
#pragma unroll
    for (int mi = 0; mi < 3; ++mi)
#pragma unroll
      for (int r = 0; r < 16; ++r) ct[ACC_ROW(wm, mi, r, lane) * LD + n] = acc[mi][ni][r];
  }
}
constexpr int LDT = 196;
template <int NT>
__device__ __forceinline__ void acc_to_lds_T(const f32x16 (&acc)[3][NT], float* ctT, int half) {
  const int tid_ = otid(); const int lane = tid_ & 63, w = tid_ >> 6, wm = w >> 2, wn = w & 3;
  if (NT == 2 && (wn >> 1) != half) return;
#pragma unroll
  for (int ni = 0; ni < NT; ++ni) {
    const int n = (NT == 2 ? (wn & 1) * 64 : wn * 32) + ni * 32 + (lane & 31);
#pragma unroll
    for (int mi = 0; mi < 3; ++mi)
#pragma unroll
      for (int g4 = 0; g4 < 4; ++g4) {
        const int r0 = wm * 96 + mi * 32 + 8 * g4 + 4 * (lane >> 5);
        float4 v; v.x = acc[mi][ni][g4 * 4 + 0]; v.y = acc[mi][ni][g4 * 4 + 1]; v.z = acc[mi][ni][g4 * 4 + 2]; v.w = acc[mi][ni][g4 * 4 + 3];
        *(float4*)(ctT + n * LDT + r0) = v;
      }
  }
}
__device__ __forceinline__ void store_tile_bf16(const float* ct, bf16_t* dst, int ldd, int tok0, int n0) {
#pragma unroll 1
  for (int it = otid(); it < 192 * 16; it += NTHR) {
    const int c8 = it & 15, r = it >> 4;
    const float4 a = *(const float4*)(ct + r * 132 + c8 * 8), b = *(const float4*)(ct + r * 132 + c8 * 8 + 4);
    uint4 o; o.x = pack2(a.x, a.y); o.y = pack2(a.z, a.w); o.z = pack2(b.x, b.y); o.w = pack2(b.z, b.w);
    *(uint4*)(dst + (size_t)(tok0 + r) * ldd + n0 + c8 * 8) = o;
  }
}

__device__ void p0_transpose_tile(const float* __restrict__ src, bf16_t* __restrict__ dst, int R, int C, int tr, int tc, char* smem) {
  float* t = (float*)smem;
  const int tid = otid();
  __syncthreads();
#pragma unroll
  for (int i = 0; i < 8; ++i) {
    int r = (tid >> 6) + 8 * i, c = tid & 63;
    t[r * 65 + c] = src[(size_t)(tr * 64 + r) * C + tc * 64 + c];
  }
  __syncthreads();
#pragma unroll
  for (int i = 0; i < 8; ++i) {
    int cc = (tid >> 6) + 8 * i, rr = tid & 63;
    dst[(size_t)(tc * 64 + cc) * R + tr * 64 + rr] = f2bf(t[rr * 65 + cc]);
  }
}

__device__ void p0_wc_item(const Params& p, int l, int ph, int kt, char* smem) {
  float* wqs = (float*)smem;
  float* ks = wqs + 64 * 129;
  const int tid = otid();
  const float* wq = p.peer_wq + (size_t)l * DM * 2048;
  const float* kk = ((ph & 1) ? p.peer_k2 : p.peer_k1) + (size_t)l * 128 * 128;
  __syncthreads();
  for (int e = tid; e < 64 * 128; e += NTHR) {
    int r = e >> 7, d = e & 127;
    wqs[r * 129 + d] = wq[(size_t)(kt * 64 + r) * 2048 + ph * 128 + d];
  }
  for (int e = tid; e < 128 * 128; e += NTHR) {
    int r = e >> 7, d = e & 127;
    ks[r * 129 + d] = kk[r * 128 + d];
  }
  __syncthreads();
  const int key = tid & 127, k0 = (tid >> 7) * 16;
  float acc[16];
#pragma unroll
  for (int i = 0; i < 16; ++i) acc[i] = 0.f;
  for (int d = 0; d < 128; ++d) {
    float kv = ks[key * 129 + d];
#pragma unroll
    for (int i = 0; i < 16; ++i) acc[i] += wqs[(k0 + i) * 129 + d] * kv;
  }
  bf16_t* dst = p.WcT + ((size_t)l * 2048 + ph * 128 + key) * DM + kt * 64 + k0;
  uint4 o0, o1;
  o0.x = pack2(acc[0], acc[1]); o0.y = pack2(acc[2], acc[3]); o0.z = pack2(acc[4], acc[5]); o0.w = pack2(acc[6], acc[7]);
  o1.x = pack2(acc[8], acc[9]); o1.y = pack2(acc[10], acc[11]); o1.z = pack2(acc[12], acc[13]); o1.w = pack2(acc[14], acc[15]);
  *(uint4*)dst = o0; *(uint4*)(dst + 8) = o1;
}

__device__ void p0_mod_item(const Params& p, int l, int cc, char* smem) {
  float* sc = (float*)smem;
  float* red = sc + 1024 * 24;
  const int tid = otid();
  __syncthreads();
  for (int e = tid; e < NB * DM; e += NTHR) {
    int b = e >> 10, k = e & 1023;
    float v = crow(p, b)[k];
    sc[k * 24 + b] = v / (1.f + __expf(-v));
  }
  __syncthreads();
  const int col = tid & 63, kg = tid >> 6;
  const int n = cc * 64 + col;
  float acc[24];
#pragma unroll
  for (int b = 0; b < 24; ++b) acc[b] = 0.f;
  const float* wm = p.w_mod + (size_t)l * DM * 6144 + n;
#pragma unroll 1
  for (int k0 = kg * 128; k0 < kg * 128 + 128; k0 += 8) {
    float wv[8];
#pragma unroll
    for (int j = 0; j < 8; ++j) wv[j] = wm[(size_t)(k0 + j) * 6144];
#pragma unroll
    for (int j = 0; j < 8; ++j) {
      const float4* s4 = (const float4*)(sc + (k0 + j) * 24);
#pragma unroll
      for (int q = 0; q < 6; ++q) {
        float4 sv = s4[q];
        acc[q * 4 + 0] += sv.x * wv[j]; acc[q * 4 + 1] += sv.y * wv[j]; acc[q * 4 + 2] += sv.z * wv[j]; acc[q * 4 + 3] += sv.w * wv[j];
      }
    }
  }
#pragma unroll
  for (int b = 0; b < 24; ++b) red[(kg * 24 + b) * 64 + col] = acc[b];
  __syncthreads();
  for (int e = tid; e < 24 * 64; e += NTHR) {
    const int b = e >> 6, c2 = e & 63;
    float sum = p.b_mod[l * 6144 + cc * 64 + c2];
#pragma unroll
    for (int g = 0; g < 8; ++g) sum += red[(g * 24 + b) * 64 + c2];
    p.mod[((size_t)l * NB + b) * 6144 + cc * 64 + c2] = sum;
  }
}

__device__ void p0_filter_item(const Params& p, int l, int tc, char* smem) {
  float* feat = (float*)smem;
  float* a1 = feat + 32 * 33;
  float* a2 = a1 + 32 * 64;
  bf16_t* stage = (bf16_t*)(a2 + 32 * 64);
  const int tid = otid();
  const int t0 = tc * 32;
  __syncthreads();
  for (int e = tid; e < 32 * 33; e += NTHR) {
    int pp = e / 33, f = e % 33;
    int ti = t0 + pp;
    float v;
    if (f == 0) v = (float)ti / (float)(SEQ - 1);
    else {
      int bi = (f - 1) & 15;
      float band = 1e-4f + (float)bi * ((15.f - 1e-4f) / 15.f);
      float wv = 2.0f * 3.14159265358979323846f * (float)ti / (float)SEQ;
      float arg = band * wv;
      v = (f <= 16) ? cosf(arg) : -sinf(arg);
    }
    feat[pp * 33 + f] = v;
  }
  __syncthreads();
  const float* w1 = p.f_w1 + l * 33 * 64; const float* b1 = p.f_b1 + l * 64; const float* fq = p.f_freq + l * 64;
  const float* w2 = p.f_w2 + l * 64 * 64; const float* b2 = p.f_b2 + l * 64;
  for (int e = tid; e < 32 * 64; e += NTHR) {
    int pp = e >> 6, j = e & 63;
    float s = b1[j];
    for (int f = 0; f < 33; ++f) s += feat[pp * 33 + f] * w1[f * 64 + j];
    a1[pp * 64 + j] = sinf(fq[j] * s);
  }
  __syncthreads();
  for (int e = tid; e < 32 * 64; e += NTHR) {
    int pp = e >> 6, j = e & 63;
    float s = b2[j];
    for (int i = 0; i < 64; ++i) s += a1[pp * 64 + i] * w2[i * 64 + j];
    a2[pp * 64 + j] = sinf(fq[j] * s);
  }
  __syncthreads();
  const float* w3 = p.f_w3 + (size_t)l * 64 * 2048;
  const float min_decay = logf(1e-2f) / 1.5f, max_decay = logf(1e-2f) / 0.3f;
  for (int q = 0; q < 4; ++q) {
    const int n = tid + 512 * q;
    const int c = n & 511;
    float wr[64];
#pragma unroll
    for (int i = 0; i < 64; ++i) wr[i] = w3[i * 2048 + n];
    const float delta = fabsf(min_decay + (max_decay - min_decay) * (float)c / 511.f);
    for (int pp = 0; pp < 32; ++pp) {
      float s = 0.f;
#pragma unroll
      for (int i = 0; i < 64; ++i) s += a2[pp * 64 + i] * wr[i];
      float tt = (float)(t0 + pp) / (float)(SEQ - 1);
      s *= __expf(-tt * delta);
      if (t0 + pp == 0 && ((n >> 9) & 1) == 0) s += p.f_bias[(l * 2 + (n >> 10)) * 512 + c];
      stage[n * 32 + pp] = f2bf(s);
    }
  }
  __syncthreads();
  for (int e = tid; e < 2048 * 32; e += NTHR) {
    int n = e >> 5, pp = e & 31;
    int o = n >> 10, d = (n >> 9) & 1, c = n & 511;
    int t = t0 + pp;
    bf16_t* g = p.Gf + ((size_t)((l * 2 + o) * 512 + c)) * 4096;
    if (d == 0) g[2048 - t] = stage[n * 32 + pp];
    else if (t >= 1) g[2048 + t] = stage[n * 32 + pp];
    if (t == 0 && d == 0) g[0] = 0;
  }
}

__device__ void p0_rope_item(const Params& p, int it) {
  int e = it * 512 + otid();
  int pos = e >> 5, i = e & 31;
  float inv = powf(10000.f, -(float)(2 * i) / 64.f);
  float ang = (float)pos * inv;
  p.rope[e * 2 + 0] = cosf(ang);
  p.rope[e * 2 + 1] = sinf(ang);
}

__device__ __forceinline__ int next_item(unsigned* cnt, char* smem) {
  int* sh = (int*)(smem + SMEM_BYTES - 16);
  __syncthreads();
  if (threadIdx.x == 0) *sh = (int)atomicAdd(cnt, 1u);
  __syncthreads();
  return *sh;
}

constexpr int P0_N_MOD = 2 * 96;
constexpr int P0_N_FILT = 2 * 64;
constexpr int P0_N_ROPE = 128;
constexpr int P0_N_WIN = 16 * 68;
constexpr int P0A_TOTAL = P0_N_FILT + P0_N_MOD + P0_N_ROPE + P0_N_WIN;
constexpr int P0_N_WC = 2 * 16 * 16;
constexpr int P0_N_SMALL = 8 * 16 + 8 * 16 + 16 * 16;
constexpr int P0B_TOTAL = P0_N_WC + P0_N_WIN + 2 * P0_N_SMALL;

__device__ __forceinline__ void p0_win_tile(const Params& p, int l, int j, char* smem) {
  p0_transpose_tile(p.w_in + (size_t)l * DM * INC, p.WinT + (size_t)l * INC * DM, DM, INC, j / 68, j % 68, smem);
}
__device__ void p0a_item(const Params& p, int i, char* smem) {
  if (i < P0_N_FILT) { p0_filter_item(p, i / 64, i % 64, smem); return; }
  i -= P0_N_FILT;
  if (i < P0_N_MOD) { p0_mod_item(p, i / 96, i % 96, smem); return; }
  i -= P0_N_MOD;
  if (i < P0_N_ROPE) { p0_rope_item(p, i); return; }
  i -= P0_N_ROPE;
  p0_win_tile(p, 0, i, smem);
}
__device__ void p0b_item(const Params& p, int i, char* smem) {
  if (i < P0_N_WC) { p0_wc_item(p, i >> 8, (i >> 4) & 15, i & 15, smem); return; }
  i -= P0_N_WC;
  if (i < P0_N_WIN) { p0_win_tile(p, 1, i, smem); return; }
  i -= P0_N_WIN;
  const int l = i / P0_N_SMALL; int j = i % P0_N_SMALL;
  if (j < 128) { p0_transpose_tile(p.w_pa + (size_t)l * HYW * DM, p.WpaT + (size_t)l * DM * HYW, HYW, DM, j / 16, j % 16, smem); return; }
  j -= 128;
  if (j < 128) { p0_transpose_tile(p.w_pb + (size_t)l * HYW * DM, p.WpbT + (size_t)l * DM * HYW, HYW, DM, j / 16, j % 16, smem); return; }
  j -= 128;
  p0_transpose_tile(p.w_out + (size_t)l * DM * DM, p.WoutT + (size_t)l * DM * DM, DM, DM, j / 16, j % 16, smem);
}
__device__ void phase_p0(const Params& p, char* smem) {
  for (int it = next_item(p.wq + 96, smem); it < P0A_TOTAL; it = next_item(p.wq + 96, smem)) p0a_item(p, it, smem);
}

__device__ void norm_rows(const Params& p, int tile, int l, int which, bool from_inputs, char* smem) {
  float* scl = (float*)smem;
  float* shf = scl + 2048;
  const int tid = otid(), lane = tid & 63, w = tid >> 6;
  const int tok0 = tile * TM;
  const int b0 = tok0 >> 11;
  const float* g = (which ? p.g2 : p.g1) + l * DM;
  __syncthreads();
  for (int e = tid; e < 2048; e += NTHR) {
    int bi = e >> 10, j = e & 1023;
    int b = b0 + bi; if (b > NB - 1) b = NB - 1;
    const float* m = p.mod + ((size_t)l * NB + b) * 6144 + which * 3072;
    scl[e] = g[j] * (1.f + m[1024 + j]);
    shf[e] = m[j];
  }
  __syncthreads();
#pragma unroll 1
  for (int r0 = w; r0 < TM; r0 += 32) {
    float4 v[4][4];
#pragma unroll
    for (int q = 0; q < 4; ++q) {
      const int tok = tok0 + r0 + 8 * q;
      const float* xr = from_inputs ? xrow_in(p, tok) : (p.out + (size_t)tok * DM);
#pragma unroll
      for (int i = 0; i < 4; ++i) v[q][i] = *(const float4*)(xr + lane * 4 + 256 * i);
    }
#pragma unroll
    for (int q = 0; q < 4; ++q) {
      const int tok = tok0 + r0 + 8 * q;
      const int bi = (tok >> 11) - b0;
      float ss = 0.f;
#pragma unroll
      for (int i = 0; i < 4; ++i) ss += v[q][i].x * v[q][i].x + v[q][i].y * v[q][i].y + v[q][i].z * v[q][i].z + v[q][i].w * v[q][i].w;
      ss = wave_sum(ss);
      const float rs = rsqrtf(ss * (1.f / DM) + 1e-6f);
#pragma unroll
      for (int i = 0; i < 4; ++i) {
        const int j = lane * 4 + 256 * i;
        const float4 sc4 = *(const float4*)(scl + bi * 1024 + j);
        const float4 sh4 = *(const float4*)(shf + bi * 1024 + j);
        uint2 o;
        o.x = pack2(v[q][i].x * rs * sc4.x + sh4.x, v[q][i].y * rs * sc4.y + sh4.y);
        o.y = pack2(v[q][i].z * rs * sc4.z + sh4.z, v[q][i].w * rs * sc4.w + sh4.w);
        *(uint2*)(p.hbuf + (size_t)tok * DM + j) = o;
      }
    }
  }
  __syncthreads();
}

__device__ void phase_c(const Params& p, int tile, int l, bool from_inputs, char* smem) {
  norm_rows(p, tile, l, 0, from_inputs, smem);
  const int tid = otid();
  const int tok0 = tile * TM;
  const bf16_t* A = p.hbuf + (size_t)tok0 * DM;
  const bf16_t* W = p.WinT + (size_t)l * INC * DM;
  float* ct = (float*)smem;
  f32x16 acc[3][2];
#pragma unroll 1
  for (int nt = 0; nt < 9; ++nt) {
    gemm_core2<2>(A, DM, W + (size_t)nt * 256 * DM, DM, DM, smem, acc);
#pragma unroll 1
    for (int half = 0; half < 2; ++half) {
      const int nc = nt * 2 + half;
      if (nc < 12) {
        acc_to_lds_T<2>(acc, ct, half);
        lds_barrier();
#pragma unroll 1
        for (int it = tid; it < 128 * 24; it += NTHR) {
          const int tg = it % 24, nl = it / 24;
          const float4 a = *(const float4*)(ct + nl * LDT + tg * 8), b4 = *(const float4*)(ct + nl * LDT + tg * 8 + 4);
          uint4 o; o.x = pack2(a.x, a.y); o.y = pack2(a.z, a.w); o.z = pack2(b4.x, b4.y); o.w = pack2(b4.z, b4.w);
          const int tok = tok0 + tg * 8;
          const int b = tok >> 11, sq = tok & 2047;
          *(uint4*)(p.zT + ((size_t)b * HYC + nc * 128 + nl) * SEQ + sq) = o;
        }
      } else {
        acc_to_lds<2>(acc, ct, 132, half);
        lds_barrier();
        store_tile_bf16(ct, p.zqkv, QKVC, tok0, nc * 128 - HYC);
      }
      lds_barrier();
    }
  }
}

__device__ __forceinline__ void load_conv8(const bf16_t* __restrict__ zrow, int s0, float w0, float w1, float w2, float cb, float (&o)[8]) {
  uint4 v = *(const uint4*)(zrow + s0);
  float z[10];
  z[0] = (s0 > 0) ? bf2f(zrow[s0 - 1]) : 0.f;
  z[1] = lo2f(v.x); z[2] = hi2f(v.x); z[3] = lo2f(v.y); z[4] = hi2f(v.y);
  z[5] = lo2f(v.z); z[6] = hi2f(v.z); z[7] = lo2f(v.w); z[8] = hi2f(v.w);
  z[9] = (s0 + 8 < SEQ) ? bf2f(zrow[s0 + 8]) : 0.f;
#pragma unroll
  for (int i = 0; i < 8; ++i) o[i] = z[i] * w0 + z[i + 1] * w1 + z[i + 2] * w2 + cb;
}

struct Conv8In { uint4 v; unsigned short l, r; };
__device__ __forceinline__ void conv8_load(const bf16_t* __restrict__ zrow, int s0, Conv8In& c) {
  c.v = *(const uint4*)(zrow + s0);
  c.l = (s0 > 0) ? zrow[s0 - 1] : (unsigned short)0;
  c.r = (s0 + 8 < SEQ) ? zrow[s0 + 8] : (unsigned short)0;
}
__device__ __forceinline__ void conv8_eval(const Conv8In& c, float w0, float w1, float w2, float cb, float (&o)[8]) {
  float z[10];
  z[0] = bf2f(c.l);
  z[1] = lo2f(c.v.x); z[2] = hi2f(c.v.x); z[3] = lo2f(c.v.y); z[4] = hi2f(c.v.y);
  z[5] = lo2f(c.v.z); z[6] = hi2f(c.v.z); z[7] = lo2f(c.v.w); z[8] = hi2f(c.v.w);
  z[9] = bf2f(c.r);
#pragma unroll
  for (int i = 0; i < 8; ++i) o[i] = z[i] * w0 + z[i + 1] * w1 + z[i + 2] * w2 + cb;
}


constexpr int HY_GS_ELEMS = 4112;
constexpr int HY_US_ROWS = 2072;
__device__ __forceinline__ void hyena_load_g(const Params& p, int l, int o, int c, bf16_t* Gs, int tid) {
  const bf16_t* g = p.Gf + ((size_t)((l * 2 + o) * 512 + c)) * 4096;
  *(uint4*)(Gs + 8 + tid * 8) = *(const uint4*)(g + tid * 8);
  if (tid == 0) { unsigned z = 0; asm volatile("" : "+v"(z)); const uint4 z4 = make_uint4(z, z, z, z); *(uint4*)Gs = z4; *(uint4*)(Gs + 4104) = z4; }
}

__device__ __forceinline__ void hyena_kloop(const bf16_t* Gs, const bf16_t* us, int rho, int lane, f32x16 (&acc)[8]) {
#pragma unroll
  for (int a = 0; a < 8; ++a)
#pragma unroll
    for (int j = 0; j < 16; ++j) acc[a][j] = 0.f;
  const int i = lane & 31, hh = lane >> 5;
  const bf16_t* ga = Gs + (2040 - 8 * i + 8 * hh) - 1792;
  const int l16 = lane & 15, q = l16 >> 2, pq = l16 & 3, g4 = lane >> 4;
  const bf16_t* ub = us + (rho + 8 * (g4 >> 1) + q) * 24 + 16 * (g4 & 1) + 4 * pq;
#pragma unroll 1
  for (int kap = 0; kap < 129; ++kap) {
    const s16x4 b0 = tr_read4(ub + kap * 384);
    const s16x4 b1 = tr_read4(ub + kap * 384 + 96);
    bf16x8 bfrag;
    bfrag[0] = b0[0]; bfrag[1] = b0[1]; bfrag[2] = b0[2]; bfrag[3] = b0[3];
    bfrag[4] = b1[0]; bfrag[5] = b1[1]; bfrag[6] = b1[2]; bfrag[7] = b1[3];
#pragma unroll
    for (int a = 0; a < 8; ++a) {
      const bf16x8 af = *(const bf16x8*)(ga + kap * 16 + 256 * (7 - a));
      acc[a] = __builtin_amdgcn_mfma_f32_32x32x16_bf16(af, bfrag, acc[a], 0, 0, 0);
    }
  }
}

__device__ __forceinline__ void hyena_acc_to_us(const f32x16 (&acc)[8], bf16_t* us, int rho, int lane) {
  const int n = lane & 31, hh = lane >> 5;
  if (n < 24) {
#pragma unroll
    for (int a = 0; a < 8; ++a)
#pragma unroll
      for (int r = 0; r < 16; ++r) {
        const int t = 256 * a + rho + 8 * ((r & 3) + 8 * (r >> 2) + 4 * hh);
        us[(t + 16) * 24 + n] = f2bf(acc[a][r]);
      }
  }
}

__device__ void hyena_item(const Params& p, int l, int c, char* smem) {
  bf16_t* Gs = (bf16_t*)smem;
  bf16_t* us = (bf16_t*)(smem + 8256);
  const int tid = otid();
  const int lane = tid & 63, w = tid >> 6;
  const float* cw = p.conv_w + (size_t)l * 3 * HYC;
  const float* cbp = p.conv_b + (size_t)l * HYC;
  __syncthreads();
  hyena_load_g(p, l, 0, c, Gs, tid);
  {
    unsigned z = 0; asm volatile("" : "+v"(z)); const uint4 z4 = make_uint4(z, z, z, z);
    if (tid < 48) *(uint4*)(us + tid * 8) = z4;
    else if (tid < 48 + 26) *(uint4*)(us + 2064 * 24 + (tid - 48) * 8) = z4;
  }
  {
    const float w0 = cw[c], w1 = cw[HYC + c], w2 = cw[2 * HYC + c], cb = cbp[c];
#pragma unroll 1
    for (int q0 = tid; q0 < 24 * 256; q0 += 4 * NTHR) {
      Conv8In cin[4];
#pragma unroll
      for (int j = 0; j < 4; ++j) {
        const int qq = q0 + j * NTHR;
        conv8_load(p.zT + ((size_t)(qq % 24) * HYC + c) * SEQ, (qq / 24) * 8, cin[j]);
      }
#pragma unroll
      for (int j = 0; j < 4; ++j) {
        const int qq = q0 + j * NTHR;
        const int b = qq % 24, s0 = (qq / 24) * 8;
        float v[8];
        conv8_eval(cin[j], w0, w1, w2, cb, v);
#pragma unroll
        for (int i = 0; i < 8; ++i) us[(s0 + i + 16) * 24 + b] = f2bf(v[i]);
      }
    }
  }
  __syncthreads();
  f32x16 acc[8];
#pragma unroll 1
  for (int o = 0; o < 2; ++o) {
    hyena_kloop(Gs, us, w, lane, acc);
    __syncthreads();
    hyena_acc_to_us(acc, us, w, lane);
    if (o == 0) hyena_load_g(p, l, 1, c, Gs, tid);
    __syncthreads();
    const int xc = (o == 0 ? 512 : 1024) + c;
    const float xw0 = cw[xc], xw1 = cw[HYC + xc], xw2 = cw[2 * HYC + xc], xcb = cbp[xc];
#pragma unroll 1
    for (int q0 = tid; q0 < 24 * 256; q0 += 4 * NTHR) {
      Conv8In cin[4];
#pragma unroll
      for (int j = 0; j < 4; ++j) {
        const int qq = q0 + j * NTHR;
        conv8_load(p.zT + ((size_t)(qq % 24) * HYC + xc) * SEQ, (qq / 24) * 8, cin[j]);
      }
#pragma unroll
      for (int j = 0; j < 4; ++j) {
        const int qq = q0 + j * NTHR;
        const int b = qq % 24, s0 = (qq / 24) * 8;
        float xv[8];
        conv8_eval(cin[j], xw0, xw1, xw2, xcb, xv);
        if (o == 0) {
#pragma unroll
          for (int i = 0; i < 8; ++i) {
            bf16_t* e = us + (s0 + i + 16) * 24 + b;
            *e = f2bf(bf2f(*e) * xv[i]);
          }
        } else {
          float r[8];
#pragma unroll
          for (int i = 0; i < 8; ++i) r[i] = bf2f(us[(s0 + i + 16) * 24 + b]) * xv[i];
          uint4 pk; pk.x = pack2(r[0], r[1]); pk.y = pack2(r[2], r[3]); pk.z = pack2(r[4], r[5]); pk.w = pack2(r[6], r[7]);
          *(uint4*)(p.yaT + ((size_t)b * HYW + c) * SEQ + s0) = pk;
        }
      }
    }
    __syncthreads();
  }
}

__device__ void attn_item(const Params& p, int l, int item, char* smem) {
  constexpr int KS = 72, VS = 96;
  bf16_t* Ks = (bf16_t*)smem;
  bf16_t* Vs = Ks + 384 * KS;
  const int tid = otid();
  const int lane = tid & 63, w = tid >> 6;
  const int kh = item & 1, qb = (item >> 1) & 15, b = item >> 5;
  const int kpos0 = qb * 128 - 128;
  __syncthreads();
  if (tid < 384) {
    const int r = tid, kpos = kpos0 + r;
    if (kpos >= 0 && kpos < SEQ) {
      const bf16_t* kr = p.zqkv + ((size_t)(b * SEQ + kpos)) * QKVC + 512 + kh * 64;
      float kf[64];
      float ss = 0.f;
#pragma unroll
      for (int c8 = 0; c8 < 8; ++c8) {
        uint4 v = *(const uint4*)(kr + c8 * 8);
        kf[c8 * 8 + 0] = lo2f(v.x); kf[c8 * 8 + 1] = hi2f(v.x); kf[c8 * 8 + 2] = lo2f(v.y); kf[c8 * 8 + 3] = hi2f(v.y);
        kf[c8 * 8 + 4] = lo2f(v.z); kf[c8 * 8 + 5] = hi2f(v.z); kf[c8 * 8 + 6] = lo2f(v.w); kf[c8 * 8 + 7] = hi2f(v.w);
      }
#pragma unroll
      for (int d = 0; d < 64; ++d) ss += kf[d] * kf[d];
      const float rs = rsqrtf(ss * (1.f / 64.f) + 1e-6f);
      const float* kg = p.k_gain + l * 64;
#pragma unroll
      for (int d = 0; d < 64; ++d) kf[d] = kf[d] * rs * kg[d];
      const float* rp = p.rope + (size_t)kpos * 64;
#pragma unroll
      for (int i = 0; i < 32; ++i) {
        const float cs = rp[i * 2], sn = rp[i * 2 + 1];
        const float a = kf[i], bb = kf[i + 32];
        kf[i] = a * cs - bb * sn; kf[i + 32] = bb * cs + a * sn;
      }
#pragma unroll
      for (int c8 = 0; c8 < 8; ++c8) {
        uint4 pk;
        pk.x = pack2(kf[c8 * 8 + 0], kf[c8 * 8 + 1]); pk.y = pack2(kf[c8 * 8 + 2], kf[c8 * 8 + 3]);
        pk.z = pack2(kf[c8 * 8 + 4], kf[c8 * 8 + 5]); pk.w = pack2(kf[c8 * 8 + 6], kf[c8 * 8 + 7]);
        *(uint4*)(Ks + r * KS + c8 * 8) = pk;
      }
    }
  }
#pragma unroll 1
  for (int e = tid; e < 384 * 8; e += NTHR) {
    const int r = e >> 3, c8 = e & 7, kpos = kpos0 + r;
    if (kpos >= 0 && kpos < SEQ)
      *(uint4*)(Vs + r * VS + c8 * 8) = *(const uint4*)(p.zqkv + ((size_t)(b * SEQ + kpos)) * QKVC + 640 + kh * 64 + c8 * 8);
  }
  __syncthreads();
  const int hl = w & 3, qh = w >> 2;
  const int head = kh * 4 + hl;
  const int n = lane & 31, hh = lane >> 5;
  const int Q0 = qb * 128 + 64 * qh;
  bf16x8 qf[2][4];
#pragma unroll
  for (int nt = 0; nt < 2; ++nt) {
    const int qpos = Q0 + 32 * nt + n;
    const bf16_t* qr = p.zqkv + ((size_t)(b * SEQ + qpos)) * QKVC + head * 64;
    float qv[4][8];
    float ss = 0.f;
#pragma unroll
    for (int kk = 0; kk < 4; ++kk) {
      uint4 v = *(const uint4*)(qr + 16 * kk + 8 * hh);
      qv[kk][0] = lo2f(v.x); qv[kk][1] = hi2f(v.x); qv[kk][2] = lo2f(v.y); qv[kk][3] = hi2f(v.y);
      qv[kk][4] = lo2f(v.z); qv[kk][5] = hi2f(v.z); qv[kk][6] = lo2f(v.w); qv[kk][7] = hi2f(v.w);
#pragma unroll
      for (int j = 0; j < 8; ++j) ss += qv[kk][j] * qv[kk][j];
    }
    ss += __shfl_xor(ss, 32, 64);
    const float rs = rsqrtf(ss * (1.f / 64.f) + 1e-6f) * 0.125f;
    const float* qg = p.q_gain + l * 64;
#pragma unroll
    for (int kk = 0; kk < 4; ++kk)
#pragma unroll
      for (int j = 0; j < 8; ++j) qv[kk][j] *= rs * qg[16 * kk + 8 * hh + j];
    const float* rp = p.rope + (size_t)qpos * 64;
#pragma unroll
    for (int kk = 0; kk < 2; ++kk)
#pragma unroll
      for (int j = 0; j < 8; ++j) {
        const int d = 16 * kk + 8 * hh + j;
        const float cs = rp[d * 2], sn = rp[d * 2 + 1];
        const float a = qv[kk][j], bb = qv[kk + 2][j];
        qv[kk][j] = a * cs - bb * sn; qv[kk + 2][j] = bb * cs + a * sn;
      }
#pragma unroll
    for (int kk = 0; kk < 4; ++kk)
#pragma unroll
      for (int j = 0; j < 8; ++j) qf[nt][kk][j] = (short)f2bf(qv[kk][j]);
  }
  f32x16 O[2][2];
#pragma unroll
  for (int dm = 0; dm < 2; ++dm)
#pragma unroll
    for (int nt = 0; nt < 2; ++nt)
#pragma unroll
      for (int r = 0; r < 16; ++r) O[dm][nt][r] = 0.f;
  float mrun[2], lsum[2];
  mrun[0] = mrun[1] = p.sink[l * 8 + head];
  lsum[0] = lsum[1] = (hh == 0) ? 1.f : 0.f;
  const int l16 = lane & 15, tq = l16 >> 2, tp = l16 & 3, g4 = lane >> 4;
  const bf16_t* vbase = Vs + (4 * (g4 >> 1) + tq) * VS + 16 * (g4 & 1) + 4 * tp;
#pragma unroll 1
  for (int kt = 2 * qh; kt < 2 * qh + 10; ++kt) {
    const int kp_t = kpos0 + 32 * kt;
    if (kp_t < 0 || kp_t >= SEQ) continue;
    bf16x8 kfr[4];
#pragma unroll
    for (int kk = 0; kk < 4; ++kk) kfr[kk] = *(const bf16x8*)(Ks + (32 * kt + n) * KS + 16 * kk + 8 * hh);
    bf16x8 pf[2][2];
#pragma unroll
    for (int nt = 0; nt < 2; ++nt) {
      f32x16 S;
#pragma unroll
      for (int r = 0; r < 16; ++r) S[r] = 0.f;
#pragma unroll
      for (int kk = 0; kk < 4; ++kk) S = __builtin_amdgcn_mfma_f32_32x32x16_bf16(kfr[kk], qf[nt][kk], S, 0, 0, 0);
      const int qpos = Q0 + 32 * nt + n;
      float mloc = -INFINITY;
#pragma unroll
      for (int r = 0; r < 16; ++r) {
        const int kpos = kp_t + (r & 3) + 8 * (r >> 2) + 4 * hh;
        int dd = kpos - qpos; dd = dd < 0 ? -dd : dd;
        S[r] = (dd <= 128) ? S[r] : -INFINITY;
        mloc = fmaxf(mloc, S[r]);
      }
      mloc = fmaxf(mloc, __shfl_xor(mloc, 32, 64));
      const float mnew = fmaxf(mrun[nt], mloc);
      const float corr = __expf(mrun[nt] - mnew);
      mrun[nt] = mnew;
      float psum = 0.f;
#pragma unroll
      for (int r = 0; r < 16; ++r) { S[r] = __expf(S[r] - mnew); psum += S[r]; }
      lsum[nt] = lsum[nt] * corr + psum;
#pragma unroll
      for (int dm = 0; dm < 2; ++dm)
#pragma unroll
        for (int r = 0; r < 16; ++r) O[dm][nt][r] *= corr;
#pragma unroll
      for (int s2 = 0; s2 < 2; ++s2)
#pragma unroll
        for (int j = 0; j < 8; ++j) pf[nt][s2][j] = (short)f2bf(S[8 * s2 + j]);
    }
#pragma unroll
    for (int dm = 0; dm < 2; ++dm)
#pragma unroll
      for (int s2 = 0; s2 < 2; ++s2) {
        const bf16_t* vp = vbase + (32 * kt + 16 * s2) * VS + 32 * dm;
        const s16x4 v0 = tr_read4(vp);
        const s16x4 v1 = tr_read4(vp + 8 * VS);
        bf16x8 vf;
        vf[0] = v0[0]; vf[1] = v0[1]; vf[2] = v0[2]; vf[3] = v0[3];
        vf[4] = v1[0]; vf[5] = v1[1]; vf[6] = v1[2]; vf[7] = v1[3];
#pragma unroll
        for (int nt = 0; nt < 2; ++nt) O[dm][nt] = __builtin_amdgcn_mfma_f32_32x32x16_bf16(vf, pf[nt][s2], O[dm][nt], 0, 0, 0);
      }
  }
#pragma unroll
  for (int nt = 0; nt < 2; ++nt) {
    const float ltot = lsum[nt] + __shfl_xor(lsum[nt], 32, 64);
    const float inv = 1.f / ltot;
    const int qpos = Q0 + 32 * nt + n;
    bf16_t* yo = p.yb + ((size_t)(b * SEQ + qpos)) * 512 + head * 64;
#pragma unroll
    for (int dm = 0; dm < 2; ++dm)
#pragma unroll
      for (int g = 0; g < 4; ++g) {
        uint2 o;
        o.x = pack2(O[dm][nt][4 * g + 0] * inv, O[dm][nt][4 * g + 1] * inv);
        o.y = pack2(O[dm][nt][4 * g + 2] * inv, O[dm][nt][4 * g + 3] * inv);
        *(uint2*)(yo + 32 * dm + 8 * g + 4 * hh) = o;
      }
  }
}

typedef float f32x2 __attribute__((ext_vector_type(2)));
__device__ void table_item(const Params& p, int l, int it) {
  const int tid = otid();
  const int lane = tid & 63, w = tid >> 6;
  const int which = it >> 9, r0 = (it & 511) * 32 + w * 4;
  const float* src = (which ? p.peer_v : p.peer_u) + (size_t)l * NEXP * DM;
  unsigned char* dst = which ? p.tabV8 : p.tabU8;
  float* sc = which ? p.sclV : p.sclU;
  float4 v[4][4];
#pragma unroll
  for (int rr = 0; rr < 4; ++rr)
#pragma unroll
    for (int i = 0; i < 4; ++i) v[rr][i] = *(const float4*)(src + (size_t)(r0 + rr) * DM + lane * 4 + 256 * i);
#pragma unroll
  for (int rr = 0; rr < 4; ++rr) {
    const int e = r0 + rr;
    float mx = 0.f;
#pragma unroll
    for (int i = 0; i < 4; ++i)
      mx = fmaxf(mx, fmaxf(fmaxf(fabsf(v[rr][i].x), fabsf(v[rr][i].y)), fmaxf(fabsf(v[rr][i].z), fabsf(v[rr][i].w))));
#pragma unroll
    for (int m = 32; m >= 1; m >>= 1) mx = fmaxf(mx, __shfl_xor(mx, m, 64));
    const float scale = (mx > 0.f) ? 440.f / mx : 1.f;
#pragma unroll
    for (int i = 0; i < 4; ++i) {
      int pk = __builtin_amdgcn_cvt_pk_fp8_f32(v[rr][i].x * scale, v[rr][i].y * scale, 0, false);
      pk = __builtin_amdgcn_cvt_pk_fp8_f32(v[rr][i].z * scale, v[rr][i].w * scale, pk, true);
      const int x = 2 * i + (lane >> 5);
      *(int*)(dst + ((size_t)x * NEXP + e) * 128 + (lane & 31) * 4) = pk;
    }
    if (lane == 0) sc[e] = (mx > 0.f) ? mx * (1.f / 440.f) : 1.f;
  }
}

constexpr int DE_N_HY = 512, DE_N_AT = 768, DE_N_TB = 1024;
__device__ void phase_de(const Params& p, int l, char* smem) {
  const int total = DE_N_HY + DE_N_AT + DE_N_TB + (l == 0 ? P0B_TOTAL : 0);
  for (int it = next_item(p.wq + 100 + l, smem); it < total; it = next_item(p.wq + 100 + l, smem)) {
    if (it < DE_N_HY) hyena_item(p, l, it, smem);
    else if (it < DE_N_HY + DE_N_AT) attn_item(p, l, it - DE_N_HY, smem);
    else if (it < DE_N_HY + DE_N_AT + DE_N_TB) table_item(p, l, it - DE_N_HY - DE_N_AT);
    else p0b_item(p, it - DE_N_HY - DE_N_AT - DE_N_TB, smem);
  }
}

__device__ void phase_f(const Params& p, int tile, int l, bool from_inputs, char* smem) {
  const int tid = otid();
  const int tok0 = tile * TM;
  const bf16_t* Ah = p.hbuf + (size_t)tok0 * DM;
  const bf16_t* Ayb = p.yb + (size_t)tok0 * HYW;
  const bf16_t* Win = p.WinT + (size_t)l * INC * DM;
  const bf16_t* Wpa = p.WpaT + (size_t)l * DM * HYW;
  const bf16_t* Wpb = p.WpbT + (size_t)l * DM * HYW;
  float* ct = (float*)smem;
  f32x16 acc[3][2];
  unsigned sgp[3][2][8];
#pragma unroll 1
  for (int nc = 0; nc < 8; ++nc) {
    gemm_f1<1>(Ah, Ah, DM, Win + (size_t)(2304 + nc * 128) * DM, Win + (size_t)(3328 + nc * 128) * DM, DM, smem, acc);
#pragma unroll
    for (int mi = 0; mi < 3; ++mi)
#pragma unroll
      for (int ni = 0; ni < 2; ++ni)
#pragma unroll
        for (int q = 0; q < 8; ++q)
          sgp[mi][ni][q] = pack2(__builtin_amdgcn_rcpf(1.f + __expf(-acc[mi][ni][2 * q])), __builtin_amdgcn_rcpf(1.f + __expf(-acc[mi][ni][2 * q + 1])));
    gemm_f1<2>(p.yaT, Ayb, HYW, Wpa + (size_t)(nc * 128) * HYW, Wpb + (size_t)(nc * 128) * HYW, HYW, smem, acc, tok0);
    {
      const int tid_ = otid(); const int lane = tid_ & 63, w = tid_ >> 6, wm = w >> 2, wn = w & 3;
      const int n = wn * 32 + (lane & 31);
#pragma unroll
      for (int mi = 0; mi < 3; ++mi)
#pragma unroll
        for (int q = 0; q < 8; ++q) {
          const float m0 = lo2f(sgp[mi][0][q]) * acc[mi][0][2 * q] + lo2f(sgp[mi][1][q]) * acc[mi][1][2 * q];
          const float m1 = hi2f(sgp[mi][0][q]) * acc[mi][0][2 * q + 1] + hi2f(sgp[mi][1][q]) * acc[mi][1][2 * q + 1];
          ct[ACC_ROW(wm, mi, 2 * q, lane) * 132 + n] = m0;
          ct[ACC_ROW(wm, mi, 2 * q + 1, lane) * 132 + n] = m1;
        }
    }
    lds_barrier();
    store_tile_bf16(ct, p.merged, DM, tok0, nc * 128);
  }
  __syncthreads();
  const bf16_t* Am = p.merged + (size_t)tok0 * DM;
  const bf16_t* Wo = p.WoutT + (size_t)l * DM * DM;
  f32x16 acc2[3][2];
#pragma unroll 1
  for (int nt = 0; nt < 4; ++nt) {
    gemm_core2<2>(Am, DM, Wo + (size_t)(nt * 256) * DM, DM, DM, smem, acc2);
#pragma unroll 1
    for (int half = 0; half < 2; ++half) {
      acc_to_lds<2>(acc2, ct, 132, half);
      lds_barrier();
#pragma unroll 4
      for (int it = tid; it < 192 * 32; it += NTHR) {
        const int c4 = it & 31, r = it >> 5;
        const int tok = tok0 + r, b = tok >> 11;
        const int n = nt * 256 + half * 128 + c4 * 4;
        const float4 a = *(const float4*)(ct + r * 132 + c4 * 4);
        const float4 gt = *(const float4*)(p.mod + ((size_t)l * NB + b) * 6144 + 2048 + n);
        const float* xs = from_inputs ? xrow_in(p, tok) : (p.out + (size_t)tok * DM);
        float4 xo = *(const float4*)(xs + n);
        xo.x += gt.x * a.x; xo.y += gt.y * a.y; xo.z += gt.z * a.z; xo.w += gt.w * a.w;
        *(float4*)(p.out + (size_t)tok * DM + n) = xo;
      }
      lds_barrier();
    }
  }
  __syncthreads();
}

__device__ __forceinline__ void sort16_desc(float (&v)[16]) {
#pragma unroll
  for (int k = 2; k <= 16; k <<= 1)
#pragma unroll
    for (int j = k >> 1; j >= 1; j >>= 1)
#pragma unroll
      for (int i = 0; i < 16; ++i) {
        const int l = i ^ j;
        if (l > i) {
          const float hi = fmaxf(v[i], v[l]), lo = fminf(v[i], v[l]);
          if ((i & k) == 0) { v[i] = hi; v[l] = lo; } else { v[i] = lo; v[l] = hi; }
        }
      }
}
__device__ __forceinline__ void merge16_desc(float (&top)[16], const float (&g)[16]) {
#pragma unroll
  for (int i = 0; i < 16; ++i) top[i] = fmaxf(top[i], g[15 - i]);
#pragma unroll
  for (int j = 8; j >= 1; j >>= 1)
#pragma unroll
    for (int i = 0; i < 16; ++i) {
      const int l = i ^ j;
      if (l > i) { const float hi = fmaxf(top[i], top[l]), lo = fminf(top[i], top[l]); top[i] = hi; top[l] = lo; }
    }
}
__device__ __forceinline__ void topk_insert(float (&key)[16], float kx) {
#pragma unroll
  for (int i = 0; i < 16; ++i) {
    const float hi = fmaxf(key[i], kx);
    kx = fminf(key[i], kx);
    key[i] = hi;
  }
}

__device__ void phase_g(const Params& p, int tile, int l, char* smem) {
  norm_rows(p, tile, l, 1, false, smem);
  const int tid = otid();
  const int tok0 = tile * TM;
  const bf16_t* Ah = p.hbuf + (size_t)tok0 * DM;
  const bf16_t* Wc = p.WcT + (size_t)l * 2048 * DM;
  float* sc = (float*)smem;
  f32x16 acc[3][2];
  float v1k[16], v2k[16];
#pragma unroll
  for (int i = 0; i < 16; ++i) { v1k[i] = 0.f; v2k[i] = 0.f; }
#pragma unroll 1
  for (int ch = 0; ch < 16; ++ch) {
    if ((ch & 1) == 0) gemm_core2<2>(Ah, DM, Wc + (size_t)(ch * 128) * DM, DM, DM, smem, acc);
    acc_to_lds<2>(acc, sc, 129, ch & 1);
    __syncthreads();
    float key[16];
    const int ttok = tid % TM, part = tid / TM;
    float* xch = (float*)(smem + 100352);
    if (tid < 2 * TM) {
      const float* row = sc + ttok * 129 + part * 64;
#pragma unroll
      for (int i = 0; i < 16; ++i) key[i] = __uint_as_float((__float_as_uint(row[i]) & 0xFFFFFF80u) | (unsigned)(part * 64 + i));
      sort16_desc(key);
#pragma unroll 1
      for (int j0 = 16; j0 < 64; j0 += 16) {
        float g[16];
#pragma unroll
        for (int i = 0; i < 16; ++i) g[i] = __uint_as_float((__float_as_uint(row[j0 + i]) & 0xFFFFFF80u) | (unsigned)(part * 64 + j0 + i));
        sort16_desc(g);
        merge16_desc(key, g);
      }
      if (part == 1) {
#pragma unroll
        for (int i = 0; i < 16; ++i) xch[ttok * 17 + i] = key[i];
      }
    }
    __syncthreads();
    if (tid < TM) {
      {
        float g[16];
#pragma unroll
        for (int i = 0; i < 16; ++i) g[i] = xch[tid * 17 + i];
        merge16_desc(key, g);
      }
      if ((ch & 1) == 0) {
#pragma unroll
        for (int i = 0; i < 16; ++i) v1k[i] = key[i];
      } else {
#pragma unroll
        for (int i = 0; i < 16; ++i) v2k[i] = key[i];
        float top[16], grp[16];
        {
          constexpr int CI[64] = {0,0,0,0,0,0,0,0,0,0,0,0,0,0,0,0, 1,1,1,1,1,1,1,1, 2,2,2,2,2, 3,3,3,3, 4,4,4, 5,5, 6,6, 7,7, 8,9,10,11,12,13,14,15, 0,0,0,0,0,0,0,0,0,0,0,0,0,0};
          constexpr int CJ[64] = {0,1,2,3,4,5,6,7,8,9,10,11,12,13,14,15, 0,1,2,3,4,5,6,7, 0,1,2,3,4, 0,1,2,3, 0,1,2, 0,1, 0,1, 0,1, 0,0,0,0,0,0,0,0, 0,0,0,0,0,0,0,0,0,0,0,0,0,0};
#pragma unroll
          for (int gq = 0; gq < 4; ++gq) {
#pragma unroll
            for (int i = 0; i < 16; ++i) {
              const int c = gq * 16 + i;
              if (c < 50) {
                const float sv = v1k[CI[c]] + v2k[CJ[c]];
                grp[i] = __uint_as_float((__float_as_uint(sv) & 0xFFFFFF00u) | (unsigned)(CI[c] * 16 + CJ[c]));
              } else grp[i] = -INFINITY;
            }
            sort16_desc(grp);
            if (gq == 0) {
#pragma unroll
              for (int i = 0; i < 16; ++i) top[i] = grp[i];
            } else merge16_desc(top, grp);
          }
        }
        const float mx = top[0];
        float ex[16], sum = 0.f;
#pragma unroll
        for (int k = 0; k < 16; ++k) { ex[k] = __expf(top[k] - mx); sum += ex[k]; }
        const float inv = 1.f / sum;
        const int hh = ch >> 1;
        const size_t ob = ((size_t)(tok0 + tid) * 8 + hh) * 16;
        unsigned char* ltab = (unsigned char*)(smem + 114688) + tid * 32;
#pragma unroll
        for (int q = 0; q < 4; ++q) {
          unsigned w1 = 0, w2 = 0;
#pragma unroll
          for (int b4 = 0; b4 < 4; ++b4) {
            w1 |= (__float_as_uint(v1k[4 * q + b4]) & 0x7Fu) << (8 * b4);
            w2 |= (__float_as_uint(v2k[4 * q + b4]) & 0x7Fu) << (8 * b4);
          }
          *(unsigned*)(ltab + 4 * q) = w1;
          *(unsigned*)(ltab + 16 + 4 * q) = w2;
        }
        unsigned ee[16];
#pragma unroll
        for (int k = 0; k < 16; ++k) {
          const unsigned code = __float_as_uint(top[k]) & 0xFFu;
          ee[k] = (unsigned)ltab[code >> 4] * 128u + (unsigned)ltab[16 + (code & 15u)];
        }
        uint4 i0, i1;
        i0.x = ee[0] | (ee[1] << 16); i0.y = ee[2] | (ee[3] << 16); i0.z = ee[4] | (ee[5] << 16); i0.w = ee[6] | (ee[7] << 16);
        i1.x = ee[8] | (ee[9] << 16); i1.y = ee[10] | (ee[11] << 16); i1.z = ee[12] | (ee[13] << 16); i1.w = ee[14] | (ee[15] << 16);
        *(uint4*)(p.pidx + ob) = i0; *(uint4*)(p.pidx + ob + 8) = i1;
#pragma unroll
        for (int q = 0; q < 4; ++q)
          *(float4*)(p.pg + ob + 4 * q) = make_float4(ex[4 * q] * inv, ex[4 * q + 1] * inv, ex[4 * q + 2] * inv, ex[4 * q + 3] * inv);
      }
    }
    __syncthreads();
  }
}

__device__ __forceinline__ unsigned xcc_id() { return (unsigned)__builtin_amdgcn_s_getreg((3 << 11) | 20) & 7u; }
__device__ __forceinline__ bool next_slice_item(unsigned* cnt, int& x, int& j, int& tries, char* smem, int tid) {
  int* sh = (int*)(smem + 8192);
  while (tries < 8) {
    __syncthreads();
    if (tid == 0) *sh = (int)atomicAdd(cnt + x, 1u);
    __syncthreads();
    j = *sh;
    if (j < I_NJ) return true;
    x = (x + 1) & 7; ++tries;
  }
  return false;
}
__device__ __forceinline__ float dpp_xor1(float v) { return __builtin_bit_cast(float, __builtin_amdgcn_update_dpp(0, __builtin_bit_cast(int, v), 0xB1, 0xF, 0xF, true)); }
__device__ __forceinline__ float dpp_xor2(float v) { return __builtin_bit_cast(float, __builtin_amdgcn_update_dpp(0, __builtin_bit_cast(int, v), 0x4E, 0xF, 0xF, true)); }
__device__ __forceinline__ float dpp_hmirror(float v) { return __builtin_bit_cast(float, __builtin_amdgcn_update_dpp(0, __builtin_bit_cast(int, v), 0x141, 0xF, 0xF, true)); }
__device__ __forceinline__ float dpp_ror8(float v) { return __builtin_bit_cast(float, __builtin_amdgcn_update_dpp(0, __builtin_bit_cast(int, v), 0x128, 0xF, 0xF, true)); }

struct I1Ctx { uint4 h0, h1, e0, e1; };
__device__ __forceinline__ void i1_load_ctx(const Params& p, int tok, int x, int g, int ch, I1Ctx& c) {
  const bf16_t* hr = p.hbuf + (size_t)tok * DM + x * 128 + ch * 16;
  c.h0 = *(const uint4*)hr; c.h1 = *(const uint4*)(hr + 8);
  const uint4* pi = (const uint4*)(p.pidx + (size_t)tok * 128 + g * 16);
  c.e0 = pi[0]; c.e1 = pi[1];
}
__device__ __forceinline__ void peer_issue_rows(const unsigned char* Tslice, unsigned lane_off, const uint4& e0, const uint4& e1, uint4 (&rows)[16]) {
  const unsigned ew[8] = {e0.x, e0.y, e0.z, e0.w, e1.x, e1.y, e1.z, e1.w};
#pragma unroll
  for (int rd = 0; rd < 16; ++rd) {
    const unsigned e = (ew[rd >> 1] >> (16 * (rd & 1))) & 0x3FFFu;
    rows[rd] = *(const uint4*)(Tslice + (e * 128u + lane_off));
  }
}
typedef _Float16 f16x2 __attribute__((ext_vector_type(2)));
__device__ __forceinline__ f16x2 bf2_to_h2(unsigned u) {
  f16x2 r; r[0] = (_Float16)lo2f(u); r[1] = (_Float16)hi2f(u); return r;
}
__device__ __forceinline__ void i1_compute(const I1Ctx& c, const uint4 (&rows)[16], bf16_t* dst, int ch) {
  f16x2 hs[8];
  hs[0] = bf2_to_h2(c.h0.x); hs[1] = bf2_to_h2(c.h0.y); hs[2] = bf2_to_h2(c.h0.z); hs[3] = bf2_to_h2(c.h0.w);
  hs[4] = bf2_to_h2(c.h1.x); hs[5] = bf2_to_h2(c.h1.y); hs[6] = bf2_to_h2(c.h1.z); hs[7] = bf2_to_h2(c.h1.w);
  float res[16];
#pragma unroll
  for (int rd = 0; rd < 16; ++rd) {
    const unsigned wd[4] = {rows[rd].x, rows[rd].y, rows[rd].z, rows[rd].w};
    float d0 = 0.f, d1 = 0.f;
#pragma unroll
    for (int q = 0; q < 4; ++q) {
      d0 = __builtin_amdgcn_fdot2(__builtin_amdgcn_cvt_scalef32_pk_f16_fp8((int)wd[q], 1.0f, false), hs[2 * q], d0, false);
      d1 = __builtin_amdgcn_fdot2(__builtin_amdgcn_cvt_scalef32_pk_f16_fp8((int)wd[q], 1.0f, true), hs[2 * q + 1], d1, false);
    }
    float d = d0 + d1;
    d += dpp_xor1(d); d += dpp_xor2(d); d += dpp_hmirror(d);
    res[rd] = d;
  }
  if (ch == 0) {
    uint4 o0, o1;
    o0.x = pack2(res[0], res[1]); o0.y = pack2(res[2], res[3]); o0.z = pack2(res[4], res[5]); o0.w = pack2(res[6], res[7]);
    o1.x = pack2(res[8], res[9]); o1.y = pack2(res[10], res[11]); o1.z = pack2(res[12], res[13]); o1.w = pack2(res[14], res[15]);
    *(uint4*)dst = o0; *(uint4*)(dst + 8) = o1;
  }
}

__device__ void phase_i1(const Params& p, int pass, char* smem) {
  const int tid = otid();
  const int lane = tid & 63, w = tid >> 6;
  const int g = lane >> 3, ch = lane & 7;
  int x = (int)xcc_id(), j = 0, tries = 0;
  while (next_slice_item(p.wq + pass * 8, x, j, tries, smem, tid)) {
    const unsigned char* Ux = p.tabU8 + (size_t)x * NEXP * 128;
    const unsigned loff = ch * 16;
    bf16_t* ap = p.apart + (size_t)x * NTOK * 128 + g * 16;
    const int tokb = j * I_TOK + w;
    I1Ctx c0, c1, c2;
    uint4 rowsA[16], rowsB[16];
    i1_load_ctx(p, tokb, x, g, ch, c0);
    i1_load_ctx(p, tokb + 8, x, g, ch, c1);
    i1_load_ctx(p, tokb + 16, x, g, ch, c2);
    peer_issue_rows(Ux, loff, c0.e0, c0.e1, rowsA);
#pragma unroll 1
    for (int i = 0; i < I_TW; i += 2) {
      I1Ctx c3, c4;
      peer_issue_rows(Ux, loff, c1.e0, c1.e1, rowsB);
      i1_load_ctx(p, tokb + 8 * min(i + 3, I_TW - 1), x, g, ch, c3);
      i1_compute(c0, rowsA, ap + (size_t)(tokb + 8 * i) * 128, ch);
      peer_issue_rows(Ux, loff, c2.e0, c2.e1, rowsA);
      i1_load_ctx(p, tokb + 8 * min(i + 4, I_TW - 1), x, g, ch, c4);
      i1_compute(c1, rowsB, ap + (size_t)(tokb + 8 * (i + 1)) * 128, ch);
      c0 = c2; c1 = c3; c2 = c4;
    }
  }
}

__device__ void phase_w(const Params& p) {
  const int tid = otid();
  const size_t npair8 = (size_t)NTOK * 128 / 8;
  for (size_t q8 = (size_t)blockIdx.x * NTHR + tid; q8 < npair8; q8 += (size_t)gridDim.x * NTHR) {
    const size_t q = q8 * 8;
    float a[8];
#pragma unroll
    for (int i = 0; i < 8; ++i) a[i] = 0.f;
#pragma unroll
    for (int xx = 0; xx < 8; ++xx) {
      const uint4 v = *(const uint4*)(p.apart + (size_t)xx * NTOK * 128 + q);
      a[0] += lo2f(v.x); a[1] += hi2f(v.x); a[2] += lo2f(v.y); a[3] += hi2f(v.y);
      a[4] += lo2f(v.z); a[5] += hi2f(v.z); a[6] += lo2f(v.w); a[7] += hi2f(v.w);
    }
    const float4 g0 = *(const float4*)(p.pg + q), g1 = *(const float4*)(p.pg + q + 4);
    const uint4 ev = *(const uint4*)(p.pidx + q);
    const unsigned ew[4] = {ev.x, ev.y, ev.z, ev.w};
    float su[8], sg[8];
    const float gg[8] = {g0.x, g0.y, g0.z, g0.w, g1.x, g1.y, g1.z, g1.w};
#pragma unroll
    for (int i = 0; i < 8; ++i) {
      const unsigned e = (ew[i >> 1] >> (16 * (i & 1))) & 0x3FFFu;
      su[i] = p.sclU[e];
      sg[i] = gg[i] * p.sclV[e];
    }
    float wv[8];
#pragma unroll
    for (int i = 0; i < 8; ++i) {
      const float av = a[i] * su[i];
      wv[i] = sg[i] * 0.5f * av * (1.f + erff(av * 0.70710678118654752f));
    }
    uint4 o; o.x = pack2(wv[0], wv[1]); o.y = pack2(wv[2], wv[3]); o.z = pack2(wv[4], wv[5]); o.w = pack2(wv[6], wv[7]);
    *(uint4*)(p.wbuf + q) = o;
  }
}

struct I2Ctx { uint4 e0, e1; };
struct I2XG { uint4 w0, w1; float2 xv, gt; };
__device__ __forceinline__ void i2_load_ctx(const Params& p, int tok, int l, int x, int g, int ch, I2Ctx& c) {
  const unsigned off = (unsigned)tok * 256u + (unsigned)g * 32u;
  const uint4* pi = (const uint4*)((const char*)p.pidx + off);
  c.e0 = pi[0]; c.e1 = pi[1];
}
__device__ __forceinline__ void i2_load_xg(const Params& p, int tok, int l, int x, int g, int ch, I2XG& c) {
  const unsigned off = (unsigned)tok * 256u + (unsigned)g * 32u;
  const uint4* pw = (const uint4*)((const char*)p.wbuf + off);
  c.w0 = pw[0]; c.w1 = pw[1];
  const unsigned col = (unsigned)(x * 128 + ch * 16 + 2 * g);
  c.xv = *(const float2*)((const char*)p.out + ((unsigned)tok * 4096u + col * 4u));
  c.gt = *(const float2*)((const char*)p.mod + ((unsigned)(l * NB + (tok >> 11)) * 24576u + 20480u + col * 4u));
}
__device__ __forceinline__ void i2_compute(const Params& p, const I2XG& xg, const uint4 (&rows)[16], int tok, int x, int g, int ch) {
  const unsigned ww[8] = {xg.w0.x, xg.w0.y, xg.w0.z, xg.w0.w, xg.w1.x, xg.w1.y, xg.w1.z, xg.w1.w};
  f32x2 acc[8];
#pragma unroll
  for (int i = 0; i < 8; ++i) acc[i] = f32x2{0.f, 0.f};
#pragma unroll
  for (int rd = 0; rd < 16; ++rd) {
    const unsigned wd[4] = {rows[rd].x, rows[rd].y, rows[rd].z, rows[rd].w};
    const float wsc = (rd & 1) ? hi2f(ww[rd >> 1]) : lo2f(ww[rd >> 1]);
    const f32x2 sw = {wsc, wsc};
#pragma unroll
    for (int q = 0; q < 4; ++q) {
      acc[2 * q] += sw * __builtin_amdgcn_cvt_pk_f32_fp8((int)wd[q], false);
      acc[2 * q + 1] += sw * __builtin_amdgcn_cvt_pk_f32_fp8((int)wd[q], true);
    }
  }
  float r[16];
#pragma unroll
  for (int i = 0; i < 8; ++i) { r[2 * i] = acc[i][0]; r[2 * i + 1] = acc[i][1]; }
  const bool b2 = (g & 4) != 0, b1 = (g & 2) != 0, b0 = (g & 1) != 0;
  float r8[8];
#pragma unroll
  for (int i = 0; i < 8; ++i) {
    const float snd = b2 ? r[i] : r[i + 8];
    const float kp = b2 ? r[i + 8] : r[i];
    r8[i] = kp + __shfl_xor(snd, 32, 64);
  }
  float r4[4];
#pragma unroll
  for (int i = 0; i < 4; ++i) {
    const float snd = b1 ? r8[i] : r8[i + 4];
    const float kp = b1 ? r8[i + 4] : r8[i];
    r4[i] = kp + __shfl_xor(snd, 16, 64);
  }
  float r2[2];
#pragma unroll
  for (int i = 0; i < 2; ++i) {
    const float snd = b0 ? r4[i] : r4[i + 2];
    const float kp = b0 ? r4[i + 2] : r4[i];
    r2[i] = kp + dpp_ror8(snd);
  }
  float2 o;
  o.x = xg.xv.x + xg.gt.x * r2[0];
  o.y = xg.xv.y + xg.gt.y * r2[1];
  *(float2*)((char*)p.out + ((unsigned)tok * 4096u + (unsigned)(x * 128 + ch * 16 + 2 * g) * 4u)) = o;
}

__device__ void phase_i2(const Params& p, int l, int pass, char* smem) {
  const int tid = otid();
  const int lane = tid & 63, w = tid >> 6;
  const int g = lane >> 3, ch = lane & 7;
  int x = (int)xcc_id(), j = 0, tries = 0;
  while (next_slice_item(p.wq + pass * 8, x, j, tries, smem, tid)) {
    const unsigned char* Vx = p.tabV8 + (size_t)x * NEXP * 128;
    const unsigned loff = ch * 16;
    const int tokb = j * I_TOK + w;
    I2Ctx c0, c1;
    I2XG xa, xb;
    uint4 rowsA[16], rowsB[16];
    i2_load_ctx(p, tokb, l, x, g, ch, c0);
    i2_load_ctx(p, tokb + 8, l, x, g, ch, c1);
    peer_issue_rows(Vx, loff, c0.e0, c0.e1, rowsA);
    i2_load_xg(p, tokb, l, x, g, ch, xa);
    i2_load_ctx(p, tokb + 8 * min(2, I_TW - 1), l, x, g, ch, c0);
#pragma unroll 1
    for (int i = 0; i < I_TW; i += 2) {
      __builtin_amdgcn_sched_barrier(0);
      peer_issue_rows(Vx, loff, c1.e0, c1.e1, rowsB);
      i2_load_xg(p, tokb + 8 * (i + 1), l, x, g, ch, xb);
      i2_load_ctx(p, tokb + 8 * min(i + 3, I_TW - 1), l, x, g, ch, c1);
      __builtin_amdgcn_sched_barrier(0);
      i2_compute(p, xa, rowsA, tokb + 8 * i, x, g, ch);
      __builtin_amdgcn_sched_barrier(0);
      peer_issue_rows(Vx, loff, c0.e0, c0.e1, rowsA);
      i2_load_xg(p, tokb + 8 * min(i + 2, I_TW - 1), l, x, g, ch, xa);
      i2_load_ctx(p, tokb + 8 * min(i + 4, I_TW - 1), l, x, g, ch, c0);
      __builtin_amdgcn_sched_barrier(0);
      i2_compute(p, xb, rowsB, tokb + 8 * (i + 1), x, g, ch);
      __builtin_amdgcn_sched_barrier(0);
    }
  }
}

__device__ __forceinline__ void grid_bar(unsigned* cnt, unsigned& epoch) {
  ++epoch;
  const unsigned target = epoch * gridDim.x;
  __syncthreads();
  if (threadIdx.x == 0) {
    __builtin_amdgcn_fence(__ATOMIC_RELEASE, "agent");
    asm volatile("s_waitcnt vmcnt(0)" ::: "memory");
    __hip_atomic_fetch_add(cnt, 1u, __ATOMIC_RELAXED, __HIP_MEMORY_SCOPE_AGENT);
    while (__hip_atomic_load(cnt, __ATOMIC_RELAXED, __HIP_MEMORY_SCOPE_AGENT) < target) __builtin_amdgcn_s_sleep(1);
    __builtin_amdgcn_fence(__ATOMIC_ACQUIRE, "agent");
    asm volatile("s_waitcnt vmcnt(0)" ::: "memory");
  }
  __syncthreads();
}

__global__ void __launch_bounds__(NTHR) mega_kernel(Params p) {
  extern __shared__ __attribute__((aligned(16))) char smem[];
  cg::grid_group grid = cg::this_grid();
  unsigned epoch = 0;
  for (int rep = 0; rep < REP_P0; ++rep) phase_p0(p, smem);
  grid.sync();
  for (int l = 0; l < 2; ++l) {
    for (int rep = 0; rep < REP_C; ++rep)
    for (int tile = blockIdx.x; tile < NTILE; tile += gridDim.x) phase_c(p, tile, l, l == 0, smem);
    grid_bar(p.wq + 64, epoch);
    for (int rep = 0; rep < REP_DE; ++rep) phase_de(p, l, smem);
    grid_bar(p.wq + 64, epoch);
    for (int tile = blockIdx.x; tile < NTILE; tile += gridDim.x) {
      phase_f(p, tile, l, l == 0, smem);
      for (int rep = 0; rep < REP_G; ++rep) phase_g(p, tile, l, smem);
    }
    grid_bar(p.wq + 64, epoch);
    phase_i1(p, 2 * l, smem);
    grid_bar(p.wq + 64, epoch);
    phase_w(p);
    grid_bar(p.wq + 64, epoch);
    phase_i2(p, l, 2 * l + 1, smem);
    if (l == 0) grid_bar(p.wq + 64, epoch);
  }
}

extern "C" void kernel_launch(void* const* d_in, const int* in_sizes, int n_in, void* d_out, int out_size, void* d_ws,
                              size_t ws_size, hipStream_t stream) {
  Params p{};
  const float* const* in = (const float* const*)d_in;
  p.x_prompt = in[0]; p.x_sample = in[1]; p.c_prompt = in[2]; p.c_sample = in[3]; p.w_mod = in[4]; p.b_mod = in[5];
  p.g1 = in[6]; p.g2 = in[7]; p.w_in = in[8]; p.conv_w = in[9]; p.conv_b = in[10]; p.f_w1 = in[11]; p.f_b1 = in[12];
  p.f_freq = in[13]; p.f_w2 = in[14]; p.f_b2 = in[15]; p.f_w3 = in[16]; p.f_bias = in[17]; p.q_gain = in[18];
  p.k_gain = in[19]; p.sink = in[20]; p.w_pa = in[21]; p.w_pb = in[22]; p.w_out = in[23]; p.peer_wq = in[24];
  p.peer_k1 = in[25]; p.peer_k2 = in[26]; p.peer_u = in[27]; p.peer_v = in[28];
  p.out = (float*)d_out;
  char* ws = (char*)d_ws;
  size_t off = 0;
  auto carve = [&](size_t bytes) { char* r = ws + off; off += (bytes + 255) & ~(size_t)255; return r; };
  p.WinT = (bf16_t*)carve((size_t)2 * INC * DM * 2);
  p.WpaT = (bf16_t*)carve((size_t)2 * DM * HYW * 2);
  p.WpbT = (bf16_t*)carve((size_t)2 * DM * HYW * 2);
  p.WoutT = (bf16_t*)carve((size_t)2 * DM * DM * 2);
  p.WcT = (bf16_t*)carve((size_t)2 * 2048 * DM * 2);
  p.Gf = (bf16_t*)carve((size_t)2 * 2 * 512 * 4096 * 2);
  p.mod = (float*)carve((size_t)2 * NB * 6144 * 4);
  p.rope = (float*)carve((size_t)SEQ * 64 * 4);
  p.tabU8 = (unsigned char*)carve((size_t)NEXP * DM);
  p.tabV8 = (unsigned char*)carve((size_t)NEXP * DM);
  p.sclU = (float*)carve((size_t)NEXP * 4);
  p.sclV = (float*)carve((size_t)NEXP * 4);
  p.wq = (unsigned*)carve(1024);
  p.zT = (bf16_t*)carve((size_t)NB * HYC * SEQ * 2);
  p.yaT = (bf16_t*)carve((size_t)NTOK * HYW * 2);
  p.yb = (bf16_t*)carve((size_t)NTOK * HYW * 2);
  p.zqkv = (bf16_t*)carve((size_t)NTOK * QKVC * 2);
  p.hbuf = (bf16_t*)carve((size_t)NTOK * DM * 2);
  p.merged = p.zT;
  p.yatok = p.zT + (size_t)NTOK * DM;
  p.apart = p.zT;
  p.pidx = (unsigned short*)p.zqkv;
  p.pg = (float*)(p.zqkv + (size_t)NTOK * 128);
  p.pgu = p.pg + (size_t)NTOK * 128;
  p.wbuf = (bf16_t*)(p.pgu + (size_t)NTOK * 128);
  if (off > ws_size) fprintf(stderr, "workspace too small: need %zu have %zu\n", off, ws_size);

  static int grid_blocks = 0;
  if (!grid_blocks) {
    int dev = 0, cus = 0, per_cu = 0;
    hipGetDevice(&dev);
    hipDeviceGetAttribute(&cus, hipDeviceAttributeMultiprocessorCount, dev);
    hipFuncSetAttribute((const void*)mega_kernel, hipFuncAttributeMaxDynamicSharedMemorySize, SMEM_BYTES);
    hipOccupancyMaxActiveBlocksPerMultiprocessor(&per_cu, mega_kernel, NTHR, SMEM_BYTES);
    if (per_cu < 1) per_cu = 1;
    grid_blocks = cus * 1;
    if (grid_blocks > NTILE) grid_blocks = NTILE;
  }
  hipMemsetAsync(p.wq, 0, 1024, stream);
  void* args[] = {&p};
  hipError_t e = hipLaunchCooperativeKernel((const void*)mega_kernel, dim3(grid_blocks), dim3(NTHR), args, SMEM_BYTES, stream);
  if (e != hipSuccess) fprintf(stderr, "cooperative launch failed: %s (grid %d)\n", hipGetErrorString(e), grid_blocks);
}
```

```cpp
#include <hip/hip_runtime.h>
#include <hip/hip_bf16.h>
#include <hip/hip_cooperative_groups.h>
#include <cstdio>
#include <cstdint>
namespace cg = cooperative_groups;

typedef unsigned short bf16_t;
using bf16x8 = __attribute__((ext_vector_type(8))) short;
using f32x16 = __attribute__((ext_vector_type(16))) float;

constexpr int DM = 1024;
constexpr int NB = 24;
constexpr int SEQ = 2048;
constexpr int NTOK = NB * SEQ;
constexpr int NBP = 16;
constexpr int INC = 4352;
constexpr int HYC = 1536;
constexpr int HYW = 512;
constexpr int QKVC = 768;
constexpr int TM = 192;
constexpr int NTILE = NTOK / TM;
constexpr int NTHR = 512;
constexpr int NEXP = 16384;
constexpr int SMEM_BYTES = 155648;
constexpr int I_TOK = 384;
constexpr int I_NJ = NTOK / I_TOK;
constexpr int I_TW = I_TOK / 8;

struct Params {
  const float *x_prompt, *x_sample, *c_prompt, *c_sample, *w_mod, *b_mod, *g1, *g2, *w_in, *conv_w, *conv_b;
  const float *f_w1, *f_b1, *f_freq, *f_w2, *f_b2, *f_w3, *f_bias, *q_gain, *k_gain, *sink, *w_pa, *w_pb, *w_out;
  const float *peer_wq, *peer_k1, *peer_k2, *peer_u, *peer_v;
  float* out;
  bf16_t *WinT, *WpaT, *WpbT, *WoutT, *WcT, *Gf, *zT, *zqkv, *yaT, *yb, *hbuf, *merged, *yatok;
  unsigned char *tabU8, *tabV8;
  unsigned short* pidx;
  bf16_t* wbuf;
  float *pg, *pgu, *mod, *rope, *sclU, *sclV;
  bf16_t* apart;
  unsigned* wq;
};

__device__ __forceinline__ float bf2f(bf16_t v) { return __uint_as_float(((unsigned)v) << 16); }
__device__ __forceinline__ bf16_t f2bf(float f) {
  unsigned u = __float_as_uint(f);
  u += 0x7FFFu + ((u >> 16) & 1u);
  return (bf16_t)(u >> 16);
}
__device__ __forceinline__ unsigned pack2(float a, float b) { return (unsigned)f2bf(a) | ((unsigned)f2bf(b) << 16); }
__device__ __forceinline__ float lo2f(unsigned u) { return __uint_as_float(u << 16); }
__device__ __forceinline__ float hi2f(unsigned u) { return __uint_as_float(u & 0xFFFF0000u); }

__device__ __forceinline__ int otid() { int t = threadIdx.x; asm volatile("" : "+v"(t)); return t; }
__device__ __forceinline__ int osgpr(int x) { asm volatile("" : "+s"(x)); return x; }
__device__ __forceinline__ void lds_barrier() { asm volatile("s_waitcnt lgkmcnt(0)\n\ts_barrier" ::: "memory"); }
__device__ __forceinline__ float wave_sum(float v) {
#pragma unroll
  for (int m = 32; m >= 1; m >>= 1) v += __shfl_xor(v, m, 64);
  return v;
}

__device__ __forceinline__ const float* xrow_in(const Params& p, int tok) {
  return (tok < NBP * SEQ) ? (p.x_prompt + (size_t)tok * DM) : (p.x_sample + (size_t)(tok - NBP * SEQ) * DM);
}
__device__ __forceinline__ const float* crow(const Params& p, int b) {
  return (b < NBP) ? (p.c_prompt + (size_t)b * DM) : (p.c_sample + (size_t)(b - NBP) * DM);
}

__device__ __forceinline__ void glds16(const bf16_t* g, char* l) {
  __builtin_amdgcn_global_load_lds((const __attribute__((address_space(1))) void*)g, (__attribute__((address_space(3))) void*)l, 16, 0, 0);
}
template <int NT>
__device__ __forceinline__ void gemm_core2(const bf16_t* __restrict__ A, int lda, const bf16_t* __restrict__ B, int ldb,
                                           int K, char* lds, f32x16 (&acc)[3][NT]) {
  constexpr int BROWS = 128 * NT;
  constexpr int STAGE = (192 + BROWS) * 128;
  const int tid = otid();
  const int lane = tid & 63, w = tid >> 6;
  const int wm = w >> 2, wn = w & 3;
#pragma unroll
  for (int i = 0; i < 3; ++i)
#pragma unroll
    for (int n = 0; n < NT; ++n)
#pragma unroll
      for (int j = 0; j < 16; ++j) acc[i][n][j] = 0.f;
  const int lr = lane >> 3, lc = lane & 7;
  const bf16_t* pa[3];
  const bf16_t* pb[2 * NT];
#pragma unroll
  for (int i = 0; i < 3; ++i) {
    const int row = (w + 8 * i) * 8 + lr;
    pa[i] = A + (size_t)row * lda + ((lc ^ ((row >> 1) & 7)) * 8);
  }
#pragma unroll
  for (int i = 0; i < 2 * NT; ++i) {
    const int row = (w + 8 * i) * 8 + lr;
    pb[i] = B + (size_t)row * ldb + ((lc ^ ((row >> 1) & 7)) * 8);
  }
  const int nk = K >> 6;
  lds_barrier();
  {
#pragma unroll
    for (int i = 0; i < 3; ++i) glds16(pa[i], lds + (w + 8 * i) * 1024);
#pragma unroll
    for (int i = 0; i < 2 * NT; ++i) glds16(pb[i], lds + 192 * 128 + (w + 8 * i) * 1024);
  }
  asm volatile("s_waitcnt vmcnt(0)" ::: "memory");
  __syncthreads();
  const int fr = lane & 31, hh = lane >> 5;
  int aoff[3], akey[3], boff[NT], bkey[NT];
#pragma unroll
  for (int mi = 0; mi < 3; ++mi) { const int r = wm * 96 + mi * 32 + fr; aoff[mi] = r * 128; akey[mi] = (r >> 1) & 7; }
#pragma unroll
  for (int ni = 0; ni < NT; ++ni) { const int r = wn * 32 * NT + ni * 32 + fr; boff[ni] = 192 * 128 + r * 128; bkey[ni] = (r >> 1) & 7; }
#pragma unroll 1
  for (int kt = 0; kt < nk; ++kt) {
    if (kt + 1 < nk) {
      char* sb = lds + ((kt + 1) & 1) * STAGE;
      const int ko = (kt + 1) << 6;
#pragma unroll
      for (int i = 0; i < 3; ++i) glds16(pa[i] + ko, sb + (w + 8 * i) * 1024);
#pragma unroll
      for (int i = 0; i < 2 * NT; ++i) glds16(pb[i] + ko, sb + 192 * 128 + (w + 8 * i) * 1024);
    }
    const char* st = lds + (kt & 1) * STAGE;
    bf16x8 afr[2][3], bfr[2][NT];
#pragma unroll
    for (int ni = 0; ni < NT; ++ni) bfr[0][ni] = *(const bf16x8*)(st + boff[ni] + ((hh ^ bkey[ni]) << 4));
#pragma unroll
    for (int mi = 0; mi < 3; ++mi) afr[0][mi] = *(const bf16x8*)(st + aoff[mi] + ((hh ^ akey[mi]) << 4));
#pragma unroll
    for (int kk = 0; kk < 4; ++kk) {
      const int cur = kk & 1, nxt = cur ^ 1;
      if (kk < 3) {
        const int kc = 2 * (kk + 1) + hh;
#pragma unroll
        for (int ni = 0; ni < NT; ++ni) bfr[nxt][ni] = *(const bf16x8*)(st + boff[ni] + ((kc ^ bkey[ni]) << 4));
#pragma unroll
        for (int mi = 0; mi < 3; ++mi) afr[nxt][mi] = *(const bf16x8*)(st + aoff[mi] + ((kc ^ akey[mi]) << 4));
      }
      __builtin_amdgcn_sched_barrier(0);
#pragma unroll
      for (int mi = 0; mi < 3; ++mi)
#pragma unroll
        for (int ni = 0; ni < NT; ++ni) acc[mi][ni] = __builtin_amdgcn_mfma_f32_32x32x16_bf16(afr[cur][mi], bfr[cur][ni], acc[mi][ni], 0, 0, 0);
      __builtin_amdgcn_sched_barrier(0);
    }
    asm volatile("s_waitcnt vmcnt(0)" ::: "memory");
    __syncthreads();
  }
}
typedef short s16x4 __attribute__((ext_vector_type(4)));
__device__ __forceinline__ s16x4 tr_read4(const bf16_t* lds_ptr) {
  return __builtin_amdgcn_ds_read_tr16_b64_v4i16((__attribute__((address_space(3))) s16x4*)(lds_ptr));
}

template <int MODE>
__device__ __forceinline__ void gemm_f1(const bf16_t* __restrict__ A0, const bf16_t* __restrict__ A1, int lda,
                                        const bf16_t* __restrict__ B0, const bf16_t* __restrict__ B1, int ldb,
                                        char* lds, f32x16 (&acc)[3][2], int tok0 = 0) {
  constexpr int STAGE = (192 + 256) * 128;
  const int tid = otid();
  const int lane = tid & 63, w = tid >> 6;
  const int wm = w >> 2, wn = w & 3;
#pragma unroll
  for (int i = 0; i < 3; ++i)
#pragma unroll
    for (int n = 0; n < 2; ++n)
#pragma unroll
      for (int j = 0; j < 16; ++j) acc[i][n][j] = 0.f;
  const int lr = lane >> 3, lc = lane & 7;
  const bool hi = (w >= 4);
  int aofs[3];
  const bf16_t* pb[4];
#pragma unroll
  for (int i = 0; i < 3; ++i) {
    const int row = (w + 8 * i) * 8 + lr;
    aofs[i] = row * lda + ((lc ^ ((row >> 1) & 7)) * 8);
  }
#pragma unroll
  for (int i = 0; i < 4; ++i) {
    const int rb = (w + 8 * i) * 8 + lr;
    const int srow = i * 32 + (w & 3) * 8 + lr;
    pb[i] = (hi ? B1 : B0) + (size_t)srow * ldb + ((lc ^ ((rb >> 1) & 7)) * 8);
  }
  constexpr int NK = 16;
  int tofs[3];
  if (MODE == 2) {
#pragma unroll
    for (int i = 0; i < 3; ++i) {
      const int q = (w + 8 * i) * 64 + lane;
      const int k = q / 24, pos = q - k * 24;
      const int cch = pos ^ (((k >> 1) & 1) << 2);
      const int tok = tok0 + cch * 8;
      tofs[i] = (((tok >> 11) * HYW + k) * SEQ) + (tok & 2047);
    }
  }
  auto issue = [&](int kt) {
    char* sb = lds + (kt & 1) * STAGE;
    const int ka = (MODE == 2) ? ((kt & 7) << 6) : (kt << 6);
    if (MODE == 2 && kt < 8) {
#pragma unroll
      for (int i = 0; i < 3; ++i) glds16(A0 + tofs[i] + (size_t)ka * SEQ, sb + (w + 8 * i) * 1024);
    } else {
      const bf16_t* Ab = (MODE == 2) ? A1 : A0;
#pragma unroll
      for (int i = 0; i < 3; ++i) glds16(Ab + aofs[i] + ka, sb + (w + 8 * i) * 1024);
    }
    if (MODE == 1 || ((kt >= 8) == hi)) {
#pragma unroll
      for (int i = 0; i < 4; ++i) glds16(pb[i] + ka, sb + 192 * 128 + (w + 8 * i) * 1024);
    }
  };
  lds_barrier();
  issue(0);
  asm volatile("s_waitcnt vmcnt(0)" ::: "memory");
  __syncthreads();
  const int fr = lane & 31, hh = lane >> 5;
  int aoff[3], akey[3], boff[2], bkey[2];
#pragma unroll
  for (int mi = 0; mi < 3; ++mi) { const int r = wm * 96 + mi * 32 + fr; aoff[mi] = r * 128; akey[mi] = (r >> 1) & 7; }
#pragma unroll
  for (int ni = 0; ni < 2; ++ni) { const int r = wn * 64 + ni * 32 + fr; boff[ni] = 192 * 128 + r * 128; bkey[ni] = (r >> 1) & 7; }
  int toff[3];
  if (MODE == 2) {
    const int g4 = lane >> 4, tq = (lane & 15) >> 2, tp = lane & 3;
    const int fk = ((tq >> 1) & 1) << 2;
#pragma unroll
    for (int mi = 0; mi < 3; ++mi) {
      const int chunk = wm * 12 + mi * 4 + 2 * (g4 & 1) + (tp >> 1);
      toff[mi] = (8 * (g4 >> 1) + tq) * 384 + ((chunk ^ fk) << 4) + (tp & 1) * 8;
    }
  }
#pragma unroll
  for (int hf = 0; hf < 2; ++hf) {
#pragma unroll 1
    for (int kt = hf * 8; kt < hf * 8 + 8; ++kt) {
      if (kt + 1 < NK) issue(kt + 1);
      const char* st = lds + (kt & 1) * STAGE;
#pragma unroll
      for (int kk = 0; kk < 4; ++kk) {
        const int kc = 2 * kk + hh;
        bf16x8 bfr[2];
#pragma unroll
        for (int ni = 0; ni < 2; ++ni) if (MODE == 1 || ni == hf) bfr[ni] = *(const bf16x8*)(st + boff[ni] + ((kc ^ bkey[ni]) << 4));
#pragma unroll
        for (int mi = 0; mi < 3; ++mi) {
          bf16x8 afr;
          if (MODE == 2 && hf == 0) {
            const s16x4 t0 = tr_read4((const bf16_t*)(st + toff[mi] + kk * 6144));
            const s16x4 t1 = tr_read4((const bf16_t*)(st + toff[mi] + kk * 6144 + 1536));
            afr[0] = t0[0]; afr[1] = t0[1]; afr[2] = t0[2]; afr[3] = t0[3];
            afr[4] = t1[0]; afr[5] = t1[1]; afr[6] = t1[2]; afr[7] = t1[3];
          } else {
            afr = *(const bf16x8*)(st + aoff[mi] + ((kc ^ akey[mi]) << 4));
          }
#pragma unroll
          for (int ni = 0; ni < 2; ++ni)
            if (MODE == 1 || ni == hf) acc[mi][ni] = __builtin_amdgcn_mfma_f32_32x32x16_bf16(afr, bfr[ni], acc[mi][ni], 0, 0, 0);
        }
      }
      asm volatile("s_waitcnt vmcnt(0)" ::: "memory");
      __syncthreads();
    }
  }
}

#define ACC_ROW(wm, mi, reg, lane) ((wm) * 96 + (mi) * 32 + ((reg) & 3) + 8 * ((reg) >> 2) + 4 * ((lane) >> 5))

template <int NT>
__device__ __forceinline__ void acc_to_lds(const f32x16 (&acc)[3][NT], float* ct, int LD, int half) {
  const int tid_ = otid(); const int lane = tid_ & 63, w = tid_ >> 6, wm = w >> 2, wn = w & 3;
  if (NT == 2 && (wn >> 1) != half) return;
#pragma unroll
  for (int ni = 0; ni < NT; ++ni) {
    const int n = (NT == 2 ? (wn & 1) * 64 : wn * 32) + ni * 32 + (lane & 31);
#pragma unroll
    for (int mi = 0; mi < 3; ++mi)
#pragma unroll
      for (int r = 0; r < 16; ++r) ct[ACC_ROW(wm, mi, r, lane) * LD + n] = acc[mi][ni][r];
  }
}
constexpr int LDT = 196;
template <int NT>
__device__ __forceinline__ void acc_to_lds_T(const f32x16 (&acc)[3][NT], float* ctT, int half) {
  const int tid_ = otid(); const int lane = tid_ & 63, w = tid_ >> 6, wm = w >> 2, wn = w & 3;
  if (NT == 2 && (wn >> 1) != half) return;
#pragma unroll
  for (int ni = 0; ni < NT; ++ni) {
    const int n = (NT == 2 ? (wn & 1) * 64 : wn * 32) + ni * 32 + (lane & 31);
#pragma unroll
    for (int mi = 0; mi < 3; ++mi)
#pragma unroll
      for (int g4 = 0; g4 < 4; ++g4) {
        const int r0 = wm * 96 + mi * 32 + 8 * g4 + 4 * (lane >> 5);
        float4 v; v.x = acc[mi][ni][g4 * 4 + 0]; v.y = acc[mi][ni][g4 * 4 + 1]; v.z = acc[mi][ni][g4 * 4 + 2]; v.w = acc[mi][ni][g4 * 4 + 3];
        *(float4*)(ctT + n * LDT + r0) = v;
      }
  }
}
__device__ __forceinline__ void store_tile_bf16(const float* ct, bf16_t* dst, int ldd, int tok0, int n0) {
#pragma unroll 1
  for (int it = otid(); it < 192 * 16; it += NTHR) {
    const int c8 = it & 15, r = it >> 4;
    const float4 a = *(const float4*)(ct + r * 132 + c8 * 8), b = *(const float4*)(ct + r * 132 + c8 * 8 + 4);
    uint4 o; o.x = pack2(a.x, a.y); o.y = pack2(a.z, a.w); o.z = pack2(b.x, b.y); o.w = pack2(b.z, b.w);
    *(uint4*)(dst + (size_t)(tok0 + r) * ldd + n0 + c8 * 8) = o;
  }
}

__device__ void p0_transpose_tile(const float* __restrict__ src, bf16_t* __restrict__ dst, int R, int C, int tr, int tc, char* smem) {
  float* t = (float*)smem;
  const int tid = otid();
  __syncthreads();
#pragma unroll
  for (int i = 0; i < 8; ++i) {
    int r = (tid >> 6) + 8 * i, c = tid & 63;
    t[r * 65 + c] = src[(size_t)(tr * 64 + r) * C + tc * 64 + c];
  }
  __syncthreads();
#pragma unroll
  for (int i = 0; i < 8; ++i) {
    int cc = (tid >> 6) + 8 * i, rr = tid & 63;
    dst[(size_t)(tc * 64 + cc) * R + tr * 64 + rr] = f2bf(t[rr * 65 + cc]);
  }
}

__device__ void p0_wc_item(const Params& p, int l, int ph, int kt, char* smem) {
  float* wqs = (float*)smem;
  float* ks = wqs + 64 * 129;
  const int tid = otid();
  const float* wq = p.peer_wq + (size_t)l * DM * 2048;
  const float* kk = ((ph & 1) ? p.peer_k2 : p.peer_k1) + (size_t)l * 128 * 128;
  __syncthreads();
  for (int e = tid; e < 64 * 128; e += NTHR) {
    int r = e >> 7, d = e & 127;
    wqs[r * 129 + d] = wq[(size_t)(kt * 64 + r) * 2048 + ph * 128 + d];
  }
  for (int e = tid; e < 128 * 128; e += NTHR) {
    int r = e >> 7, d = e & 127;
    ks[r * 129 + d] = kk[r * 128 + d];
  }
  __syncthreads();
  const int key = tid & 127, k0 = (tid >> 7) * 16;
  float acc[16];
#pragma unroll
  for (int i = 0; i < 16; ++i) acc[i] = 0.f;
  for (int d = 0; d < 128; ++d) {
    float kv = ks[key * 129 + d];
#pragma unroll
    for (int i = 0; i < 16; ++i) acc[i] += wqs[(k0 + i) * 129 + d] * kv;
  }
  bf16_t* dst = p.WcT + ((size_t)l * 2048 + ph * 128 + key) * DM + kt * 64 + k0;
  uint4 o0, o1;
  o0.x = pack2(acc[0], acc[1]); o0.y = pack2(acc[2], acc[3]); o0.z = pack2(acc[4], acc[5]); o0.w = pack2(acc[6], acc[7]);
  o1.x = pack2(acc[8], acc[9]); o1.y = pack2(acc[10], acc[11]); o1.z = pack2(acc[12], acc[13]); o1.w = pack2(acc[14], acc[15]);
  *(uint4*)dst = o0; *(uint4*)(dst + 8) = o1;
}

__device__ void p0_mod_item(const Params& p, int l, int cc, char* smem) {
  float* sc = (float*)smem;
  float* red = sc + 1024 * 24;
  const int tid = otid();
  __syncthreads();
  for (int e = tid; e < NB * DM; e += NTHR) {
    int b = e >> 10, k = e & 1023;
    float v = crow(p, b)[k];
    sc[k * 24 + b] = v / (1.f + __expf(-v));
  }
  __syncthreads();
  const int col = tid & 63, kg = tid >> 6;
  const int n = cc * 64 + col;
  float acc[24];
#pragma unroll
  for (int b = 0; b < 24; ++b) acc[b] = 0.f;
  const float* wm = p.w_mod + (size_t)l * DM * 6144 + n;
#pragma unroll 1
  for (int k0 = kg * 128; k0 < kg * 128 + 128; k0 += 8) {
    float wv[8];
#pragma unroll
    for (int j = 0; j < 8; ++j) wv[j] = wm[(size_t)(k0 + j) * 6144];
#pragma unroll
    for (int j = 0; j < 8; ++j) {
      const float4* s4 = (const float4*)(sc + (k0 + j) * 24);
#pragma unroll
      for (int q = 0; q < 6; ++q) {
        float4 sv = s4[q];
        acc[q * 4 + 0] += sv.x * wv[j]; acc[q * 4 + 1] += sv.y * wv[j]; acc[q * 4 + 2] += sv.z * wv[j]; acc[q * 4 + 3] += sv.w * wv[j];
      }
    }
  }
#pragma unroll
  for (int b = 0; b < 24; ++b) red[(kg * 24 + b) * 64 + col] = acc[b];
  __syncthreads();
  for (int e = tid; e < 24 * 64; e += NTHR) {
    const int b = e >> 6, c2 = e & 63;
    float sum = p.b_mod[l * 6144 + cc * 64 + c2];
#pragma unroll
    for (int g = 0; g < 8; ++g) sum += red[(g * 24 + b) * 64 + c2];
    p.mod[((size_t)l * NB + b) * 6144 + cc * 64 + c2] = sum;
  }
}

__device__ void p0_filter_item(const Params& p, int l, int tc, char* smem) {
  float* feat = (float*)smem;
  float* a1 = feat + 32 * 33;
  float* a2 = a1 + 32 * 64;
  bf16_t* stage = (bf16_t*)(a2 + 32 * 64);
  const int tid = otid();
  const int t0 = tc * 32;
  __syncthreads();
  for (int e = tid; e < 32 * 33; e += NTHR) {
    int pp = e / 33, f = e % 33;
    int ti = t0 + pp;
    float v;
    if (f == 0) v = (float)ti / (float)(SEQ - 1);
    else {
      int bi = (f - 1) & 15;
      float band = 1e-4f + (float)bi * ((15.f - 1e-4f) / 15.f);
      float wv = 2.0f * 3.14159265358979323846f * (float)ti / (float)SEQ;
      float arg = band * wv;
      v = (f <= 16) ? cosf(arg) : -sinf(arg);
    }
    feat[pp * 33 + f] = v;
  }
  __syncthreads();
  const float* w1 = p.f_w1 + l * 33 * 64; const float* b1 = p.f_b1 + l * 64; const float* fq = p.f_freq + l * 64;
  const float* w2 = p.f_w2 + l * 64 * 64; const float* b2 = p.f_b2 + l * 64;
  for (int e = tid; e < 32 * 64; e += NTHR) {
    int pp = e >> 6, j = e & 63;
    float s = b1[j];
    for (int f = 0; f < 33; ++f) s += feat[pp * 33 + f] * w1[f * 64 + j];
    a1[pp * 64 + j] = sinf(fq[j] * s);
  }
  __syncthreads();
  for (int e = tid; e < 32 * 64; e += NTHR) {
    int pp = e >> 6, j = e & 63;
    float s = b2[j];
    for (int i = 0; i < 64; ++i) s += a1[pp * 64 + i] * w2[i * 64 + j];
    a2[pp * 64 + j] = sinf(fq[j] * s);
  }
  __syncthreads();
  const float* w3 = p.f_w3 + (size_t)l * 64 * 2048;
  const float min_decay = logf(1e-2f) / 1.5f, max_decay = logf(1e-2f) / 0.3f;
  for (int q = 0; q < 4; ++q) {
    const int n = tid + 512 * q;
    const int c = n & 511;
    float wr[64];
#pragma unroll
    for (int i = 0; i < 64; ++i) wr[i] = w3[i * 2048 + n];
    const float delta = fabsf(min_decay + (max_decay - min_decay) * (float)c / 511.f);
    for (int pp = 0; pp < 32; ++pp) {
      float s = 0.f;
#pragma unroll
      for (int i = 0; i < 64; ++i) s += a2[pp * 64 + i] * wr[i];
      float tt = (float)(t0 + pp) / (float)(SEQ - 1);
      s *= __expf(-tt * delta);
      if (t0 + pp == 0 && ((n >> 9) & 1) == 0) s += p.f_bias[(l * 2 + (n >> 10)) * 512 + c];
      stage[n * 32 + pp] = f2bf(s);
    }
  }
  __syncthreads();
  for (int e = tid; e < 2048 * 32; e += NTHR) {
    int n = e >> 5, pp = e & 31;
    int o = n >> 10, d = (n >> 9) & 1, c = n & 511;
    int t = t0 + pp;
    bf16_t* g = p.Gf + ((size_t)((l * 2 + o) * 512 + c)) * 4096;
    if (d == 0) g[2048 - t] = stage[n * 32 + pp];
    else if (t >= 1) g[2048 + t] = stage[n * 32 + pp];
    if (t == 0 && d == 0) g[0] = 0;
  }
}

__device__ void p0_rope_item(const Params& p, int it) {
  int e = it * 512 + otid();
  int pos = e >> 5, i = e & 31;
  float inv = powf(10000.f, -(float)(2 * i) / 64.f);
  float ang = (float)pos * inv;
  p.rope[e * 2 + 0] = cosf(ang);
  p.rope[e * 2 + 1] = sinf(ang);
}

__device__ __forceinline__ int next_item(unsigned* cnt, char* smem) {
  int* sh = (int*)(smem + SMEM_BYTES - 16);
  __syncthreads();
  if (threadIdx.x == 0) *sh = (int)atomicAdd(cnt, 1u);
  __syncthreads();
  return *sh;
}

constexpr int P0_N_MOD = 2 * 96;
constexpr int P0_N_FILT = 2 * 64;
constexpr int P0_N_ROPE = 128;
constexpr int P0_N_WIN = 16 * 68;
constexpr int P0A_TOTAL = P0_N_FILT + P0_N_MOD + P0_N_ROPE + P0_N_WIN;
constexpr int P0_N_WC = 2 * 16 * 16;
constexpr int P0_N_SMALL = 8 * 16 + 8 * 16 + 16 * 16;
constexpr int P0B_TOTAL = P0_N_WC + P0_N_WIN + 2 * P0_N_SMALL;

__device__ __forceinline__ void p0_win_tile(const Params& p, int l, int j, char* smem) {
  p0_transpose_tile(p.w_in + (size_t)l * DM * INC, p.WinT + (size_t)l * INC * DM, DM, INC, j / 68, j % 68, smem);
}
__device__ void p0a_item(const Params& p, int i, char* smem) {
  if (i < P0_N_FILT) { p0_filter_item(p, i / 64, i % 64, smem); return; }
  i -= P0_N_FILT;
  if (i < P0_N_MOD) { p0_mod_item(p, i / 96, i % 96, smem); return; }
  i -= P0_N_MOD;
  if (i < P0_N_ROPE) { p0_rope_item(p, i); return; }
  i -= P0_N_ROPE;
  p0_win_tile(p, 0, i, smem);
}
__device__ void p0b_item(const Params& p, int i, char* smem) {
  if (i < P0_N_WC) { p0_wc_item(p, i >> 8, (i >> 4) & 15, i & 15, smem); return; }
  i -= P0_N_WC;
  if (i < P0_N_WIN) { p0_win_tile(p, 1, i, smem); return; }
  i -= P0_N_WIN;
  const int l = i / P0_N_SMALL; int j = i % P0_N_SMALL;
  if (j < 128) { p0_transpose_tile(p.w_pa + (size_t)l * HYW * DM, p.WpaT + (size_t)l * DM * HYW, HYW, DM, j / 16, j % 16, smem); return; }
  j -= 128;
  if (j < 128) { p0_transpose_tile(p.w_pb + (size_t)l * HYW * DM, p.WpbT + (size_t)l * DM * HYW, HYW, DM, j / 16, j % 16, smem); return; }
  j -= 128;
  p0_transpose_tile(p.w_out + (size_t)l * DM * DM, p.WoutT + (size_t)l * DM * DM, DM, DM, j / 16, j % 16, smem);
}
__device__ void phase_p0(const Params& p, char* smem) {
  for (int it = next_item(p.wq + 96, smem); it < P0A_TOTAL; it = next_item(p.wq + 96, smem)) p0a_item(p, it, smem);
}

__device__ void norm_rows(const Params& p, int tile, int l, int which, bool from_inputs, char* smem) {
  float* scl = (float*)smem;
  float* shf = scl + 2048;
  const int tid = otid(), lane = tid & 63, w = tid >> 6;
  const int tok0 = tile * TM;
  const int b0 = tok0 >> 11;
  const float* g = (which ? p.g2 : p.g1) + l * DM;
  __syncthreads();
  for (int e = tid; e < 2048; e += NTHR) {
    int bi = e >> 10, j = e & 1023;
    int b = b0 + bi; if (b > NB - 1) b = NB - 1;
    const float* m = p.mod + ((size_t)l * NB + b) * 6144 + which * 3072;
    scl[e] = g[j] * (1.f + m[1024 + j]);
    shf[e] = m[j];
  }
  __syncthreads();
#pragma unroll 1
  for (int r0 = w; r0 < TM; r0 += 32) {
    float4 v[4][4];
#pragma unroll
    for (int q = 0; q < 4; ++q) {
      const int tok = tok0 + r0 + 8 * q;
      const float* xr = from_inputs ? xrow_in(p, tok) : (p.out + (size_t)tok * DM);
#pragma unroll
      for (int i = 0; i < 4; ++i) v[q][i] = *(const float4*)(xr + lane * 4 + 256 * i);
    }
#pragma unroll
    for (int q = 0; q < 4; ++q) {
      const int tok = tok0 + r0 + 8 * q;
      const int bi = (tok >> 11) - b0;
      float ss = 0.f;
#pragma unroll
      for (int i = 0; i < 4; ++i) ss += v[q][i].x * v[q][i].x + v[q][i].y * v[q][i].y + v[q][i].z * v[q][i].z + v[q][i].w * v[q][i].w;
      ss = wave_sum(ss);
      const float rs = rsqrtf(ss * (1.f / DM) + 1e-6f);
#pragma unroll
      for (int i = 0; i < 4; ++i) {
        const int j = lane * 4 + 256 * i;
        const float4 sc4 = *(const float4*)(scl + bi * 1024 + j);
        const float4 sh4 = *(const float4*)(shf + bi * 1024 + j);
        uint2 o;
        o.x = pack2(v[q][i].x * rs * sc4.x + sh4.x, v[q][i].y * rs * sc4.y + sh4.y);
        o.y = pack2(v[q][i].z * rs * sc4.z + sh4.z, v[q][i].w * rs * sc4.w + sh4.w);
        *(uint2*)(p.hbuf + (size_t)tok * DM + j) = o;
      }
    }
  }
  __syncthreads();
}

__device__ void phase_c(const Params& p, int tile, int l, bool from_inputs, char* smem) {
  norm_rows(p, tile, l, 0, from_inputs, smem);
  const int tid = otid();
  const int tok0 = tile * TM;
  const bf16_t* A = p.hbuf + (size_t)tok0 * DM;
  const bf16_t* W = p.WinT + (size_t)l * INC * DM;
  float* ct = (float*)smem;
  f32x16 acc[3][2];
#pragma unroll 1
  for (int nt = 0; nt < 9; ++nt) {
    gemm_core2<2>(A, DM, W + (size_t)nt * 256 * DM, DM, DM, smem, acc);
#pragma unroll 1
    for (int half = 0; half < 2; ++half) {
      const int nc = nt * 2 + half;
      if (nc < 12) {
        acc_to_lds_T<2>(acc, ct, half);
        lds_barrier();
#pragma unroll 1
        for (int it = tid; it < 128 * 24; it += NTHR) {
          const int tg = it % 24, nl = it / 24;
          const float4 a = *(const float4*)(ct + nl * LDT + tg * 8), b4 = *(const float4*)(ct + nl * LDT + tg * 8 + 4);
          uint4 o; o.x = pack2(a.x, a.y); o.y = pack2(a.z, a.w); o.z = pack2(b4.x, b4.y); o.w = pack2(b4.z, b4.w);
          const int tok = tok0 + tg * 8;
          const int b = tok >> 11, sq = tok & 2047;
          *(uint4*)(p.zT + ((size_t)b * HYC + nc * 128 + nl) * SEQ + sq) = o;
        }
      } else {
        acc_to_lds<2>(acc, ct, 132, half);
        lds_barrier();
        store_tile_bf16(ct, p.zqkv, QKVC, tok0, nc * 128 - HYC);
      }
      lds_barrier();
    }
  }
}

__device__ __forceinline__ void load_conv8(const bf16_t* __restrict__ zrow, int s0, float w0, float w1, float w2, float cb, float (&o)[8]) {
  uint4 v = *(const uint4*)(zrow + s0);
  float z[10];
  z[0] = (s0 > 0) ? bf2f(zrow[s0 - 1]) : 0.f;
  z[1] = lo2f(v.x); z[2] = hi2f(v.x); z[3] = lo2f(v.y); z[4] = hi2f(v.y);
  z[5] = lo2f(v.z); z[6] = hi2f(v.z); z[7] = lo2f(v.w); z[8] = hi2f(v.w);
  z[9] = (s0 + 8 < SEQ) ? bf2f(zrow[s0 + 8]) : 0.f;
#pragma unroll
  for (int i = 0; i < 8; ++i) o[i] = z[i] * w0 + z[i + 1] * w1 + z[i + 2] * w2 + cb;
}

struct Conv8In { uint4 v; unsigned short l, r; };
__device__ __forceinline__ void conv8_load(const bf16_t* __restrict__ zrow, int s0, Conv8In& c) {
  c.v = *(const uint4*)(zrow + s0);
  c.l = (s0 > 0) ? zrow[s0 - 1] : (unsigned short)0;
  c.r = (s0 + 8 < SEQ) ? zrow[s0 + 8] : (unsigned short)0;
}
__device__ __forceinline__ void conv8_eval(const Conv8In& c, float w0, float w1, float w2, float cb, float (&o)[8]) {
  float z[10];
  z[0] = bf2f(c.l);
  z[1] = lo2f(c.v.x); z[2] = hi2f(c.v.x); z[3] = lo2f(c.v.y); z[4] = hi2f(c.v.y);
  z[5] = lo2f(c.v.z); z[6] = hi2f(c.v.z); z[7] = lo2f(c.v.w); z[8] = hi2f(c.v.w);
  z[9] = bf2f(c.r);
#pragma unroll
  for (int i = 0; i < 8; ++i) o[i] = z[i] * w0 + z[i + 1] * w1 + z[i + 2] * w2 + cb;
}


constexpr int HY_GS_ELEMS = 4112;
constexpr int HY_US_ROWS = 2072;
__device__ __forceinline__ void hyena_load_g(const Params& p, int l, int o, int c, bf16_t* Gs, int tid) {
  const bf16_t* g = p.Gf + ((size_t)((l * 2 + o) * 512 + c)) * 4096;
  *(uint4*)(Gs + 8 + tid * 8) = *(const uint4*)(g + tid * 8);
  if (tid == 0) { unsigned z = 0; asm volatile("" : "+v"(z)); const uint4 z4 = make_uint4(z, z, z, z); *(uint4*)Gs = z4; *(uint4*)(Gs + 4104) = z4; }
}

__device__ __forceinline__ void hyena_kloop(const bf16_t* Gs, const bf16_t* us, int rho, int lane, f32x16 (&acc)[8]) {
#pragma unroll
  for (int a = 0; a < 8; ++a)
#pragma unroll
    for (int j = 0; j < 16; ++j) acc[a][j] = 0.f;
  const int i = lane & 31, hh = lane >> 5;
  const bf16_t* ga = Gs + (2040 - 8 * i + 8 * hh) - 1792;
  const int l16 = lane & 15, q = l16 >> 2, pq = l16 & 3, g4 = lane >> 4;
  const bf16_t* ub = us + (rho + 8 * (g4 >> 1) + q) * 24 + 16 * (g4 & 1) + 4 * pq;
#pragma unroll 1
  for (int kap = 0; kap < 129; ++kap) {
    const s16x4 b0 = tr_read4(ub + kap * 384);
    const s16x4 b1 = tr_read4(ub + kap * 384 + 96);
    bf16x8 bfrag;
    bfrag[0] = b0[0]; bfrag[1] = b0[1]; bfrag[2] = b0[2]; bfrag[3] = b0[3];
    bfrag[4] = b1[0]; bfrag[5] = b1[1]; bfrag[6] = b1[2]; bfrag[7] = b1[3];
#pragma unroll
    for (int a = 0; a < 8; ++a) {
      const bf16x8 af = *(const bf16x8*)(ga + kap * 16 + 256 * (7 - a));
      acc[a] = __builtin_amdgcn_mfma_f32_32x32x16_bf16(af, bfrag, acc[a], 0, 0, 0);
    }
  }
}

__device__ __forceinline__ void hyena_acc_to_us(const f32x16 (&acc)[8], bf16_t* us, int rho, int lane) {
  const int n = lane & 31, hh = lane >> 5;
  if (n < 24) {
#pragma unroll
    for (int a = 0; a < 8; ++a)
#pragma unroll
      for (int r = 0; r < 16; ++r) {
        const int t = 256 * a + rho + 8 * ((r & 3) + 8 * (r >> 2) + 4 * hh);
        us[(t + 16) * 24 + n] = f2bf(acc[a][r]);
      }
  }
}

__device__ void hyena_item(const Params& p, int l, int c, char* smem) {
  bf16_t* Gs = (bf16_t*)smem;
  bf16_t* us = (bf16_t*)(smem + 8256);
  const int tid = otid();
  const int lane = tid & 63, w = tid >> 6;
  const float* cw = p.conv_w + (size_t)l * 3 * HYC;
  const float* cbp = p.conv_b + (size_t)l * HYC;
  __syncthreads();
  hyena_load_g(p, l, 0, c, Gs, tid);
  {
    unsigned z = 0; asm volatile("" : "+v"(z)); const uint4 z4 = make_uint4(z, z, z, z);
    if (tid < 48) *(uint4*)(us + tid * 8) = z4;
    else if (tid < 48 + 26) *(uint4*)(us + 2064 * 24 + (tid - 48) * 8) = z4;
  }
  {
    const float w0 = cw[c], w1 = cw[HYC + c], w2 = cw[2 * HYC + c], cb = cbp[c];
#pragma unroll 1
    for (int q0 = tid; q0 < 24 * 256; q0 += 4 * NTHR) {
      Conv8In cin[4];
#pragma unroll
      for (int j = 0; j < 4; ++j) {
        const int qq = q0 + j * NTHR;
        conv8_load(p.zT + ((size_t)(qq % 24) * HYC + c) * SEQ, (qq / 24) * 8, cin[j]);
      }
#pragma unroll
      for (int j = 0; j < 4; ++j) {
        const int qq = q0 + j * NTHR;
        const int b = qq % 24, s0 = (qq / 24) * 8;
        float v[8];
        conv8_eval(cin[j], w0, w1, w2, cb, v);
#pragma unroll
        for (int i = 0; i < 8; ++i) us[(s0 + i + 16) * 24 + b] = f2bf(v[i]);
      }
    }
  }
  __syncthreads();
  f32x16 acc[8];
#pragma unroll 1
  for (int o = 0; o < 2; ++o) {
    hyena_kloop(Gs, us, w, lane, acc);
    __syncthreads();
    hyena_acc_to_us(acc, us, w, lane);
    if (o == 0) hyena_load_g(p, l, 1, c, Gs, tid);
    __syncthreads();
    const int xc = (o == 0 ? 512 : 1024) + c;
    const float xw0 = cw[xc], xw1 = cw[HYC + xc], xw2 = cw[2 * HYC + xc], xcb = cbp[xc];
#pragma unroll 1
    for (int q0 = tid; q0 < 24 * 256; q0 += 4 * NTHR) {
      Conv8In cin[4];
#pragma unroll
      for (int j = 0; j < 4; ++j) {
        const int qq = q0 + j * NTHR;
        conv8_load(p.zT + ((size_t)(qq % 24) * HYC + xc) * SEQ, (qq / 24) * 8, cin[j]);
      }
#pragma unroll
      for (int j = 0; j < 4; ++j) {
        const int qq = q0 + j * NTHR;
        const int b = qq % 24, s0 = (qq / 24) * 8;
        float xv[8];
        conv8_eval(cin[j], xw0, xw1, xw2, xcb, xv);
        if (o == 0) {
#pragma unroll
          for (int i = 0; i < 8; ++i) {
            bf16_t* e = us + (s0 + i + 16) * 24 + b;
            *e = f2bf(bf2f(*e) * xv[i]);
          }
        } else {
          float r[8];
#pragma unroll
          for (int i = 0; i < 8; ++i) r[i] = bf2f(us[(s0 + i + 16) * 24 + b]) * xv[i];
          uint4 pk; pk.x = pack2(r[0], r[1]); pk.y = pack2(r[2], r[3]); pk.z = pack2(r[4], r[5]); pk.w = pack2(r[6], r[7]);
          *(uint4*)(p.yaT + ((size_t)b * HYW + c) * SEQ + s0) = pk;
        }
      }
    }
    __syncthreads();
  }
}

__device__ void attn_item(const Params& p, int l, int item, char* smem) {
  constexpr int KS = 72, VS = 96;
  bf16_t* Ks = (bf16_t*)smem;
  bf16_t* Vs = Ks + 384 * KS;
  const int tid = otid();
  const int lane = tid & 63, w = tid >> 6;
  const int kh = item & 1, qb = (item >> 1) & 15, b = item >> 5;
  const int kpos0 = qb * 128 - 128;
  __syncthreads();
  if (tid < 384) {
    const int r = tid, kpos = kpos0 + r;
    if (kpos >= 0 && kpos < SEQ) {
      const bf16_t* kr = p.zqkv + ((size_t)(b * SEQ + kpos)) * QKVC + 512 + kh * 64;
      float kf[64];
      float ss = 0.f;
#pragma unroll
      for (int c8 = 0; c8 < 8; ++c8) {
        uint4 v = *(const uint4*)(kr + c8 * 8);
        kf[c8 * 8 + 0] = lo2f(v.x); kf[c8 * 8 + 1] = hi2f(v.x); kf[c8 * 8 + 2] = lo2f(v.y); kf[c8 * 8 + 3] = hi2f(v.y);
        kf[c8 * 8 + 4] = lo2f(v.z); kf[c8 * 8 + 5] = hi2f(v.z); kf[c8 * 8 + 6] = lo2f(v.w); kf[c8 * 8 + 7] = hi2f(v.w);
      }
#pragma unroll
      for (int d = 0; d < 64; ++d) ss += kf[d] * kf[d];
      const float rs = rsqrtf(ss * (1.f / 64.f) + 1e-6f);
      const float* kg = p.k_gain + l * 64;
#pragma unroll
      for (int d = 0; d < 64; ++d) kf[d] = kf[d] * rs * kg[d];
      const float* rp = p.rope + (size_t)kpos * 64;
#pragma unroll
      for (int i = 0; i < 32; ++i) {
        const float cs = rp[i * 2], sn = rp[i * 2 + 1];
        const float a = kf[i], bb = kf[i + 32];
        kf[i] = a * cs - bb * sn; kf[i + 32] = bb * cs + a * sn;
      }
#pragma unroll
      for (int c8 = 0; c8 < 8; ++c8) {
        uint4 pk;
        pk.x = pack2(kf[c8 * 8 + 0], kf[c8 * 8 + 1]); pk.y = pack2(kf[c8 * 8 + 2], kf[c8 * 8 + 3]);
        pk.z = pack2(kf[c8 * 8 + 4], kf[c8 * 8 + 5]); pk.w = pack2(kf[c8 * 8 + 6], kf[c8 * 8 + 7]);
        *(uint4*)(Ks + r * KS + c8 * 8) = pk;
      }
    }
  }
#pragma unroll 1
  for (int e = tid; e < 384 * 8; e += NTHR) {
    const int r = e >> 3, c8 = e & 7, kpos = kpos0 + r;
    if (kpos >= 0 && kpos < SEQ)
      *(uint4*)(Vs + r * VS + c8 * 8) = *(const uint4*)(p.zqkv + ((size_t)(b * SEQ + kpos)) * QKVC + 640 + kh * 64 + c8 * 8);
  }
  __syncthreads();
  const int hl = w & 3, qh = w >> 2;
  const int head = kh * 4 + hl;
  const int n = lane & 31, hh = lane >> 5;
  const int Q0 = qb * 128 + 64 * qh;
  bf16x8 qf[2][4];
#pragma unroll
  for (int nt = 0; nt < 2; ++nt) {
    const int qpos = Q0 + 32 * nt + n;
    const bf16_t* qr = p.zqkv + ((size_t)(b * SEQ + qpos)) * QKVC + head * 64;
    float qv[4][8];
    float ss = 0.f;
#pragma unroll
    for (int kk = 0; kk < 4; ++kk) {
      uint4 v = *(const uint4*)(qr + 16 * kk + 8 * hh);
      qv[kk][0] = lo2f(v.x); qv[kk][1] = hi2f(v.x); qv[kk][2] = lo2f(v.y); qv[kk][3] = hi2f(v.y);
      qv[kk][4] = lo2f(v.z); qv[kk][5] = hi2f(v.z); qv[kk][6] = lo2f(v.w); qv[kk][7] = hi2f(v.w);
#pragma unroll
      for (int j = 0; j < 8; ++j) ss += qv[kk][j] * qv[kk][j];
    }
    ss += __shfl_xor(ss, 32, 64);
    const float rs = rsqrtf(ss * (1.f / 64.f) + 1e-6f) * 0.125f;
    const float* qg = p.q_gain + l * 64;
#pragma unroll
    for (int kk = 0; kk < 4; ++kk)
#pragma unroll
      for (int j = 0; j < 8; ++j) qv[kk][j] *= rs * qg[16 * kk + 8 * hh + j];
    const float* rp = p.rope + (size_t)qpos * 64;
#pragma unroll
    for (int kk = 0; kk < 2; ++kk)
#pragma unroll
      for (int j = 0; j < 8; ++j) {
        const int d = 16 * kk + 8 * hh + j;
        const float cs = rp[d * 2], sn = rp[d * 2 + 1];
        const float a = qv[kk][j], bb = qv[kk + 2][j];
        qv[kk][j] = a * cs - bb * sn; qv[kk + 2][j] = bb * cs + a * sn;
      }
#pragma unroll
    for (int kk = 0; kk < 4; ++kk)
#pragma unroll
      for (int j = 0; j < 8; ++j) qf[nt][kk][j] = (short)f2bf(qv[kk][j]);
  }
  f32x16 O[2][2];
#pragma unroll
  for (int dm = 0; dm < 2; ++dm)
#pragma unroll
    for (int nt = 0; nt < 2; ++nt)
#pragma unroll
      for (int r = 0; r < 16; ++r) O[dm][nt][r] = 0.f;
  float mrun[2], lsum[2];
  mrun[0] = mrun[1] = p.sink[l * 8 + head];
  lsum[0] = lsum[1] = (hh == 0) ? 1.f : 0.f;
  const int l16 = lane & 15, tq = l16 >> 2, tp = l16 & 3, g4 = lane >> 4;
  const bf16_t* vbase = Vs + (4 * (g4 >> 1) + tq) * VS + 16 * (g4 & 1) + 4 * tp;
#pragma unroll 1
  for (int kt = 2 * qh; kt < 2 * qh + 10; ++kt) {
    const int kp_t = kpos0 + 32 * kt;
    if (kp_t < 0 || kp_t >= SEQ) continue;
    bf16x8 kfr[4];
#pragma unroll
    for (int kk = 0; kk < 4; ++kk) kfr[kk] = *(const bf16x8*)(Ks + (32 * kt + n) * KS + 16 * kk + 8 * hh);
    bf16x8 pf[2][2];
#pragma unroll
    for (int nt = 0; nt < 2; ++nt) {
      f32x16 S;
#pragma unroll
      for (int r = 0; r < 16; ++r) S[r] = 0.f;
#pragma unroll
      for (int kk = 0; kk < 4; ++kk) S = __builtin_amdgcn_mfma_f32_32x32x16_bf16(kfr[kk], qf[nt][kk], S, 0, 0, 0);
      const int qpos = Q0 + 32 * nt + n;
      float mloc = -INFINITY;
#pragma unroll
      for (int r = 0; r < 16; ++r) {
        const int kpos = kp_t + (r & 3) + 8 * (r >> 2) + 4 * hh;
        int dd = kpos - qpos; dd = dd < 0 ? -dd : dd;
        S[r] = (dd <= 128) ? S[r] : -INFINITY;
        mloc = fmaxf(mloc, S[r]);
      }
      mloc = fmaxf(mloc, __shfl_xor(mloc, 32, 64));
      const float mnew = fmaxf(mrun[nt], mloc);
      const float corr = __expf(mrun[nt] - mnew);
      mrun[nt] = mnew;
      float psum = 0.f;
#pragma unroll
      for (int r = 0; r < 16; ++r) { S[r] = __expf(S[r] - mnew); psum += S[r]; }
      lsum[nt] = lsum[nt] * corr + psum;
#pragma unroll
      for (int dm = 0; dm < 2; ++dm)
#pragma unroll
        for (int r = 0; r < 16; ++r) O[dm][nt][r] *= corr;
#pragma unroll
      for (int s2 = 0; s2 < 2; ++s2)
#pragma unroll
        for (int j = 0; j < 8; ++j) pf[nt][s2][j] = (short)f2bf(S[8 * s2 + j]);
    }
#pragma unroll
    for (int dm = 0; dm < 2; ++dm)
#pragma unroll
      for (int s2 = 0; s2 < 2; ++s2) {
        const bf16_t* vp = vbase + (32 * kt + 16 * s2) * VS + 32 * dm;
        const s16x4 v0 = tr_read4(vp);
        const s16x4 v1 = tr_read4(vp + 8 * VS);
        bf16x8 vf;
        vf[0] = v0[0]; vf[1] = v0[1]; vf[2] = v0[2]; vf[3] = v0[3];
        vf[4] = v1[0]; vf[5] = v1[1]; vf[6] = v1[2]; vf[7] = v1[3];
#pragma unroll
        for (int nt = 0; nt < 2; ++nt) O[dm][nt] = __builtin_amdgcn_mfma_f32_32x32x16_bf16(vf, pf[nt][s2], O[dm][nt], 0, 0, 0);
      }
  }
#pragma unroll
  for (int nt = 0; nt < 2; ++nt) {
    const float ltot = lsum[nt] + __shfl_xor(lsum[nt], 32, 64);
    const float inv = 1.f / ltot;
    const int qpos = Q0 + 32 * nt + n;
    bf16_t* yo = p.yb + ((size_t)(b * SEQ + qpos)) * 512 + head * 64;
#pragma unroll
    for (int dm = 0; dm < 2; ++dm)
#pragma unroll
      for (int g = 0; g < 4; ++g) {
        uint2 o;
        o.x = pack2(O[dm][nt][4 * g + 0] * inv, O[dm][nt][4 * g + 1] * inv);
        o.y = pack2(O[dm][nt][4 * g + 2] * inv, O[dm][nt][4 * g + 3] * inv);
        *(uint2*)(yo + 32 * dm + 8 * g + 4 * hh) = o;
      }
  }
}

typedef float f32x2 __attribute__((ext_vector_type(2)));
__device__ void table_item(const Params& p, int l, int it) {
  const int tid = otid();
  const int lane = tid & 63, w = tid >> 6;
  const int which = it >> 9, r0 = (it & 511) * 32 + w * 4;
  const float* src = (which ? p.peer_v : p.peer_u) + (size_t)l * NEXP * DM;
  unsigned char* dst = which ? p.tabV8 : p.tabU8;
  float* sc = which ? p.sclV : p.sclU;
  float4 v[4][4];
#pragma unroll
  for (int rr = 0; rr < 4; ++rr)
#pragma unroll
    for (int i = 0; i < 4; ++i) v[rr][i] = *(const float4*)(src + (size_t)(r0 + rr) * DM + lane * 4 + 256 * i);
#pragma unroll
  for (int rr = 0; rr < 4; ++rr) {
    const int e = r0 + rr;
    float mx = 0.f;
#pragma unroll
    for (int i = 0; i < 4; ++i)
      mx = fmaxf(mx, fmaxf(fmaxf(fabsf(v[rr][i].x), fabsf(v[rr][i].y)), fmaxf(fabsf(v[rr][i].z), fabsf(v[rr][i].w))));
#pragma unroll
    for (int m = 32; m >= 1; m >>= 1) mx = fmaxf(mx, __shfl_xor(mx, m, 64));
    const float scale = (mx > 0.f) ? 440.f / mx : 1.f;
#pragma unroll
    for (int i = 0; i < 4; ++i) {
      int pk = __builtin_amdgcn_cvt_pk_fp8_f32(v[rr][i].x * scale, v[rr][i].y * scale, 0, false);
      pk = __builtin_amdgcn_cvt_pk_fp8_f32(v[rr][i].z * scale, v[rr][i].w * scale, pk, true);
      const int x = 2 * i + (lane >> 5);
      *(int*)(dst + ((size_t)x * NEXP + e) * 128 + (lane & 31) * 4) = pk;
    }
    if (lane == 0) sc[e] = (mx > 0.f) ? mx * (1.f / 440.f) : 1.f;
  }
}

constexpr int DE_N_HY = 512, DE_N_AT = 768, DE_N_TB = 1024;
__device__ void phase_de(const Params& p, int l, char* smem) {
  const int total = DE_N_HY + DE_N_AT + DE_N_TB + (l == 0 ? P0B_TOTAL : 0);
  for (int it = next_item(p.wq + 100 + l, smem); it < total; it = next_item(p.wq + 100 + l, smem)) {
    if (it < DE_N_HY) hyena_item(p, l, it, smem);
    else if (it < DE_N_HY + DE_N_AT) attn_item(p, l, it - DE_N_HY, smem);
    else if (it < DE_N_HY + DE_N_AT + DE_N_TB) table_item(p, l, it - DE_N_HY - DE_N_AT);
    else p0b_item(p, it - DE_N_HY - DE_N_AT - DE_N_TB, smem);
  }
}

__device__ void phase_f(const Params& p, int tile, int l, bool from_inputs, char* smem) {
  const int tid = otid();
  const int tok0 = tile * TM;
  const bf16_t* Ah = p.hbuf + (size_t)tok0 * DM;
  const bf16_t* Ayb = p.yb + (size_t)tok0 * HYW;
  const bf16_t* Win = p.WinT + (size_t)l * INC * DM;
  const bf16_t* Wpa = p.WpaT + (size_t)l * DM * HYW;
  const bf16_t* Wpb = p.WpbT + (size_t)l * DM * HYW;
  float* ct = (float*)smem;
  f32x16 acc[3][2];
  unsigned sgp[3][2][8];
#pragma unroll 1
  for (int nc = 0; nc < 8; ++nc) {
    gemm_f1<1>(Ah, Ah, DM, Win + (size_t)(2304 + nc * 128) * DM, Win + (size_t)(3328 + nc * 128) * DM, DM, smem, acc);
#pragma unroll
    for (int mi = 0; mi < 3; ++mi)
#pragma unroll
      for (int ni = 0; ni < 2; ++ni)
#pragma unroll
        for (int q = 0; q < 8; ++q)
          sgp[mi][ni][q] = pack2(__builtin_amdgcn_rcpf(1.f + __expf(-acc[mi][ni][2 * q])), __builtin_amdgcn_rcpf(1.f + __expf(-acc[mi][ni][2 * q + 1])));
    gemm_f1<2>(p.yaT, Ayb, HYW, Wpa + (size_t)(nc * 128) * HYW, Wpb + (size_t)(nc * 128) * HYW, HYW, smem, acc, tok0);
    {
      const int tid_ = otid(); const int lane = tid_ & 63, w = tid_ >> 6, wm = w >> 2, wn = w & 3;
      const int n = wn * 32 + (lane & 31);
#pragma unroll
      for (int mi = 0; mi < 3; ++mi)
#pragma unroll
        for (int q = 0; q < 8; ++q) {
          const float m0 = lo2f(sgp[mi][0][q]) * acc[mi][0][2 * q] + lo2f(sgp[mi][1][q]) * acc[mi][1][2 * q];
          const float m1 = hi2f(sgp[mi][0][q]) * acc[mi][0][2 * q + 1] + hi2f(sgp[mi][1][q]) * acc[mi][1][2 * q + 1];
          ct[ACC_ROW(wm, mi, 2 * q, lane) * 132 + n] = m0;
          ct[ACC_ROW(wm, mi, 2 * q + 1, lane) * 132 + n] = m1;
        }
    }
    lds_barrier();
    store_tile_bf16(ct, p.merged, DM, tok0, nc * 128);
  }
  __syncthreads();
  const bf16_t* Am = p.merged + (size_t)tok0 * DM;
  const bf16_t* Wo = p.WoutT + (size_t)l * DM * DM;
  f32x16 acc2[3][2];
#pragma unroll 1
  for (int nt = 0; nt < 4; ++nt) {
    gemm_core2<2>(Am, DM, Wo + (size_t)(nt * 256) * DM, DM, DM, smem, acc2);
#pragma unroll 1
    for (int half = 0; half < 2; ++half) {
      acc_to_lds<2>(acc2, ct, 132, half);
      lds_barrier();
#pragma unroll 4
      for (int it = tid; it < 192 * 32; it += NTHR) {
        const int c4 = it & 31, r = it >> 5;
        const int tok = tok0 + r, b = tok >> 11;
        const int n = nt * 256 + half * 128 + c4 * 4;
        const float4 a = *(const float4*)(ct + r * 132 + c4 * 4);
        const float4 gt = *(const float4*)(p.mod + ((size_t)l * NB + b) * 6144 + 2048 + n);
        const float* xs = from_inputs ? xrow_in(p, tok) : (p.out + (size_t)tok * DM);
        float4 xo = *(const float4*)(xs + n);
        xo.x += gt.x * a.x; xo.y += gt.y * a.y; xo.z += gt.z * a.z; xo.w += gt.w * a.w;
        *(float4*)(p.out + (size_t)tok * DM + n) = xo;
      }
      lds_barrier();
    }
  }
  __syncthreads();
}

__device__ __forceinline__ void sort16_desc(float (&v)[16]) {
#pragma unroll
  for (int k = 2; k <= 16; k <<= 1)
#pragma unroll
    for (int j = k >> 1; j >= 1; j >>= 1)
#pragma unroll
      for (int i = 0; i < 16; ++i) {
        const int l = i ^ j;
        if (l > i) {
          const float hi = fmaxf(v[i], v[l]), lo = fminf(v[i], v[l]);
          if ((i & k) == 0) { v[i] = hi; v[l] = lo; } else { v[i] = lo; v[l] = hi; }
        }
      }
}
__device__ __forceinline__ void merge16_desc(float (&top)[16], const float (&g)[16]) {
#pragma unroll
  for (int i = 0; i < 16; ++i) top[i] = fmaxf(top[i], g[15 - i]);
#pragma unroll
  for (int j = 8; j >= 1; j >>= 1)
#pragma unroll
    for (int i = 0; i < 16; ++i) {
      const int l = i ^ j;
      if (l > i) { const float hi = fmaxf(top[i], top[l]), lo = fminf(top[i], top[l]); top[i] = hi; top[l] = lo; }
    }
}
__device__ __forceinline__ void topk_insert(float (&key)[16], float kx) {
#pragma unroll
  for (int i = 0; i < 16; ++i) {
    const float hi = fmaxf(key[i], kx);
    kx = fminf(key[i], kx);
    key[i] = hi;
  }
}

__device__ void phase_g(const Params& p, int tile, int l, char* smem) {
  norm_rows(p, tile, l, 1, false, smem);
  const int tid = otid();
  const int tok0 = tile * TM;
  const bf16_t* Ah = p.hbuf + (size_t)tok0 * DM;
  const bf16_t* Wc = p.WcT + (size_t)l * 2048 * DM;
  float* sc = (float*)smem;
  f32x16 acc[3][2];
  float v1k[16], v2k[16];
#pragma unroll
  for (int i = 0; i < 16; ++i) { v1k[i] = 0.f; v2k[i] = 0.f; }
#pragma unroll 1
  for (int ch = 0; ch < 16; ++ch) {
    if ((ch & 1) == 0) gemm_core2<2>(Ah, DM, Wc + (size_t)(ch * 128) * DM, DM, DM, smem, acc);
    acc_to_lds<2>(acc, sc, 129, ch & 1);
    __syncthreads();
    float key[16];
    const int ttok = tid % TM, part = tid / TM;
    float* xch = (float*)(smem + 100352);
    if (tid < 2 * TM) {
      const float* row = sc + ttok * 129 + part * 64;
#pragma unroll
      for (int i = 0; i < 16; ++i) key[i] = __uint_as_float((__float_as_uint(row[i]) & 0xFFFFFF80u) | (unsigned)(part * 64 + i));
      sort16_desc(key);
#pragma unroll 1
      for (int j0 = 16; j0 < 64; j0 += 16) {
        float g[16];
#pragma unroll
        for (int i = 0; i < 16; ++i) g[i] = __uint_as_float((__float_as_uint(row[j0 + i]) & 0xFFFFFF80u) | (unsigned)(part * 64 + j0 + i));
        sort16_desc(g);
        merge16_desc(key, g);
      }
      if (part == 1) {
#pragma unroll
        for (int i = 0; i < 16; ++i) xch[ttok * 17 + i] = key[i];
      }
    }
    __syncthreads();
    if (tid < TM) {
      {
        float g[16];
#pragma unroll
        for (int i = 0; i < 16; ++i) g[i] = xch[tid * 17 + i];
        merge16_desc(key, g);
      }
      if ((ch & 1) == 0) {
#pragma unroll
        for (int i = 0; i < 16; ++i) v1k[i] = key[i];
      } else {
#pragma unroll
        for (int i = 0; i < 16; ++i) v2k[i] = key[i];
        float top[16], grp[16];
        {
          constexpr int CI[64] = {0,0,0,0,0,0,0,0,0,0,0,0,0,0,0,0, 1,1,1,1,1,1,1,1, 2,2,2,2,2, 3,3,3,3, 4,4,4, 5,5, 6,6, 7,7, 8,9,10,11,12,13,14,15, 0,0,0,0,0,0,0,0,0,0,0,0,0,0};
          constexpr int CJ[64] = {0,1,2,3,4,5,6,7,8,9,10,11,12,13,14,15, 0,1,2,3,4,5,6,7, 0,1,2,3,4, 0,1,2,3, 0,1,2, 0,1, 0,1, 0,1, 0,0,0,0,0,0,0,0, 0,0,0,0,0,0,0,0,0,0,0,0,0,0};
#pragma unroll
          for (int gq = 0; gq < 4; ++gq) {
#pragma unroll
            for (int i = 0; i < 16; ++i) {
              const int c = gq * 16 + i;
              if (c < 50) {
                const float sv = v1k[CI[c]] + v2k[CJ[c]];
                grp[i] = __uint_as_float((__float_as_uint(sv) & 0xFFFFFF00u) | (unsigned)(CI[c] * 16 + CJ[c]));
              } else grp[i] = -INFINITY;
            }
            sort16_desc(grp);
            if (gq == 0) {
#pragma unroll
              for (int i = 0; i < 16; ++i) top[i] = grp[i];
            } else merge16_desc(top, grp);
          }
        }
        const float mx = top[0];
        float ex[16], sum = 0.f;
#pragma unroll
        for (int k = 0; k < 16; ++k) { ex[k] = __expf(top[k] - mx); sum += ex[k]; }
        const float inv = 1.f / sum;
        const int hh = ch >> 1;
        const size_t ob = ((size_t)(tok0 + tid) * 8 + hh) * 16;
        unsigned char* ltab = (unsigned char*)(smem + 114688) + tid * 32;
#pragma unroll
        for (int q = 0; q < 4; ++q) {
          unsigned w1 = 0, w2 = 0;
#pragma unroll
          for (int b4 = 0; b4 < 4; ++b4) {
            w1 |= (__float_as_uint(v1k[4 * q + b4]) & 0x7Fu) << (8 * b4);
            w2 |= (__float_as_uint(v2k[4 * q + b4]) & 0x7Fu) << (8 * b4);
          }
          *(unsigned*)(ltab + 4 * q) = w1;
          *(unsigned*)(ltab + 16 + 4 * q) = w2;
        }
        unsigned ee[16];
#pragma unroll
        for (int k = 0; k < 16; ++k) {
          const unsigned code = __float_as_uint(top[k]) & 0xFFu;
          ee[k] = (unsigned)ltab[code >> 4] * 128u + (unsigned)ltab[16 + (code & 15u)];
        }
        uint4 i0, i1;
        i0.x = ee[0] | (ee[1] << 16); i0.y = ee[2] | (ee[3] << 16); i0.z = ee[4] | (ee[5] << 16); i0.w = ee[6] | (ee[7] << 16);
        i1.x = ee[8] | (ee[9] << 16); i1.y = ee[10] | (ee[11] << 16); i1.z = ee[12] | (ee[13] << 16); i1.w = ee[14] | (ee[15] << 16);
        *(uint4*)(p.pidx + ob) = i0; *(uint4*)(p.pidx + ob + 8) = i1;
#pragma unroll
        for (int q = 0; q < 4; ++q)
          *(float4*)(p.pg + ob + 4 * q) = make_float4(ex[4 * q] * inv, ex[4 * q + 1] * inv, ex[4 * q + 2] * inv, ex[4 * q + 3] * inv);
      }
    }
    __syncthreads();
  }
}

__device__ __forceinline__ unsigned xcc_id() { return (unsigned)__builtin_amdgcn_s_getreg((3 << 11) | 20) & 7u; }
__device__ __forceinline__ bool next_slice_item(unsigned* cnt, int& x, int& j, int& tries, char* smem, int tid) {
  int* sh = (int*)(smem + 8192);
  while (tries < 8) {
    __syncthreads();
    if (tid == 0) *sh = (int)atomicAdd(cnt + x, 1u);
    __syncthreads();
    j = *sh;
    if (j < I_NJ) return true;
    x = (x + 1) & 7; ++tries;
  }
  return false;
}
__device__ __forceinline__ float dpp_xor1(float v) { return __builtin_bit_cast(float, __builtin_amdgcn_update_dpp(0, __builtin_bit_cast(int, v), 0xB1, 0xF, 0xF, true)); }
__device__ __forceinline__ float dpp_xor2(float v) { return __builtin_bit_cast(float, __builtin_amdgcn_update_dpp(0, __builtin_bit_cast(int, v), 0x4E, 0xF, 0xF, true)); }
__device__ __forceinline__ float dpp_hmirror(float v) { return __builtin_bit_cast(float, __builtin_amdgcn_update_dpp(0, __builtin_bit_cast(int, v), 0x141, 0xF, 0xF, true)); }
__device__ __forceinline__ float dpp_ror8(float v) { return __builtin_bit_cast(float, __builtin_amdgcn_update_dpp(0, __builtin_bit_cast(int, v), 0x128, 0xF, 0xF, true)); }

struct I1Ctx { uint4 h0, h1, e0, e1; };
__device__ __forceinline__ void i1_load_ctx(const Params& p, int tok, int x, int g, int ch, I1Ctx& c) {
  const bf16_t* hr = p.hbuf + (size_t)tok * DM + x * 128 + ch * 16;
  c.h0 = *(const uint4*)hr; c.h1 = *(const uint4*)(hr + 8);
  const uint4* pi = (const uint4*)(p.pidx + (size_t)tok * 128 + g * 16);
  c.e0 = pi[0]; c.e1 = pi[1];
}
__device__ __forceinline__ void peer_issue_rows(const unsigned char* Tslice, unsigned lane_off, const uint4& e0, const uint4& e1, uint4 (&rows)[16]) {
  const unsigned ew[8] = {e0.x, e0.y, e0.z, e0.w, e1.x, e1.y, e1.z, e1.w};
#pragma unroll
  for (int rd = 0; rd < 16; ++rd) {
    const unsigned e = (ew[rd >> 1] >> (16 * (rd & 1))) & 0x3FFFu;
    rows[rd] = *(const uint4*)(Tslice + (e * 128u + lane_off));
  }
}
typedef _Float16 f16x2 __attribute__((ext_vector_type(2)));
__device__ __forceinline__ f16x2 bf2_to_h2(unsigned u) {
  f16x2 r; r[0] = (_Float16)lo2f(u); r[1] = (_Float16)hi2f(u); return r;
}
__device__ __forceinline__ void i1_compute(const I1Ctx& c, const uint4 (&rows)[16], bf16_t* dst, int ch) {
  f16x2 hs[8];
  hs[0] = bf2_to_h2(c.h0.x); hs[1] = bf2_to_h2(c.h0.y); hs[2] = bf2_to_h2(c.h0.z); hs[3] = bf2_to_h2(c.h0.w);
  hs[4] = bf2_to_h2(c.h1.x); hs[5] = bf2_to_h2(c.h1.y); hs[6] = bf2_to_h2(c.h1.z); hs[7] = bf2_to_h2(c.h1.w);
  float res[16];
#pragma unroll
  for (int rd = 0; rd < 16; ++rd) {
    const unsigned wd[4] = {rows[rd].x, rows[rd].y, rows[rd].z, rows[rd].w};
    float d0 = 0.f, d1 = 0.f;
#pragma unroll
    for (int q = 0; q < 4; ++q) {
      d0 = __builtin_amdgcn_fdot2(__builtin_amdgcn_cvt_scalef32_pk_f16_fp8((int)wd[q], 1.0f, false), hs[2 * q], d0, false);
      d1 = __builtin_amdgcn_fdot2(__builtin_amdgcn_cvt_scalef32_pk_f16_fp8((int)wd[q], 1.0f, true), hs[2 * q + 1], d1, false);
    }
    float d = d0 + d1;
    d += dpp_xor1(d); d += dpp_xor2(d); d += dpp_hmirror(d);
    res[rd] = d;
  }
  if (ch == 0) {
    uint4 o0, o1;
    o0.x = pack2(res[0], res[1]); o0.y = pack2(res[2], res[3]); o0.z = pack2(res[4], res[5]); o0.w = pack2(res[6], res[7]);
    o1.x = pack2(res[8], res[9]); o1.y = pack2(res[10], res[11]); o1.z = pack2(res[12], res[13]); o1.w = pack2(res[14], res[15]);
    *(uint4*)dst = o0; *(uint4*)(dst + 8) = o1;
  }
}

__device__ void phase_i1(const Params& p, int pass, char* smem) {
  const int tid = otid();
  const int lane = tid & 63, w = tid >> 6;
  const int g = lane >> 3, ch = lane & 7;
  int x = (int)xcc_id(), j = 0, tries = 0;
  while (next_slice_item(p.wq + pass * 8, x, j, tries, smem, tid)) {
    const unsigned char* Ux = p.tabU8 + (size_t)x * NEXP * 128;
    const unsigned loff = ch * 16;
    bf16_t* ap = p.apart + (size_t)x * NTOK * 128 + g * 16;
    const int tokb = j * I_TOK + w;
    I1Ctx c0, c1, c2;
    uint4 rowsA[16], rowsB[16];
    i1_load_ctx(p, tokb, x, g, ch, c0);
    i1_load_ctx(p, tokb + 8, x, g, ch, c1);
    i1_load_ctx(p, tokb + 16, x, g, ch, c2);
    peer_issue_rows(Ux, loff, c0.e0, c0.e1, rowsA);
#pragma unroll 1
    for (int i = 0; i < I_TW; i += 2) {
      I1Ctx c3, c4;
      peer_issue_rows(Ux, loff, c1.e0, c1.e1, rowsB);
      i1_load_ctx(p, tokb + 8 * min(i + 3, I_TW - 1), x, g, ch, c3);
      i1_compute(c0, rowsA, ap + (size_t)(tokb + 8 * i) * 128, ch);
      peer_issue_rows(Ux, loff, c2.e0, c2.e1, rowsA);
      i1_load_ctx(p, tokb + 8 * min(i + 4, I_TW - 1), x, g, ch, c4);
      i1_compute(c1, rowsB, ap + (size_t)(tokb + 8 * (i + 1)) * 128, ch);
      c0 = c2; c1 = c3; c2 = c4;
    }
  }
}

__device__ void phase_w(const Params& p) {
  const int tid = otid();
  const size_t npair8 = (size_t)NTOK * 128 / 8;
  for (size_t q8 = (size_t)blockIdx.x * NTHR + tid; q8 < npair8; q8 += (size_t)gridDim.x * NTHR) {
    const size_t q = q8 * 8;
    float a[8];
#pragma unroll
    for (int i = 0; i < 8; ++i) a[i] = 0.f;
#pragma unroll
    for (int xx = 0; xx < 8; ++xx) {
      const uint4 v = *(const uint4*)(p.apart + (size_t)xx * NTOK * 128 + q);
      a[0] += lo2f(v.x); a[1] += hi2f(v.x); a[2] += lo2f(v.y); a[3] += hi2f(v.y);
      a[4] += lo2f(v.z); a[5] += hi2f(v.z); a[6] += lo2f(v.w); a[7] += hi2f(v.w);
    }
    const float4 g0 = *(const float4*)(p.pg + q), g1 = *(const float4*)(p.pg + q + 4);
    const uint4 ev = *(const uint4*)(p.pidx + q);
    const unsigned ew[4] = {ev.x, ev.y, ev.z, ev.w};
    float su[8], sg[8];
    const float gg[8] = {g0.x, g0.y, g0.z, g0.w, g1.x, g1.y, g1.z, g1.w};
#pragma unroll
    for (int i = 0; i < 8; ++i) {
      const unsigned e = (ew[i >> 1] >> (16 * (i & 1))) & 0x3FFFu;
      su[i] = p.sclU[e];
      sg[i] = gg[i] * p.sclV[e];
    }
    float wv[8];
#pragma unroll
    for (int i = 0; i < 8; ++i) {
      const float av = a[i] * su[i];
      wv[i] = sg[i] * 0.5f * av * (1.f + erff(av * 0.70710678118654752f));
    }
    uint4 o; o.x = pack2(wv[0], wv[1]); o.y = pack2(wv[2], wv[3]); o.z = pack2(wv[4], wv[5]); o.w = pack2(wv[6], wv[7]);
    *(uint4*)(p.wbuf + q) = o;
  }
}

struct I2Ctx { uint4 e0, e1; };
struct I2XG { uint4 w0, w1; float2 xv, gt; };
__device__ __forceinline__ void i2_load_ctx(const Params& p, int tok, int l, int x, int g, int ch, I2Ctx& c) {
  const unsigned off = (unsigned)tok * 256u + (unsigned)g * 32u;
  const uint4* pi = (const uint4*)((const char*)p.pidx + off);
  c.e0 = pi[0]; c.e1 = pi[1];
}
__device__ __forceinline__ void i2_load_xg(const Params& p, int tok, int l, int x, int g, int ch, I2XG& c) {
  const unsigned off = (unsigned)tok * 256u + (unsigned)g * 32u;
  const uint4* pw = (const uint4*)((const char*)p.wbuf + off);
  c.w0 = pw[0]; c.w1 = pw[1];
  const unsigned col = (unsigned)(x * 128 + ch * 16 + 2 * g);
  c.xv = *(const float2*)((const char*)p.out + ((unsigned)tok * 4096u + col * 4u));
  c.gt = *(const float2*)((const char*)p.mod + ((unsigned)(l * NB + (tok >> 11)) * 24576u + 20480u + col * 4u));
}
__device__ __forceinline__ void i2_compute(const Params& p, const I2XG& xg, const uint4 (&rows)[16], int tok, int x, int g, int ch) {
  const unsigned ww[8] = {xg.w0.x, xg.w0.y, xg.w0.z, xg.w0.w, xg.w1.x, xg.w1.y, xg.w1.z, xg.w1.w};
  f32x2 acc[8];
#pragma unroll
  for (int i = 0; i < 8; ++i) acc[i] = f32x2{0.f, 0.f};
#pragma unroll
  for (int rd = 0; rd < 16; ++rd) {
    const unsigned wd[4] = {rows[rd].x, rows[rd].y, rows[rd].z, rows[rd].w};
    const float wsc = (rd & 1) ? hi2f(ww[rd >> 1]) : lo2f(ww[rd >> 1]);
    const f32x2 sw = {wsc, wsc};
#pragma unroll
    for (int q = 0; q < 4; ++q) {
      acc[2 * q] += sw * __builtin_amdgcn_cvt_pk_f32_fp8((int)wd[q], false);
      acc[2 * q + 1] += sw * __builtin_amdgcn_cvt_pk_f32_fp8((int)wd[q], true);
    }
  }
  float r[16];
#pragma unroll
  for (int i = 0; i < 8; ++i) { r[2 * i] = acc[i][0]; r[2 * i + 1] = acc[i][1]; }
  const bool b2 = (g & 4) != 0, b1 = (g & 2) != 0, b0 = (g & 1) != 0;
  float r8[8];
#pragma unroll
  for (int i = 0; i < 8; ++i) {
    const float snd = b2 ? r[i] : r[i + 8];
    const float kp = b2 ? r[i + 8] : r[i];
    r8[i] = kp + __shfl_xor(snd, 32, 64);
  }
  float r4[4];
#pragma unroll
  for (int i = 0; i < 4; ++i) {
    const float snd = b1 ? r8[i] : r8[i + 4];
    const float kp = b1 ? r8[i + 4] : r8[i];
    r4[i] = kp + __shfl_xor(snd, 16, 64);
  }
  float r2[2];
#pragma unroll
  for (int i = 0; i < 2; ++i) {
    const float snd = b0 ? r4[i] : r4[i + 2];
    const float kp = b0 ? r4[i + 2] : r4[i];
    r2[i] = kp + dpp_ror8(snd);
  }
  float2 o;
  o.x = xg.xv.x + xg.gt.x * r2[0];
  o.y = xg.xv.y + xg.gt.y * r2[1];
  *(float2*)((char*)p.out + ((unsigned)tok * 4096u + (unsigned)(x * 128 + ch * 16 + 2 * g) * 4u)) = o;
}

__device__ void phase_i2(const Params& p, int l, int pass, char* smem) {
  const int tid = otid();
  const int lane = tid & 63, w = tid >> 6;
  const int g = lane >> 3, ch = lane & 7;
  int x = (int)xcc_id(), j = 0, tries = 0;
  while (next_slice_item(p.wq + pass * 8, x, j, tries, smem, tid)) {
    const unsigned char* Vx = p.tabV8 + (size_t)x * NEXP * 128;
    const unsigned loff = ch * 16;
    const int tokb = j * I_TOK + w;
    I2Ctx c0, c1;
    I2XG xa, xb;
    uint4 rowsA[16], rowsB[16];
    i2_load_ctx(p, tokb, l, x, g, ch, c0);
    i2_load_ctx(p, tokb + 8, l, x, g, ch, c1);
    peer_issue_rows(Vx, loff, c0.e0, c0.e1, rowsA);
    i2_load_xg(p, tokb, l, x, g, ch, xa);
    i2_load_ctx(p, tokb + 8 * min(2, I_TW - 1), l, x, g, ch, c0);
#pragma unroll 1
    for (int i = 0; i < I_TW; i += 2) {
      __builtin_amdgcn_sched_barrier(0);
      peer_issue_rows(Vx, loff, c1.e0, c1.e1, rowsB);
      i2_load_xg(p, tokb + 8 * (i + 1), l, x, g, ch, xb);
      i2_load_ctx(p, tokb + 8 * min(i + 3, I_TW - 1), l, x, g, ch, c1);
      __builtin_amdgcn_sched_barrier(0);
      i2_compute(p, xa, rowsA, tokb + 8 * i, x, g, ch);
      __builtin_amdgcn_sched_barrier(0);
      peer_issue_rows(Vx, loff, c0.e0, c0.e1, rowsA);
      i2_load_xg(p, tokb + 8 * min(i + 2, I_TW - 1), l, x, g, ch, xa);
      i2_load_ctx(p, tokb + 8 * min(i + 4, I_TW - 1), l, x, g, ch, c0);
      __builtin_amdgcn_sched_barrier(0);
      i2_compute(p, xb, rowsB, tokb + 8 * (i + 1), x, g, ch);
      __builtin_amdgcn_sched_barrier(0);
    }
  }
}

__device__ __forceinline__ void grid_bar(unsigned* cnt, unsigned& epoch) {
  ++epoch;
  const unsigned target = epoch * gridDim.x;
  __syncthreads();
  if (threadIdx.x == 0) {
    __builtin_amdgcn_fence(__ATOMIC_RELEASE, "agent");
    asm volatile("s_waitcnt vmcnt(0)" ::: "memory");
    __hip_atomic_fetch_add(cnt, 1u, __ATOMIC_RELAXED, __HIP_MEMORY_SCOPE_AGENT);
    while (__hip_atomic_load(cnt, __ATOMIC_RELAXED, __HIP_MEMORY_SCOPE_AGENT) < target) __builtin_amdgcn_s_sleep(1);
    __builtin_amdgcn_fence(__ATOMIC_ACQUIRE, "agent");
    asm volatile("s_waitcnt vmcnt(0)" ::: "memory");
  }
  __syncthreads();
}

__global__ void __launch_bounds__(NTHR) mega_kernel(Params p) {
  extern __shared__ __attribute__((aligned(16))) char smem[];
  cg::grid_group grid = cg::this_grid();
  unsigned epoch = 0;
  phase_p0(p, smem);
  grid.sync();
  for (int l = 0; l < 2; ++l) {
    for (int tile = blockIdx.x; tile < NTILE; tile += gridDim.x) phase_c(p, tile, l, l == 0, smem);
    grid_bar(p.wq + 64, epoch);
    phase_de(p, l, smem);
    grid_bar(p.wq + 64, epoch);
    for (int tile = blockIdx.x; tile < NTILE; tile += gridDim.x) {
      phase_f(p, tile, l, l == 0, smem);
      phase_g(p, tile, l, smem);
    }
    grid_bar(p.wq + 64, epoch);
    phase_i1(p, 2 * l, smem);
    grid_bar(p.wq + 64, epoch);
    phase_w(p);
    grid_bar(p.wq + 64, epoch);
    phase_i2(p, l, 2 * l + 1, smem);
    if (l == 0) grid_bar(p.wq + 64, epoch);
  }
}

extern "C" void kernel_launch(void* const* d_in, const int* in_sizes, int n_in, void* d_out, int out_size, void* d_ws,
                              size_t ws_size, hipStream_t stream) {
  Params p{};
  const float* const* in = (const float* const*)d_in;
  p.x_prompt = in[0]; p.x_sample = in[1]; p.c_prompt = in[2]; p.c_sample = in[3]; p.w_mod = in[4]; p.b_mod = in[5];
  p.g1 = in[6]; p.g2 = in[7]; p.w_in = in[8]; p.conv_w = in[9]; p.conv_b = in[10]; p.f_w1 = in[11]; p.f_b1 = in[12];
  p.f_freq = in[13]; p.f_w2 = in[14]; p.f_b2 = in[15]; p.f_w3 = in[16]; p.f_bias = in[17]; p.q_gain = in[18];
  p.k_gain = in[19]; p.sink = in[20]; p.w_pa = in[21]; p.w_pb = in[22]; p.w_out = in[23]; p.peer_wq = in[24];
  p.peer_k1 = in[25]; p.peer_k2 = in[26]; p.peer_u = in[27]; p.peer_v = in[28];
  p.out = (float*)d_out;
  char* ws = (char*)d_ws;
  size_t off = 0;
  auto carve = [&](size_t bytes) { char* r = ws + off; off += (bytes + 255) & ~(size_t)255; return r; };
  p.WinT = (bf16_t*)carve((size_t)2 * INC * DM * 2);
  p.WpaT = (bf16_t*)carve((size_t)2 * DM * HYW * 2);
  p.WpbT = (bf16_t*)carve((size_t)2 * DM * HYW * 2);
  p.WoutT = (bf16_t*)carve((size_t)2 * DM * DM * 2);
  p.WcT = (bf16_t*)carve((size_t)2 * 2048 * DM * 2);
  p.Gf = (bf16_t*)carve((size_t)2 * 2 * 512 * 4096 * 2);
  p.mod = (float*)carve((size_t)2 * NB * 6144 * 4);
  p.rope = (float*)carve((size_t)SEQ * 64 * 4);
  p.tabU8 = (unsigned char*)carve((size_t)NEXP * DM);
  p.tabV8 = (unsigned char*)carve((size_t)NEXP * DM);
  p.sclU = (float*)carve((size_t)NEXP * 4);
  p.sclV = (float*)carve((size_t)NEXP * 4);
  p.wq = (unsigned*)carve(1024);
  p.zT = (bf16_t*)carve((size_t)NB * HYC * SEQ * 2);
  p.yaT = (bf16_t*)carve((size_t)NTOK * HYW * 2);
  p.yb = (bf16_t*)carve((size_t)NTOK * HYW * 2);
  p.zqkv = (bf16_t*)carve((size_t)NTOK * QKVC * 2);
  p.hbuf = (bf16_t*)carve((size_t)NTOK * DM * 2);
  p.merged = p.zT;
  p.yatok = p.zT + (size_t)NTOK * DM;
  p.apart = p.zT;
  p.pidx = (unsigned short*)p.zqkv;
  p.pg = (float*)(p.zqkv + (size_t)NTOK * 128);
  p.pgu = p.pg + (size_t)NTOK * 128;
  p.wbuf = (bf16_t*)(p.pgu + (size_t)NTOK * 128);
  if (off > ws_size) fprintf(stderr, "workspace too small: need %zu have %zu\n", off, ws_size);

  static int grid_blocks = 0;
  if (!grid_blocks) {
    int dev = 0, cus = 0, per_cu = 0;
    hipGetDevice(&dev);
    hipDeviceGetAttribute(&cus, hipDeviceAttributeMultiprocessorCount, dev);
    hipFuncSetAttribute((const void*)mega_kernel, hipFuncAttributeMaxDynamicSharedMemorySize, SMEM_BYTES);
    hipOccupancyMaxActiveBlocksPerMultiprocessor(&per_cu, mega_kernel, NTHR, SMEM_BYTES);
    if (per_cu < 1) per_cu = 1;
    grid_blocks = cus * 1;
    if (grid_blocks > NTILE) grid_blocks = NTILE;
  }
  hipMemsetAsync(p.wq, 0, 1024, stream);
  void* args[] = {&p};
  hipError_t e = hipLaunchCooperativeKernel((const void*)mega_kernel, dim3(grid_blocks), dim3(NTHR), args, SMEM_BYTES, stream);
  if (e != hipSuccess) fprintf(stderr, "cooperative launch failed: %s (grid %d)\n", hipGetErrorString(e), grid_blocks);
}
```

```cpp
#include <hip/hip_runtime.h>
#include <hip/hip_bf16.h>
#include <hip/hip_cooperative_groups.h>
#include <cstdio>
#include <cstdint>
namespace cg = cooperative_groups;

typedef unsigned short bf16_t;
using bf16x8 = __attribute__((ext_vector_type(8))) short;
using f32x16 = __attribute__((ext_vector_type(16))) float;

constexpr int DM = 1024;
constexpr int NB = 24;
constexpr int SEQ = 2048;
constexpr int NTOK = NB * SEQ;
constexpr int NBP = 16;
constexpr int INC = 4352;
constexpr int HYC = 1536;
constexpr int HYW = 512;
constexpr int QKVC = 768;
constexpr int TM = 192;
constexpr int NTILE = NTOK / TM;
constexpr int NTHR = 512;
constexpr int NEXP = 16384;
constexpr int SMEM_BYTES = 155648;
constexpr int I_TOK = 1536;
constexpr int I_NJ = NTOK / I_TOK;
constexpr int I_TW = I_TOK / 8;

struct Params {
  const float *x_prompt, *x_sample, *c_prompt, *c_sample, *w_mod, *b_mod, *g1, *g2, *w_in, *conv_w, *conv_b;
  const float *f_w1, *f_b1, *f_freq, *f_w2, *f_b2, *f_w3, *f_bias, *q_gain, *k_gain, *sink, *w_pa, *w_pb, *w_out;
  const float *peer_wq, *peer_k1, *peer_k2, *peer_u, *peer_v;
  float* out;
  bf16_t *WinT, *WpaT, *WpbT, *WoutT, *WcT, *Gf, *zT, *zqkv, *yaT, *yb, *hbuf, *merged, *yatok;
  unsigned char *tabU8, *tabV8;
  unsigned short* pidx;
  bf16_t* wbuf;
  float *pg, *pgu, *mod, *rope, *sclU, *sclV;
  bf16_t* apart;
  unsigned* wq;
};

__device__ __forceinline__ float bf2f(bf16_t v) { return __uint_as_float(((unsigned)v) << 16); }
__device__ __forceinline__ bf16_t f2bf(float f) {
  unsigned u = __float_as_uint(f);
  u += 0x7FFFu + ((u >> 16) & 1u);
  return (bf16_t)(u >> 16);
}
__device__ __forceinline__ unsigned pack2(float a, float b) { return (unsigned)f2bf(a) | ((unsigned)f2bf(b) << 16); }
__device__ __forceinline__ float lo2f(unsigned u) { return __uint_as_float(u << 16); }
__device__ __forceinline__ float hi2f(unsigned u) { return __uint_as_float(u & 0xFFFF0000u); }

__device__ __forceinline__ int otid() { int t = threadIdx.x; asm volatile("" : "+v"(t)); return t; }
__device__ __forceinline__ int osgpr(int x) { asm volatile("" : "+s"(x)); return x; }
__device__ __forceinline__ void lds_barrier() { asm volatile("s_waitcnt lgkmcnt(0)\n\ts_barrier" ::: "memory"); }
__device__ __forceinline__ float wave_sum(float v) {
#pragma unroll
  for (int m = 32; m >= 1; m >>= 1) v += __shfl_xor(v, m, 64);
  return v;
}

__device__ __forceinline__ const float* xrow_in(const Params& p, int tok) {
  return (tok < NBP * SEQ) ? (p.x_prompt + (size_t)tok * DM) : (p.x_sample + (size_t)(tok - NBP * SEQ) * DM);
}
__device__ __forceinline__ const float* crow(const Params& p, int b) {
  return (b < NBP) ? (p.c_prompt + (size_t)b * DM) : (p.c_sample + (size_t)(b - NBP) * DM);
}

__device__ __forceinline__ void glds16(const bf16_t* g, char* l) {
  __builtin_amdgcn_global_load_lds((const __attribute__((address_space(1))) void*)g, (__attribute__((address_space(3))) void*)l, 16, 0, 0);
}
template <int NT>
__device__ __forceinline__ void gemm_core2(const bf16_t* __restrict__ A, int lda, const bf16_t* __restrict__ B, int ldb,
                                           int K, char* lds, f32x16 (&acc)[3][NT]) {
  constexpr int BROWS = 128 * NT;
  constexpr int STAGE = (192 + BROWS) * 128;
  const int tid = otid();
  const int lane = tid & 63, w = tid >> 6;
  const int wm = w >> 2, wn = w & 3;
#pragma unroll
  for (int i = 0; i < 3; ++i)
#pragma unroll
    for (int n = 0; n < NT; ++n)
#pragma unroll
      for (int j = 0; j < 16; ++j) acc[i][n][j] = 0.f;
  const int lr = lane >> 3, lc = lane & 7;
  const bf16_t* pa[3];
  const bf16_t* pb[2 * NT];
#pragma unroll
  for (int i = 0; i < 3; ++i) {
    const int row = (w + 8 * i) * 8 + lr;
    pa[i] = A + (size_t)row * lda + ((lc ^ ((row >> 1) & 7)) * 8);
  }
#pragma unroll
  for (int i = 0; i < 2 * NT; ++i) {
    const int row = (w + 8 * i) * 8 + lr;
    pb[i] = B + (size_t)row * ldb + ((lc ^ ((row >> 1) & 7)) * 8);
  }
  const int nk = K >> 6;
  lds_barrier();
  {
#pragma unroll
    for (int i = 0; i < 3; ++i) glds16(pa[i], lds + (w + 8 * i) * 1024);
#pragma unroll
    for (int i = 0; i < 2 * NT; ++i) glds16(pb[i], lds + 192 * 128 + (w + 8 * i) * 1024);
  }
  asm volatile("s_waitcnt vmcnt(0)" ::: "memory");
  __syncthreads();
  const int fr = lane & 31, hh = lane >> 5;
  int aoff[3], akey[3], boff[NT], bkey[NT];
#pragma unroll
  for (int mi = 0; mi < 3; ++mi) { const int r = wm * 96 + mi * 32 + fr; aoff[mi] = r * 128; akey[mi] = (r >> 1) & 7; }
#pragma unroll
  for (int ni = 0; ni < NT; ++ni) { const int r = wn * 32 * NT + ni * 32 + fr; boff[ni] = 192 * 128 + r * 128; bkey[ni] = (r >> 1) & 7; }
#pragma unroll 1
  for (int kt = 0; kt < nk; ++kt) {
    if (kt + 1 < nk) {
      char* sb = lds + ((kt + 1) & 1) * STAGE;
      const int ko = (kt + 1) << 6;
#pragma unroll
      for (int i = 0; i < 3; ++i) glds16(pa[i] + ko, sb + (w + 8 * i) * 1024);
#pragma unroll
      for (int i = 0; i < 2 * NT; ++i) glds16(pb[i] + ko, sb + 192 * 128 + (w + 8 * i) * 1024);
    }
    const char* st = lds + (kt & 1) * STAGE;
    bf16x8 afr[2][3], bfr[2][NT];
#pragma unroll
    for (int ni = 0; ni < NT; ++ni) bfr[0][ni] = *(const bf16x8*)(st + boff[ni] + ((hh ^ bkey[ni]) << 4));
#pragma unroll
    for (int mi = 0; mi < 3; ++mi) afr[0][mi] = *(const bf16x8*)(st + aoff[mi] + ((hh ^ akey[mi]) << 4));
#pragma unroll
    for (int kk = 0; kk < 4; ++kk) {
      const int cur = kk & 1, nxt = cur ^ 1;
      if (kk < 3) {
        const int kc = 2 * (kk + 1) + hh;
#pragma unroll
        for (int ni = 0; ni < NT; ++ni) bfr[nxt][ni] = *(const bf16x8*)(st + boff[ni] + ((kc ^ bkey[ni]) << 4));
#pragma unroll
        for (int mi = 0; mi < 3; ++mi) afr[nxt][mi] = *(const bf16x8*)(st + aoff[mi] + ((kc ^ akey[mi]) << 4));
      }
      __builtin_amdgcn_sched_barrier(0);
#pragma unroll
      for (int mi = 0; mi < 3; ++mi)
#pragma unroll
        for (int ni = 0; ni < NT; ++ni) acc[mi][ni] = __builtin_amdgcn_mfma_f32_32x32x16_bf16(afr[cur][mi], bfr[cur][ni], acc[mi][ni], 0, 0, 0);
      __builtin_amdgcn_sched_barrier(0);
    }
    asm volatile("s_waitcnt vmcnt(0)" ::: "memory");
    __syncthreads();
  }
}
typedef short s16x4 __attribute__((ext_vector_type(4)));
__device__ __forceinline__ s16x4 tr_read4(const bf16_t* lds_ptr) {
  return __builtin_amdgcn_ds_read_tr16_b64_v4i16((__attribute__((address_space(3))) s16x4*)(lds_ptr));
}

template <int MODE>
__device__ __forceinline__ void gemm_f1(const bf16_t* __restrict__ A0, const bf16_t* __restrict__ A1, int lda,
                                        const bf16_t* __restrict__ B0, const bf16_t* __restrict__ B1, int ldb,
                                        char* lds, f32x16 (&acc)[3][2], int tok0 = 0) {
  constexpr int STAGE = (192 + 256) * 128;
  const int tid = otid();
  const int lane = tid & 63, w = tid >> 6;
  const int wm = w >> 2, wn = w & 3;
#pragma unroll
  for (int i = 0; i < 3; ++i)
#pragma unroll
    for (int n = 0; n < 2; ++n)
#pragma unroll
      for (int j = 0; j < 16; ++j) acc[i][n][j] = 0.f;
  const int lr = lane >> 3, lc = lane & 7;
  const bool hi = (w >= 4);
  int aofs[3];
  const bf16_t* pb[4];
#pragma unroll
  for (int i = 0; i < 3; ++i) {
    const int row = (w + 8 * i) * 8 + lr;
    aofs[i] = row * lda + ((lc ^ ((row >> 1) & 7)) * 8);
  }
#pragma unroll
  for (int i = 0; i < 4; ++i) {
    const int rb = (w + 8 * i) * 8 + lr;
    const int srow = i * 32 + (w & 3) * 8 + lr;
    pb[i] = (hi ? B1 : B0) + (size_t)srow * ldb + ((lc ^ ((rb >> 1) & 7)) * 8);
  }
  constexpr int NK = 16;
  int tofs[3];
  if (MODE == 2) {
#pragma unroll
    for (int i = 0; i < 3; ++i) {
      const int q = (w + 8 * i) * 64 + lane;
      const int k = q / 24, pos = q - k * 24;
      const int cch = pos ^ (((k >> 1) & 1) << 2);
      const int tok = tok0 + cch * 8;
      tofs[i] = (((tok >> 11) * HYW + k) * SEQ) + (tok & 2047);
    }
  }
  auto issue = [&](int kt) {
    char* sb = lds + (kt & 1) * STAGE;
    const int ka = (MODE == 2) ? ((kt & 7) << 6) : (kt << 6);
    if (MODE == 2 && kt < 8) {
#pragma unroll
      for (int i = 0; i < 3; ++i) glds16(A0 + tofs[i] + (size_t)ka * SEQ, sb + (w + 8 * i) * 1024);
    } else {
      const bf16_t* Ab = (MODE == 2) ? A1 : A0;
#pragma unroll
      for (int i = 0; i < 3; ++i) glds16(Ab + aofs[i] + ka, sb + (w + 8 * i) * 1024);
    }
    if (MODE == 1 || ((kt >= 8) == hi)) {
#pragma unroll
      for (int i = 0; i < 4; ++i) glds16(pb[i] + ka, sb + 192 * 128 + (w + 8 * i) * 1024);
    }
  };
  lds_barrier();
  issue(0);
  asm volatile("s_waitcnt vmcnt(0)" ::: "memory");
  __syncthreads();
  const int fr = lane & 31, hh = lane >> 5;
  int aoff[3], akey[3], boff[2], bkey[2];
#pragma unroll
  for (int mi = 0; mi < 3; ++mi) { const int r = wm * 96 + mi * 32 + fr; aoff[mi] = r * 128; akey[mi] = (r >> 1) & 7; }
#pragma unroll
  for (int ni = 0; ni < 2; ++ni) { const int r = wn * 64 + ni * 32 + fr; boff[ni] = 192 * 128 + r * 128; bkey[ni] = (r >> 1) & 7; }
  int toff[3];
  if (MODE == 2) {
    const int g4 = lane >> 4, tq = (lane & 15) >> 2, tp = lane & 3;
    const int fk = ((tq >> 1) & 1) << 2;
#pragma unroll
    for (int mi = 0; mi < 3; ++mi) {
      const int chunk = wm * 12 + mi * 4 + 2 * (g4 & 1) + (tp >> 1);
      toff[mi] = (8 * (g4 >> 1) + tq) * 384 + ((chunk ^ fk) << 4) + (tp & 1) * 8;
    }
  }
#pragma unroll
  for (int hf = 0; hf < 2; ++hf) {
#pragma unroll 1
    for (int kt = hf * 8; kt < hf * 8 + 8; ++kt) {
      if (kt + 1 < NK) issue(kt + 1);
      const char* st = lds + (kt & 1) * STAGE;
#pragma unroll
      for (int kk = 0; kk < 4; ++kk) {
        const int kc = 2 * kk + hh;
        bf16x8 bfr[2];
#pragma unroll
        for (int ni = 0; ni < 2; ++ni) if (MODE == 1 || ni == hf) bfr[ni] = *(const bf16x8*)(st + boff[ni] + ((kc ^ bkey[ni]) << 4));
#pragma unroll
        for (int mi = 0; mi < 3; ++mi) {
          bf16x8 afr;
          if (MODE == 2 && hf == 0) {
            const s16x4 t0 = tr_read4((const bf16_t*)(st + toff[mi] + kk * 6144));
            const s16x4 t1 = tr_read4((const bf16_t*)(st + toff[mi] + kk * 6144 + 1536));
            afr[0] = t0[0]; afr[1] = t0[1]; afr[2] = t0[2]; afr[3] = t0[3];
            afr[4] = t1[0]; afr[5] = t1[1]; afr[6] = t1[2]; afr[7] = t1[3];
          } else {
            afr = *(const bf16x8*)(st + aoff[mi] + ((kc ^ akey[mi]) << 4));
          }
#pragma unroll
          for (int ni = 0; ni < 2; ++ni)
            if (MODE == 1 || ni == hf) acc[mi][ni] = __builtin_amdgcn_mfma_f32_32x32x16_bf16(afr, bfr[ni], acc[mi][ni], 0, 0, 0);
        }
      }
      asm volatile("s_waitcnt vmcnt(0)" ::: "memory");
      __syncthreads();
    }
  }
}

#define ACC_ROW(wm, mi, reg, lane) ((wm) * 96 + (mi) * 32 + ((reg) & 3) + 8 * ((reg) >> 2) + 4 * ((lane) >> 5))

template <int NT>
__device__ __forceinline__ void acc_to_lds(const f32x16 (&acc)[3][NT], float* ct, int LD, int half) {
  const int tid_ = otid(); const int lane = tid_ & 63, w = tid_ >> 6, wm = w >> 2, wn = w & 3;
  if (NT == 2 && (wn >> 1) != half) return;
#pragma unroll
  for (int ni = 0; ni < NT; ++ni) {
    const int n = (NT == 2 ? (wn & 1) * 64 : wn * 32) + ni * 32 + (lane & 31);
#pragma unroll
    for (int mi = 0; mi < 3; ++mi)
#pragma unroll
      for (int r = 0; r < 16; ++r) ct[ACC_ROW(wm, mi, r, lane) * LD + n] = acc[mi][ni][r];
  }
}
constexpr int LDT = 196;
template <int NT>
__device__ __forceinline__ void acc_to_lds_T(const f32x16 (&acc)[3][NT], float* ctT, int half) {
  const int tid_ = otid(); const int lane = tid_ & 63, w = tid_ >> 6, wm = w >> 2, wn = w & 3;
  if (NT == 2 && (wn >> 1) != half) return;
#pragma unroll
  for (int ni = 0; ni < NT; ++ni) {
    const int n = (NT == 2 ? (wn & 1) * 64 : wn * 32) + ni * 32 + (lane & 31);
#pragma unroll
    for (int mi = 0; mi < 3; ++mi)
#pragma unroll
      for (int g4 = 0; g4 < 4; ++g4) {
        const int r0 = wm * 96 + mi * 32 + 8 * g4 + 4 * (lane >> 5);
        float4 v; v.x = acc[mi][ni][g4 * 4 + 0]; v.y = acc[mi][ni][g4 * 4 + 1]; v.z = acc[mi][ni][g4 * 4 + 2]; v.w = acc[mi][ni][g4 * 4 + 3];
        *(float4*)(ctT + n * LDT + r0) = v;
      }
  }
}
__device__ __forceinline__ void store_tile_bf16(const float* ct, bf16_t* dst, int ldd, int tok0, int n0) {
#pragma unroll 1
  for (int it = otid(); it < 192 * 16; it += NTHR) {
    const int c8 = it & 15, r = it >> 4;
    const float4 a = *(const float4*)(ct + r * 132 + c8 * 8), b = *(const float4*)(ct + r * 132 + c8 * 8 + 4);
    uint4 o; o.x = pack2(a.x, a.y); o.y = pack2(a.z, a.w); o.z = pack2(b.x, b.y); o.w = pack2(b.z, b.w);
    *(uint4*)(dst + (size_t)(tok0 + r) * ldd + n0 + c8 * 8) = o;
  }
}

__device__ void p0_transpose_tile(const float* __restrict__ src, bf16_t* __restrict__ dst, int R, int C, int tr, int tc, char* smem) {
  float* t = (float*)smem;
  const int tid = otid();
  __syncthreads();
#pragma unroll
  for (int i = 0; i < 8; ++i) {
    int r = (tid >> 6) + 8 * i, c = tid & 63;
    t[r * 65 + c] = src[(size_t)(tr * 64 + r) * C + tc * 64 + c];
  }
  __syncthreads();
#pragma unroll
  for (int i = 0; i < 8; ++i) {
    int cc = (tid >> 6) + 8 * i, rr = tid & 63;
    dst[(size_t)(tc * 64 + cc) * R + tr * 64 + rr] = f2bf(t[rr * 65 + cc]);
  }
}

__device__ void p0_wc_item(const Params& p, int l, int ph, int kt, char* smem) {
  float* wqs = (float*)smem;
  float* ks = wqs + 64 * 129;
  const int tid = otid();
  const float* wq = p.peer_wq + (size_t)l * DM * 2048;
  const float* kk = ((ph & 1) ? p.peer_k2 : p.peer_k1) + (size_t)l * 128 * 128;
  __syncthreads();
  for (int e = tid; e < 64 * 128; e += NTHR) {
    int r = e >> 7, d = e & 127;
    wqs[r * 129 + d] = wq[(size_t)(kt * 64 + r) * 2048 + ph * 128 + d];
  }
  for (int e = tid; e < 128 * 128; e += NTHR) {
    int r = e >> 7, d = e & 127;
    ks[r * 129 + d] = kk[r * 128 + d];
  }
  __syncthreads();
  const int key = tid & 127, k0 = (tid >> 7) * 16;
  float acc[16];
#pragma unroll
  for (int i = 0; i < 16; ++i) acc[i] = 0.f;
  for (int d = 0; d < 128; ++d) {
    float kv = ks[key * 129 + d];
#pragma unroll
    for (int i = 0; i < 16; ++i) acc[i] += wqs[(k0 + i) * 129 + d] * kv;
  }
  bf16_t* dst = p.WcT + ((size_t)l * 2048 + ph * 128 + key) * DM + kt * 64 + k0;
  uint4 o0, o1;
  o0.x = pack2(acc[0], acc[1]); o0.y = pack2(acc[2], acc[3]); o0.z = pack2(acc[4], acc[5]); o0.w = pack2(acc[6], acc[7]);
  o1.x = pack2(acc[8], acc[9]); o1.y = pack2(acc[10], acc[11]); o1.z = pack2(acc[12], acc[13]); o1.w = pack2(acc[14], acc[15]);
  *(uint4*)dst = o0; *(uint4*)(dst + 8) = o1;
}

__device__ void p0_mod_item(const Params& p, int l, int cc, char* smem) {
  float* sc = (float*)smem;
  float* red = sc + 1024 * 24;
  const int tid = otid();
  __syncthreads();
  for (int e = tid; e < NB * DM; e += NTHR) {
    int b = e >> 10, k = e & 1023;
    float v = crow(p, b)[k];
    sc[k * 24 + b] = v / (1.f + __expf(-v));
  }
  __syncthreads();
  const int col = tid & 63, kg = tid >> 6;
  const int n = cc * 64 + col;
  float acc[24];
#pragma unroll
  for (int b = 0; b < 24; ++b) acc[b] = 0.f;
  const float* wm = p.w_mod + (size_t)l * DM * 6144 + n;
#pragma unroll 1
  for (int k0 = kg * 128; k0 < kg * 128 + 128; k0 += 8) {
    float wv[8];
#pragma unroll
    for (int j = 0; j < 8; ++j) wv[j] = wm[(size_t)(k0 + j) * 6144];
#pragma unroll
    for (int j = 0; j < 8; ++j) {
      const float4* s4 = (const float4*)(sc + (k0 + j) * 24);
#pragma unroll
      for (int q = 0; q < 6; ++q) {
        float4 sv = s4[q];
        acc[q * 4 + 0] += sv.x * wv[j]; acc[q * 4 + 1] += sv.y * wv[j]; acc[q * 4 + 2] += sv.z * wv[j]; acc[q * 4 + 3] += sv.w * wv[j];
      }
    }
  }
#pragma unroll
  for (int b = 0; b < 24; ++b) red[(kg * 24 + b) * 64 + col] = acc[b];
  __syncthreads();
  for (int e = tid; e < 24 * 64; e += NTHR) {
    const int b = e >> 6, c2 = e & 63;
    float sum = p.b_mod[l * 6144 + cc * 64 + c2];
#pragma unroll
    for (int g = 0; g < 8; ++g) sum += red[(g * 24 + b) * 64 + c2];
    p.mod[((size_t)l * NB + b) * 6144 + cc * 64 + c2] = sum;
  }
}

__device__ void p0_filter_item(const Params& p, int l, int tc, char* smem) {
  float* feat = (float*)smem;
  float* a1 = feat + 32 * 33;
  float* a2 = a1 + 32 * 64;
  bf16_t* stage = (bf16_t*)(a2 + 32 * 64);
  const int tid = otid();
  const int t0 = tc * 32;
  __syncthreads();
  for (int e = tid; e < 32 * 33; e += NTHR) {
    int pp = e / 33, f = e % 33;
    int ti = t0 + pp;
    float v;
    if (f == 0) v = (float)ti / (float)(SEQ - 1);
    else {
      int bi = (f - 1) & 15;
      float band = 1e-4f + (float)bi * ((15.f - 1e-4f) / 15.f);
      float wv = 2.0f * 3.14159265358979323846f * (float)ti / (float)SEQ;
      float arg = band * wv;
      v = (f <= 16) ? cosf(arg) : -sinf(arg);
    }
    feat[pp * 33 + f] = v;
  }
  __syncthreads();
  const float* w1 = p.f_w1 + l * 33 * 64; const float* b1 = p.f_b1 + l * 64; const float* fq = p.f_freq + l * 64;
  const float* w2 = p.f_w2 + l * 64 * 64; const float* b2 = p.f_b2 + l * 64;
  for (int e = tid; e < 32 * 64; e += NTHR) {
    int pp = e >> 6, j = e & 63;
    float s = b1[j];
    for (int f = 0; f < 33; ++f) s += feat[pp * 33 + f] * w1[f * 64 + j];
    a1[pp * 64 + j] = sinf(fq[j] * s);
  }
  __syncthreads();
  for (int e = tid; e < 32 * 64; e += NTHR) {
    int pp = e >> 6, j = e & 63;
    float s = b2[j];
    for (int i = 0; i < 64; ++i) s += a1[pp * 64 + i] * w2[i * 64 + j];
    a2[pp * 64 + j] = sinf(fq[j] * s);
  }
  __syncthreads();
  const float* w3 = p.f_w3 + (size_t)l * 64 * 2048;
  const float min_decay = logf(1e-2f) / 1.5f, max_decay = logf(1e-2f) / 0.3f;
  for (int q = 0; q < 4; ++q) {
    const int n = tid + 512 * q;
    const int c = n & 511;
    float wr[64];
#pragma unroll
    for (int i = 0; i < 64; ++i) wr[i] = w3[i * 2048 + n];
    const float delta = fabsf(min_decay + (max_decay - min_decay) * (float)c / 511.f);
    for (int pp = 0; pp < 32; ++pp) {
      float s = 0.f;
#pragma unroll
      for (int i = 0; i < 64; ++i) s += a2[pp * 64 + i] * wr[i];
      float tt = (float)(t0 + pp) / (float)(SEQ - 1);
      s *= __expf(-tt * delta);
      if (t0 + pp == 0 && ((n >> 9) & 1) == 0) s += p.f_bias[(l * 2 + (n >> 10)) * 512 + c];
      stage[n * 32 + pp] = f2bf(s);
    }
  }
  __syncthreads();
  for (int e = tid; e < 2048 * 32; e += NTHR) {
    int n = e >> 5, pp = e & 31;
    int o = n >> 10, d = (n >> 9) & 1, c = n & 511;
    int t = t0 + pp;
    bf16_t* g = p.Gf + ((size_t)((l * 2 + o) * 512 + c)) * 4096;
    if (d == 0) g[2048 - t] = stage[n * 32 + pp];
    else if (t >= 1) g[2048 + t] = stage[n * 32 + pp];
    if (t == 0 && d == 0) g[0] = 0;
  }
}

__device__ void p0_rope_item(const Params& p, int it) {
  int e = it * 512 + otid();
  int pos = e >> 5, i = e & 31;
  float inv = powf(10000.f, -(float)(2 * i) / 64.f);
  float ang = (float)pos * inv;
  p.rope[e * 2 + 0] = cosf(ang);
  p.rope[e * 2 + 1] = sinf(ang);
}

__device__ __forceinline__ int next_item(unsigned* cnt, char* smem) {
  int* sh = (int*)(smem + SMEM_BYTES - 16);
  __syncthreads();
  if (threadIdx.x == 0) *sh = (int)atomicAdd(cnt, 1u);
  __syncthreads();
  return *sh;
}

constexpr int P0_N_MOD = 2 * 96;
constexpr int P0_N_FILT = 2 * 64;
constexpr int P0_N_ROPE = 128;
constexpr int P0_N_WIN = 16 * 68;
constexpr int P0A_TOTAL = P0_N_FILT + P0_N_MOD + P0_N_ROPE + P0_N_WIN;
constexpr int P0_N_WC = 2 * 16 * 16;
constexpr int P0_N_SMALL = 8 * 16 + 8 * 16 + 16 * 16;
constexpr int P0B_TOTAL = P0_N_WC + P0_N_WIN + 2 * P0_N_SMALL;

__device__ __forceinline__ void p0_win_tile(const Params& p, int l, int j, char* smem) {
  p0_transpose_tile(p.w_in + (size_t)l * DM * INC, p.WinT + (size_t)l * INC * DM, DM, INC, j / 68, j % 68, smem);
}
__device__ void p0a_item(const Params& p, int i, char* smem) {
  if (i < P0_N_FILT) { p0_filter_item(p, i / 64, i % 64, smem); return; }
  i -= P0_N_FILT;
  if (i < P0_N_MOD) { p0_mod_item(p, i / 96, i % 96, smem); return; }
  i -= P0_N_MOD;
  if (i < P0_N_ROPE) { p0_rope_item(p, i); return; }
  i -= P0_N_ROPE;
  p0_win_tile(p, 0, i, smem);
}
__device__ void p0b_item(const Params& p, int i, char* smem) {
  if (i < P0_N_WC) { p0_wc_item(p, i >> 8, (i >> 4) & 15, i & 15, smem); return; }
  i -= P0_N_WC;
  if (i < P0_N_WIN) { p0_win_tile(p, 1, i, smem); return; }
  i -= P0_N_WIN;
  const int l = i / P0_N_SMALL; int j = i % P0_N_SMALL;
  if (j < 128) { p0_transpose_tile(p.w_pa + (size_t)l * HYW * DM, p.WpaT + (size_t)l * DM * HYW, HYW, DM, j / 16, j % 16, smem); return; }
  j -= 128;
  if (j < 128) { p0_transpose_tile(p.w_pb + (size_t)l * HYW * DM, p.WpbT + (size_t)l * DM * HYW, HYW, DM, j / 16, j % 16, smem); return; }
  j -= 128;
  p0_transpose_tile(p.w_out + (size_t)l * DM * DM, p.WoutT + (size_t)l * DM * DM, DM, DM, j / 16, j % 16, smem);
}
__device__ void phase_p0(const Params& p, char* smem) {
  for (int it = next_item(p.wq + 96, smem); it < P0A_TOTAL; it = next_item(p.wq + 96, smem)) p0a_item(p, it, smem);
}

__device__ void norm_rows(const Params& p, int tile, int l, int which, bool from_inputs, char* smem) {
  float* scl = (float*)smem;
  float* shf = scl + 2048;
  const int tid = otid(), lane = tid & 63, w = tid >> 6;
  const int tok0 = tile * TM;
  const int b0 = tok0 >> 11;
  const float* g = (which ? p.g2 : p.g1) + l * DM;
  __syncthreads();
  for (int e = tid; e < 2048; e += NTHR) {
    int bi = e >> 10, j = e & 1023;
    int b = b0 + bi; if (b > NB - 1) b = NB - 1;
    const float* m = p.mod + ((size_t)l * NB + b) * 6144 + which * 3072;
    scl[e] = g[j] * (1.f + m[1024 + j]);
    shf[e] = m[j];
  }
  __syncthreads();
#pragma unroll 1
  for (int r0 = w; r0 < TM; r0 += 32) {
    float4 v[4][4];
#pragma unroll
    for (int q = 0; q < 4; ++q) {
      const int tok = tok0 + r0 + 8 * q;
      const float* xr = from_inputs ? xrow_in(p, tok) : (p.out + (size_t)tok * DM);
#pragma unroll
      for (int i = 0; i < 4; ++i) v[q][i] = *(const float4*)(xr + lane * 4 + 256 * i);
    }
#pragma unroll
    for (int q = 0; q < 4; ++q) {
      const int tok = tok0 + r0 + 8 * q;
      const int bi = (tok >> 11) - b0;
      float ss = 0.f;
#pragma unroll
      for (int i = 0; i < 4; ++i) ss += v[q][i].x * v[q][i].x + v[q][i].y * v[q][i].y + v[q][i].z * v[q][i].z + v[q][i].w * v[q][i].w;
      ss = wave_sum(ss);
      const float rs = rsqrtf(ss * (1.f / DM) + 1e-6f);
#pragma unroll
      for (int i = 0; i < 4; ++i) {
        const int j = lane * 4 + 256 * i;
        const float4 sc4 = *(const float4*)(scl + bi * 1024 + j);
        const float4 sh4 = *(const float4*)(shf + bi * 1024 + j);
        uint2 o;
        o.x = pack2(v[q][i].x * rs * sc4.x + sh4.x, v[q][i].y * rs * sc4.y + sh4.y);
        o.y = pack2(v[q][i].z * rs * sc4.z + sh4.z, v[q][i].w * rs * sc4.w + sh4.w);
        *(uint2*)(p.hbuf + (size_t)tok * DM + j) = o;
      }
    }
  }
  __syncthreads();
}

__device__ void phase_c(const Params& p, int tile, int l, bool from_inputs, char* smem) {
  norm_rows(p, tile, l, 0, from_inputs, smem);
  const int tid = otid();
  const int tok0 = tile * TM;
  const bf16_t* A = p.hbuf + (size_t)tok0 * DM;
  const bf16_t* W = p.WinT + (size_t)l * INC * DM;
  float* ct = (float*)smem;
  f32x16 acc[3][2];
#pragma unroll 1
  for (int nt = 0; nt < 9; ++nt) {
    gemm_core2<2>(A, DM, W + (size_t)nt * 256 * DM, DM, DM, smem, acc);
#pragma unroll 1
    for (int half = 0; half < 2; ++half) {
      const int nc = nt * 2 + half;
      if (nc < 12) {
        acc_to_lds_T<2>(acc, ct, half);
        lds_barrier();
#pragma unroll 1
        for (int it = tid; it < 128 * 24; it += NTHR) {
          const int tg = it % 24, nl = it / 24;
          const float4 a = *(const float4*)(ct + nl * LDT + tg * 8), b4 = *(const float4*)(ct + nl * LDT + tg * 8 + 4);
          uint4 o; o.x = pack2(a.x, a.y); o.y = pack2(a.z, a.w); o.z = pack2(b4.x, b4.y); o.w = pack2(b4.z, b4.w);
          const int tok = tok0 + tg * 8;
          const int b = tok >> 11, sq = tok & 2047;
          *(uint4*)(p.zT + ((size_t)b * HYC + nc * 128 + nl) * SEQ + sq) = o;
        }
      } else {
        acc_to_lds<2>(acc, ct, 132, half);
        lds_barrier();
        store_tile_bf16(ct, p.zqkv, QKVC, tok0, nc * 128 - HYC);
      }
      lds_barrier();
    }
  }
}

__device__ __forceinline__ void load_conv8(const bf16_t* __restrict__ zrow, int s0, float w0, float w1, float w2, float cb, float (&o)[8]) {
  uint4 v = *(const uint4*)(zrow + s0);
  float z[10];
  z[0] = (s0 > 0) ? bf2f(zrow[s0 - 1]) : 0.f;
  z[1] = lo2f(v.x); z[2] = hi2f(v.x); z[3] = lo2f(v.y); z[4] = hi2f(v.y);
  z[5] = lo2f(v.z); z[6] = hi2f(v.z); z[7] = lo2f(v.w); z[8] = hi2f(v.w);
  z[9] = (s0 + 8 < SEQ) ? bf2f(zrow[s0 + 8]) : 0.f;
#pragma unroll
  for (int i = 0; i < 8; ++i) o[i] = z[i] * w0 + z[i + 1] * w1 + z[i + 2] * w2 + cb;
}

struct Conv8In { uint4 v; unsigned short l, r; };
__device__ __forceinline__ void conv8_load(const bf16_t* __restrict__ zrow, int s0, Conv8In& c) {
  c.v = *(const uint4*)(zrow + s0);
  c.l = (s0 > 0) ? zrow[s0 - 1] : (unsigned short)0;
  c.r = (s0 + 8 < SEQ) ? zrow[s0 + 8] : (unsigned short)0;
}
__device__ __forceinline__ void conv8_eval(const Conv8In& c, float w0, float w1, float w2, float cb, float (&o)[8]) {
  float z[10];
  z[0] = bf2f(c.l);
  z[1] = lo2f(c.v.x); z[2] = hi2f(c.v.x); z[3] = lo2f(c.v.y); z[4] = hi2f(c.v.y);
  z[5] = lo2f(c.v.z); z[6] = hi2f(c.v.z); z[7] = lo2f(c.v.w); z[8] = hi2f(c.v.w);
  z[9] = bf2f(c.r);
#pragma unroll
  for (int i = 0; i < 8; ++i) o[i] = z[i] * w0 + z[i + 1] * w1 + z[i + 2] * w2 + cb;
}


constexpr int HY_GS_ELEMS = 4112;
constexpr int HY_US_ROWS = 2072;
__device__ __forceinline__ void hyena_load_g(const Params& p, int l, int o, int c, bf16_t* Gs, int tid) {
  const bf16_t* g = p.Gf + ((size_t)((l * 2 + o) * 512 + c)) * 4096;
  *(uint4*)(Gs + 8 + tid * 8) = *(const uint4*)(g + tid * 8);
  if (tid == 0) { unsigned z = 0; asm volatile("" : "+v"(z)); const uint4 z4 = make_uint4(z, z, z, z); *(uint4*)Gs = z4; *(uint4*)(Gs + 4104) = z4; }
}

__device__ __forceinline__ void hyena_kloop(const bf16_t* Gs, const bf16_t* us, int rho, int lane, f32x16 (&acc)[8]) {
#pragma unroll
  for (int a = 0; a < 8; ++a)
#pragma unroll
    for (int j = 0; j < 16; ++j) acc[a][j] = 0.f;
  const int i = lane & 31, hh = lane >> 5;
  const bf16_t* ga = Gs + (2040 - 8 * i + 8 * hh) - 1792;
  const int l16 = lane & 15, q = l16 >> 2, pq = l16 & 3, g4 = lane >> 4;
  const bf16_t* ub = us + (rho + 8 * (g4 >> 1) + q) * 24 + 16 * (g4 & 1) + 4 * pq;
#pragma unroll 1
  for (int kap = 0; kap < 129; ++kap) {
    const s16x4 b0 = tr_read4(ub + kap * 384);
    const s16x4 b1 = tr_read4(ub + kap * 384 + 96);
    bf16x8 bfrag;
    bfrag[0] = b0[0]; bfrag[1] = b0[1]; bfrag[2] = b0[2]; bfrag[3] = b0[3];
    bfrag[4] = b1[0]; bfrag[5] = b1[1]; bfrag[6] = b1[2]; bfrag[7] = b1[3];
#pragma unroll
    for (int a = 0; a < 8; ++a) {
      const bf16x8 af = *(const bf16x8*)(ga + kap * 16 + 256 * (7 - a));
      acc[a] = __builtin_amdgcn_mfma_f32_32x32x16_bf16(af, bfrag, acc[a], 0, 0, 0);
    }
  }
}

__device__ __forceinline__ void hyena_acc_to_us(const f32x16 (&acc)[8], bf16_t* us, int rho, int lane) {
  const int n = lane & 31, hh = lane >> 5;
  if (n < 24) {
#pragma unroll
    for (int a = 0; a < 8; ++a)
#pragma unroll
      for (int r = 0; r < 16; ++r) {
        const int t = 256 * a + rho + 8 * ((r & 3) + 8 * (r >> 2) + 4 * hh);
        us[(t + 16) * 24 + n] = f2bf(acc[a][r]);
      }
  }
}

__device__ void hyena_item(const Params& p, int l, int c, char* smem) {
  bf16_t* Gs = (bf16_t*)smem;
  bf16_t* us = (bf16_t*)(smem + 8256);
  const int tid = otid();
  const int lane = tid & 63, w = tid >> 6;
  const float* cw = p.conv_w + (size_t)l * 3 * HYC;
  const float* cbp = p.conv_b + (size_t)l * HYC;
  __syncthreads();
  hyena_load_g(p, l, 0, c, Gs, tid);
  {
    unsigned z = 0; asm volatile("" : "+v"(z)); const uint4 z4 = make_uint4(z, z, z, z);
    if (tid < 48) *(uint4*)(us + tid * 8) = z4;
    else if (tid < 48 + 26) *(uint4*)(us + 2064 * 24 + (tid - 48) * 8) = z4;
  }
  {
    const float w0 = cw[c], w1 = cw[HYC + c], w2 = cw[2 * HYC + c], cb = cbp[c];
#pragma unroll 1
    for (int q0 = tid; q0 < 24 * 256; q0 += 6 * NTHR) {
      Conv8In cin[6];
#pragma unroll
      for (int j = 0; j < 6; ++j) {
        const int qq = q0 + j * NTHR;
        conv8_load(p.zT + ((size_t)(qq % 24) * HYC + c) * SEQ, (qq / 24) * 8, cin[j]);
      }
#pragma unroll
      for (int j = 0; j < 6; ++j) {
        const int qq = q0 + j * NTHR;
        const int b = qq % 24, s0 = (qq / 24) * 8;
        float v[8];
        conv8_eval(cin[j], w0, w1, w2, cb, v);
#pragma unroll
        for (int i = 0; i < 8; ++i) us[(s0 + i + 16) * 24 + b] = f2bf(v[i]);
      }
    }
  }
  __syncthreads();
  f32x16 acc[8];
#pragma unroll 1
  for (int o = 0; o < 2; ++o) {
    hyena_kloop(Gs, us, w, lane, acc);
    __syncthreads();
    hyena_acc_to_us(acc, us, w, lane);
    if (o == 0) hyena_load_g(p, l, 1, c, Gs, tid);
    __syncthreads();
    const int xc = (o == 0 ? 512 : 1024) + c;
    const float xw0 = cw[xc], xw1 = cw[HYC + xc], xw2 = cw[2 * HYC + xc], xcb = cbp[xc];
#pragma unroll 1
    for (int q0 = tid; q0 < 24 * 256; q0 += 6 * NTHR) {
      Conv8In cin[6];
#pragma unroll
      for (int j = 0; j < 6; ++j) {
        const int qq = q0 + j * NTHR;
        conv8_load(p.zT + ((size_t)(qq % 24) * HYC + xc) * SEQ, (qq / 24) * 8, cin[j]);
      }
#pragma unroll
      for (int j = 0; j < 6; ++j) {
        const int qq = q0 + j * NTHR;
        const int b = qq % 24, s0 = (qq / 24) * 8;
        float xv[8];
        conv8_eval(cin[j], xw0, xw1, xw2, xcb, xv);
        if (o == 0) {
#pragma unroll
          for (int i = 0; i < 8; ++i) {
            bf16_t* e = us + (s0 + i + 16) * 24 + b;
            *e = f2bf(bf2f(*e) * xv[i]);
          }
        } else {
          float r[8];
#pragma unroll
          for (int i = 0; i < 8; ++i) r[i] = bf2f(us[(s0 + i + 16) * 24 + b]) * xv[i];
          uint4 pk; pk.x = pack2(r[0], r[1]); pk.y = pack2(r[2], r[3]); pk.z = pack2(r[4], r[5]); pk.w = pack2(r[6], r[7]);
          *(uint4*)(p.yaT + ((size_t)b * HYW + c) * SEQ + s0) = pk;
        }
      }
    }
    __syncthreads();
  }
}

__device__ void attn_item(const Params& p, int l, int item, char* smem) {
  constexpr int KS = 72, VS = 96;
  bf16_t* Ks = (bf16_t*)smem;
  bf16_t* Vs = Ks + 384 * KS;
  const int tid = otid();
  const int lane = tid & 63, w = tid >> 6;
  const int kh = item & 1, qb = (item >> 1) & 15, b = item >> 5;
  const int kpos0 = qb * 128 - 128;
  __syncthreads();
  if (tid < 384) {
    const int r = tid, kpos = kpos0 + r;
    if (kpos >= 0 && kpos < SEQ) {
      const bf16_t* kr = p.zqkv + ((size_t)(b * SEQ + kpos)) * QKVC + 512 + kh * 64;
      float kf[64];
      float ss = 0.f;
#pragma unroll
      for (int c8 = 0; c8 < 8; ++c8) {
        uint4 v = *(const uint4*)(kr + c8 * 8);
        kf[c8 * 8 + 0] = lo2f(v.x); kf[c8 * 8 + 1] = hi2f(v.x); kf[c8 * 8 + 2] = lo2f(v.y); kf[c8 * 8 + 3] = hi2f(v.y);
        kf[c8 * 8 + 4] = lo2f(v.z); kf[c8 * 8 + 5] = hi2f(v.z); kf[c8 * 8 + 6] = lo2f(v.w); kf[c8 * 8 + 7] = hi2f(v.w);
      }
#pragma unroll
      for (int d = 0; d < 64; ++d) ss += kf[d] * kf[d];
      const float rs = rsqrtf(ss * (1.f / 64.f) + 1e-6f);
      const float* kg = p.k_gain + l * 64;
#pragma unroll
      for (int d = 0; d < 64; ++d) kf[d] = kf[d] * rs * kg[d];
      const float* rp = p.rope + (size_t)kpos * 64;
#pragma unroll
      for (int i = 0; i < 32; ++i) {
        const float cs = rp[i * 2], sn = rp[i * 2 + 1];
        const float a = kf[i], bb = kf[i + 32];
        kf[i] = a * cs - bb * sn; kf[i + 32] = bb * cs + a * sn;
      }
#pragma unroll
      for (int c8 = 0; c8 < 8; ++c8) {
        uint4 pk;
        pk.x = pack2(kf[c8 * 8 + 0], kf[c8 * 8 + 1]); pk.y = pack2(kf[c8 * 8 + 2], kf[c8 * 8 + 3]);
        pk.z = pack2(kf[c8 * 8 + 4], kf[c8 * 8 + 5]); pk.w = pack2(kf[c8 * 8 + 6], kf[c8 * 8 + 7]);
        *(uint4*)(Ks + r * KS + c8 * 8) = pk;
      }
    }
  }
#pragma unroll 1
  for (int e = tid; e < 384 * 8; e += NTHR) {
    const int r = e >> 3, c8 = e & 7, kpos = kpos0 + r;
    if (kpos >= 0 && kpos < SEQ)
      *(uint4*)(Vs + r * VS + c8 * 8) = *(const uint4*)(p.zqkv + ((size_t)(b * SEQ + kpos)) * QKVC + 640 + kh * 64 + c8 * 8);
  }
  __syncthreads();
  const int hl = w & 3, qh = w >> 2;
  const int head = kh * 4 + hl;
  const int n = lane & 31, hh = lane >> 5;
  const int Q0 = qb * 128 + 64 * qh;
  bf16x8 qf[2][4];
#pragma unroll
  for (int nt = 0; nt < 2; ++nt) {
    const int qpos = Q0 + 32 * nt + n;
    const bf16_t* qr = p.zqkv + ((size_t)(b * SEQ + qpos)) * QKVC + head * 64;
    float qv[4][8];
    float ss = 0.f;
#pragma unroll
    for (int kk = 0; kk < 4; ++kk) {
      uint4 v = *(const uint4*)(qr + 16 * kk + 8 * hh);
      qv[kk][0] = lo2f(v.x); qv[kk][1] = hi2f(v.x); qv[kk][2] = lo2f(v.y); qv[kk][3] = hi2f(v.y);
      qv[kk][4] = lo2f(v.z); qv[kk][5] = hi2f(v.z); qv[kk][6] = lo2f(v.w); qv[kk][7] = hi2f(v.w);
#pragma unroll
      for (int j = 0; j < 8; ++j) ss += qv[kk][j] * qv[kk][j];
    }
    ss += __shfl_xor(ss, 32, 64);
    const float rs = rsqrtf(ss * (1.f / 64.f) + 1e-6f) * 0.125f;
    const float* qg = p.q_gain + l * 64;
#pragma unroll
    for (int kk = 0; kk < 4; ++kk)
#pragma unroll
      for (int j = 0; j < 8; ++j) qv[kk][j] *= rs * qg[16 * kk + 8 * hh + j];
    const float* rp = p.rope + (size_t)qpos * 64;
#pragma unroll
    for (int kk = 0; kk < 2; ++kk)
#pragma unroll
      for (int j = 0; j < 8; ++j) {
        const int d = 16 * kk + 8 * hh + j;
        const float cs = rp[d * 2], sn = rp[d * 2 + 1];
        const float a = qv[kk][j], bb = qv[kk + 2][j];
        qv[kk][j] = a * cs - bb * sn; qv[kk + 2][j] = bb * cs + a * sn;
      }
#pragma unroll
    for (int kk = 0; kk < 4; ++kk)
#pragma unroll
      for (int j = 0; j < 8; ++j) qf[nt][kk][j] = (short)f2bf(qv[kk][j]);
  }
  f32x16 O[2][2];
#pragma unroll
  for (int dm = 0; dm < 2; ++dm)
#pragma unroll
    for (int nt = 0; nt < 2; ++nt)
#pragma unroll
      for (int r = 0; r < 16; ++r) O[dm][nt][r] = 0.f;
  float mrun[2], lsum[2];
  mrun[0] = mrun[1] = p.sink[l * 8 + head];
  lsum[0] = lsum[1] = (hh == 0) ? 1.f : 0.f;
  const int l16 = lane & 15, tq = l16 >> 2, tp = l16 & 3, g4 = lane >> 4;
  const bf16_t* vbase = Vs + (4 * (g4 >> 1) + tq) * VS + 16 * (g4 & 1) + 4 * tp;
#pragma unroll 1
  for (int kt = 2 * qh; kt < 2 * qh + 10; ++kt) {
    const int kp_t = kpos0 + 32 * kt;
    if (kp_t < 0 || kp_t >= SEQ) continue;
    bf16x8 kfr[4];
#pragma unroll
    for (int kk = 0; kk < 4; ++kk) kfr[kk] = *(const bf16x8*)(Ks + (32 * kt + n) * KS + 16 * kk + 8 * hh);
    bf16x8 pf[2][2];
#pragma unroll
    for (int nt = 0; nt < 2; ++nt) {
      f32x16 S;
#pragma unroll
      for (int r = 0; r < 16; ++r) S[r] = 0.f;
#pragma unroll
      for (int kk = 0; kk < 4; ++kk) S = __builtin_amdgcn_mfma_f32_32x32x16_bf16(kfr[kk], qf[nt][kk], S, 0, 0, 0);
      const int qpos = Q0 + 32 * nt + n;
      float mloc = -INFINITY;
#pragma unroll
      for (int r = 0; r < 16; ++r) {
        const int kpos = kp_t + (r & 3) + 8 * (r >> 2) + 4 * hh;
        int dd = kpos - qpos; dd = dd < 0 ? -dd : dd;
        S[r] = (dd <= 128) ? S[r] : -INFINITY;
        mloc = fmaxf(mloc, S[r]);
      }
      mloc = fmaxf(mloc, __shfl_xor(mloc, 32, 64));
      const float mnew = fmaxf(mrun[nt], mloc);
      const float corr = __expf(mrun[nt] - mnew);
      mrun[nt] = mnew;
      float psum = 0.f;
#pragma unroll
      for (int r = 0; r < 16; ++r) { S[r] = __expf(S[r] - mnew); psum += S[r]; }
      lsum[nt] = lsum[nt] * corr + psum;
#pragma unroll
      for (int dm = 0; dm < 2; ++dm)
#pragma unroll
        for (int r = 0; r < 16; ++r) O[dm][nt][r] *= corr;
#pragma unroll
      for (int s2 = 0; s2 < 2; ++s2)
#pragma unroll
        for (int j = 0; j < 8; ++j) pf[nt][s2][j] = (short)f2bf(S[8 * s2 + j]);
    }
#pragma unroll
    for (int dm = 0; dm < 2; ++dm)
#pragma unroll
      for (int s2 = 0; s2 < 2; ++s2) {
        const bf16_t* vp = vbase + (32 * kt + 16 * s2) * VS + 32 * dm;
        const s16x4 v0 = tr_read4(vp);
        const s16x4 v1 = tr_read4(vp + 8 * VS);
        bf16x8 vf;
        vf[0] = v0[0]; vf[1] = v0[1]; vf[2] = v0[2]; vf[3] = v0[3];
        vf[4] = v1[0]; vf[5] = v1[1]; vf[6] = v1[2]; vf[7] = v1[3];
#pragma unroll
        for (int nt = 0; nt < 2; ++nt) O[dm][nt] = __builtin_amdgcn_mfma_f32_32x32x16_bf16(vf, pf[nt][s2], O[dm][nt], 0, 0, 0);
      }
  }
#pragma unroll
  for (int nt = 0; nt < 2; ++nt) {
    const float ltot = lsum[nt] + __shfl_xor(lsum[nt], 32, 64);
    const float inv = 1.f / ltot;
    const int qpos = Q0 + 32 * nt + n;
    bf16_t* yo = p.yb + ((size_t)(b * SEQ + qpos)) * 512 + head * 64;
#pragma unroll
    for (int dm = 0; dm < 2; ++dm)
#pragma unroll
      for (int g = 0; g < 4; ++g) {
        uint2 o;
        o.x = pack2(O[dm][nt][4 * g + 0] * inv, O[dm][nt][4 * g + 1] * inv);
        o.y = pack2(O[dm][nt][4 * g + 2] * inv, O[dm][nt][4 * g + 3] * inv);
        *(uint2*)(yo + 32 * dm + 8 * g + 4 * hh) = o;
      }
  }
}

typedef float f32x2 __attribute__((ext_vector_type(2)));
__device__ void table_item(const Params& p, int l, int it) {
  const int tid = otid();
  const int lane = tid & 63, w = tid >> 6;
  const int which = it >> 9, r0 = (it & 511) * 32 + w * 4;
  const float* src = (which ? p.peer_v : p.peer_u) + (size_t)l * NEXP * DM;
  unsigned char* dst = which ? p.tabV8 : p.tabU8;
  float* sc = which ? p.sclV : p.sclU;
  float4 v[4][4];
#pragma unroll
  for (int rr = 0; rr < 4; ++rr)
#pragma unroll
    for (int i = 0; i < 4; ++i) v[rr][i] = *(const float4*)(src + (size_t)(r0 + rr) * DM + lane * 4 + 256 * i);
#pragma unroll
  for (int rr = 0; rr < 4; ++rr) {
    const int e = r0 + rr;
    float mx = 0.f;
#pragma unroll
    for (int i = 0; i < 4; ++i)
      mx = fmaxf(mx, fmaxf(fmaxf(fabsf(v[rr][i].x), fabsf(v[rr][i].y)), fmaxf(fabsf(v[rr][i].z), fabsf(v[rr][i].w))));
#pragma unroll
    for (int m = 32; m >= 1; m >>= 1) mx = fmaxf(mx, __shfl_xor(mx, m, 64));
    const float scale = (mx > 0.f) ? 440.f / mx : 1.f;
#pragma unroll
    for (int i = 0; i < 4; ++i) {
      int pk = __builtin_amdgcn_cvt_pk_fp8_f32(v[rr][i].x * scale, v[rr][i].y * scale, 0, false);
      pk = __builtin_amdgcn_cvt_pk_fp8_f32(v[rr][i].z * scale, v[rr][i].w * scale, pk, true);
      const int x = 2 * i + (lane >> 5);
      *(int*)(dst + ((size_t)x * NEXP + e) * 128 + (lane & 31) * 4) = pk;
    }
    if (lane == 0) sc[e] = (mx > 0.f) ? mx * (1.f / 440.f) : 1.f;
  }
}

constexpr int DE_N_HY = 512, DE_N_AT = 768, DE_N_TB = 1024;
__device__ void phase_de(const Params& p, int l, char* smem) {
  const int total = DE_N_HY + DE_N_AT + DE_N_TB + (l == 0 ? P0B_TOTAL : 0);
  for (int it = next_item(p.wq + 100 + l, smem); it < total; it = next_item(p.wq + 100 + l, smem)) {
    if (it < DE_N_HY) hyena_item(p, l, it, smem);
    else if (it < DE_N_HY + DE_N_AT) attn_item(p, l, it - DE_N_HY, smem);
    else if (it < DE_N_HY + DE_N_AT + DE_N_TB) table_item(p, l, it - DE_N_HY - DE_N_AT);
    else p0b_item(p, it - DE_N_HY - DE_N_AT - DE_N_TB, smem);
  }
}

__device__ void phase_f(const Params& p, int tile, int l, bool from_inputs, char* smem) {
  const int tid = otid();
  const int tok0 = tile * TM;
  const bf16_t* Ah = p.hbuf + (size_t)tok0 * DM;
  const bf16_t* Ayb = p.yb + (size_t)tok0 * HYW;
  const bf16_t* Win = p.WinT + (size_t)l * INC * DM;
  const bf16_t* Wpa = p.WpaT + (size_t)l * DM * HYW;
  const bf16_t* Wpb = p.WpbT + (size_t)l * DM * HYW;
  float* ct = (float*)smem;
  f32x16 acc[3][2];
  unsigned sgp[3][2][8];
#pragma unroll 1
  for (int nc = 0; nc < 8; ++nc) {
    gemm_f1<1>(Ah, Ah, DM, Win + (size_t)(2304 + nc * 128) * DM, Win + (size_t)(3328 + nc * 128) * DM, DM, smem, acc);
#pragma unroll
    for (int mi = 0; mi < 3; ++mi)
#pragma unroll
      for (int ni = 0; ni < 2; ++ni)
#pragma unroll
        for (int q = 0; q < 8; ++q)
          sgp[mi][ni][q] = pack2(__builtin_amdgcn_rcpf(1.f + __expf(-acc[mi][ni][2 * q])), __builtin_amdgcn_rcpf(1.f + __expf(-acc[mi][ni][2 * q + 1])));
    gemm_f1<2>(p.yaT, Ayb, HYW, Wpa + (size_t)(nc * 128) * HYW, Wpb + (size_t)(nc * 128) * HYW, HYW, smem, acc, tok0);
    {
      const int tid_ = otid(); const int lane = tid_ & 63, w = tid_ >> 6, wm = w >> 2, wn = w & 3;
      const int n = wn * 32 + (lane & 31);
#pragma unroll
      for (int mi = 0; mi < 3; ++mi)
#pragma unroll
        for (int q = 0; q < 8; ++q) {
          const float m0 = lo2f(sgp[mi][0][q]) * acc[mi][0][2 * q] + lo2f(sgp[mi][1][q]) * acc[mi][1][2 * q];
          const float m1 = hi2f(sgp[mi][0][q]) * acc[mi][0][2 * q + 1] + hi2f(sgp[mi][1][q]) * acc[mi][1][2 * q + 1];
          ct[ACC_ROW(wm, mi, 2 * q, lane) * 132 + n] = m0;
          ct[ACC_ROW(wm, mi, 2 * q + 1, lane) * 132 + n] = m1;
        }
    }
    lds_barrier();
    store_tile_bf16(ct, p.merged, DM, tok0, nc * 128);
  }
  __syncthreads();
  const bf16_t* Am = p.merged + (size_t)tok0 * DM;
  const bf16_t* Wo = p.WoutT + (size_t)l * DM * DM;
  f32x16 acc2[3][2];
#pragma unroll 1
  for (int nt = 0; nt < 4; ++nt) {
    gemm_core2<2>(Am, DM, Wo + (size_t)(nt * 256) * DM, DM, DM, smem, acc2);
#pragma unroll 1
    for (int half = 0; half < 2; ++half) {
      acc_to_lds<2>(acc2, ct, 132, half);
      lds_barrier();
#pragma unroll 4
      for (int it = tid; it < 192 * 32; it += NTHR) {
        const int c4 = it & 31, r = it >> 5;
        const int tok = tok0 + r, b = tok >> 11;
        const int n = nt * 256 + half * 128 + c4 * 4;
        const float4 a = *(const float4*)(ct + r * 132 + c4 * 4);
        const float4 gt = *(const float4*)(p.mod + ((size_t)l * NB + b) * 6144 + 2048 + n);
        const float* xs = from_inputs ? xrow_in(p, tok) : (p.out + (size_t)tok * DM);
        float4 xo = *(const float4*)(xs + n);
        xo.x += gt.x * a.x; xo.y += gt.y * a.y; xo.z += gt.z * a.z; xo.w += gt.w * a.w;
        *(float4*)(p.out + (size_t)tok * DM + n) = xo;
      }
      lds_barrier();
    }
  }
  __syncthreads();
}

__device__ __forceinline__ void sort16_desc(float (&v)[16]) {
#pragma unroll
  for (int k = 2; k <= 16; k <<= 1)
#pragma unroll
    for (int j = k >> 1; j >= 1; j >>= 1)
#pragma unroll
      for (int i = 0; i < 16; ++i) {
        const int l = i ^ j;
        if (l > i) {
          const float hi = fmaxf(v[i], v[l]), lo = fminf(v[i], v[l]);
          if ((i & k) == 0) { v[i] = hi; v[l] = lo; } else { v[i] = lo; v[l] = hi; }
        }
      }
}
__device__ __forceinline__ void merge16_desc(float (&top)[16], const float (&g)[16]) {
#pragma unroll
  for (int i = 0; i < 16; ++i) top[i] = fmaxf(top[i], g[15 - i]);
#pragma unroll
  for (int j = 8; j >= 1; j >>= 1)
#pragma unroll
    for (int i = 0; i < 16; ++i) {
      const int l = i ^ j;
      if (l > i) { const float hi = fmaxf(top[i], top[l]), lo = fminf(top[i], top[l]); top[i] = hi; top[l] = lo; }
    }
}
__device__ __forceinline__ void topk_insert(float (&key)[16], float kx) {
#pragma unroll
  for (int i = 0; i < 16; ++i) {
    const float hi = fmaxf(key[i], kx);
    kx = fminf(key[i], kx);
    key[i] = hi;
  }
}

__device__ void phase_g(const Params& p, int tile, int l, char* smem) {
  norm_rows(p, tile, l, 1, false, smem);
  const int tid = otid();
  const int tok0 = tile * TM;
  const bf16_t* Ah = p.hbuf + (size_t)tok0 * DM;
  const bf16_t* Wc = p.WcT + (size_t)l * 2048 * DM;
  float* sc = (float*)smem;
  f32x16 acc[3][2];
  float v1k[16], v2k[16];
#pragma unroll
  for (int i = 0; i < 16; ++i) { v1k[i] = 0.f; v2k[i] = 0.f; }
#pragma unroll 1
  for (int ch = 0; ch < 16; ++ch) {
    if ((ch & 1) == 0) gemm_core2<2>(Ah, DM, Wc + (size_t)(ch * 128) * DM, DM, DM, smem, acc);
    acc_to_lds<2>(acc, sc, 129, ch & 1);
    __syncthreads();
    float key[16];
    const int ttok = tid % TM, part = tid / TM;
    float* xch = (float*)(smem + 100352);
    if (tid < 2 * TM) {
      const float* row = sc + ttok * 129 + part * 64;
#pragma unroll
      for (int i = 0; i < 16; ++i) key[i] = __uint_as_float((__float_as_uint(row[i]) & 0xFFFFFF80u) | (unsigned)(part * 64 + i));
      sort16_desc(key);
#pragma unroll 1
      for (int j0 = 16; j0 < 64; j0 += 16) {
        float g[16];
#pragma unroll
        for (int i = 0; i < 16; ++i) g[i] = __uint_as_float((__float_as_uint(row[j0 + i]) & 0xFFFFFF80u) | (unsigned)(part * 64 + j0 + i));
        sort16_desc(g);
        merge16_desc(key, g);
      }
      if (part == 1) {
#pragma unroll
        for (int i = 0; i < 16; ++i) xch[ttok * 17 + i] = key[i];
      }
    }
    __syncthreads();
    if (tid < TM) {
      {
        float g[16];
#pragma unroll
        for (int i = 0; i < 16; ++i) g[i] = xch[tid * 17 + i];
        merge16_desc(key, g);
      }
      if ((ch & 1) == 0) {
#pragma unroll
        for (int i = 0; i < 16; ++i) v1k[i] = key[i];
      } else {
#pragma unroll
        for (int i = 0; i < 16; ++i) v2k[i] = key[i];
        float top[16], grp[16];
        {
          constexpr int CI[64] = {0,0,0,0,0,0,0,0,0,0,0,0,0,0,0,0, 1,1,1,1,1,1,1,1, 2,2,2,2,2, 3,3,3,3, 4,4,4, 5,5, 6,6, 7,7, 8,9,10,11,12,13,14,15, 0,0,0,0,0,0,0,0,0,0,0,0,0,0};
          constexpr int CJ[64] = {0,1,2,3,4,5,6,7,8,9,10,11,12,13,14,15, 0,1,2,3,4,5,6,7, 0,1,2,3,4, 0,1,2,3, 0,1,2, 0,1, 0,1, 0,1, 0,0,0,0,0,0,0,0, 0,0,0,0,0,0,0,0,0,0,0,0,0,0};
#pragma unroll
          for (int gq = 0; gq < 4; ++gq) {
#pragma unroll
            for (int i = 0; i < 16; ++i) {
              const int c = gq * 16 + i;
              if (c < 50) {
                const float sv = v1k[CI[c]] + v2k[CJ[c]];
                grp[i] = __uint_as_float((__float_as_uint(sv) & 0xFFFFFF00u) | (unsigned)(CI[c] * 16 + CJ[c]));
              } else grp[i] = -INFINITY;
            }
            sort16_desc(grp);
            if (gq == 0) {
#pragma unroll
              for (int i = 0; i < 16; ++i) top[i] = grp[i];
            } else merge16_desc(top, grp);
          }
        }
        const float mx = top[0];
        float ex[16], sum = 0.f;
#pragma unroll
        for (int k = 0; k < 16; ++k) { ex[k] = __expf(top[k] - mx); sum += ex[k]; }
        const float inv = 1.f / sum;
        const int hh = ch >> 1;
        const size_t ob = ((size_t)(tok0 + tid) * 8 + hh) * 16;
        unsigned char* ltab = (unsigned char*)(smem + 114688) + tid * 32;
#pragma unroll
        for (int q = 0; q < 4; ++q) {
          unsigned w1 = 0, w2 = 0;
#pragma unroll
          for (int b4 = 0; b4 < 4; ++b4) {
            w1 |= (__float_as_uint(v1k[4 * q + b4]) & 0x7Fu) << (8 * b4);
            w2 |= (__float_as_uint(v2k[4 * q + b4]) & 0x7Fu) << (8 * b4);
          }
          *(unsigned*)(ltab + 4 * q) = w1;
          *(unsigned*)(ltab + 16 + 4 * q) = w2;
        }
        unsigned ee[16];
#pragma unroll
        for (int k = 0; k < 16; ++k) {
          const unsigned code = __float_as_uint(top[k]) & 0xFFu;
          ee[k] = (unsigned)ltab[code >> 4] * 128u + (unsigned)ltab[16 + (code & 15u)];
        }
        uint4 i0, i1;
        i0.x = ee[0] | (ee[1] << 16); i0.y = ee[2] | (ee[3] << 16); i0.z = ee[4] | (ee[5] << 16); i0.w = ee[6] | (ee[7] << 16);
        i1.x = ee[8] | (ee[9] << 16); i1.y = ee[10] | (ee[11] << 16); i1.z = ee[12] | (ee[13] << 16); i1.w = ee[14] | (ee[15] << 16);
        *(uint4*)(p.pidx + ob) = i0; *(uint4*)(p.pidx + ob + 8) = i1;
#pragma unroll
        for (int q = 0; q < 4; ++q)
          *(float4*)(p.pg + ob + 4 * q) = make_float4(ex[4 * q] * inv, ex[4 * q + 1] * inv, ex[4 * q + 2] * inv, ex[4 * q + 3] * inv);
      }
    }
    __syncthreads();
  }
}

__device__ __forceinline__ unsigned xcc_id() { return (unsigned)__builtin_amdgcn_s_getreg((3 << 11) | 20) & 7u; }
__device__ __forceinline__ bool next_slice_item(unsigned* cnt, int& x, int& j, int& tries, char* smem, int tid) {
  int* sh = (int*)(smem + 8192);
  while (tries < 8) {
    __syncthreads();
    if (tid == 0) *sh = (int)atomicAdd(cnt + x, 1u);
    __syncthreads();
    j = *sh;
    if (j < I_NJ) return true;
    x = (x + 1) & 7; ++tries;
  }
  return false;
}
__device__ __forceinline__ float dpp_xor1(float v) { return __builtin_bit_cast(float, __builtin_amdgcn_update_dpp(0, __builtin_bit_cast(int, v), 0xB1, 0xF, 0xF, true)); }
__device__ __forceinline__ float dpp_xor2(float v) { return __builtin_bit_cast(float, __builtin_amdgcn_update_dpp(0, __builtin_bit_cast(int, v), 0x4E, 0xF, 0xF, true)); }
__device__ __forceinline__ float dpp_hmirror(float v) { return __builtin_bit_cast(float, __builtin_amdgcn_update_dpp(0, __builtin_bit_cast(int, v), 0x141, 0xF, 0xF, true)); }
__device__ __forceinline__ float dpp_ror8(float v) { return __builtin_bit_cast(float, __builtin_amdgcn_update_dpp(0, __builtin_bit_cast(int, v), 0x128, 0xF, 0xF, true)); }

struct I1Ctx { uint4 h0, h1, e0, e1; };
__device__ __forceinline__ void i1_load_ctx(const Params& p, int tok, int x, int g, int ch, I1Ctx& c) {
  const bf16_t* hr = p.hbuf + (size_t)tok * DM + x * 128 + ch * 16;
  c.h0 = *(const uint4*)hr; c.h1 = *(const uint4*)(hr + 8);
  const uint4* pi = (const uint4*)(p.pidx + (size_t)tok * 128 + g * 16);
  c.e0 = pi[0]; c.e1 = pi[1];
}
__device__ __forceinline__ void peer_issue_rows(const unsigned char* Tslice, unsigned lane_off, const uint4& e0, const uint4& e1, uint4 (&rows)[16]) {
  const unsigned ew[8] = {e0.x, e0.y, e0.z, e0.w, e1.x, e1.y, e1.z, e1.w};
#pragma unroll
  for (int rd = 0; rd < 16; ++rd) {
    const unsigned e = (ew[rd >> 1] >> (16 * (rd & 1))) & 0x3FFFu;
    rows[rd] = *(const uint4*)(Tslice + (e * 128u + lane_off));
  }
}
typedef _Float16 f16x2 __attribute__((ext_vector_type(2)));
__device__ __forceinline__ f16x2 bf2_to_h2(unsigned u) {
  f16x2 r; r[0] = (_Float16)lo2f(u); r[1] = (_Float16)hi2f(u); return r;
}
__device__ __forceinline__ void i1_compute(const I1Ctx& c, const uint4 (&rows)[16], bf16_t* dst, int ch) {
  f16x2 hs[8];
  hs[0] = bf2_to_h2(c.h0.x); hs[1] = bf2_to_h2(c.h0.y); hs[2] = bf2_to_h2(c.h0.z); hs[3] = bf2_to_h2(c.h0.w);
  hs[4] = bf2_to_h2(c.h1.x); hs[5] = bf2_to_h2(c.h1.y); hs[6] = bf2_to_h2(c.h1.z); hs[7] = bf2_to_h2(c.h1.w);
  float res[16];
#pragma unroll
  for (int rd = 0; rd < 16; ++rd) {
    const unsigned wd[4] = {rows[rd].x, rows[rd].y, rows[rd].z, rows[rd].w};
    float d0 = 0.f, d1 = 0.f;
#pragma unroll
    for (int q = 0; q < 4; ++q) {
      d0 = __builtin_amdgcn_fdot2(__builtin_amdgcn_cvt_scalef32_pk_f16_fp8((int)wd[q], 1.0f, false), hs[2 * q], d0, false);
      d1 = __builtin_amdgcn_fdot2(__builtin_amdgcn_cvt_scalef32_pk_f16_fp8((int)wd[q], 1.0f, true), hs[2 * q + 1], d1, false);
    }
    float d = d0 + d1;
    d += dpp_xor1(d); d += dpp_xor2(d); d += dpp_hmirror(d);
    res[rd] = d;
  }
  if (ch == 0) {
    uint4 o0, o1;
    o0.x = pack2(res[0], res[1]); o0.y = pack2(res[2], res[3]); o0.z = pack2(res[4], res[5]); o0.w = pack2(res[6], res[7]);
    o1.x = pack2(res[8], res[9]); o1.y = pack2(res[10], res[11]); o1.z = pack2(res[12], res[13]); o1.w = pack2(res[14], res[15]);
    *(uint4*)dst = o0; *(uint4*)(dst + 8) = o1;
  }
}

__device__ void phase_i1(const Params& p, int pass, char* smem) {
  const int tid = otid();
  const int lane = tid & 63, w = tid >> 6;
  const int g = lane >> 3, ch = lane & 7;
  int x = (int)xcc_id(), j = 0, tries = 0;
  while (next_slice_item(p.wq + pass * 8, x, j, tries, smem, tid)) {
    const unsigned char* Ux = p.tabU8 + (size_t)x * NEXP * 128;
    const unsigned loff = ch * 16;
    bf16_t* ap = p.apart + (size_t)x * NTOK * 128 + g * 16;
    const int tokb = j * I_TOK + w;
    I1Ctx c0, c1, c2;
    uint4 rowsA[16], rowsB[16];
    i1_load_ctx(p, tokb, x, g, ch, c0);
    i1_load_ctx(p, tokb + 8, x, g, ch, c1);
    i1_load_ctx(p, tokb + 16, x, g, ch, c2);
    peer_issue_rows(Ux, loff, c0.e0, c0.e1, rowsA);
#pragma unroll 1
    for (int i = 0; i < I_TW; i += 2) {
      I1Ctx c3, c4;
      peer_issue_rows(Ux, loff, c1.e0, c1.e1, rowsB);
      i1_load_ctx(p, tokb + 8 * min(i + 3, I_TW - 1), x, g, ch, c3);
      i1_compute(c0, rowsA, ap + (size_t)(tokb + 8 * i) * 128, ch);
      peer_issue_rows(Ux, loff, c2.e0, c2.e1, rowsA);
      i1_load_ctx(p, tokb + 8 * min(i + 4, I_TW - 1), x, g, ch, c4);
      i1_compute(c1, rowsB, ap + (size_t)(tokb + 8 * (i + 1)) * 128, ch);
      c0 = c2; c1 = c3; c2 = c4;
    }
  }
}

__device__ void phase_w(const Params& p) {
  const int tid = otid();
  const size_t npair8 = (size_t)NTOK * 128 / 8;
  for (size_t q8 = (size_t)blockIdx.x * NTHR + tid; q8 < npair8; q8 += (size_t)gridDim.x * NTHR) {
    const size_t q = q8 * 8;
    float a[8];
#pragma unroll
    for (int i = 0; i < 8; ++i) a[i] = 0.f;
#pragma unroll
    for (int xx = 0; xx < 8; ++xx) {
      const uint4 v = *(const uint4*)(p.apart + (size_t)xx * NTOK * 128 + q);
      a[0] += lo2f(v.x); a[1] += hi2f(v.x); a[2] += lo2f(v.y); a[3] += hi2f(v.y);
      a[4] += lo2f(v.z); a[5] += hi2f(v.z); a[6] += lo2f(v.w); a[7] += hi2f(v.w);
    }
    const float4 g0 = *(const float4*)(p.pg + q), g1 = *(const float4*)(p.pg + q + 4);
    const uint4 ev = *(const uint4*)(p.pidx + q);
    const unsigned ew[4] = {ev.x, ev.y, ev.z, ev.w};
    float su[8], sg[8];
    const float gg[8] = {g0.x, g0.y, g0.z, g0.w, g1.x, g1.y, g1.z, g1.w};
#pragma unroll
    for (int i = 0; i < 8; ++i) {
      const unsigned e = (ew[i >> 1] >> (16 * (i & 1))) & 0x3FFFu;
      su[i] = p.sclU[e];
      sg[i] = gg[i] * p.sclV[e];
    }
    float wv[8];
#pragma unroll
    for (int i = 0; i < 8; ++i) {
      const float av = a[i] * su[i];
      wv[i] = sg[i] * 0.5f * av * (1.f + erff(av * 0.70710678118654752f));
    }
    uint4 o; o.x = pack2(wv[0], wv[1]); o.y = pack2(wv[2], wv[3]); o.z = pack2(wv[4], wv[5]); o.w = pack2(wv[6], wv[7]);
    *(uint4*)(p.wbuf + q) = o;
  }
}

struct I2Ctx { uint4 e0, e1; };
struct I2XG { uint4 w0, w1; float2 xv, gt; };
__device__ __forceinline__ void i2_load_ctx(const Params& p, int tok, int l, int x, int g, int ch, I2Ctx& c) {
  const unsigned off = (unsigned)tok * 256u + (unsigned)g * 32u;
  const uint4* pi = (const uint4*)((const char*)p.pidx + off);
  c.e0 = pi[0]; c.e1 = pi[1];
}
__device__ __forceinline__ void i2_load_xg(const Params& p, int tok, int l, int x, int g, int ch, I2XG& c) {
  const unsigned off = (unsigned)tok * 256u + (unsigned)g * 32u;
  const uint4* pw = (const uint4*)((const char*)p.wbuf + off);
  c.w0 = pw[0]; c.w1 = pw[1];
  const unsigned col = (unsigned)(x * 128 + ch * 16 + 2 * g);
  c.xv = *(const float2*)((const char*)p.out + ((unsigned)tok * 4096u + col * 4u));
  c.gt = *(const float2*)((const char*)p.mod + ((unsigned)(l * NB + (tok >> 11)) * 24576u + 20480u + col * 4u));
}
__device__ __forceinline__ void i2_compute(const Params& p, const I2XG& xg, const uint4 (&rows)[16], int tok, int x, int g, int ch) {
  const unsigned ww[8] = {xg.w0.x, xg.w0.y, xg.w0.z, xg.w0.w, xg.w1.x, xg.w1.y, xg.w1.z, xg.w1.w};
  f32x2 acc[8];
#pragma unroll
  for (int i = 0; i < 8; ++i) acc[i] = f32x2{0.f, 0.f};
#pragma unroll
  for (int rd = 0; rd < 16; ++rd) {
    const unsigned wd[4] = {rows[rd].x, rows[rd].y, rows[rd].z, rows[rd].w};
    const float wsc = (rd & 1) ? hi2f(ww[rd >> 1]) : lo2f(ww[rd >> 1]);
    const f32x2 sw = {wsc, wsc};
#pragma unroll
    for (int q = 0; q < 4; ++q) {
      acc[2 * q] += sw * __builtin_amdgcn_cvt_pk_f32_fp8((int)wd[q], false);
      acc[2 * q + 1] += sw * __builtin_amdgcn_cvt_pk_f32_fp8((int)wd[q], true);
    }
  }
  float r[16];
#pragma unroll
  for (int i = 0; i < 8; ++i) { r[2 * i] = acc[i][0]; r[2 * i + 1] = acc[i][1]; }
  const bool b2 = (g & 4) != 0, b1 = (g & 2) != 0, b0 = (g & 1) != 0;
  float r8[8];
#pragma unroll
  for (int i = 0; i < 8; ++i) {
    const float snd = b2 ? r[i] : r[i + 8];
    const float kp = b2 ? r[i + 8] : r[i];
    r8[i] = kp + __shfl_xor(snd, 32, 64);
  }
  float r4[4];
#pragma unroll
  for (int i = 0; i < 4; ++i) {
    const float snd = b1 ? r8[i] : r8[i + 4];
    const float kp = b1 ? r8[i + 4] : r8[i];
    r4[i] = kp + __shfl_xor(snd, 16, 64);
  }
  float r2[2];
#pragma unroll
  for (int i = 0; i < 2; ++i) {
    const float snd = b0 ? r4[i] : r4[i + 2];
    const float kp = b0 ? r4[i + 2] : r4[i];
    r2[i] = kp + dpp_ror8(snd);
  }
  float2 o;
  o.x = xg.xv.x + xg.gt.x * r2[0];
  o.y = xg.xv.y + xg.gt.y * r2[1];
  *(float2*)((char*)p.out + ((unsigned)tok * 4096u + (unsigned)(x * 128 + ch * 16 + 2 * g) * 4u)) = o;
}

__device__ void phase_i2(const Params& p, int l, int pass, char* smem) {
  const int tid = otid();
  const int lane = tid & 63, w = tid >> 6;
  const int g = lane >> 3, ch = lane & 7;
  int x = (int)xcc_id(), j = 0, tries = 0;
  while (next_slice_item(p.wq + pass * 8, x, j, tries, smem, tid)) {
    const unsigned char* Vx = p.tabV8 + (size_t)x * NEXP * 128;
    const unsigned loff = ch * 16;
    const int tokb = j * I_TOK + w;
    I2Ctx c0, c1;
    I2XG xa, xb;
    uint4 rowsA[16], rowsB[16];
    i2_load_ctx(p, tokb, l, x, g, ch, c0);
    i2_load_ctx(p, tokb + 8, l, x, g, ch, c1);
    peer_issue_rows(Vx, loff, c0.e0, c0.e1, rowsA);
    i2_load_xg(p, tokb, l, x, g, ch, xa);
    i2_load_ctx(p, tokb + 8 * min(2, I_TW - 1), l, x, g, ch, c0);
#pragma unroll 1
    for (int i = 0; i < I_TW; i += 2) {
      __builtin_amdgcn_sched_barrier(0);
      peer_issue_rows(Vx, loff, c1.e0, c1.e1, rowsB);
      i2_load_xg(p, tokb + 8 * (i + 1), l, x, g, ch, xb);
      i2_load_ctx(p, tokb + 8 * min(i + 3, I_TW - 1), l, x, g, ch, c1);
      __builtin_amdgcn_sched_barrier(0);
      i2_compute(p, xa, rowsA, tokb + 8 * i, x, g, ch);
      __builtin_amdgcn_sched_barrier(0);
      peer_issue_rows(Vx, loff, c0.e0, c0.e1, rowsA);
      i2_load_xg(p, tokb + 8 * min(i + 2, I_TW - 1), l, x, g, ch, xa);
      i2_load_ctx(p, tokb + 8 * min(i + 4, I_TW - 1), l, x, g, ch, c0);
      __builtin_amdgcn_sched_barrier(0);
      i2_compute(p, xb, rowsB, tokb + 8 * (i + 1), x, g, ch);
      __builtin_amdgcn_sched_barrier(0);
    }
  }
}

__device__ __forceinline__ void grid_bar(unsigned* cnt, unsigned& epoch) {
  ++epoch;
  const unsigned target = epoch * gridDim.x;
  __syncthreads();
  if (threadIdx.x == 0) {
    __builtin_amdgcn_fence(__ATOMIC_RELEASE, "agent");
    asm volatile("s_waitcnt vmcnt(0)" ::: "memory");
    __hip_atomic_fetch_add(cnt, 1u, __ATOMIC_RELAXED, __HIP_MEMORY_SCOPE_AGENT);
    while (__hip_atomic_load(cnt, __ATOMIC_RELAXED, __HIP_MEMORY_SCOPE_AGENT) < target) __builtin_amdgcn_s_sleep(1);
    __builtin_amdgcn_fence(__ATOMIC_ACQUIRE, "agent");
    asm volatile("s_waitcnt vmcnt(0)" ::: "memory");
  }
  __syncthreads();
}

__global__ void __launch_bounds__(NTHR) mega_kernel(Params p) {
  extern __shared__ __attribute__((aligned(16))) char smem[];
  cg::grid_group grid = cg::this_grid();
  unsigned epoch = 0;
  phase_p0(p, smem);
  grid.sync();
  for (int l = 0; l < 2; ++l) {
    for (int tile = blockIdx.x; tile < NTILE; tile += gridDim.x) phase_c(p, tile, l, l == 0, smem);
    grid_bar(p.wq + 64, epoch);
    phase_de(p, l, smem);
    grid_bar(p.wq + 64, epoch);
    for (int tile = blockIdx.x; tile < NTILE; tile += gridDim.x) {
      phase_f(p, tile, l, l == 0, smem);
      phase_g(p, tile, l, smem);
    }
    grid_bar(p.wq + 64, epoch);
    phase_i1(p, 2 * l, smem);
    grid_bar(p.wq + 64, epoch);
    phase_w(p);
    grid_bar(p.wq + 64, epoch);
    phase_i2(p, l, 2 * l + 1, smem);
    if (l == 0) grid_bar(p.wq + 64, epoch);
  }
}

extern "C" void kernel_launch(void* const* d_in, const int* in_sizes, int n_in, void* d_out, int out_size, void* d_ws,
                              size_t ws_size, hipStream_t stream) {
  Params p{};
  const float* const* in = (const float* const*)d_in;
  p.x_prompt = in[0]; p.x_sample = in[1]; p.c_prompt = in[2]; p.c_sample = in[3]; p.w_mod = in[4]; p.b_mod = in[5];
  p.g1 = in[6]; p.g2 = in[7]; p.w_in = in[8]; p.conv_w = in[9]; p.conv_b = in[10]; p.f_w1 = in[11]; p.f_b1 = in[12];
  p.f_freq = in[13]; p.f_w2 = in[14]; p.f_b2 = in[15]; p.f_w3 = in[16]; p.f_bias = in[17]; p.q_gain = in[18];
  p.k_gain = in[19]; p.sink = in[20]; p.w_pa = in[21]; p.w_pb = in[22]; p.w_out = in[23]; p.peer_wq = in[24];
  p.peer_k1 = in[25]; p.peer_k2 = in[26]; p.peer_u = in[27]; p.peer_v = in[28];
  p.out = (float*)d_out;
  char* ws = (char*)d_ws;
  size_t off = 0;
  auto carve = [&](size_t bytes) { char* r = ws + off; off += (bytes + 255) & ~(size_t)255; return r; };
  p.WinT = (bf16_t*)carve((size_t)2 * INC * DM * 2);
  p.WpaT = (bf16_t*)carve((size_t)2 * DM * HYW * 2);
  p.WpbT = (bf16_t*)carve((size_t)2 * DM * HYW * 2);
  p.WoutT = (bf16_t*)carve((size_t)2 * DM * DM * 2);
  p.WcT = (bf16_t*)carve((size_t)2 * 2048 * DM * 2);
  p.Gf = (bf16_t*)carve((size_t)2 * 2 * 512 * 4096 * 2);
  p.mod = (float*)carve((size_t)2 * NB * 6144 * 4);
  p.rope = (float*)carve((size_t)SEQ * 64 * 4);
  p.tabU8 = (unsigned char*)carve((size_t)NEXP * DM);
  p.tabV8 = (unsigned char*)carve((size_t)NEXP * DM);
  p.sclU = (float*)carve((size_t)NEXP * 4);
  p.sclV = (float*)carve((size_t)NEXP * 4);
  p.wq = (unsigned*)carve(1024);
  p.zT = (bf16_t*)carve((size_t)NB * HYC * SEQ * 2);
  p.yaT = (bf16_t*)carve((size_t)NTOK * HYW * 2);
  p.yb = (bf16_t*)carve((size_t)NTOK * HYW * 2);
  p.zqkv = (bf16_t*)carve((size_t)NTOK * QKVC * 2);
  p.hbuf = (bf16_t*)carve((size_t)NTOK * DM * 2);
  p.merged = p.zT;
  p.yatok = p.zT + (size_t)NTOK * DM;
  p.apart = p.zT;
  p.pidx = (unsigned short*)p.zqkv;
  p.pg = (float*)(p.zqkv + (size_t)NTOK * 128);
  p.pgu = p.pg + (size_t)NTOK * 128;
  p.wbuf = (bf16_t*)(p.pgu + (size_t)NTOK * 128);
  if (off > ws_size) fprintf(stderr, "workspace too small: need %zu have %zu\n", off, ws_size);

  static int grid_blocks = 0;
  if (!grid_blocks) {
    int dev = 0, cus = 0, per_cu = 0;
    hipGetDevice(&dev);
    hipDeviceGetAttribute(&cus, hipDeviceAttributeMultiprocessorCount, dev);
    hipFuncSetAttribute((const void*)mega_kernel, hipFuncAttributeMaxDynamicSharedMemorySize, SMEM_BYTES);
    hipOccupancyMaxActiveBlocksPerMultiprocessor(&per_cu, mega_kernel, NTHR, SMEM_BYTES);
    if (per_cu < 1) per_cu = 1;
    grid_blocks = cus * 1;
    if (grid_blocks > NTILE) grid_blocks = NTILE;
  }
  hipMemsetAsync(p.wq, 0, 1024, stream);
  void* args[] = {&p};
  hipError_t e = hipLaunchCooperativeKernel((const void*)mega_kernel, dim3(grid_blocks), dim3(NTHR), args, SMEM_BYTES, stream);
  if (e != hipSuccess) fprintf(stderr, "cooperative launch failed: %s (grid %d)\n", hipGetErrorString(e), grid_blocks);
}
```

```cpp
#include <hip/hip_runtime.h>
#include <hip/hip_bf16.h>
#include <hip/hip_cooperative_groups.h>
#include <cstdio>
#include <cstdint>
namespace cg = cooperative_groups;

typedef unsigned short bf16_t;
using bf16x8 = __attribute__((ext_vector_type(8))) short;
using f32x16 = __attribute__((ext_vector_type(16))) float;

constexpr int DM = 1024;
constexpr int NB = 24;
constexpr int SEQ = 2048;
constexpr int NTOK = NB * SEQ;
constexpr int NBP = 16;
constexpr int INC = 4352;
constexpr int HYC = 1536;
constexpr int HYW = 512;
constexpr int QKVC = 768;
constexpr int TM = 192;
constexpr int NTILE = NTOK / TM;
constexpr int NTHR = 512;
constexpr int NEXP = 16384;
constexpr int SMEM_BYTES = 155648;
constexpr int I_TOK = 1536;
constexpr int I_NJ = NTOK / I_TOK;
constexpr int I_TW = I_TOK / 8;

struct Params {
  const float *x_prompt, *x_sample, *c_prompt, *c_sample, *w_mod, *b_mod, *g1, *g2, *w_in, *conv_w, *conv_b;
  const float *f_w1, *f_b1, *f_freq, *f_w2, *f_b2, *f_w3, *f_bias, *q_gain, *k_gain, *sink, *w_pa, *w_pb, *w_out;
  const float *peer_wq, *peer_k1, *peer_k2, *peer_u, *peer_v;
  float* out;
  bf16_t *WinT, *WpaT, *WpbT, *WoutT, *WcT, *Gf, *zT, *zqkv, *yaT, *yb, *hbuf, *merged, *yatok;
  unsigned char *tabU8, *tabV8;
  unsigned short* pidx;
  bf16_t* wbuf;
  float *pg, *pgu, *mod, *rope, *sclU, *sclV;
  bf16_t* apart;
  unsigned* wq;
};

__device__ __forceinline__ float bf2f(bf16_t v) { return __uint_as_float(((unsigned)v) << 16); }
__device__ __forceinline__ bf16_t f2bf(float f) {
  unsigned u = __float_as_uint(f);
  u += 0x7FFFu + ((u >> 16) & 1u);
  return (bf16_t)(u >> 16);
}
__device__ __forceinline__ unsigned pack2(float a, float b) { return (unsigned)f2bf(a) | ((unsigned)f2bf(b) << 16); }
__device__ __forceinline__ float lo2f(unsigned u) { return __uint_as_float(u << 16); }
__device__ __forceinline__ float hi2f(unsigned u) { return __uint_as_float(u & 0xFFFF0000u); }

__device__ __forceinline__ int otid() { int t = threadIdx.x; asm volatile("" : "+v"(t)); return t; }
__device__ __forceinline__ int osgpr(int x) { asm volatile("" : "+s"(x)); return x; }
__device__ __forceinline__ void lds_barrier() { asm volatile("s_waitcnt lgkmcnt(0)\n\ts_barrier" ::: "memory"); }
__device__ __forceinline__ float wave_sum(float v) {
#pragma unroll
  for (int m = 32; m >= 1; m >>= 1) v += __shfl_xor(v, m, 64);
  return v;
}

__device__ __forceinline__ const float* xrow_in(const Params& p, int tok) {
  return (tok < NBP * SEQ) ? (p.x_prompt + (size_t)tok * DM) : (p.x_sample + (size_t)(tok - NBP * SEQ) * DM);
}
__device__ __forceinline__ const float* crow(const Params& p, int b) {
  return (b < NBP) ? (p.c_prompt + (size_t)b * DM) : (p.c_sample + (size_t)(b - NBP) * DM);
}

__device__ __forceinline__ void glds16(const bf16_t* g, char* l) {
  __builtin_amdgcn_global_load_lds((const __attribute__((address_space(1))) void*)g, (__attribute__((address_space(3))) void*)l, 16, 0, 0);
}
template <int NT>
__device__ __forceinline__ void gemm_core2(const bf16_t* __restrict__ A, int lda, const bf16_t* __restrict__ B, int ldb,
                                           int K, char* lds, f32x16 (&acc)[3][NT]) {
  constexpr int BROWS = 128 * NT;
  constexpr int STAGE = (192 + BROWS) * 128;
  const int tid = otid();
  const int lane = tid & 63, w = tid >> 6;
  const int wm = w >> 2, wn = w & 3;
#pragma unroll
  for (int i = 0; i < 3; ++i)
#pragma unroll
    for (int n = 0; n < NT; ++n)
#pragma unroll
      for (int j = 0; j < 16; ++j) acc[i][n][j] = 0.f;
  const int lr = lane >> 3, lc = lane & 7;
  const bf16_t* pa[3];
  const bf16_t* pb[2 * NT];
#pragma unroll
  for (int i = 0; i < 3; ++i) {
    const int row = (w + 8 * i) * 8 + lr;
    pa[i] = A + (size_t)row * lda + ((lc ^ ((row >> 1) & 7)) * 8);
  }
#pragma unroll
  for (int i = 0; i < 2 * NT; ++i) {
    const int row = (w + 8 * i) * 8 + lr;
    pb[i] = B + (size_t)row * ldb + ((lc ^ ((row >> 1) & 7)) * 8);
  }
  const int nk = K >> 6;
  lds_barrier();
  {
#pragma unroll
    for (int i = 0; i < 3; ++i) glds16(pa[i], lds + (w + 8 * i) * 1024);
#pragma unroll
    for (int i = 0; i < 2 * NT; ++i) glds16(pb[i], lds + 192 * 128 + (w + 8 * i) * 1024);
  }
  asm volatile("s_waitcnt vmcnt(0)" ::: "memory");
  __syncthreads();
  const int fr = lane & 31, hh = lane >> 5;
  int aoff[3], akey[3], boff[NT], bkey[NT];
#pragma unroll
  for (int mi = 0; mi < 3; ++mi) { const int r = wm * 96 + mi * 32 + fr; aoff[mi] = r * 128; akey[mi] = (r >> 1) & 7; }
#pragma unroll
  for (int ni = 0; ni < NT; ++ni) { const int r = wn * 32 * NT + ni * 32 + fr; boff[ni] = 192 * 128 + r * 128; bkey[ni] = (r >> 1) & 7; }
#pragma unroll 1
  for (int kt = 0; kt < nk; ++kt) {
    if (kt + 1 < nk) {
      char* sb = lds + ((kt + 1) & 1) * STAGE;
      const int ko = (kt + 1) << 6;
#pragma unroll
      for (int i = 0; i < 3; ++i) glds16(pa[i] + ko, sb + (w + 8 * i) * 1024);
#pragma unroll
      for (int i = 0; i < 2 * NT; ++i) glds16(pb[i] + ko, sb + 192 * 128 + (w + 8 * i) * 1024);
    }
    const char* st = lds + (kt & 1) * STAGE;
    bf16x8 afr[2][3], bfr[2][NT];
#pragma unroll
    for (int ni = 0; ni < NT; ++ni) bfr[0][ni] = *(const bf16x8*)(st + boff[ni] + ((hh ^ bkey[ni]) << 4));
#pragma unroll
    for (int mi = 0; mi < 3; ++mi) afr[0][mi] = *(const bf16x8*)(st + aoff[mi] + ((hh ^ akey[mi]) << 4));
#pragma unroll
    for (int kk = 0; kk < 4; ++kk) {
      const int cur = kk & 1, nxt = cur ^ 1;
      if (kk < 3) {
        const int kc = 2 * (kk + 1) + hh;
#pragma unroll
        for (int ni = 0; ni < NT; ++ni) bfr[nxt][ni] = *(const bf16x8*)(st + boff[ni] + ((kc ^ bkey[ni]) << 4));
#pragma unroll
        for (int mi = 0; mi < 3; ++mi) afr[nxt][mi] = *(const bf16x8*)(st + aoff[mi] + ((kc ^ akey[mi]) << 4));
      }
      __builtin_amdgcn_sched_barrier(0);
#pragma unroll
      for (int mi = 0; mi < 3; ++mi)
#pragma unroll
        for (int ni = 0; ni < NT; ++ni) acc[mi][ni] = __builtin_amdgcn_mfma_f32_32x32x16_bf16(afr[cur][mi], bfr[cur][ni], acc[mi][ni], 0, 0, 0);
      __builtin_amdgcn_sched_barrier(0);
    }
    asm volatile("s_waitcnt vmcnt(0)" ::: "memory");
    __syncthreads();
  }
}
typedef short s16x4 __attribute__((ext_vector_type(4)));
__device__ __forceinline__ s16x4 tr_read4(const bf16_t* lds_ptr) {
  return __builtin_amdgcn_ds_read_tr16_b64_v4i16((__attribute__((address_space(3))) s16x4*)(lds_ptr));
}

template <int MODE>
__device__ __forceinline__ void gemm_f1(const bf16_t* __restrict__ A0, const bf16_t* __restrict__ A1, int lda,
                                        const bf16_t* __restrict__ B0, const bf16_t* __restrict__ B1, int ldb,
                                        char* lds, f32x16 (&acc)[3][2], int tok0 = 0) {
  constexpr int STAGE = (192 + 256) * 128;
  const int tid = otid();
  const int lane = tid & 63, w = tid >> 6;
  const int wm = w >> 2, wn = w & 3;
#pragma unroll
  for (int i = 0; i < 3; ++i)
#pragma unroll
    for (int n = 0; n < 2; ++n)
#pragma unroll
      for (int j = 0; j < 16; ++j) acc[i][n][j] = 0.f;
  const int lr = lane >> 3, lc = lane & 7;
  const bool hi = (w >= 4);
  int aofs[3];
  const bf16_t* pb[4];
#pragma unroll
  for (int i = 0; i < 3; ++i) {
    const int row = (w + 8 * i) * 8 + lr;
    aofs[i] = row * lda + ((lc ^ ((row >> 1) & 7)) * 8);
  }
#pragma unroll
  for (int i = 0; i < 4; ++i) {
    const int rb = (w + 8 * i) * 8 + lr;
    const int srow = i * 32 + (w & 3) * 8 + lr;
    pb[i] = (hi ? B1 : B0) + (size_t)srow * ldb + ((lc ^ ((rb >> 1) & 7)) * 8);
  }
  constexpr int NK = 16;
  int tofs[3];
  if (MODE == 2) {
#pragma unroll
    for (int i = 0; i < 3; ++i) {
      const int q = (w + 8 * i) * 64 + lane;
      const int k = q / 24, pos = q - k * 24;
      const int cch = pos ^ (((k >> 1) & 1) << 2);
      const int tok = tok0 + cch * 8;
      tofs[i] = (((tok >> 11) * HYW + k) * SEQ) + (tok & 2047);
    }
  }
  auto issue = [&](int kt) {
    char* sb = lds + (kt & 1) * STAGE;
    const int ka = (MODE == 2) ? ((kt & 7) << 6) : (kt << 6);
    if (MODE == 2 && kt < 8) {
#pragma unroll
      for (int i = 0; i < 3; ++i) glds16(A0 + tofs[i] + (size_t)ka * SEQ, sb + (w + 8 * i) * 1024);
    } else {
      const bf16_t* Ab = (MODE == 2) ? A1 : A0;
#pragma unroll
      for (int i = 0; i < 3; ++i) glds16(Ab + aofs[i] + ka, sb + (w + 8 * i) * 1024);
    }
    if (MODE == 1 || ((kt >= 8) == hi)) {
#pragma unroll
      for (int i = 0; i < 4; ++i) glds16(pb[i] + ka, sb + 192 * 128 + (w + 8 * i) * 1024);
    }
  };
  lds_barrier();
  issue(0);
  asm volatile("s_waitcnt vmcnt(0)" ::: "memory");
  __syncthreads();
  const int fr = lane & 31, hh = lane >> 5;
  int aoff[3], akey[3], boff[2], bkey[2];
#pragma unroll
  for (int mi = 0; mi < 3; ++mi) { const int r = wm * 96 + mi * 32 + fr; aoff[mi] = r * 128; akey[mi] = (r >> 1) & 7; }
#pragma unroll
  for (int ni = 0; ni < 2; ++ni) { const int r = wn * 64 + ni * 32 + fr; boff[ni] = 192 * 128 + r * 128; bkey[ni] = (r >> 1) & 7; }
  int toff[3];
  if (MODE == 2) {
    const int g4 = lane >> 4, tq = (lane & 15) >> 2, tp = lane & 3;
    const int fk = ((tq >> 1) & 1) << 2;
#pragma unroll
    for (int mi = 0; mi < 3; ++mi) {
      const int chunk = wm * 12 + mi * 4 + 2 * (g4 & 1) + (tp >> 1);
      toff[mi] = (8 * (g4 >> 1) + tq) * 384 + ((chunk ^ fk) << 4) + (tp & 1) * 8;
    }
  }
#pragma unroll
  for (int hf = 0; hf < 2; ++hf) {
#pragma unroll 1
    for (int kt = hf * 8; kt < hf * 8 + 8; ++kt) {
      if (kt + 1 < NK) issue(kt + 1);
      const char* st = lds + (kt & 1) * STAGE;
#pragma unroll
      for (int kk = 0; kk < 4; ++kk) {
        const int kc = 2 * kk + hh;
        bf16x8 bfr[2];
#pragma unroll
        for (int ni = 0; ni < 2; ++ni) if (MODE == 1 || ni == hf) bfr[ni] = *(const bf16x8*)(st + boff[ni] + ((kc ^ bkey[ni]) << 4));
#pragma unroll
        for (int mi = 0; mi < 3; ++mi) {
          bf16x8 afr;
          if (MODE == 2 && hf == 0) {
            const s16x4 t0 = tr_read4((const bf16_t*)(st + toff[mi] + kk * 6144));
            const s16x4 t1 = tr_read4((const bf16_t*)(st + toff[mi] + kk * 6144 + 1536));
            afr[0] = t0[0]; afr[1] = t0[1]; afr[2] = t0[2]; afr[3] = t0[3];
            afr[4] = t1[0]; afr[5] = t1[1]; afr[6] = t1[2]; afr[7] = t1[3];
          } else {
            afr = *(const bf16x8*)(st + aoff[mi] + ((kc ^ akey[mi]) << 4));
          }
#pragma unroll
          for (int ni = 0; ni < 2; ++ni)
            if (MODE == 1 || ni == hf) acc[mi][ni] = __builtin_amdgcn_mfma_f32_32x32x16_bf16(afr, bfr[ni], acc[mi][ni], 0, 0, 0);
        }
      }
      asm volatile("s_waitcnt vmcnt(0)" ::: "memory");
      __syncthreads();
    }
  }
}

#define ACC_ROW(wm, mi, reg, lane) ((wm) * 96 + (mi) * 32 + ((reg) & 3) + 8 * ((reg) >> 2) + 4 * ((lane) >> 5))

template <int NT>
__device__ __forceinline__ void acc_to_lds(const f32x16 (&acc)[3][NT], float* ct, int LD, int half) {
  const int tid_ = otid(); const int lane = tid_ & 63, w = tid_ >> 6, wm = w >> 2, wn = w & 3;
  if (NT == 2 && (wn >> 1) != half) return;
#pragma unroll
  for (int ni = 0; ni < NT; ++ni) {
    const int n = (NT == 2 ? (wn & 1) * 64 : wn * 32) + ni * 32 + (lane & 31);
#pragma unroll
    for (int mi = 0; mi < 3; ++mi)
#pragma unroll
      for (int r = 0; r < 16; ++r) ct[ACC_ROW(wm, mi, r, lane) * LD + n] = acc[mi][ni][r];
  }
}
constexpr int LDT = 196;
template <int NT>
__device__ __forceinline__ void acc_to_lds_T(const f32x16 (&acc)[3][NT], float* ctT, int half) {
  const int tid_ = otid(); const int lane = tid_ & 63, w = tid_ >> 6, wm = w >> 2, wn = w & 3;
  if (NT == 2 && (wn >> 1) != half) return;
#pragma unroll
  for (int ni = 0; ni < NT; ++ni) {
    const int n = (NT == 2 ? (wn & 1) * 64 : wn * 32) + ni * 32 + (lane & 31);
#pragma unroll
    for (int mi = 0; mi < 3; ++mi)
#pragma unroll
      for (int g4 = 0; g4 < 4; ++g4) {
        const int r0 = wm * 96 + mi * 32 + 8 * g4 + 4 * (lane >> 5);
        float4 v; v.x = acc[mi][ni][g4 * 4 + 0]; v.y = acc[mi][ni][g4 * 4 + 1]; v.z = acc[mi][ni][g4 * 4 + 2]; v.w = acc[mi][ni][g4 * 4 + 3];
        *(float4*)(ctT + n * LDT + r0) = v;
      }
  }
}
__device__ __forceinline__ void store_tile_bf16(const float* ct, bf16_t* dst, int ldd, int tok0, int n0) {
#pragma unroll 1
  for (int it = otid(); it < 192 * 16; it += NTHR) {
    const int c8 = it & 15, r = it >> 4;
    const float4 a = *(const float4*)(ct + r * 132 + c8 * 8), b = *(const float4*)(ct + r * 132 + c8 * 8 + 4);
    uint4 o; o.x = pack2(a.x, a.y); o.y = pack2(a.z, a.w); o.z = pack2(b.x, b.y); o.w = pack2(b.z, b.w);
    *(uint4*)(dst + (size_t)(tok0 + r) * ldd + n0 + c8 * 8) = o;
  }
}

__device__ void p0_transpose_tile(const float* __restrict__ src, bf16_t* __restrict__ dst, int R, int C, int tr, int tc, char* smem) {
  float* t = (float*)smem;
  const int tid = otid();
  __syncthreads();
#pragma unroll
  for (int i = 0; i < 8; ++i) {
    int r = (tid >> 6) + 8 * i, c = tid & 63;
    t[r * 65 + c] = src[(size_t)(tr * 64 + r) * C + tc * 64 + c];
  }
  __syncthreads();
#pragma unroll
  for (int i = 0; i < 8; ++i) {
    int cc = (tid >> 6) + 8 * i, rr = tid & 63;
    dst[(size_t)(tc * 64 + cc) * R + tr * 64 + rr] = f2bf(t[rr * 65 + cc]);
  }
}

__device__ void p0_wc_item(const Params& p, int l, int ph, int kt, char* smem) {
  float* wqs = (float*)smem;
  float* ks = wqs + 64 * 129;
  const int tid = otid();
  const float* wq = p.peer_wq + (size_t)l * DM * 2048;
  const float* kk = ((ph & 1) ? p.peer_k2 : p.peer_k1) + (size_t)l * 128 * 128;
  __syncthreads();
  for (int e = tid; e < 64 * 128; e += NTHR) {
    int r = e >> 7, d = e & 127;
    wqs[r * 129 + d] = wq[(size_t)(kt * 64 + r) * 2048 + ph * 128 + d];
  }
  for (int e = tid; e < 128 * 128; e += NTHR) {
    int r = e >> 7, d = e & 127;
    ks[r * 129 + d] = kk[r * 128 + d];
  }
  __syncthreads();
  const int key = tid & 127, k0 = (tid >> 7) * 16;
  float acc[16];
#pragma unroll
  for (int i = 0; i < 16; ++i) acc[i] = 0.f;
  for (int d = 0; d < 128; ++d) {
    float kv = ks[key * 129 + d];
#pragma unroll
    for (int i = 0; i < 16; ++i) acc[i] += wqs[(k0 + i) * 129 + d] * kv;
  }
  bf16_t* dst = p.WcT + ((size_t)l * 2048 + ph * 128 + key) * DM + kt * 64 + k0;
  uint4 o0, o1;
  o0.x = pack2(acc[0], acc[1]); o0.y = pack2(acc[2], acc[3]); o0.z = pack2(acc[4], acc[5]); o0.w = pack2(acc[6], acc[7]);
  o1.x = pack2(acc[8], acc[9]); o1.y = pack2(acc[10], acc[11]); o1.z = pack2(acc[12], acc[13]); o1.w = pack2(acc[14], acc[15]);
  *(uint4*)dst = o0; *(uint4*)(dst + 8) = o1;
}

__device__ void p0_mod_item(const Params& p, int l, int cc, char* smem) {
  float* sc = (float*)smem;
  float* red = sc + 1024 * 24;
  const int tid = otid();
  __syncthreads();
  for (int e = tid; e < NB * DM; e += NTHR) {
    int b = e >> 10, k = e & 1023;
    float v = crow(p, b)[k];
    sc[k * 24 + b] = v / (1.f + __expf(-v));
  }
  __syncthreads();
  const int col = tid & 63, kg = tid >> 6;
  const int n = cc * 64 + col;
  float acc[24];
#pragma unroll
  for (int b = 0; b < 24; ++b) acc[b] = 0.f;
  const float* wm = p.w_mod + (size_t)l * DM * 6144 + n;
#pragma unroll 1
  for (int k0 = kg * 128; k0 < kg * 128 + 128; k0 += 8) {
    float wv[8];
#pragma unroll
    for (int j = 0; j < 8; ++j) wv[j] = wm[(size_t)(k0 + j) * 6144];
#pragma unroll
    for (int j = 0; j < 8; ++j) {
      const float4* s4 = (const float4*)(sc + (k0 + j) * 24);
#pragma unroll
      for (int q = 0; q < 6; ++q) {
        float4 sv = s4[q];
        acc[q * 4 + 0] += sv.x * wv[j]; acc[q * 4 + 1] += sv.y * wv[j]; acc[q * 4 + 2] += sv.z * wv[j]; acc[q * 4 + 3] += sv.w * wv[j];
      }
    }
  }
#pragma unroll
  for (int b = 0; b < 24; ++b) red[(kg * 24 + b) * 64 + col] = acc[b];
  __syncthreads();
  for (int e = tid; e < 24 * 64; e += NTHR) {
    const int b = e >> 6, c2 = e & 63;
    float sum = p.b_mod[l * 6144 + cc * 64 + c2];
#pragma unroll
    for (int g = 0; g < 8; ++g) sum += red[(g * 24 + b) * 64 + c2];
    p.mod[((size_t)l * NB + b) * 6144 + cc * 64 + c2] = sum;
  }
}

__device__ void p0_filter_item(const Params& p, int l, int tc, char* smem) {
  float* feat = (float*)smem;
  float* a1 = feat + 32 * 33;
  float* a2 = a1 + 32 * 64;
  bf16_t* stage = (bf16_t*)(a2 + 32 * 64);
  const int tid = otid();
  const int t0 = tc * 32;
  __syncthreads();
  for (int e = tid; e < 32 * 33; e += NTHR) {
    int pp = e / 33, f = e % 33;
    int ti = t0 + pp;
    float v;
    if (f == 0) v = (float)ti / (float)(SEQ - 1);
    else {
      int bi = (f - 1) & 15;
      float band = 1e-4f + (float)bi * ((15.f - 1e-4f) / 15.f);
      float wv = 2.0f * 3.14159265358979323846f * (float)ti / (float)SEQ;
      float arg = band * wv;
      v = (f <= 16) ? cosf(arg) : -sinf(arg);
    }
    feat[pp * 33 + f] = v;
  }
  __syncthreads();
  const float* w1 = p.f_w1 + l * 33 * 64; const float* b1 = p.f_b1 + l * 64; const float* fq = p.f_freq + l * 64;
  const float* w2 = p.f_w2 + l * 64 * 64; const float* b2 = p.f_b2 + l * 64;
  for (int e = tid; e < 32 * 64; e += NTHR) {
    int pp = e >> 6, j = e & 63;
    float s = b1[j];
    for (int f = 0; f < 33; ++f) s += feat[pp * 33 + f] * w1[f * 64 + j];
    a1[pp * 64 + j] = sinf(fq[j] * s);
  }
  __syncthreads();
  for (int e = tid; e < 32 * 64; e += NTHR) {
    int pp = e >> 6, j = e & 63;
    float s = b2[j];
    for (int i = 0; i < 64; ++i) s += a1[pp * 64 + i] * w2[i * 64 + j];
    a2[pp * 64 + j] = sinf(fq[j] * s);
  }
  __syncthreads();
  const float* w3 = p.f_w3 + (size_t)l * 64 * 2048;
  const float min_decay = logf(1e-2f) / 1.5f, max_decay = logf(1e-2f) / 0.3f;
  for (int q = 0; q < 4; ++q) {
    const int n = tid + 512 * q;
    const int c = n & 511;
    float wr[64];
#pragma unroll
    for (int i = 0; i < 64; ++i) wr[i] = w3[i * 2048 + n];
    const float delta = fabsf(min_decay + (max_decay - min_decay) * (float)c / 511.f);
    for (int pp = 0; pp < 32; ++pp) {
      float s = 0.f;
#pragma unroll
      for (int i = 0; i < 64; ++i) s += a2[pp * 64 + i] * wr[i];
      float tt = (float)(t0 + pp) / (float)(SEQ - 1);
      s *= __expf(-tt * delta);
      if (t0 + pp == 0 && ((n >> 9) & 1) == 0) s += p.f_bias[(l * 2 + (n >> 10)) * 512 + c];
      stage[n * 32 + pp] = f2bf(s);
    }
  }
  __syncthreads();
  for (int e = tid; e < 2048 * 32; e += NTHR) {
    int n = e >> 5, pp = e & 31;
    int o = n >> 10, d = (n >> 9) & 1, c = n & 511;
    int t = t0 + pp;
    bf16_t* g = p.Gf + ((size_t)((l * 2 + o) * 512 + c)) * 4096;
    if (d == 0) g[2048 - t] = stage[n * 32 + pp];
    else if (t >= 1) g[2048 + t] = stage[n * 32 + pp];
    if (t == 0 && d == 0) g[0] = 0;
  }
}

__device__ void p0_rope_item(const Params& p, int it) {
  int e = it * 512 + otid();
  int pos = e >> 5, i = e & 31;
  float inv = powf(10000.f, -(float)(2 * i) / 64.f);
  float ang = (float)pos * inv;
  p.rope[e * 2 + 0] = cosf(ang);
  p.rope[e * 2 + 1] = sinf(ang);
}

__device__ __forceinline__ int next_item(unsigned* cnt, char* smem) {
  int* sh = (int*)(smem + SMEM_BYTES - 16);
  __syncthreads();
  if (threadIdx.x == 0) *sh = (int)atomicAdd(cnt, 1u);
  __syncthreads();
  return *sh;
}

constexpr int P0_N_MOD = 2 * 96;
constexpr int P0_N_FILT = 2 * 64;
constexpr int P0_N_ROPE = 128;
constexpr int P0_N_WIN = 16 * 68;
constexpr int P0A_TOTAL = P0_N_FILT + P0_N_MOD + P0_N_ROPE + P0_N_WIN;
constexpr int P0_N_WC = 2 * 16 * 16;
constexpr int P0_N_SMALL = 8 * 16 + 8 * 16 + 16 * 16;
constexpr int P0B_TOTAL = P0_N_WC + P0_N_WIN + 2 * P0_N_SMALL;

__device__ __forceinline__ void p0_win_tile(const Params& p, int l, int j, char* smem) {
  p0_transpose_tile(p.w_in + (size_t)l * DM * INC, p.WinT + (size_t)l * INC * DM, DM, INC, j / 68, j % 68, smem);
}
__device__ void p0a_item(const Params& p, int i, char* smem) {
  if (i < P0_N_FILT) { p0_filter_item(p, i / 64, i % 64, smem); return; }
  i -= P0_N_FILT;
  if (i < P0_N_MOD) { p0_mod_item(p, i / 96, i % 96, smem); return; }
  i -= P0_N_MOD;
  if (i < P0_N_ROPE) { p0_rope_item(p, i); return; }
  i -= P0_N_ROPE;
  p0_win_tile(p, 0, i, smem);
}
__device__ void p0b_item(const Params& p, int i, char* smem) {
  if (i < P0_N_WC) { p0_wc_item(p, i >> 8, (i >> 4) & 15, i & 15, smem); return; }
  i -= P0_N_WC;
  if (i < P0_N_WIN) { p0_win_tile(p, 1, i, smem); return; }
  i -= P0_N_WIN;
  const int l = i / P0_N_SMALL; int j = i % P0_N_SMALL;
  if (j < 128) { p0_transpose_tile(p.w_pa + (size_t)l * HYW * DM, p.WpaT + (size_t)l * DM * HYW, HYW, DM, j / 16, j % 16, smem); return; }
  j -= 128;
  if (j < 128) { p0_transpose_tile(p.w_pb + (size_t)l * HYW * DM, p.WpbT + (size_t)l * DM * HYW, HYW, DM, j / 16, j % 16, smem); return; }
  j -= 128;
  p0_transpose_tile(p.w_out + (size_t)l * DM * DM, p.WoutT + (size_t)l * DM * DM, DM, DM, j / 16, j % 16, smem);
}
__device__ void phase_p0(const Params& p, char* smem) {
  for (int it = next_item(p.wq + 96, smem); it < P0A_TOTAL; it = next_item(p.wq + 96, smem)) p0a_item(p, it, smem);
}

__device__ void norm_rows(const Params& p, int tile, int l, int which, bool from_inputs, char* smem) {
  float* scl = (float*)smem;
  float* shf = scl + 2048;
  const int tid = otid(), lane = tid & 63, w = tid >> 6;
  const int tok0 = tile * TM;
  const int b0 = tok0 >> 11;
  const float* g = (which ? p.g2 : p.g1) + l * DM;
  __syncthreads();
  for (int e = tid; e < 2048; e += NTHR) {
    int bi = e >> 10, j = e & 1023;
    int b = b0 + bi; if (b > NB - 1) b = NB - 1;
    const float* m = p.mod + ((size_t)l * NB + b) * 6144 + which * 3072;
    scl[e] = g[j] * (1.f + m[1024 + j]);
    shf[e] = m[j];
  }
  __syncthreads();
#pragma unroll 1
  for (int r0 = w; r0 < TM; r0 += 32) {
    float4 v[4][4];
#pragma unroll
    for (int q = 0; q < 4; ++q) {
      const int tok = tok0 + r0 + 8 * q;
      const float* xr = from_inputs ? xrow_in(p, tok) : (p.out + (size_t)tok * DM);
#pragma unroll
      for (int i = 0; i < 4; ++i) v[q][i] = *(const float4*)(xr + lane * 4 + 256 * i);
    }
#pragma unroll
    for (int q = 0; q < 4; ++q) {
      const int tok = tok0 + r0 + 8 * q;
      const int bi = (tok >> 11) - b0;
      float ss = 0.f;
#pragma unroll
      for (int i = 0; i < 4; ++i) ss += v[q][i].x * v[q][i].x + v[q][i].y * v[q][i].y + v[q][i].z * v[q][i].z + v[q][i].w * v[q][i].w;
      ss = wave_sum(ss);
      const float rs = rsqrtf(ss * (1.f / DM) + 1e-6f);
#pragma unroll
      for (int i = 0; i < 4; ++i) {
        const int j = lane * 4 + 256 * i;
        const float4 sc4 = *(const float4*)(scl + bi * 1024 + j);
        const float4 sh4 = *(const float4*)(shf + bi * 1024 + j);
        uint2 o;
        o.x = pack2(v[q][i].x * rs * sc4.x + sh4.x, v[q][i].y * rs * sc4.y + sh4.y);
        o.y = pack2(v[q][i].z * rs * sc4.z + sh4.z, v[q][i].w * rs * sc4.w + sh4.w);
        *(uint2*)(p.hbuf + (size_t)tok * DM + j) = o;
      }
    }
  }
  __syncthreads();
}

__device__ void phase_c(const Params& p, int tile, int l, bool from_inputs, char* smem) {
  norm_rows(p, tile, l, 0, from_inputs, smem);
  const int tid = otid();
  const int tok0 = tile * TM;
  const bf16_t* A = p.hbuf + (size_t)tok0 * DM;
  const bf16_t* W = p.WinT + (size_t)l * INC * DM;
  float* ct = (float*)smem;
  f32x16 acc[3][2];
#pragma unroll 1
  for (int nt = 0; nt < 9; ++nt) {
    gemm_core2<2>(A, DM, W + (size_t)nt * 256 * DM, DM, DM, smem, acc);
#pragma unroll 1
    for (int half = 0; half < 2; ++half) {
      const int nc = nt * 2 + half;
      if (nc < 12) {
        acc_to_lds_T<2>(acc, ct, half);
        lds_barrier();
#pragma unroll 1
        for (int it = tid; it < 128 * 24; it += NTHR) {
          const int tg = it % 24, nl = it / 24;
          const float4 a = *(const float4*)(ct + nl * LDT + tg * 8), b4 = *(const float4*)(ct + nl * LDT + tg * 8 + 4);
          uint4 o; o.x = pack2(a.x, a.y); o.y = pack2(a.z, a.w); o.z = pack2(b4.x, b4.y); o.w = pack2(b4.z, b4.w);
          const int tok = tok0 + tg * 8;
          const int b = tok >> 11, sq = tok & 2047;
          *(uint4*)(p.zT + ((size_t)b * HYC + nc * 128 + nl) * SEQ + sq) = o;
        }
      } else {
        acc_to_lds<2>(acc, ct, 132, half);
        lds_barrier();
        store_tile_bf16(ct, p.zqkv, QKVC, tok0, nc * 128 - HYC);
      }
      lds_barrier();
    }
  }
}

__device__ __forceinline__ void load_conv8(const bf16_t* __restrict__ zrow, int s0, float w0, float w1, float w2, float cb, float (&o)[8]) {
  uint4 v = *(const uint4*)(zrow + s0);
  float z[10];
  z[0] = (s0 > 0) ? bf2f(zrow[s0 - 1]) : 0.f;
  z[1] = lo2f(v.x); z[2] = hi2f(v.x); z[3] = lo2f(v.y); z[4] = hi2f(v.y);
  z[5] = lo2f(v.z); z[6] = hi2f(v.z); z[7] = lo2f(v.w); z[8] = hi2f(v.w);
  z[9] = (s0 + 8 < SEQ) ? bf2f(zrow[s0 + 8]) : 0.f;
#pragma unroll
  for (int i = 0; i < 8; ++i) o[i] = z[i] * w0 + z[i + 1] * w1 + z[i + 2] * w2 + cb;
}

struct Conv8In { uint4 v; unsigned short l, r; };
__device__ __forceinline__ void conv8_load(const bf16_t* __restrict__ zrow, int s0, Conv8In& c) {
  c.v = *(const uint4*)(zrow + s0);
  c.l = (s0 > 0) ? zrow[s0 - 1] : (unsigned short)0;
  c.r = (s0 + 8 < SEQ) ? zrow[s0 + 8] : (unsigned short)0;
}
__device__ __forceinline__ void conv8_eval(const Conv8In& c, float w0, float w1, float w2, float cb, float (&o)[8]) {
  float z[10];
  z[0] = bf2f(c.l);
  z[1] = lo2f(c.v.x); z[2] = hi2f(c.v.x); z[3] = lo2f(c.v.y); z[4] = hi2f(c.v.y);
  z[5] = lo2f(c.v.z); z[6] = hi2f(c.v.z); z[7] = lo2f(c.v.w); z[8] = hi2f(c.v.w);
  z[9] = bf2f(c.r);
#pragma unroll
  for (int i = 0; i < 8; ++i) o[i] = z[i] * w0 + z[i + 1] * w1 + z[i + 2] * w2 + cb;
}


constexpr int HY_GS_ELEMS = 4112;
constexpr int HY_US_ROWS = 2072;
__device__ __forceinline__ void hyena_load_g(const Params& p, int l, int o, int c, bf16_t* Gs, int tid) {
  const bf16_t* g = p.Gf + ((size_t)((l * 2 + o) * 512 + c)) * 4096;
  *(uint4*)(Gs + 8 + tid * 8) = *(const uint4*)(g + tid * 8);
  if (tid == 0) { unsigned z = 0; asm volatile("" : "+v"(z)); const uint4 z4 = make_uint4(z, z, z, z); *(uint4*)Gs = z4; *(uint4*)(Gs + 4104) = z4; }
}

__device__ __forceinline__ void hyena_kloop(const bf16_t* Gs, const bf16_t* us, int rho, int lane, f32x16 (&acc)[8]) {
#pragma unroll
  for (int a = 0; a < 8; ++a)
#pragma unroll
    for (int j = 0; j < 16; ++j) acc[a][j] = 0.f;
  const int i = lane & 31, hh = lane >> 5;
  const bf16_t* ga = Gs + (2040 - 8 * i + 8 * hh) - 1792;
  const int l16 = lane & 15, q = l16 >> 2, pq = l16 & 3, g4 = lane >> 4;
  const bf16_t* ub = us + (rho + 8 * (g4 >> 1) + q) * 24 + 16 * (g4 & 1) + 4 * pq;
#pragma unroll 1
  for (int kap = 0; kap < 129; ++kap) {
    const s16x4 b0 = tr_read4(ub + kap * 384);
    const s16x4 b1 = tr_read4(ub + kap * 384 + 96);
    bf16x8 bfrag;
    bfrag[0] = b0[0]; bfrag[1] = b0[1]; bfrag[2] = b0[2]; bfrag[3] = b0[3];
    bfrag[4] = b1[0]; bfrag[5] = b1[1]; bfrag[6] = b1[2]; bfrag[7] = b1[3];
#pragma unroll
    for (int a = 0; a < 8; ++a) {
      const bf16x8 af = *(const bf16x8*)(ga + kap * 16 + 256 * (7 - a));
      acc[a] = __builtin_amdgcn_mfma_f32_32x32x16_bf16(af, bfrag, acc[a], 0, 0, 0);
    }
  }
}

__device__ __forceinline__ void hyena_acc_to_us(const f32x16 (&acc)[8], bf16_t* us, int rho, int lane) {
  const int n = lane & 31, hh = lane >> 5;
  if (n < 24) {
#pragma unroll
    for (int a = 0; a < 8; ++a)
#pragma unroll
      for (int r = 0; r < 16; ++r) {
        const int t = 256 * a + rho + 8 * ((r & 3) + 8 * (r >> 2) + 4 * hh);
        us[(t + 16) * 24 + n] = f2bf(acc[a][r]);
      }
  }
}

__device__ void hyena_item(const Params& p, int l, int c, char* smem) {
  bf16_t* Gs = (bf16_t*)smem;
  bf16_t* us = (bf16_t*)(smem + 8256);
  const int tid = otid();
  const int lane = tid & 63, w = tid >> 6;
  const float* cw = p.conv_w + (size_t)l * 3 * HYC;
  const float* cbp = p.conv_b + (size_t)l * HYC;
  __syncthreads();
  hyena_load_g(p, l, 0, c, Gs, tid);
  {
    unsigned z = 0; asm volatile("" : "+v"(z)); const uint4 z4 = make_uint4(z, z, z, z);
    if (tid < 48) *(uint4*)(us + tid * 8) = z4;
    else if (tid < 48 + 26) *(uint4*)(us + 2064 * 24 + (tid - 48) * 8) = z4;
  }
  {
    const float w0 = cw[c], w1 = cw[HYC + c], w2 = cw[2 * HYC + c], cb = cbp[c];
#pragma unroll 1
    for (int q0 = tid; q0 < 24 * 256; q0 += 6 * NTHR) {
      Conv8In cin[6];
#pragma unroll
      for (int j = 0; j < 6; ++j) {
        const int qq = q0 + j * NTHR;
        conv8_load(p.zT + ((size_t)(qq % 24) * HYC + c) * SEQ, (qq / 24) * 8, cin[j]);
      }
#pragma unroll
      for (int j = 0; j < 6; ++j) {
        const int qq = q0 + j * NTHR;
        const int b = qq % 24, s0 = (qq / 24) * 8;
        float v[8];
        conv8_eval(cin[j], w0, w1, w2, cb, v);
#pragma unroll
        for (int i = 0; i < 8; ++i) us[(s0 + i + 16) * 24 + b] = f2bf(v[i]);
      }
    }
  }
  __syncthreads();
  f32x16 acc[8];
#pragma unroll 1
  for (int o = 0; o < 2; ++o) {
    hyena_kloop(Gs, us, w, lane, acc);
    __syncthreads();
    hyena_acc_to_us(acc, us, w, lane);
    if (o == 0) hyena_load_g(p, l, 1, c, Gs, tid);
    __syncthreads();
    const int xc = (o == 0 ? 512 : 1024) + c;
    const float xw0 = cw[xc], xw1 = cw[HYC + xc], xw2 = cw[2 * HYC + xc], xcb = cbp[xc];
#pragma unroll 1
    for (int q0 = tid; q0 < 24 * 256; q0 += 6 * NTHR) {
      Conv8In cin[6];
#pragma unroll
      for (int j = 0; j < 6; ++j) {
        const int qq = q0 + j * NTHR;
        conv8_load(p.zT + ((size_t)(qq % 24) * HYC + xc) * SEQ, (qq / 24) * 8, cin[j]);
      }
#pragma unroll
      for (int j = 0; j < 6; ++j) {
        const int qq = q0 + j * NTHR;
        const int b = qq % 24, s0 = (qq / 24) * 8;
        float xv[8];
        conv8_eval(cin[j], xw0, xw1, xw2, xcb, xv);
        if (o == 0) {
#pragma unroll
          for (int i = 0; i < 8; ++i) {
            bf16_t* e = us + (s0 + i + 16) * 24 + b;
            *e = f2bf(bf2f(*e) * xv[i]);
          }
        } else {
          float r[8];
#pragma unroll
          for (int i = 0; i < 8; ++i) r[i] = bf2f(us[(s0 + i + 16) * 24 + b]) * xv[i];
          uint4 pk; pk.x = pack2(r[0], r[1]); pk.y = pack2(r[2], r[3]); pk.z = pack2(r[4], r[5]); pk.w = pack2(r[6], r[7]);
          *(uint4*)(p.yaT + ((size_t)b * HYW + c) * SEQ + s0) = pk;
        }
      }
    }
    __syncthreads();
  }
}

__device__ void attn_item(const Params& p, int l, int item, char* smem) {
  constexpr int KS = 72, VS = 96;
  bf16_t* Ks = (bf16_t*)smem;
  bf16_t* Vs = Ks + 384 * KS;
  const int tid = otid();
  const int lane = tid & 63, w = tid >> 6;
  const int kh = item & 1, qb = (item >> 1) & 15, b = item >> 5;
  const int kpos0 = qb * 128 - 128;
  __syncthreads();
  if (tid < 384) {
    const int r = tid, kpos = kpos0 + r;
    if (kpos >= 0 && kpos < SEQ) {
      const bf16_t* kr = p.zqkv + ((size_t)(b * SEQ + kpos)) * QKVC + 512 + kh * 64;
      float kf[64];
      float ss = 0.f;
#pragma unroll
      for (int c8 = 0; c8 < 8; ++c8) {
        uint4 v = *(const uint4*)(kr + c8 * 8);
        kf[c8 * 8 + 0] = lo2f(v.x); kf[c8 * 8 + 1] = hi2f(v.x); kf[c8 * 8 + 2] = lo2f(v.y); kf[c8 * 8 + 3] = hi2f(v.y);
        kf[c8 * 8 + 4] = lo2f(v.z); kf[c8 * 8 + 5] = hi2f(v.z); kf[c8 * 8 + 6] = lo2f(v.w); kf[c8 * 8 + 7] = hi2f(v.w);
      }
#pragma unroll
      for (int d = 0; d < 64; ++d) ss += kf[d] * kf[d];
      const float rs = rsqrtf(ss * (1.f / 64.f) + 1e-6f);
      const float* kg = p.k_gain + l * 64;
#pragma unroll
      for (int d = 0; d < 64; ++d) kf[d] = kf[d] * rs * kg[d];
      const float* rp = p.rope + (size_t)kpos * 64;
#pragma unroll
      for (int i = 0; i < 32; ++i) {
        const float cs = rp[i * 2], sn = rp[i * 2 + 1];
        const float a = kf[i], bb = kf[i + 32];
        kf[i] = a * cs - bb * sn; kf[i + 32] = bb * cs + a * sn;
      }
#pragma unroll
      for (int c8 = 0; c8 < 8; ++c8) {
        uint4 pk;
        pk.x = pack2(kf[c8 * 8 + 0], kf[c8 * 8 + 1]); pk.y = pack2(kf[c8 * 8 + 2], kf[c8 * 8 + 3]);
        pk.z = pack2(kf[c8 * 8 + 4], kf[c8 * 8 + 5]); pk.w = pack2(kf[c8 * 8 + 6], kf[c8 * 8 + 7]);
        *(uint4*)(Ks + r * KS + c8 * 8) = pk;
      }
    }
  }
#pragma unroll 1
  for (int e = tid; e < 384 * 8; e += NTHR) {
    const int r = e >> 3, c8 = e & 7, kpos = kpos0 + r;
    if (kpos >= 0 && kpos < SEQ)
      *(uint4*)(Vs + r * VS + c8 * 8) = *(const uint4*)(p.zqkv + ((size_t)(b * SEQ + kpos)) * QKVC + 640 + kh * 64 + c8 * 8);
  }
  __syncthreads();
  const int hl = w & 3, qh = w >> 2;
  const int head = kh * 4 + hl;
  const int n = lane & 31, hh = lane >> 5;
  const int Q0 = qb * 128 + 64 * qh;
  bf16x8 qf[2][4];
#pragma unroll
  for (int nt = 0; nt < 2; ++nt) {
    const int qpos = Q0 + 32 * nt + n;
    const bf16_t* qr = p.zqkv + ((size_t)(b * SEQ + qpos)) * QKVC + head * 64;
    float qv[4][8];
    float ss = 0.f;
#pragma unroll
    for (int kk = 0; kk < 4; ++kk) {
      uint4 v = *(const uint4*)(qr + 16 * kk + 8 * hh);
      qv[kk][0] = lo2f(v.x); qv[kk][1] = hi2f(v.x); qv[kk][2] = lo2f(v.y); qv[kk][3] = hi2f(v.y);
      qv[kk][4] = lo2f(v.z); qv[kk][5] = hi2f(v.z); qv[kk][6] = lo2f(v.w); qv[kk][7] = hi2f(v.w);
#pragma unroll
      for (int j = 0; j < 8; ++j) ss += qv[kk][j] * qv[kk][j];
    }
    ss += __shfl_xor(ss, 32, 64);
    const float rs = rsqrtf(ss * (1.f / 64.f) + 1e-6f) * 0.125f;
    const float* qg = p.q_gain + l * 64;
#pragma unroll
    for (int kk = 0; kk < 4; ++kk)
#pragma unroll
      for (int j = 0; j < 8; ++j) qv[kk][j] *= rs * qg[16 * kk + 8 * hh + j];
    const float* rp = p.rope + (size_t)qpos * 64;
#pragma unroll
    for (int kk = 0; kk < 2; ++kk)
#pragma unroll
      for (int j = 0; j < 8; ++j) {
        const int d = 16 * kk + 8 * hh + j;
        const float cs = rp[d * 2], sn = rp[d * 2 + 1];
        const float a = qv[kk][j], bb = qv[kk + 2][j];
        qv[kk][j] = a * cs - bb * sn; qv[kk + 2][j] = bb * cs + a * sn;
      }
#pragma unroll
    for (int kk = 0; kk < 4; ++kk)
#pragma unroll
      for (int j = 0; j < 8; ++j) qf[nt][kk][j] = (short)f2bf(qv[kk][j]);
  }
  f32x16 O[2][2];
#pragma unroll
  for (int dm = 0; dm < 2; ++dm)
#pragma unroll
    for (int nt = 0; nt < 2; ++nt)
#pragma unroll
      for (int r = 0; r < 16; ++r) O[dm][nt][r] = 0.f;
  float mrun[2], lsum[2];
  mrun[0] = mrun[1] = p.sink[l * 8 + head];
  lsum[0] = lsum[1] = (hh == 0) ? 1.f : 0.f;
  const int l16 = lane & 15, tq = l16 >> 2, tp = l16 & 3, g4 = lane >> 4;
  const bf16_t* vbase = Vs + (4 * (g4 >> 1) + tq) * VS + 16 * (g4 & 1) + 4 * tp;
#pragma unroll 1
  for (int kt = 2 * qh; kt < 2 * qh + 10; ++kt) {
    const int kp_t = kpos0 + 32 * kt;
    if (kp_t < 0 || kp_t >= SEQ) continue;
    bf16x8 kfr[4];
#pragma unroll
    for (int kk = 0; kk < 4; ++kk) kfr[kk] = *(const bf16x8*)(Ks + (32 * kt + n) * KS + 16 * kk + 8 * hh);
    bf16x8 pf[2][2];
#pragma unroll
    for (int nt = 0; nt < 2; ++nt) {
      f32x16 S;
#pragma unroll
      for (int r = 0; r < 16; ++r) S[r] = 0.f;
#pragma unroll
      for (int kk = 0; kk < 4; ++kk) S = __builtin_amdgcn_mfma_f32_32x32x16_bf16(kfr[kk], qf[nt][kk], S, 0, 0, 0);
      const int qpos = Q0 + 32 * nt + n;
      float mloc = -INFINITY;
#pragma unroll
      for (int r = 0; r < 16; ++r) {
        const int kpos = kp_t + (r & 3) + 8 * (r >> 2) + 4 * hh;
        int dd = kpos - qpos; dd = dd < 0 ? -dd : dd;
        S[r] = (dd <= 128) ? S[r] : -INFINITY;
        mloc = fmaxf(mloc, S[r]);
      }
      mloc = fmaxf(mloc, __shfl_xor(mloc, 32, 64));
      const float mnew = fmaxf(mrun[nt], mloc);
      const float corr = __expf(mrun[nt] - mnew);
      mrun[nt] = mnew;
      float psum = 0.f;
#pragma unroll
      for (int r = 0; r < 16; ++r) { S[r] = __expf(S[r] - mnew); psum += S[r]; }
      lsum[nt] = lsum[nt] * corr + psum;
#pragma unroll
      for (int dm = 0; dm < 2; ++dm)
#pragma unroll
        for (int r = 0; r < 16; ++r) O[dm][nt][r] *= corr;
#pragma unroll
      for (int s2 = 0; s2 < 2; ++s2)
#pragma unroll
        for (int j = 0; j < 8; ++j) pf[nt][s2][j] = (short)f2bf(S[8 * s2 + j]);
    }
#pragma unroll
    for (int dm = 0; dm < 2; ++dm)
#pragma unroll
      for (int s2 = 0; s2 < 2; ++s2) {
        const bf16_t* vp = vbase + (32 * kt + 16 * s2) * VS + 32 * dm;
        const s16x4 v0 = tr_read4(vp);
        const s16x4 v1 = tr_read4(vp + 8 * VS);
        bf16x8 vf;
        vf[0] = v0[0]; vf[1] = v0[1]; vf[2] = v0[2]; vf[3] = v0[3];
        vf[4] = v1[0]; vf[5] = v1[1]; vf[6] = v1[2]; vf[7] = v1[3];
#pragma unroll
        for (int nt = 0; nt < 2; ++nt) O[dm][nt] = __builtin_amdgcn_mfma_f32_32x32x16_bf16(vf, pf[nt][s2], O[dm][nt], 0, 0, 0);
      }
  }
#pragma unroll
  for (int nt = 0; nt < 2; ++nt) {
    const float ltot = lsum[nt] + __shfl_xor(lsum[nt], 32, 64);
    const float inv = 1.f / ltot;
    const int qpos = Q0 + 32 * nt + n;
    bf16_t* yo = p.yb + ((size_t)(b * SEQ + qpos)) * 512 + head * 64;
#pragma unroll
    for (int dm = 0; dm < 2; ++dm)
#pragma unroll
      for (int g = 0; g < 4; ++g) {
        uint2 o;
        o.x = pack2(O[dm][nt][4 * g + 0] * inv, O[dm][nt][4 * g + 1] * inv);
        o.y = pack2(O[dm][nt][4 * g + 2] * inv, O[dm][nt][4 * g + 3] * inv);
        *(uint2*)(yo + 32 * dm + 8 * g + 4 * hh) = o;
      }
  }
}

typedef float f32x2 __attribute__((ext_vector_type(2)));
__device__ void table_item(const Params& p, int l, int it) {
  const int tid = otid();
  const int lane = tid & 63, w = tid >> 6;
  const int which = it >> 9, r0 = (it & 511) * 32 + w * 4;
  const float* src = (which ? p.peer_v : p.peer_u) + (size_t)l * NEXP * DM;
  unsigned char* dst = which ? p.tabV8 : p.tabU8;
  float* sc = which ? p.sclV : p.sclU;
  float4 v[4][4];
#pragma unroll
  for (int rr = 0; rr < 4; ++rr)
#pragma unroll
    for (int i = 0; i < 4; ++i) v[rr][i] = *(const float4*)(src + (size_t)(r0 + rr) * DM + lane * 4 + 256 * i);
#pragma unroll
  for (int rr = 0; rr < 4; ++rr) {
    const int e = r0 + rr;
    float mx = 0.f;
#pragma unroll
    for (int i = 0; i < 4; ++i)
      mx = fmaxf(mx, fmaxf(fmaxf(fabsf(v[rr][i].x), fabsf(v[rr][i].y)), fmaxf(fabsf(v[rr][i].z), fabsf(v[rr][i].w))));
#pragma unroll
    for (int m = 32; m >= 1; m >>= 1) mx = fmaxf(mx, __shfl_xor(mx, m, 64));
    const float scale = (mx > 0.f) ? 440.f / mx : 1.f;
#pragma unroll
    for (int i = 0; i < 4; ++i) {
      int pk = __builtin_amdgcn_cvt_pk_fp8_f32(v[rr][i].x * scale, v[rr][i].y * scale, 0, false);
      pk = __builtin_amdgcn_cvt_pk_fp8_f32(v[rr][i].z * scale, v[rr][i].w * scale, pk, true);
      const int x = 2 * i + (lane >> 5);
      *(int*)(dst + ((size_t)x * NEXP + e) * 128 + (lane & 31) * 4) = pk;
    }
    if (lane == 0) sc[e] = (mx > 0.f) ? mx * (1.f / 440.f) : 1.f;
  }
}

constexpr int DE_N_HY = 512, DE_N_AT = 768, DE_N_TB = 1024;
__device__ void phase_de(const Params& p, int l, char* smem) {
  const int total = DE_N_HY + DE_N_AT + DE_N_TB + (l == 0 ? P0B_TOTAL : 0);
  for (int it = next_item(p.wq + 100 + l, smem); it < total; it = next_item(p.wq + 100 + l, smem)) {
    if (it < DE_N_HY) hyena_item(p, l, it, smem);
    else if (it < DE_N_HY + DE_N_AT) attn_item(p, l, it - DE_N_HY, smem);
    else if (it < DE_N_HY + DE_N_AT + DE_N_TB) table_item(p, l, it - DE_N_HY - DE_N_AT);
    else p0b_item(p, it - DE_N_HY - DE_N_AT - DE_N_TB, smem);
  }
}

__device__ void phase_f(const Params& p, int tile, int l, bool from_inputs, char* smem) {
  const int tid = otid();
  const int tok0 = tile * TM;
  const bf16_t* Ah = p.hbuf + (size_t)tok0 * DM;
  const bf16_t* Ayb = p.yb + (size_t)tok0 * HYW;
  const bf16_t* Win = p.WinT + (size_t)l * INC * DM;
  const bf16_t* Wpa = p.WpaT + (size_t)l * DM * HYW;
  const bf16_t* Wpb = p.WpbT + (size_t)l * DM * HYW;
  float* ct = (float*)smem;
  f32x16 acc[3][2];
  unsigned sgp[3][2][8];
#pragma unroll 1
  for (int nc = 0; nc < 8; ++nc) {
    gemm_f1<1>(Ah, Ah, DM, Win + (size_t)(2304 + nc * 128) * DM, Win + (size_t)(3328 + nc * 128) * DM, DM, smem, acc);
#pragma unroll
    for (int mi = 0; mi < 3; ++mi)
#pragma unroll
      for (int ni = 0; ni < 2; ++ni)
#pragma unroll
        for (int q = 0; q < 8; ++q)
          sgp[mi][ni][q] = pack2(__builtin_amdgcn_rcpf(1.f + __expf(-acc[mi][ni][2 * q])), __builtin_amdgcn_rcpf(1.f + __expf(-acc[mi][ni][2 * q + 1])));
    gemm_f1<2>(p.yaT, Ayb, HYW, Wpa + (size_t)(nc * 128) * HYW, Wpb + (size_t)(nc * 128) * HYW, HYW, smem, acc, tok0);
    {
      const int tid_ = otid(); const int lane = tid_ & 63, w = tid_ >> 6, wm = w >> 2, wn = w & 3;
      const int n = wn * 32 + (lane & 31);
#pragma unroll
      for (int mi = 0; mi < 3; ++mi)
#pragma unroll
        for (int q = 0; q < 8; ++q) {
          const float m0 = lo2f(sgp[mi][0][q]) * acc[mi][0][2 * q] + lo2f(sgp[mi][1][q]) * acc[mi][1][2 * q];
          const float m1 = hi2f(sgp[mi][0][q]) * acc[mi][0][2 * q + 1] + hi2f(sgp[mi][1][q]) * acc[mi][1][2 * q + 1];
          ct[ACC_ROW(wm, mi, 2 * q, lane) * 132 + n] = m0;
          ct[ACC_ROW(wm, mi, 2 * q + 1, lane) * 132 + n] = m1;
        }
    }
    lds_barrier();
    store_tile_bf16(ct, p.merged, DM, tok0, nc * 128);
  }
  __syncthreads();
  const bf16_t* Am = p.merged + (size_t)tok0 * DM;
  const bf16_t* Wo = p.WoutT + (size_t)l * DM * DM;
  f32x16 acc2[3][2];
#pragma unroll 1
  for (int nt = 0; nt < 4; ++nt) {
    gemm_core2<2>(Am, DM, Wo + (size_t)(nt * 256) * DM, DM, DM, smem, acc2);
#pragma unroll 1
    for (int half = 0; half < 2; ++half) {
      acc_to_lds<2>(acc2, ct, 132, half);
      lds_barrier();
#pragma unroll 4
      for (int it = tid; it < 192 * 32; it += NTHR) {
        const int c4 = it & 31, r = it >> 5;
        const int tok = tok0 + r, b = tok >> 11;
        const int n = nt * 256 + half * 128 + c4 * 4;
        const float4 a = *(const float4*)(ct + r * 132 + c4 * 4);
        const float4 gt = *(const float4*)(p.mod + ((size_t)l * NB + b) * 6144 + 2048 + n);
        const float* xs = from_inputs ? xrow_in(p, tok) : (p.out + (size_t)tok * DM);
        float4 xo = *(const float4*)(xs + n);
        xo.x += gt.x * a.x; xo.y += gt.y * a.y; xo.z += gt.z * a.z; xo.w += gt.w * a.w;
        *(float4*)(p.out + (size_t)tok * DM + n) = xo;
      }
      lds_barrier();
    }
  }
  __syncthreads();
}

__device__ __forceinline__ void sort16_desc(float (&v)[16]) {
#pragma unroll
  for (int k = 2; k <= 16; k <<= 1)
#pragma unroll
    for (int j = k >> 1; j >= 1; j >>= 1)
#pragma unroll
      for (int i = 0; i < 16; ++i) {
        const int l = i ^ j;
        if (l > i) {
          const float hi = fmaxf(v[i], v[l]), lo = fminf(v[i], v[l]);
          if ((i & k) == 0) { v[i] = hi; v[l] = lo; } else { v[i] = lo; v[l] = hi; }
        }
      }
}
__device__ __forceinline__ void merge16_desc(float (&top)[16], const float (&g)[16]) {
#pragma unroll
  for (int i = 0; i < 16; ++i) top[i] = fmaxf(top[i], g[15 - i]);
#pragma unroll
  for (int j = 8; j >= 1; j >>= 1)
#pragma unroll
    for (int i = 0; i < 16; ++i) {
      const int l = i ^ j;
      if (l > i) { const float hi = fmaxf(top[i], top[l]), lo = fminf(top[i], top[l]); top[i] = hi; top[l] = lo; }
    }
}
__device__ __forceinline__ void topk_insert(float (&key)[16], float kx) {
#pragma unroll
  for (int i = 0; i < 16; ++i) {
    const float hi = fmaxf(key[i], kx);
    kx = fminf(key[i], kx);
    key[i] = hi;
  }
}

__device__ void phase_g(const Params& p, int tile, int l, char* smem) {
  norm_rows(p, tile, l, 1, false, smem);
  const int tid = otid();
  const int tok0 = tile * TM;
  const bf16_t* Ah = p.hbuf + (size_t)tok0 * DM;
  const bf16_t* Wc = p.WcT + (size_t)l * 2048 * DM;
  float* sc = (float*)smem;
  f32x16 acc[3][2];
  float v1k[16], v2k[16];
#pragma unroll
  for (int i = 0; i < 16; ++i) { v1k[i] = 0.f; v2k[i] = 0.f; }
#pragma unroll 1
  for (int ch = 0; ch < 16; ++ch) {
    if ((ch & 1) == 0) gemm_core2<2>(Ah, DM, Wc + (size_t)(ch * 128) * DM, DM, DM, smem, acc);
    acc_to_lds<2>(acc, sc, 129, ch & 1);
    __syncthreads();
    float key[16];
    const int ttok = tid % TM, part = tid / TM;
    float* xch = (float*)(smem + 100352);
    if (tid < 2 * TM) {
      const float* row = sc + ttok * 129 + part * 64;
#pragma unroll
      for (int i = 0; i < 16; ++i) key[i] = __uint_as_float((__float_as_uint(row[i]) & 0xFFFFFF80u) | (unsigned)(part * 64 + i));
      sort16_desc(key);
#pragma unroll 1
      for (int j0 = 16; j0 < 64; j0 += 16) {
        float g[16];
#pragma unroll
        for (int i = 0; i < 16; ++i) g[i] = __uint_as_float((__float_as_uint(row[j0 + i]) & 0xFFFFFF80u) | (unsigned)(part * 64 + j0 + i));
        sort16_desc(g);
        merge16_desc(key, g);
      }
      if (part == 1) {
#pragma unroll
        for (int i = 0; i < 16; ++i) xch[ttok * 17 + i] = key[i];
      }
    }
    __syncthreads();
    if (tid < TM) {
      {
        float g[16];
#pragma unroll
        for (int i = 0; i < 16; ++i) g[i] = xch[tid * 17 + i];
        merge16_desc(key, g);
      }
      if ((ch & 1) == 0) {
#pragma unroll
        for (int i = 0; i < 16; ++i) v1k[i] = key[i];
      } else {
#pragma unroll
        for (int i = 0; i < 16; ++i) v2k[i] = key[i];
        float top[16], grp[16];
        {
          constexpr int CI[64] = {0,0,0,0,0,0,0,0,0,0,0,0,0,0,0,0, 1,1,1,1,1,1,1,1, 2,2,2,2,2, 3,3,3,3, 4,4,4, 5,5, 6,6, 7,7, 8,9,10,11,12,13,14,15, 0,0,0,0,0,0,0,0,0,0,0,0,0,0};
          constexpr int CJ[64] = {0,1,2,3,4,5,6,7,8,9,10,11,12,13,14,15, 0,1,2,3,4,5,6,7, 0,1,2,3,4, 0,1,2,3, 0,1,2, 0,1, 0,1, 0,1, 0,0,0,0,0,0,0,0, 0,0,0,0,0,0,0,0,0,0,0,0,0,0};
#pragma unroll
          for (int gq = 0; gq < 4; ++gq) {
#pragma unroll
            for (int i = 0; i < 16; ++i) {
              const int c = gq * 16 + i;
              if (c < 50) {
                const float sv = v1k[CI[c]] + v2k[CJ[c]];
                grp[i] = __uint_as_float((__float_as_uint(sv) & 0xFFFFFF00u) | (unsigned)(CI[c] * 16 + CJ[c]));
              } else grp[i] = -INFINITY;
            }
            sort16_desc(grp);
            if (gq == 0) {
#pragma unroll
              for (int i = 0; i < 16; ++i) top[i] = grp[i];
            } else merge16_desc(top, grp);
          }
        }
        const float mx = top[0];
        float ex[16], sum = 0.f;
#pragma unroll
        for (int k = 0; k < 16; ++k) { ex[k] = __expf(top[k] - mx); sum += ex[k]; }
        const float inv = 1.f / sum;
        const int hh = ch >> 1;
        const size_t ob = ((size_t)(tok0 + tid) * 8 + hh) * 16;
        unsigned char* ltab = (unsigned char*)(smem + 114688) + tid * 32;
#pragma unroll
        for (int q = 0; q < 4; ++q) {
          unsigned w1 = 0, w2 = 0;
#pragma unroll
          for (int b4 = 0; b4 < 4; ++b4) {
            w1 |= (__float_as_uint(v1k[4 * q + b4]) & 0x7Fu) << (8 * b4);
            w2 |= (__float_as_uint(v2k[4 * q + b4]) & 0x7Fu) << (8 * b4);
          }
          *(unsigned*)(ltab + 4 * q) = w1;
          *(unsigned*)(ltab + 16 + 4 * q) = w2;
        }
        unsigned ee[16];
#pragma unroll
        for (int k = 0; k < 16; ++k) {
          const unsigned code = __float_as_uint(top[k]) & 0xFFu;
          ee[k] = (unsigned)ltab[code >> 4] * 128u + (unsigned)ltab[16 + (code & 15u)];
        }
        uint4 i0, i1;
        i0.x = ee[0] | (ee[1] << 16); i0.y = ee[2] | (ee[3] << 16); i0.z = ee[4] | (ee[5] << 16); i0.w = ee[6] | (ee[7] << 16);
        i1.x = ee[8] | (ee[9] << 16); i1.y = ee[10] | (ee[11] << 16); i1.z = ee[12] | (ee[13] << 16); i1.w = ee[14] | (ee[15] << 16);
        *(uint4*)(p.pidx + ob) = i0; *(uint4*)(p.pidx + ob + 8) = i1;
#pragma unroll
        for (int q = 0; q < 4; ++q)
          *(float4*)(p.pg + ob + 4 * q) = make_float4(ex[4 * q] * inv, ex[4 * q + 1] * inv, ex[4 * q + 2] * inv, ex[4 * q + 3] * inv);
      }
    }
    __syncthreads();
  }
}

__device__ __forceinline__ unsigned xcc_id() { return (unsigned)__builtin_amdgcn_s_getreg((3 << 11) | 20) & 7u; }
__device__ __forceinline__ bool next_slice_item(unsigned* cnt, int& x, int& j, int& tries, char* smem, int tid) {
  int* sh = (int*)(smem + 8192);
  while (tries < 8) {
    __syncthreads();
    if (tid == 0) *sh = (int)atomicAdd(cnt + x, 1u);
    __syncthreads();
    j = *sh;
    if (j < I_NJ) return true;
    x = (x + 1) & 7; ++tries;
  }
  return false;
}
__device__ __forceinline__ float dpp_xor1(float v) { return __builtin_bit_cast(float, __builtin_amdgcn_update_dpp(0, __builtin_bit_cast(int, v), 0xB1, 0xF, 0xF, true)); }
__device__ __forceinline__ float dpp_xor2(float v) { return __builtin_bit_cast(float, __builtin_amdgcn_update_dpp(0, __builtin_bit_cast(int, v), 0x4E, 0xF, 0xF, true)); }
__device__ __forceinline__ float dpp_hmirror(float v) { return __builtin_bit_cast(float, __builtin_amdgcn_update_dpp(0, __builtin_bit_cast(int, v), 0x141, 0xF, 0xF, true)); }
__device__ __forceinline__ float dpp_ror8(float v) { return __builtin_bit_cast(float, __builtin_amdgcn_update_dpp(0, __builtin_bit_cast(int, v), 0x128, 0xF, 0xF, true)); }

struct I1Ctx { uint4 h0, h1, e0, e1; };
__device__ __forceinline__ void i1_load_ctx(const Params& p, int tok, int x, int g, int ch, I1Ctx& c) {
  const bf16_t* hr = p.hbuf + (size_t)tok * DM + x * 128 + ch * 16;
  c.h0 = *(const uint4*)hr; c.h1 = *(const uint4*)(hr + 8);
  const uint4* pi = (const uint4*)(p.pidx + (size_t)tok * 128 + g * 16);
  c.e0 = pi[0]; c.e1 = pi[1];
}
__device__ __forceinline__ void peer_issue_rows(const unsigned char* Tslice, unsigned lane_off, const uint4& e0, const uint4& e1, uint4 (&rows)[16]) {
  const unsigned ew[8] = {e0.x, e0.y, e0.z, e0.w, e1.x, e1.y, e1.z, e1.w};
#pragma unroll
  for (int rd = 0; rd < 16; ++rd) {
    const unsigned e = (ew[rd >> 1] >> (16 * (rd & 1))) & 0x3FFFu;
    rows[rd] = *(const uint4*)(Tslice + (e * 128u + lane_off));
  }
}
typedef _Float16 f16x2 __attribute__((ext_vector_type(2)));
__device__ __forceinline__ f16x2 bf2_to_h2(unsigned u) {
  f16x2 r; r[0] = (_Float16)lo2f(u); r[1] = (_Float16)hi2f(u); return r;
}
__device__ __forceinline__ void i1_compute(const I1Ctx& c, const uint4 (&rows)[16], bf16_t* dst, int ch) {
  f16x2 hs[8];
  hs[0] = bf2_to_h2(c.h0.x); hs[1] = bf2_to_h2(c.h0.y); hs[2] = bf2_to_h2(c.h0.z); hs[3] = bf2_to_h2(c.h0.w);
  hs[4] = bf2_to_h2(c.h1.x); hs[5] = bf2_to_h2(c.h1.y); hs[6] = bf2_to_h2(c.h1.z); hs[7] = bf2_to_h2(c.h1.w);
  float res[16];
#pragma unroll
  for (int rd = 0; rd < 16; ++rd) {
    const unsigned wd[4] = {rows[rd].x, rows[rd].y, rows[rd].z, rows[rd].w};
    float d0 = 0.f, d1 = 0.f;
#pragma unroll
    for (int q = 0; q < 4; ++q) {
      d0 = __builtin_amdgcn_fdot2(__builtin_amdgcn_cvt_scalef32_pk_f16_fp8((int)wd[q], 1.0f, false), hs[2 * q], d0, false);
      d1 = __builtin_amdgcn_fdot2(__builtin_amdgcn_cvt_scalef32_pk_f16_fp8((int)wd[q], 1.0f, true), hs[2 * q + 1], d1, false);
    }
    float d = d0 + d1;
    d += dpp_xor1(d); d += dpp_xor2(d); d += dpp_hmirror(d);
    res[rd] = d;
  }
  if (ch == 0) {
    uint4 o0, o1;
    o0.x = pack2(res[0], res[1]); o0.y = pack2(res[2], res[3]); o0.z = pack2(res[4], res[5]); o0.w = pack2(res[6], res[7]);
    o1.x = pack2(res[8], res[9]); o1.y = pack2(res[10], res[11]); o1.z = pack2(res[12], res[13]); o1.w = pack2(res[14], res[15]);
    *(uint4*)dst = o0; *(uint4*)(dst + 8) = o1;
  }
}

__device__ void phase_i1(const Params& p, int pass, char* smem) {
  const int tid = otid();
  const int lane = tid & 63, w = tid >> 6;
  const int g = lane >> 3, ch = lane & 7;
  int x = (int)xcc_id(), j = 0, tries = 0;
  while (next_slice_item(p.wq + pass * 8, x, j, tries, smem, tid)) {
    const unsigned char* Ux = p.tabU8 + (size_t)x * NEXP * 128;
    const unsigned loff = ch * 16;
    bf16_t* ap = p.apart + (size_t)x * NTOK * 128 + g * 16;
    const int tokb = j * I_TOK + w;
    I1Ctx c0, c1, c2;
    uint4 rowsA[16], rowsB[16];
    i1_load_ctx(p, tokb, x, g, ch, c0);
    i1_load_ctx(p, tokb + 8, x, g, ch, c1);
    i1_load_ctx(p, tokb + 16, x, g, ch, c2);
    peer_issue_rows(Ux, loff, c0.e0, c0.e1, rowsA);
#pragma unroll 1
    for (int i = 0; i < I_TW; i += 2) {
      I1Ctx c3, c4;
      peer_issue_rows(Ux, loff, c1.e0, c1.e1, rowsB);
      i1_load_ctx(p, tokb + 8 * min(i + 3, I_TW - 1), x, g, ch, c3);
      i1_compute(c0, rowsA, ap + (size_t)(tokb + 8 * i) * 128, ch);
      peer_issue_rows(Ux, loff, c2.e0, c2.e1, rowsA);
      i1_load_ctx(p, tokb + 8 * min(i + 4, I_TW - 1), x, g, ch, c4);
      i1_compute(c1, rowsB, ap + (size_t)(tokb + 8 * (i + 1)) * 128, ch);
      c0 = c2; c1 = c3; c2 = c4;
    }
  }
}

__device__ void phase_w(const Params& p) {
  const int tid = otid();
  const size_t npair8 = (size_t)NTOK * 128 / 8;
  for (size_t q8 = (size_t)blockIdx.x * NTHR + tid; q8 < npair8; q8 += (size_t)gridDim.x * NTHR) {
    const size_t q = q8 * 8;
    float a[8];
#pragma unroll
    for (int i = 0; i < 8; ++i) a[i] = 0.f;
#pragma unroll
    for (int xx = 0; xx < 8; ++xx) {
      const uint4 v = *(const uint4*)(p.apart + (size_t)xx * NTOK * 128 + q);
      a[0] += lo2f(v.x); a[1] += hi2f(v.x); a[2] += lo2f(v.y); a[3] += hi2f(v.y);
      a[4] += lo2f(v.z); a[5] += hi2f(v.z); a[6] += lo2f(v.w); a[7] += hi2f(v.w);
    }
    const float4 g0 = *(const float4*)(p.pg + q), g1 = *(const float4*)(p.pg + q + 4);
    const uint4 ev = *(const uint4*)(p.pidx + q);
    const unsigned ew[4] = {ev.x, ev.y, ev.z, ev.w};
    float su[8], sg[8];
    const float gg[8] = {g0.x, g0.y, g0.z, g0.w, g1.x, g1.y, g1.z, g1.w};
#pragma unroll
    for (int i = 0; i < 8; ++i) {
      const unsigned e = (ew[i >> 1] >> (16 * (i & 1))) & 0x3FFFu;
      su[i] = p.sclU[e];
      sg[i] = gg[i] * p.sclV[e];
    }
    float wv[8];
#pragma unroll
    for (int i = 0; i < 8; ++i) {
      const float av = a[i] * su[i];
      wv[i] = sg[i] * 0.5f * av * (1.f + erff(av * 0.70710678118654752f));
    }
    uint4 o; o.x = pack2(wv[0], wv[1]); o.y = pack2(wv[2], wv[3]); o.z = pack2(wv[4], wv[5]); o.w = pack2(wv[6], wv[7]);
    *(uint4*)(p.wbuf + q) = o;
  }
}

struct I2Ctx { uint4 e0, e1; };
struct I2XG { uint4 w0, w1; float2 xv, gt; };
__device__ __forceinline__ void i2_load_ctx(const Params& p, int tok, int l, int x, int g, int ch, I2Ctx& c) {
  const unsigned off = (unsigned)tok * 256u + (unsigned)g * 32u;
  const uint4* pi = (const uint4*)((const char*)p.pidx + off);
  c.e0 = pi[0]; c.e1 = pi[1];
}
__device__ __forceinline__ void i2_load_xg(const Params& p, int tok, int l, int x, int g, int ch, I2XG& c) {
  const unsigned off = (unsigned)tok * 256u + (unsigned)g * 32u;
  const uint4* pw = (const uint4*)((const char*)p.wbuf + off);
  c.w0 = pw[0]; c.w1 = pw[1];
  const unsigned col = (unsigned)(x * 128 + ch * 16 + 2 * g);
  c.xv = *(const float2*)((const char*)p.out + ((unsigned)tok * 4096u + col * 4u));
  c.gt = *(const float2*)((const char*)p.mod + ((unsigned)(l * NB + (tok >> 11)) * 24576u + 20480u + col * 4u));
}
__device__ __forceinline__ void i2_compute(const Params& p, const I2XG& xg, const uint4 (&rows)[16], int tok, int x, int g, int ch) {
  const unsigned ww[8] = {xg.w0.x, xg.w0.y, xg.w0.z, xg.w0.w, xg.w1.x, xg.w1.y, xg.w1.z, xg.w1.w};
  f32x2 acc[8];
#pragma unroll
  for (int i = 0; i < 8; ++i) acc[i] = f32x2{0.f, 0.f};
#pragma unroll
  for (int rd = 0; rd < 16; ++rd) {
    const unsigned wd[4] = {rows[rd].x, rows[rd].y, rows[rd].z, rows[rd].w};
    const float wsc = (rd & 1) ? hi2f(ww[rd >> 1]) : lo2f(ww[rd >> 1]);
    const f32x2 sw = {wsc, wsc};
#pragma unroll
    for (int q = 0; q < 4; ++q) {
      acc[2 * q] += sw * __builtin_amdgcn_cvt_pk_f32_fp8((int)wd[q], false);
      acc[2 * q + 1] += sw * __builtin_amdgcn_cvt_pk_f32_fp8((int)wd[q], true);
    }
  }
  float r[16];
#pragma unroll
  for (int i = 0; i < 8; ++i) { r[2 * i] = acc[i][0]; r[2 * i + 1] = acc[i][1]; }
  const bool b2 = (g & 4) != 0, b1 = (g & 2) != 0, b0 = (g & 1) != 0;
  float r8[8];
#pragma unroll
  for (int i = 0; i < 8; ++i) {
    const float snd = b2 ? r[i] : r[i + 8];
    const float kp = b2 ? r[i + 8] : r[i];
    r8[i] = kp + __shfl_xor(snd, 32, 64);
  }
  float r4[4];
#pragma unroll
  for (int i = 0; i < 4; ++i) {
    const float snd = b1 ? r8[i] : r8[i + 4];
    const float kp = b1 ? r8[i + 4] : r8[i];
    r4[i] = kp + __shfl_xor(snd, 16, 64);
  }
  float r2[2];
#pragma unroll
  for (int i = 0; i < 2; ++i) {
    const float snd = b0 ? r4[i] : r4[i + 2];
    const float kp = b0 ? r4[i + 2] : r4[i];
    r2[i] = kp + dpp_ror8(snd);
  }
  float2 o;
  o.x = xg.xv.x + xg.gt.x * r2[0];
  o.y = xg.xv.y + xg.gt.y * r2[1];
  *(float2*)((char*)p.out + ((unsigned)tok * 4096u + (unsigned)(x * 128 + ch * 16 + 2 * g) * 4u)) = o;
}

__device__ void phase_i2(const Params& p, int l, int pass, char* smem) {
  const int tid = otid();
  const int lane = tid & 63, w = tid >> 6;
  const int g = lane >> 3, ch = lane & 7;
  int x = (int)xcc_id(), j = 0, tries = 0;
  while (next_slice_item(p.wq + pass * 8, x, j, tries, smem, tid)) {
    const unsigned char* Vx = p.tabV8 + (size_t)x * NEXP * 128;
    const unsigned loff = ch * 16;
    const int tokb = j * I_TOK + w;
    I2Ctx c0, c1;
    I2XG xa, xb;
    uint4 rowsA[16], rowsB[16];
    i2_load_ctx(p, tokb, l, x, g, ch, c0);
    i2_load_ctx(p, tokb + 8, l, x, g, ch, c1);
    peer_issue_rows(Vx, loff, c0.e0, c0.e1, rowsA);
    i2_load_xg(p, tokb, l, x, g, ch, xa);
    i2_load_ctx(p, tokb + 8 * min(2, I_TW - 1), l, x, g, ch, c0);
#pragma unroll 1
    for (int i = 0; i < I_TW; i += 2) {
      __builtin_amdgcn_sched_barrier(0);
      peer_issue_rows(Vx, loff, c1.e0, c1.e1, rowsB);
      i2_load_xg(p, tokb + 8 * (i + 1), l, x, g, ch, xb);
      i2_load_ctx(p, tokb + 8 * min(i + 3, I_TW - 1), l, x, g, ch, c1);
      __builtin_amdgcn_sched_barrier(0);
      i2_compute(p, xa, rowsA, tokb + 8 * i, x, g, ch);
      __builtin_amdgcn_sched_barrier(0);
      peer_issue_rows(Vx, loff, c0.e0, c0.e1, rowsA);
      i2_load_xg(p, tokb + 8 * min(i + 2, I_TW - 1), l, x, g, ch, xa);
      i2_load_ctx(p, tokb + 8 * min(i + 4, I_TW - 1), l, x, g, ch, c0);
      __builtin_amdgcn_sched_barrier(0);
      i2_compute(p, xb, rowsB, tokb + 8 * (i + 1), x, g, ch);
      __builtin_amdgcn_sched_barrier(0);
    }
  }
}

constexpr int XB_XCNT = 256, XB_XSUB = 1024, XB_TOP = 2048, XB_GEN = 2112;
struct XBar { unsigned* w; unsigned xcc, nb, nx, epoch; };
__device__ __forceinline__ void xbar_setup(XBar& xb, unsigned* w) {
  xb.w = w; xb.xcc = xcc_id(); xb.epoch = 0;
  xb.nb = __hip_atomic_load(w + XB_XCNT + 64 * xb.xcc, __ATOMIC_RELAXED, __HIP_MEMORY_SCOPE_AGENT);
  unsigned nx = 0;
#pragma unroll
  for (int j = 0; j < 8; ++j) nx += (__hip_atomic_load(w + XB_XCNT + 64 * j, __ATOMIC_RELAXED, __HIP_MEMORY_SCOPE_AGENT) != 0u) ? 1u : 0u;
  xb.nx = nx;
}
__device__ __forceinline__ void grid_bar(XBar& xb) {
  ++xb.epoch;
  __syncthreads();
  if (threadIdx.x == 0) {
    const unsigned old = __hip_atomic_fetch_add(xb.w + XB_XSUB + 64 * xb.xcc, 1u, __ATOMIC_RELAXED, __HIP_MEMORY_SCOPE_AGENT);
    if (old + 1u == xb.epoch * xb.nb) {
      __builtin_amdgcn_fence(__ATOMIC_RELEASE, "agent");
      asm volatile("s_waitcnt vmcnt(0)" ::: "memory");
      const unsigned old2 = __hip_atomic_fetch_add(xb.w + XB_TOP, 1u, __ATOMIC_RELAXED, __HIP_MEMORY_SCOPE_AGENT);
      if (old2 + 1u == xb.epoch * xb.nx) __hip_atomic_store(xb.w + XB_GEN, xb.epoch, __ATOMIC_RELAXED, __HIP_MEMORY_SCOPE_AGENT);
    }
    while (__hip_atomic_load(xb.w + XB_GEN, __ATOMIC_RELAXED, __HIP_MEMORY_SCOPE_AGENT) < xb.epoch) __builtin_amdgcn_s_sleep(1);
    __builtin_amdgcn_fence(__ATOMIC_ACQUIRE, "agent");
    asm volatile("s_waitcnt vmcnt(0)" ::: "memory");
  }
  __syncthreads();
}

__global__ void __launch_bounds__(NTHR) mega_kernel(Params p) {
  extern __shared__ __attribute__((aligned(16))) char smem[];
  cg::grid_group grid = cg::this_grid();
  if (threadIdx.x == 0) __hip_atomic_fetch_add(p.wq + XB_XCNT + 64 * xcc_id(), 1u, __ATOMIC_RELAXED, __HIP_MEMORY_SCOPE_AGENT);
  phase_p0(p, smem);
  grid.sync();
  XBar xb;
  xbar_setup(xb, p.wq);
  for (int l = 0; l < 2; ++l) {
    for (int tile = blockIdx.x; tile < NTILE; tile += gridDim.x) phase_c(p, tile, l, l == 0, smem);
    grid_bar(xb);
    phase_de(p, l, smem);
    grid_bar(xb);
    for (int tile = blockIdx.x; tile < NTILE; tile += gridDim.x) {
      phase_f(p, tile, l, l == 0, smem);
      phase_g(p, tile, l, smem);
    }
    grid_bar(xb);
    phase_i1(p, 2 * l, smem);
    grid_bar(xb);
    phase_w(p);
    grid_bar(xb);
    phase_i2(p, l, 2 * l + 1, smem);
    if (l == 0) grid_bar(xb);
  }
}

extern "C" void kernel_launch(void* const* d_in, const int* in_sizes, int n_in, void* d_out, int out_size, void* d_ws,
                              size_t ws_size, hipStream_t stream) {
  Params p{};
  const float* const* in = (const float* const*)d_in;
  p.x_prompt = in[0]; p.x_sample = in[1]; p.c_prompt = in[2]; p.c_sample = in[3]; p.w_mod = in[4]; p.b_mod = in[5];
  p.g1 = in[6]; p.g2 = in[7]; p.w_in = in[8]; p.conv_w = in[9]; p.conv_b = in[10]; p.f_w1 = in[11]; p.f_b1 = in[12];
  p.f_freq = in[13]; p.f_w2 = in[14]; p.f_b2 = in[15]; p.f_w3 = in[16]; p.f_bias = in[17]; p.q_gain = in[18];
  p.k_gain = in[19]; p.sink = in[20]; p.w_pa = in[21]; p.w_pb = in[22]; p.w_out = in[23]; p.peer_wq = in[24];
  p.peer_k1 = in[25]; p.peer_k2 = in[26]; p.peer_u = in[27]; p.peer_v = in[28];
  p.out = (float*)d_out;
  char* ws = (char*)d_ws;
  size_t off = 0;
  auto carve = [&](size_t bytes) { char* r = ws + off; off += (bytes + 255) & ~(size_t)255; return r; };
  p.WinT = (bf16_t*)carve((size_t)2 * INC * DM * 2);
  p.WpaT = (bf16_t*)carve((size_t)2 * DM * HYW * 2);
  p.WpbT = (bf16_t*)carve((size_t)2 * DM * HYW * 2);
  p.WoutT = (bf16_t*)carve((size_t)2 * DM * DM * 2);
  p.WcT = (bf16_t*)carve((size_t)2 * 2048 * DM * 2);
  p.Gf = (bf16_t*)carve((size_t)2 * 2 * 512 * 4096 * 2);
  p.mod = (float*)carve((size_t)2 * NB * 6144 * 4);
  p.rope = (float*)carve((size_t)SEQ * 64 * 4);
  p.tabU8 = (unsigned char*)carve((size_t)NEXP * DM);
  p.tabV8 = (unsigned char*)carve((size_t)NEXP * DM);
  p.sclU = (float*)carve((size_t)NEXP * 4);
  p.sclV = (float*)carve((size_t)NEXP * 4);
  p.wq = (unsigned*)carve(16384);
  p.zT = (bf16_t*)carve((size_t)NB * HYC * SEQ * 2);
  p.yaT = (bf16_t*)carve((size_t)NTOK * HYW * 2);
  p.yb = (bf16_t*)carve((size_t)NTOK * HYW * 2);
  p.zqkv = (bf16_t*)carve((size_t)NTOK * QKVC * 2);
  p.hbuf = (bf16_t*)carve((size_t)NTOK * DM * 2);
  p.merged = p.zT;
  p.yatok = p.zT + (size_t)NTOK * DM;
  p.apart = p.zT;
  p.pidx = (unsigned short*)p.zqkv;
  p.pg = (float*)(p.zqkv + (size_t)NTOK * 128);
  p.pgu = p.pg + (size_t)NTOK * 128;
  p.wbuf = (bf16_t*)(p.pgu + (size_t)NTOK * 128);
  if (off > ws_size) fprintf(stderr, "workspace too small: need %zu have %zu\n", off, ws_size);

  static int grid_blocks = 0;
  if (!grid_blocks) {
    int dev = 0, cus = 0, per_cu = 0;
    hipGetDevice(&dev);
    hipDeviceGetAttribute(&cus, hipDeviceAttributeMultiprocessorCount, dev);
    hipFuncSetAttribute((const void*)mega_kernel, hipFuncAttributeMaxDynamicSharedMemorySize, SMEM_BYTES);
    hipOccupancyMaxActiveBlocksPerMultiprocessor(&per_cu, mega_kernel, NTHR, SMEM_BYTES);
    if (per_cu < 1) per_cu = 1;
    grid_blocks = cus * 1;
    if (grid_blocks > NTILE) grid_blocks = NTILE;
  }
  hipMemsetAsync(p.wq, 0, 16384, stream);
  void* args[] = {&p};
  hipError_t e = hipLaunchCooperativeKernel((const void*)mega_kernel, dim3(grid_blocks), dim3(NTHR), args, SMEM_BYTES, stream);
  if (e != hipSuccess) fprintf(stderr, "cooperative launch failed: %s (grid %d)\n", hipGetErrorString(e), grid_blocks);
}
```
